# Optimizing an MI355X kernel written in HIP

```python
import math
import jax, jax.numpy as jnp
from jax import lax
import numpy as np

D_MODEL = 1024
BATCH = 4
SEQ = 8192
DEPTH = 4

GRID_W = 64
CTX_LEN = 256
N_MIXERS = 3
N_HEADS = 8
HEAD_DIM = D_MODEL // (2 * N_HEADS)
V_DIM = 2 * HEAD_DIM
Q_BLOCK = 128
ROPE_BASE = 10000.0
CONV_WIDTH = 3
GROUP_SIZE = 16
N_GROUPS = D_MODEL // GROUP_SIZE
STATE_DIM = 64
DT_MIN = 1e-3
DT_MAX = 1e-1
D_FF = (D_MODEL * 11) // 4
N_EXPERTS = 8
TOP_K = 2
EPS = 1e-6

kernel_name = 'hybrid_conv_diffattn_s5_moe_prefix_dit'


def rmsnorm(x, g):
    xf = x.astype(jnp.float32)
    y = xf * lax.rsqrt(jnp.mean(xf * xf, axis=-1, keepdims=True) + EPS)
    return (y * g.astype(jnp.float32)).astype(x.dtype)


def adaln(cond, w, b):
    m = (jax.nn.silu(cond) @ w + b).reshape(cond.shape[0], 1, 6, D_MODEL)
    return [m[:, :, j] for j in range(6)]


def modulate(h, g, shift, scale):
    return rmsnorm(h, g) * (1.0 + scale) + shift


def axial_rope_tables(n):
    rows = n // GRID_W
    row = jnp.repeat(jnp.arange(rows, dtype=jnp.float32), GRID_W)
    col = jnp.tile(jnp.arange(GRID_W, dtype=jnp.float32), rows)
    n_freq = HEAD_DIM // 4
    inv = ROPE_BASE ** (-jnp.arange(n_freq, dtype=jnp.float32) / n_freq)
    ang = jnp.concatenate([row[:, None] * inv, col[:, None] * inv], axis=-1)
    return jnp.cos(ang), jnp.sin(ang)


def _rotate(x, cos, sin):
    x1, x2 = jnp.split(x, 2, axis=-1)
    return jnp.concatenate([x1 * cos - x2 * sin, x2 * cos + x1 * sin], axis=-1)


def axial_rope(x, cos, sin):
    f = HEAD_DIM // 4
    c = cos[:, None, None, :]
    s = sin[:, None, None, :]
    xr, xc = jnp.split(x.astype(jnp.float32), 2, axis=-1)
    out = jnp.concatenate([_rotate(xr, c[..., :f], s[..., :f]), _rotate(xc, c[..., f:], s[..., f:])], axis=-1)
    return out.astype(x.dtype)


def short_conv_mixer(h, w_in, w_conv, w_out):
    b_gate, c_gate, v = jnp.split(h @ w_in, 3, axis=-1)
    z = c_gate * v
    L = z.shape[1]
    zp = jnp.pad(z, ((0, 0), (1, 1), (0, 0)))
    y = w_conv[0] * zp[:, :L] + w_conv[1] * zp[:, 1:L + 1] + w_conv[2] * zp[:, 2:]
    return (b_gate * y) @ w_out


def diff_softmax_attend(q, k, v, lam, lam_init, subln):
    s = jnp.einsum('bqhmd,bkhmd->bhmqk', q, k).astype(jnp.float32) * (HEAD_DIM ** -0.5)
    p = jax.nn.softmax(s, axis=-1)
    a = p[:, :, 0] - lam * p[:, :, 1]
    o = jnp.einsum('bhqk,bkhe->bqhe', a, v.astype(jnp.float32))
    o = rmsnorm(o, subln) * (1.0 - lam_init)
    return o.reshape(o.shape[0], o.shape[1], N_HEADS * V_DIM)


def diff_attention_mixer(hc, hl, w_qkv, lam_vecs, subln, w_o, cos, sin, lam_init, need_ctx):
    B, L, _ = hl.shape
    Lc = hc.shape[1]
    lv = lam_vecs.astype(jnp.float32)
    lam = jnp.exp(jnp.sum(lv[0] * lv[1])) - jnp.exp(jnp.sum(lv[2] * lv[3])) + lam_init
    q_l, k_l, v_l = jnp.split(hl @ w_qkv, 3, axis=-1)
    q_l = axial_rope(q_l.reshape(B, L, N_HEADS, 2, HEAD_DIM), cos, sin)
    k_l = axial_rope(k_l.reshape(B, L, N_HEADS, 2, HEAD_DIM), cos, sin)
    v_l = v_l.reshape(B, L, N_HEADS, V_DIM)
    k_c, v_c = jnp.split(hc @ w_qkv[:, D_MODEL:], 2, axis=-1)
    k_c = k_c.reshape(B, Lc, N_HEADS, 2, HEAD_DIM)
    v_c = v_c.reshape(B, Lc, N_HEADS, V_DIM)
    k_all = jnp.concatenate([k_c, k_l], axis=1)
    v_all = jnp.concatenate([v_c, v_l], axis=1)
    n_blocks = L // Q_BLOCK
    q_blocks = q_l.reshape(B, n_blocks, Q_BLOCK, N_HEADS, 2, HEAD_DIM).swapaxes(0, 1)
    o_blocks = lax.map(lambda qb: diff_softmax_attend(qb, k_all, v_all, lam, lam_init, subln), q_blocks)
    y_l = o_blocks.swapaxes(0, 1).reshape(B, L, N_HEADS * V_DIM).astype(hl.dtype) @ w_o
    y_c = None
    if need_ctx:
        q_c = (hc @ w_qkv[:, :D_MODEL]).reshape(B, Lc, N_HEADS, 2, HEAD_DIM)
        y_c = diff_softmax_attend(q_c, k_c, v_c, lam, lam_init, subln).astype(hc.dtype) @ w_o
    return y_c, y_l


def s5_discretise(a_re, a_im, log_dt, b_re, b_im):
    f32 = jnp.float32
    a_re, a_im = a_re.astype(f32), a_im.astype(f32)
    b_re, b_im = b_re.astype(f32), b_im.astype(f32)
    dt = jnp.exp(log_dt.astype(f32))[:, None]
    mag = jnp.exp(dt * a_re)
    ab_re = mag * jnp.cos(dt * a_im)
    ab_im = mag * jnp.sin(dt * a_im)
    den = a_re * a_re + a_im * a_im
    nr = ab_re - 1.0
    co_re = (nr * a_re + ab_im * a_im) / den
    co_im = (ab_im * a_re - nr * a_im) / den
    bb_re = co_re[..., None] * b_re - co_im[..., None] * b_im
    bb_im = co_re[..., None] * b_im + co_im[..., None] * b_re
    return ab_re, ab_im, bb_re, bb_im


def _linear_recurrence_combine(e1, e2):
    a1r, a1i, b1r, b1i = e1
    a2r, a2i, b2r, b2i = e2
    return (a2r * a1r - a2i * a1i, a2r * a1i + a2i * a1r,
            a2r * b1r - a2i * b1i + b2r, a2r * b1i + a2i * b1r + b2i)


def s5_scan(u, disc, h0):
    ab_re, ab_im, bb_re, bb_im = disc
    bu_re = jnp.einsum('blgs,gps->blgp', u, bb_re)
    bu_im = jnp.einsum('blgs,gps->blgp', u, bb_im)
    if h0 is not None:
        h_re, h_im = h0
        bu_re = bu_re.at[:, 0].add(ab_re * h_re - ab_im * h_im)
        bu_im = bu_im.at[:, 0].add(ab_re * h_im + ab_im * h_re)
    L = u.shape[1]
    a_re = jnp.broadcast_to(ab_re, (L,) + ab_re.shape)
    a_im = jnp.broadcast_to(ab_im, (L,) + ab_im.shape)
    def scan_one(br, bi):
        out = lax.associative_scan(_linear_recurrence_combine, (a_re, a_im, br, bi), axis=0)
        return out[2], out[3]
    return jax.vmap(scan_one)(bu_re, bu_im)


def s5_readout(h_re, h_im, c_re, c_im):
    return jnp.einsum('blgp,gsp->blgs', h_re, c_re) - jnp.einsum('blgp,gsp->blgs', h_im, c_im)


def _flip(t, rev):
    return t[:, ::-1] if rev else t


def s5_mixer(hc, hl, a_re, a_im, log_dt, b_re, b_im, c_re, c_im, d_skip, w_glu, need_ctx):
    f32 = jnp.float32
    B, L, _ = hl.shape
    Lc = hc.shape[1]
    u_c = hc.astype(f32).reshape(B, Lc, N_GROUPS, GROUP_SIZE)
    u_l = hl.astype(f32).reshape(B, L, N_GROUPS, GROUP_SIZE)
    d = d_skip.astype(f32)
    y_l = d * hl.astype(f32)
    y_c = d * hc.astype(f32) if need_ctx else None
    for direction in range(2):
        rev = direction == 1
        disc = s5_discretise(a_re[direction], a_im[direction], log_dt[direction], b_re[direction], b_im[direction])
        cr = c_re[direction].astype(f32)
        ci = c_im[direction].astype(f32)
        sc_re, sc_im = s5_scan(_flip(u_c, rev), disc, None)
        sl_re, sl_im = s5_scan(_flip(u_l, rev), disc, (sc_re[:, -1], sc_im[:, -1]))
        y_l = y_l + _flip(s5_readout(sl_re, sl_im, cr, ci), rev).reshape(B, L, D_MODEL)
        if need_ctx:
            y_c = y_c + _flip(s5_readout(sc_re, sc_im, cr, ci), rev).reshape(B, Lc, D_MODEL)
    def glu(y, dtype):
        val, gate = jnp.split(jax.nn.gelu(y).astype(dtype) @ w_glu, 2, axis=-1)
        return val * jax.nn.sigmoid(gate)
    y_c_out = glu(y_c, hc.dtype) if need_ctx else None
    return y_c_out, glu(y_l, hl.dtype)


def swiglu(h, w_gu, w_down):
    g, u = jnp.split(h @ w_gu, 2, axis=-1)
    return (jax.nn.silu(g) * u) @ w_down


def moe_swiglu(h, w_router, w_gu, w_down):
    f32 = jnp.float32
    logits = (h @ w_router).astype(f32)
    top_v, top_i = lax.top_k(logits, TOP_K)
    top_w = jax.nn.softmax(top_v, axis=-1)
    gates = jnp.sum(jax.nn.one_hot(top_i, N_EXPERTS, dtype=f32) * top_w[..., None], axis=-2)
    out = jnp.zeros(h.shape, f32)
    for e in range(N_EXPERTS):
        out = out + gates[..., e:e + 1] * swiglu(h, w_gu[e], w_down[e])
    return out.astype(h.dtype)


def setup_inputs(seed: int = 0) -> dict:
    key = jax.random.key(seed)
    keys = iter(jax.random.split(key, 16 * DEPTH + 8))
    f32 = jnp.float32
    D = D_MODEL
    def nrm(shape, scale=1.0):
        return jax.random.normal(next(keys), shape, f32) * scale
    def gain(n):
        return 1.0 + nrm((n,), 0.02)
    inp = {'x': nrm((BATCH, SEQ, D)), 'c': nrm((BATCH, D)),
           'ctx': nrm((BATCH, CTX_LEN, D)), 'c_ctx': nrm((D,))}
    for i in range(DEPTH):
        p = 'l%d_' % i
        inp[p + 'ada_w'] = nrm((D, 6 * D), 0.5 * D ** -0.5)
        inp[p + 'ada_b'] = nrm((6 * D,), 0.02)
        inp[p + 'norm_mix'] = gain(D)
        inp[p + 'norm_ffn'] = gain(D)
        kind = i % N_MIXERS
        if kind == 0:
            inp[p + 'conv_w_in'] = nrm((D, 3 * D), D ** -0.5)
            inp[p + 'conv_w'] = nrm((CONV_WIDTH, D), CONV_WIDTH ** -0.5)
            inp[p + 'conv_w_out'] = nrm((D, D), D ** -0.5)
        elif kind == 1:
            inp[p + 'attn_w_qkv'] = nrm((D, 3 * D), D ** -0.5)
            inp[p + 'attn_lam'] = nrm((4, HEAD_DIM), 0.1)
            inp[p + 'attn_subln'] = gain(V_DIM)
            inp[p + 'attn_w_o'] = nrm((D, D), D ** -0.5)
        else:
            inp[p + 'ssm_a_re'] = -0.5 + nrm((2, N_GROUPS, STATE_DIM), 0.01)
            inp[p + 'ssm_a_im'] = math.pi * jnp.arange(STATE_DIM, dtype=f32) + nrm((2, N_GROUPS, STATE_DIM), 0.01)
            inp[p + 'ssm_log_dt'] = jax.random.uniform(next(keys), (2, N_GROUPS), f32, math.log(DT_MIN), math.log(DT_MAX))
            inp[p + 'ssm_b_re'] = nrm((2, N_GROUPS, STATE_DIM, GROUP_SIZE), (2 * GROUP_SIZE) ** -0.5)
            inp[p + 'ssm_b_im'] = nrm((2, N_GROUPS, STATE_DIM, GROUP_SIZE), (2 * GROUP_SIZE) ** -0.5)
            inp[p + 'ssm_c_re'] = nrm((2, N_GROUPS, GROUP_SIZE, STATE_DIM), STATE_DIM ** -0.5)
            inp[p + 'ssm_c_im'] = nrm((2, N_GROUPS, GROUP_SIZE, STATE_DIM), STATE_DIM ** -0.5)
            inp[p + 'ssm_d'] = nrm((D,))
            inp[p + 'ssm_w_glu'] = nrm((D, 2 * D), D ** -0.5)
        if i % 2 == 0:
            inp[p + 'ffn_w_gu'] = nrm((D, 2 * D_FF), D ** -0.5)
            inp[p + 'ffn_w_down'] = nrm((D_FF, D), D_FF ** -0.5)
        else:
            inp[p + 'moe_router'] = nrm((D, N_EXPERTS), D ** -0.5)
            inp[p + 'moe_w_gu'] = nrm((N_EXPERTS, D, 2 * D_FF), D ** -0.5)
            inp[p + 'moe_w_down'] = nrm((N_EXPERTS, D_FF, D), D_FF ** -0.5)
    inp['final_norm'] = gain(D)
    return inp


def reference(x, c, ctx, c_ctx,
              l0_ada_w, l0_ada_b, l0_norm_mix, l0_norm_ffn, l0_conv_w_in, l0_conv_w, l0_conv_w_out, l0_ffn_w_gu, l0_ffn_w_down,
              l1_ada_w, l1_ada_b, l1_norm_mix, l1_norm_ffn, l1_attn_w_qkv, l1_attn_lam, l1_attn_subln, l1_attn_w_o, l1_moe_router, l1_moe_w_gu, l1_moe_w_down,
              l2_ada_w, l2_ada_b, l2_norm_mix, l2_norm_ffn, l2_ssm_a_re, l2_ssm_a_im, l2_ssm_log_dt, l2_ssm_b_re, l2_ssm_b_im, l2_ssm_c_re, l2_ssm_c_im, l2_ssm_d, l2_ssm_w_glu, l2_ffn_w_gu, l2_ffn_w_down,
              l3_ada_w, l3_ada_b, l3_norm_mix, l3_norm_ffn, l3_conv_w_in, l3_conv_w, l3_conv_w_out, l3_moe_router, l3_moe_w_gu, l3_moe_w_down,
              final_norm):
    layers = [
        dict(ada=(l0_ada_w, l0_ada_b), norms=(l0_norm_mix, l0_norm_ffn),
             mixer=(l0_conv_w_in, l0_conv_w, l0_conv_w_out), ffn=(l0_ffn_w_gu, l0_ffn_w_down)),
        dict(ada=(l1_ada_w, l1_ada_b), norms=(l1_norm_mix, l1_norm_ffn),
             mixer=(l1_attn_w_qkv, l1_attn_lam, l1_attn_subln, l1_attn_w_o), ffn=(l1_moe_router, l1_moe_w_gu, l1_moe_w_down)),
        dict(ada=(l2_ada_w, l2_ada_b), norms=(l2_norm_mix, l2_norm_ffn),
             mixer=(l2_ssm_a_re, l2_ssm_a_im, l2_ssm_log_dt, l2_ssm_b_re, l2_ssm_b_im, l2_ssm_c_re, l2_ssm_c_im, l2_ssm_d, l2_ssm_w_glu),
             ffn=(l2_ffn_w_gu, l2_ffn_w_down)),
        dict(ada=(l3_ada_w, l3_ada_b), norms=(l3_norm_mix, l3_norm_ffn),
             mixer=(l3_conv_w_in, l3_conv_w, l3_conv_w_out), ffn=(l3_moe_router, l3_moe_w_gu, l3_moe_w_down)),
    ]
    n = x.shape[1]
    n_ctx = ctx.shape[1]
    cos, sin = axial_rope_tables(n)
    kinds = [i % N_MIXERS for i in range(DEPTH)]
    h_ctx = ctx
    for i in range(DEPTH):
        p = layers[i]
        kind = kinds[i]
        reads_ctx = kind != 0
        ctx_next = any(k != 0 for k in kinds[i + 1:])
        use_ctx = reads_ctx or ctx_next
        norm_mix, norm_ffn = p['norms']
        sh1, sc1, g1, sh2, sc2, g2 = adaln(c, *p['ada'])
        hl = modulate(x, norm_mix, sh1, sc1)
        hc = None
        if use_ctx:
            csh1, csc1, cg1, csh2, csc2, cg2 = adaln(c_ctx[None], *p['ada'])
            hc = modulate(h_ctx, norm_mix, csh1, csc1)
        if kind == 0:
            y_l = short_conv_mixer(hl, *p['mixer'])
            y_c = short_conv_mixer(hc, *p['mixer']) if ctx_next else None
        elif kind == 1:
            y_c, y_l = diff_attention_mixer(hc, hl, *p['mixer'], cos=cos, sin=sin,
                                            lam_init=0.8 - 0.6 * math.exp(-0.3 * i), need_ctx=ctx_next)
        else:
            y_c, y_l = s5_mixer(hc, hl, *p['mixer'], need_ctx=ctx_next)
        x = x + g1 * y_l
        if ctx_next:
            h_ctx = h_ctx + cg1 * y_c
        ffn = swiglu if i % 2 == 0 else moe_swiglu
        hl2 = modulate(x, norm_ffn, sh2, sc2)
        if ctx_next:
            hc2 = modulate(h_ctx, norm_ffn, csh2, csc2)
            out = ffn(jnp.concatenate([hc2, hl2], axis=1), *p['ffn'])
            h_ctx = h_ctx + cg2 * out[:, :n_ctx]
            x = x + g2 * out[:, n_ctx:]
        else:
            x = x + g2 * ffn(hl2, *p['ffn'])
    return rmsnorm(x, final_norm)
```

```cpp
#include <hip/hip_runtime.h>
#include <hip/hip_bf16.h>
#include <cstdio>
#include <cstdint>
#include <cmath>

#ifndef MK_SITEMASK
#define MK_SITEMASK 0xffffffffu
#endif
#ifndef MK_REPEAT_SITE
#define MK_REPEAT_SITE -1
#endif
#ifndef MK_DBG_NOMOE
#define MK_DBG_NOMOE 0
#endif
#ifndef MK_EXTRA_BARS
#define MK_EXTRA_BARS 0
#endif
#ifndef MK_FP8_FFN
#define MK_FP8_FFN 0x4
#endif
#ifndef MK_FP8_QKV
#define MK_FP8_QKV 1
#endif
#ifndef MK_FP8_GLU
#define MK_FP8_GLU 1
#endif
#ifndef MK_ATT_XMFMA
#define MK_ATT_XMFMA 0
#endif
#ifndef MK_ATT_XEXP
#define MK_ATT_XEXP 0
#endif
#ifndef MK_ATT3
#define MK_ATT3 1
#endif
#ifndef MK_XBF16
#define MK_XBF16 1
#endif
#ifndef MK_ATT2
#define MK_ATT2 1
#endif
#ifndef MK_ONE_LAUNCH
#define MK_ONE_LAUNCH 1
#endif

constexpr int DM = 1024, NB = 4, SEQ = 8192, CTXL = 256, RPB = CTXL + SEQ, MALL = NB * RPB;
constexpr int TPB = RPB / 256, NT_ALL = MALL / 256, NT_LAT = NB * SEQ / 256;
constexpr int DFF = 2816, NE = 8, NHEAD = 8;
constexpr float EPS = 1e-6f;
constexpr int NWAVES = 8, NTHREADS = 512;
constexpr int CPB = RPB / 16;
constexpr int MOE_MAXT = 272;

constexpr size_t MiB = 1u << 20;
constexpr size_t WS_CTL = 0, CTL_ZERO_BYTES = 64 * 1024;
constexpr size_t WS_MOD = 1 * MiB;
constexpr size_t WS_ROPE = WS_MOD + 512 * 1024;
constexpr size_t WS_SEL = 2 * MiB;
constexpr size_t WS_SLOT = WS_SEL + (size_t)MALL * 16;
constexpr size_t WS_CNT = WS_SLOT + (size_t)MALL * 8;
constexpr size_t WS_TEXP = WS_CNT + 1024 * 8 * 4;
constexpr size_t WS_S5M3 = 8 * MiB;
constexpr size_t WS_S5M1 = 24 * MiB;
constexpr size_t WS_W = 32 * MiB;
constexpr size_t WS_X = 357 * MiB;
constexpr size_t WS_HL = 489 * MiB;
constexpr size_t WS_BIG = 555 * MiB;
constexpr size_t WS_END = 879 * MiB;
static_assert(WS_TEXP + 4096 <= WS_S5M3, "ws map");
constexpr size_t BIG_BZ = 0, BIG_U = 132 * MiB;
constexpr size_t BIG_Q8 = 0, BIG_K8 = 33 * MiB, BIG_V8 = 66 * MiB, BIG_VT8 = 99 * MiB;
constexpr size_t BIG_QKV = 0, BIG_KH = 66 * MiB, BIG_VH = 132 * MiB, BIG_O0 = 198 * MiB;
constexpr size_t BIG_HID = 0;
constexpr size_t BIG_APERM = 0, BIG_MHID = 136 * MiB;
constexpr size_t BIG_H = 0, BIG_SBUF = 144 * MiB, BIG_YG = 210 * MiB;
static_assert(BIG_MHID + (size_t)MOE_MAXT * 256 * DFF <= WS_END - WS_BIG && BIG_YG + 66 * MiB <= WS_END - WS_BIG && BIG_O0 + 66 * MiB <= WS_END - WS_BIG, "big map");

constexpr size_t WSZ_CONVIN = (size_t)3072 * 1024 * 2, WSZ_SQ = (size_t)1024 * 1024 * 2, WSZ_GU = (size_t)5632 * 1024 * 2, WSZ_DOWN = (size_t)1024 * 2816 * 2, WSZ_GLU = (size_t)2048 * 1024 * 2;
constexpr size_t WO_L0_CONVIN = 0, WO_L0_CONVOUT = WO_L0_CONVIN + WSZ_CONVIN, WO_L0_GU = WO_L0_CONVOUT + WSZ_SQ, WO_L0_DOWN = WO_L0_GU + WSZ_GU;
constexpr size_t WO_L1_QKV = WO_L0_DOWN + WSZ_DOWN, WO_L1_WO = WO_L1_QKV + WSZ_CONVIN, WO_L1_MGU = WO_L1_WO + WSZ_SQ, WO_L1_MDOWN = WO_L1_MGU + 8 * WSZ_GU;
constexpr size_t WO_L2_GLU = WO_L1_MDOWN + 8 * WSZ_DOWN, WO_L2_GU = WO_L2_GLU + WSZ_GLU, WO_L2_DOWN = WO_L2_GU + WSZ_GU;
constexpr size_t WO_L3_CONVIN = WO_L2_DOWN + WSZ_DOWN, WO_L3_CONVOUT = WO_L3_CONVIN + WSZ_CONVIN, WO_L3_MGU = WO_L3_CONVOUT + WSZ_SQ, WO_L3_MDOWN = WO_L3_MGU + 8 * WSZ_GU;
constexpr size_t WO_END = WO_L3_MDOWN + 8 * WSZ_DOWN;
static_assert(WS_W + WO_END <= WS_X, "weights fit");

enum { IN_X = 0, IN_C = 1, IN_CTX = 2, IN_CCTX = 3, IN_FINAL = 49 };
__host__ __device__ constexpr int lbase(int L) { return L == 0 ? 4 : L == 1 ? 13 : L == 2 ? 24 : 39; }

#define LAS __attribute__((address_space(3)))
typedef unsigned short bf16_t;
typedef short bf16x8 __attribute__((ext_vector_type(8)));
typedef float f32x4 __attribute__((ext_vector_type(4)));
typedef float f32x2 __attribute__((ext_vector_type(2)));
typedef unsigned u32x4 __attribute__((ext_vector_type(4)));
typedef unsigned u32x2 __attribute__((ext_vector_type(2)));
#define LDS_WAIT() asm volatile("s_waitcnt lgkmcnt(0)" ::: "memory")
#define VM_WAIT() asm volatile("s_waitcnt vmcnt(0)" ::: "memory")
__device__ __forceinline__ unsigned cvt_pk_bf16(float lo, float hi) { unsigned r; asm volatile("v_cvt_pk_bf16_f32 %0, %1, %2" : "=v"(r) : "v"(lo), "v"(hi)); return r; }
__device__ __forceinline__ float clamp8(float v) { return __builtin_amdgcn_fmed3f(v, -448.f, 448.f); }
__device__ __forceinline__ unsigned cvt4_fp8(float a, float b, float c, float d) {
    unsigned w = 0; w = __builtin_amdgcn_cvt_pk_fp8_f32(clamp8(a), clamp8(b), w, false); w = __builtin_amdgcn_cvt_pk_fp8_f32(clamp8(c), clamp8(d), w, true); return w; }
__device__ __forceinline__ unsigned cvt4_fp8_nc(float a, float b, float c, float d) {
    unsigned w = 0; w = __builtin_amdgcn_cvt_pk_fp8_f32(a, b, w, false); w = __builtin_amdgcn_cvt_pk_fp8_f32(c, d, w, true); return w; }
__device__ __forceinline__ float bf_lo(unsigned w) { return __uint_as_float(w << 16); }
__device__ __forceinline__ float bf_hi(unsigned w) { return __uint_as_float(w & 0xffff0000u); }
#if MK_XBF16
typedef bf16_t xel_t;
__device__ __forceinline__ f32x4 x_ld4(const xel_t* p) { const u32x2 w = *(const u32x2*)p; return (f32x4){bf_lo(w.x), bf_hi(w.x), bf_lo(w.y), bf_hi(w.y)}; }
__device__ __forceinline__ void x_st4(xel_t* p, f32x4 v) { u32x2 w; w.x = cvt_pk_bf16(v[0], v[1]); w.y = cvt_pk_bf16(v[2], v[3]); *(u32x2*)p = w; }
#else
typedef float xel_t;
__device__ __forceinline__ f32x4 x_ld4(const xel_t* p) { return *(const f32x4*)p; }
__device__ __forceinline__ void x_st4(xel_t* p, f32x4 v) { *(f32x4*)p = v; }
#endif
__device__ __forceinline__ float row16_sum(float v) {
    v += __int_as_float(__builtin_amdgcn_mov_dpp(__float_as_int(v), 0xB1, 0xf, 0xf, true));
    v += __int_as_float(__builtin_amdgcn_mov_dpp(__float_as_int(v), 0x4E, 0xf, 0xf, true));
    v += __int_as_float(__builtin_amdgcn_mov_dpp(__float_as_int(v), 0x141, 0xf, 0xf, true));
    v += __int_as_float(__builtin_amdgcn_mov_dpp(__float_as_int(v), 0x140, 0xf, 0xf, true));
    return v;
}
__device__ __forceinline__ float wave_sum(float v) {
    v = row16_sum(v);
    const int vi = __float_as_int(v);
    const float a = __int_as_float(__builtin_amdgcn_readlane(vi, 0)), b = __int_as_float(__builtin_amdgcn_readlane(vi, 16)), c = __int_as_float(__builtin_amdgcn_readlane(vi, 32)), d = __int_as_float(__builtin_amdgcn_readlane(vi, 48));
    return (a + b) + (c + d);
}
__device__ __forceinline__ float fast_sigmoid(float x) { return __builtin_amdgcn_rcpf(1.0f + __builtin_amdgcn_exp2f(-1.4426950408889634f * x)); }
__device__ __forceinline__ float silu_f(float x) { return x * fast_sigmoid(x); }
__device__ __forceinline__ float gelu_tanh_f(float x) { const float u = 0.7978845608028654f * (x + 0.044715f * x * x * x); return x * fast_sigmoid(2.0f * u); }
__device__ __forceinline__ int row_cond(int row) { const int b = row / RPB; return (row - b * RPB) < CTXL ? 4 : b; }
__device__ __forceinline__ int tile_cond(int pm) { const int b = pm / TPB; return (pm - b * TPB) == 0 ? 4 : b; }

#define XB_TMO      128
#define XB_XCNT(j)  (256  + 64 * (j))
#define XB_XSUB(j)  (1280 + 64 * (j))
#define XB_XGEN(j)  (2304 + 64 * (j))
#define XB_TOP      3328
#define XB_TOPGEN   3392
#define XCD_BAR_WORDS 3456
#define XB_SPIN_CAP (1u << 18)
__device__ __forceinline__ unsigned xb_ld(unsigned* p)              { return __hip_atomic_load(p, __ATOMIC_RELAXED, __HIP_MEMORY_SCOPE_AGENT); }
__device__ __forceinline__ unsigned xb_add(unsigned* p, unsigned v) { return __hip_atomic_fetch_add(p, v, __ATOMIC_RELAXED, __HIP_MEMORY_SCOPE_AGENT); }
__device__ __forceinline__ unsigned xb_xcc_id() { return (unsigned)__builtin_amdgcn_s_getreg((3 << 11) | 20) & 0xFu; }
#define XB_SPIN(cond, bar) do { unsigned _sp = 0; while (cond) { __builtin_amdgcn_s_sleep(1); \
    if ((++_sp & 255u) == 0u) { if (xb_ld(&(bar)[XB_TMO])) break; if (_sp > XB_SPIN_CAP) { atomicAdd(&(bar)[XB_TMO], 1u); break; } } } } while (0)
struct XcdBarrier { unsigned* bar; unsigned x; volatile LAS unsigned* st; };
__device__ __forceinline__ XcdBarrier xcd_barrier_post(unsigned* bar, volatile LAS unsigned* st) {
    XcdBarrier b; b.bar = bar; b.x = xb_xcc_id(); b.st = st;
    if (threadIdx.x == 0) (void)xb_add(&bar[XB_XCNT(b.x)], 1u);
    return b;
}
__device__ __forceinline__ void xcd_barrier_complete(unsigned* bar, unsigned x, unsigned& nloc, unsigned& nx) {
    const unsigned G = gridDim.x * gridDim.y * gridDim.z;
    unsigned sum, cnt, mine, sp = 0u;
    for (;;) {
        sum = 0u; cnt = 0u; mine = 0u;
#pragma unroll
        for (unsigned j = 0; j < 16; ++j) { const unsigned c = xb_ld(&bar[XB_XCNT(j)]); sum += c; cnt += (c > 0u) ? 1u : 0u; mine = (j == x) ? c : mine; }
        if (sum == G) break;
        __builtin_amdgcn_s_sleep(1);
        if ((++sp & 255u) == 0u) { if (xb_ld(&bar[XB_TMO])) break; if (sp > XB_SPIN_CAP) { atomicAdd(&bar[XB_TMO], 1u); break; } }
    }
    nloc = mine > 0u ? mine : 1u; nx = cnt > 0u ? cnt : 1u;
}
__device__ __forceinline__ void xcd_barrier(const XcdBarrier& b) {
    asm volatile("s_waitcnt vmcnt(0)" ::: "memory");
    __syncthreads();
    if (threadIdx.x == 0) {
        unsigned* bar = b.bar;
        __builtin_amdgcn_s_waitcnt(0);
        unsigned nloc = b.st[0], nx = b.st[1];
        if (nloc == 0u) { xcd_barrier_complete(bar, b.x, nloc, nx); b.st[0] = nloc; b.st[1] = nx; }
        const unsigned old = xb_add(&bar[XB_XSUB(b.x)], 1u);
        const unsigned gen = old / nloc;
        if (old + 1u == (gen + 1u) * nloc) {
            __builtin_amdgcn_fence(__ATOMIC_RELEASE, "agent");
            asm volatile("s_waitcnt vmcnt(0)" ::: "memory");
            const unsigned og = xb_add(&bar[XB_TOP], 1u);
            const unsigned tg = og / nx;
            if (og + 1u == (tg + 1u) * nx) xb_add(&bar[XB_TOPGEN], 1u);
            else XB_SPIN(xb_ld(&bar[XB_TOPGEN]) == tg, bar);
            __builtin_amdgcn_fence(__ATOMIC_ACQUIRE, "agent");
            xb_add(&bar[XB_XGEN(b.x)], 1u);
            asm volatile("s_waitcnt vmcnt(0)" ::: "memory");
        } else {
            XB_SPIN(xb_ld(&bar[XB_XGEN(b.x)]) == gen, bar);
            __builtin_amdgcn_fence(__ATOMIC_ACQUIRE, "agent");
            asm volatile("s_waitcnt vmcnt(0)" ::: "memory");
        }
    }
    __syncthreads();
}

namespace pg8 {
constexpr int BM = 256, BK = 64, HALF = 128, HTB = HALF * BK * 2, STAGE_BYTES = 8 * HTB, NXCD = 8, WGM = 8;
__host__ __device__ __forceinline__ int lds_byte(int r, int c) { const int st = (r >> 4) * 2 + (c >> 5), rr = r & 15, cc = c & 31, ob = rr * 64 + cc * 2; return st * 1024 + (ob ^ (((ob >> 9) & 1) << 5)); }
__host__ __device__ __forceinline__ void stage_rc(int b, int& R, int& C) { const int st = b / 1024, sb = b % 1024, swz = sb ^ (((sb >> 9) & 1) << 5); R = (st >> 1) * 16 + swz / 64; C = (st & 1) * 32 + (swz % 64) / 2; }
__host__ __device__ __forceinline__ int perm32(int rho) { const int n = rho >> 4, i = rho & 15; return 8 * (i >> 2) + 4 * n + (i & 3); }
struct Unit { int pm, pn, aux; };
__device__ __forceinline__ void order_map(int L, int nM, int nN, int& tm, int& tn) {
    const int nwg = nM * nN; int wgid = L; { const int q = nwg / NXCD, r = nwg % NXCD, xcd = wgid % NXCD, off = wgid / NXCD; wgid = (xcd < r ? xcd * (q + 1) : r * (q + 1) + (xcd - r) * q) + off; }
    const int nig = WGM * nN, gid = wgid / nig, fm = gid * WGM, gsz = (nM - fm) < WGM ? (nM - fm) : WGM;
    tm = fm + ((wgid % nig) % gsz); tn = (wgid % nig) / gsz;
}

template <class Epi, class Prob, bool ALIGN_EPI, bool FP8 = false>
__device__ __forceinline__ void gemm_phase(LAS unsigned char* lds, const Prob& P, const Epi& E, const int tid) {
    const int wid = __builtin_amdgcn_readfirstlane(tid >> 6), lane = tid & 63, wr = wid >> 2, wc = wid & 3, fr = lane & 15, fq = lane >> 4;
    const int nt = P.nt;
    unsigned voffA[2], voffB[2];
#pragma unroll
    for (int i = 0; i < 2; ++i) { int R, C; stage_rc(tid * 16 + i * 8192, R, C); const int Rb = Epi::PERM ? ((R & ~31) + perm32(R & 31)) : R;
        voffA[i] = P.lane_off_a(R, C); voffB[i] = P.lane_off_b(Rb, C); }
    const size_t hsA = P.hstep_a(), hsB = P.hstep_b();
    const unsigned ldsw = (unsigned)wid * 1024u;
    const int aoff = lds_byte(wr * 64 + fr, fq * 8), boff = lds_byte(wc * 32 + fr, fq * 8);
#define PG8_SA(b, h) (((b) * 2 + (h)) * HTB)
#define PG8_SB(b, h) ((4 + (b) * 2 + (h)) * HTB)
#define PG8_STAGE(bufoff, gbase, voff) do { _Pragma("unroll") for (int _i = 0; _i < 2; ++_i) \
        __builtin_amdgcn_global_load_lds((const unsigned*)((const char*)(gbase) + (voff)[_i]), (LAS unsigned*)(lds + (bufoff) + ldsw + _i * 8192), 16, 0, 0); } while (0)
#define PG8_LDA(dst, b, h) do { _Pragma("unroll") for (int m = 0; m < 4; ++m) _Pragma("unroll") for (int k = 0; k < 2; ++k) dst[m][k] = *(const LAS bf16x8*)(lds + PG8_SA(b, h) + aoff + m * 2048 + k * 1024); } while (0)
#define PG8_LDB(dst, b, h) do { _Pragma("unroll") for (int n = 0; n < 2; ++n) _Pragma("unroll") for (int k = 0; k < 2; ++k) dst[n][k] = *(const LAS bf16x8*)(lds + PG8_SB(b, h) + boff + n * 2048 + k * 1024); } while (0)
#define PG8_MMA(ai, bj, At, Bt) do { __builtin_amdgcn_s_setprio(1); _Pragma("unroll") for (int m = 0; m < 4; ++m) _Pragma("unroll") for (int n = 0; n < 2; ++n) { \
        if constexpr (FP8) { typedef int v4i_ __attribute__((ext_vector_type(4))); typedef int v8i_ __attribute__((ext_vector_type(8))); \
            const v4i_ b0_ = __builtin_bit_cast(v4i_, Bt[n][0]), b1_ = __builtin_bit_cast(v4i_, Bt[n][1]), a0_ = __builtin_bit_cast(v4i_, At[m][0]), a1_ = __builtin_bit_cast(v4i_, At[m][1]); \
            const v8i_ bb_ = {b0_[0], b0_[1], b0_[2], b0_[3], b1_[0], b1_[1], b1_[2], b1_[3]}, aa_ = {a0_[0], a0_[1], a0_[2], a0_[3], a1_[0], a1_[1], a1_[2], a1_[3]}; \
              \
            asm volatile("v_mfma_scale_f32_16x16x128_f8f6f4 %0, %1, %2, %0, %3, %3 op_sel_hi:[0,0,0]" : "+v"(acc[ai][bj][m][n]) : "v"(bb_), "v"(aa_), "v"(0x7f7f7f7f)); } \
        else { _Pragma("unroll") for (int k = 0; k < 2; ++k) acc[ai][bj][m][n] = __builtin_amdgcn_mfma_f32_16x16x32_bf16(Bt[n][k], At[m][k], acc[ai][bj][m][n], 0, 0, 0); } } \
        __builtin_amdgcn_s_setprio(0); } while (0)
#define PG8_WAIT_V(n) asm volatile("s_waitcnt vmcnt(" #n ")" ::: "memory")
#define PG8_WAIT_L(n) asm volatile("s_waitcnt lgkmcnt(" #n ")" ::: "memory")
#define PG8_BAR __builtin_amdgcn_s_barrier()
#define PG8_SCHED __builtin_amdgcn_sched_barrier(0)
    Unit cur, nxt; int ui = 0;
    if (!P.next(0, cur)) return;
    f32x4 acc[2][2][4][2];
#pragma unroll
    for (int a = 0; a < 2; ++a)
#pragma unroll
        for (int b = 0; b < 2; ++b)
#pragma unroll
            for (int m = 0; m < 4; ++m)
#pragma unroll
                for (int n = 0; n < 2; ++n) acc[a][b][m][n] = (f32x4){0.f, 0.f, 0.f, 0.f};
    bf16x8 At[4][2], B0[2][2], B1[2][2];
    {
        const char* cA = P.a_ptr(cur, 0); const char* cB = P.b_ptr(cur, 0); const char* cA1 = P.a_ptr(cur, 1); const char* cB1 = P.b_ptr(cur, 1);
        PG8_STAGE(PG8_SB(0, 0), cB, voffB); PG8_STAGE(PG8_SB(0, 1), cB + hsB, voffB); PG8_STAGE(PG8_SA(0, 0), cA, voffA); PG8_STAGE(PG8_SA(0, 1), cA + hsA, voffA);
        if (wr == 1) PG8_BAR;
        PG8_WAIT_V(2); PG8_BAR;
        PG8_STAGE(PG8_SB(1, 0), cB1, voffB); PG8_STAGE(PG8_SA(1, 0), cA1, voffA); PG8_STAGE(PG8_SB(1, 1), cB1 + hsB, voffB);
        PG8_WAIT_V(6); PG8_BAR;
    }
    for (;;) {
        const bool has_next = P.next(ui + 1, nxt);
        const Unit nu = has_next ? nxt : cur;
        for (int t = 0; t < nt; t += 2) {
            const bool last = (t == nt - 2);
            const char* a1 = P.a_ptr(cur, t + 1);
            const char* a2 = last ? P.a_ptr(nu, 0) : P.a_ptr(cur, t + 2); const char* b2 = last ? P.b_ptr(nu, 0) : P.b_ptr(cur, t + 2);
            const char* a3 = last ? P.a_ptr(nu, 1) : P.a_ptr(cur, t + 3); const char* b3 = last ? P.b_ptr(nu, 1) : P.b_ptr(cur, t + 3);
            PG8_LDB(B0, 0, 0); PG8_LDB(B1, 0, 1); PG8_SCHED; PG8_LDA(At, 0, 0); PG8_STAGE(PG8_SA(1, 1), a1 + hsA, voffA);
            PG8_WAIT_V(8); PG8_WAIT_L(0); PG8_BAR; PG8_MMA(0, 0, At, B0); PG8_MMA(0, 1, At, B1); PG8_BAR; PG8_SCHED;
            PG8_LDA(At, 0, 1); PG8_STAGE(PG8_SB(0, 0), b2, voffB); PG8_STAGE(PG8_SB(0, 1), b2 + hsB, voffB); PG8_STAGE(PG8_SA(0, 0), a2, voffA);
            PG8_WAIT_V(8); PG8_WAIT_L(0); PG8_BAR; PG8_MMA(1, 0, At, B0); PG8_MMA(1, 1, At, B1); PG8_BAR; PG8_SCHED;
            PG8_LDB(B0, 1, 0); PG8_LDB(B1, 1, 1); PG8_SCHED; PG8_LDA(At, 1, 0); PG8_STAGE(PG8_SA(0, 1), a2 + hsA, voffA);
            PG8_WAIT_V(8); PG8_WAIT_L(0); PG8_BAR; PG8_MMA(0, 0, At, B0); PG8_MMA(0, 1, At, B1); PG8_BAR; PG8_SCHED;
            PG8_LDA(At, 1, 1); PG8_STAGE(PG8_SB(1, 0), b3, voffB); PG8_STAGE(PG8_SB(1, 1), b3 + hsB, voffB); PG8_STAGE(PG8_SA(1, 0), a3, voffA);
            PG8_WAIT_V(8); PG8_WAIT_L(0); PG8_BAR; PG8_MMA(1, 0, At, B0); PG8_MMA(1, 1, At, B1); PG8_BAR; PG8_SCHED;
        }
        if constexpr (ALIGN_EPI) { if (wr == 0) PG8_BAR; }
        if constexpr (FP8) { asm volatile("s_nop 15\n\ts_nop 15" ::: "memory");
#pragma unroll
            for (int a_ = 0; a_ < 2; ++a_)
#pragma unroll
                for (int b_ = 0; b_ < 2; ++b_)
#pragma unroll
                    for (int m_ = 0; m_ < 4; ++m_) asm volatile("" : "+v"(acc[a_][b_][m_][0]), "+v"(acc[a_][b_][m_][1])); }
        { int l_e; asm volatile("v_mbcnt_lo_u32_b32 %0, -1, 0\n\tv_mbcnt_hi_u32_b32 %0, -1, %0" : "=v"(l_e)); E(acc, cur, wr, wc, l_e & 15, l_e >> 4); }
        if (!has_next) break;
#pragma unroll
        for (int a = 0; a < 2; ++a)
#pragma unroll
            for (int b = 0; b < 2; ++b)
#pragma unroll
                for (int m = 0; m < 4; ++m)
#pragma unroll
                    for (int n = 0; n < 2; ++n) acc[a][b][m][n] = (f32x4){0.f, 0.f, 0.f, 0.f};
        cur = nxt; ++ui;
        if constexpr (ALIGN_EPI) { if (wr == 1) PG8_BAR; }
    }
    PG8_WAIT_V(0);
    if constexpr (!ALIGN_EPI) { if (wr == 0) PG8_BAR; }
    PG8_BAR;
#undef PG8_SA
#undef PG8_SB
#undef PG8_STAGE
#undef PG8_LDA
#undef PG8_LDB
#undef PG8_MMA
#undef PG8_WAIT_V
#undef PG8_WAIT_L
#undef PG8_BAR
#undef PG8_SCHED
}

struct ProbPlain {
    const char* A; const char* Bt; int lda_b, ldb_b, nt, nM, nN, G, c; bool latent;
    __device__ __forceinline__ bool next(int i, Unit& u) const {
        const long L = (long)i * G + c; if (L >= (long)nM * nN) return false;
        int tm, tn; order_map((int)L, nM, nN, tm, tn); u.pm = latent ? tm + (tm >> 5) + 1 : tm; u.pn = tn; u.aux = 0; return true; }
    __device__ __forceinline__ const char* a_ptr(const Unit& u, int kt) const { return A + (size_t)u.pm * 256 * lda_b + (size_t)kt * 128; }
    __device__ __forceinline__ const char* b_ptr(const Unit& u, int kt) const { return Bt + (size_t)u.pn * 256 * ldb_b + (size_t)kt * 128; }
    __device__ __forceinline__ size_t hstep_a() const { return (size_t)128 * lda_b; }
    __device__ __forceinline__ size_t hstep_b() const { return (size_t)128 * ldb_b; }
    __device__ __forceinline__ unsigned lane_off_a(int R, int C) const { return (unsigned)(R * lda_b + C * 2); }
    __device__ __forceinline__ unsigned lane_off_b(int R, int C) const { return (unsigned)(R * ldb_b + C * 2); }
};
struct ProbMoe {
    const char* A; const char* Bt; int lda_b, ldb_b, nt, nN, G, c; size_t bstride_e; const int* texp; int tile0, ntile, a_rel;
    __device__ __forceinline__ bool next(int i, Unit& u) const {
        const long L = (long)i * G + c; if (L >= (long)ntile * nN) return false;
        int tm, tn; order_map((int)L, ntile, nN, tm, tn); u.pm = tile0 + tm; u.pn = tn; u.aux = __builtin_amdgcn_readfirstlane(texp[u.pm]); return true; }
    __device__ __forceinline__ const char* a_ptr(const Unit& u, int kt) const { return A + (size_t)(u.pm - a_rel) * 256 * lda_b + (size_t)kt * 128; }
    __device__ __forceinline__ const char* b_ptr(const Unit& u, int kt) const { return Bt + (size_t)u.aux * bstride_e + (size_t)u.pn * 256 * ldb_b + (size_t)kt * 128; }
    __device__ __forceinline__ size_t hstep_a() const { return (size_t)128 * lda_b; }
    __device__ __forceinline__ size_t hstep_b() const { return (size_t)128 * ldb_b; }
    __device__ __forceinline__ unsigned lane_off_a(int R, int C) const { return (unsigned)(R * lda_b + C * 2); }
    __device__ __forceinline__ unsigned lane_off_b(int R, int C) const { return (unsigned)(R * ldb_b + C * 2); }
};
struct ProbS5 {
    const char* A0; const char* A1; const char* Bt; int nt, nt0, ntile, G, c; size_t bstride_g; bool s3;
    __device__ __forceinline__ bool next(int i, Unit& u) const {
        const int vcu = (G % 8 == 0) ? (c % 8) * (G / 8) + c / 8 : c;
        const long L = (long)i * G + vcu; if (L >= (long)ntile * 64) return false;
        u.pm = (int)(L >> 6); u.pn = (int)(L & 63); u.aux = 0; return true; }
    __device__ __forceinline__ size_t tokbase(int pm) const { return s3 ? (size_t)(pm >> 1) * RPB + CTXL + (size_t)(pm & 1) * 4096 : (size_t)pm * 4096; }
    __device__ __forceinline__ const char* a_ptr(const Unit& u, int kt) const { return (kt < nt0 ? A0 + (size_t)kt * 8192 : A1 + (size_t)(kt - nt0) * 8192) + tokbase(u.pm) * 2048 + (size_t)u.pn * 32; }
    __device__ __forceinline__ const char* b_ptr(const Unit& u, int kt) const { return Bt + (size_t)u.pn * bstride_g + (size_t)kt * 128; }
    __device__ __forceinline__ size_t hstep_a() const { return (size_t)128 * 16 * 2048; }
    __device__ __forceinline__ size_t hstep_b() const { return (size_t)128 * nt * 128; }
    __device__ __forceinline__ unsigned lane_off_a(int R, int C) const { return (unsigned)(R * 32768 + (C >> 4) * 2048 + (C & 15) * 2); }
    __device__ __forceinline__ unsigned lane_off_b(int R, int C) const { return (unsigned)(R * nt * 128 + C * 2); }
};

typedef f32x4 Acc[2][2][4][2];
constexpr float W8SCALE = 64.f, W8INV = 1.f / 64.f;
constexpr float QSCALE = 0.125f * 1.4426950408889634f;
__device__ __forceinline__ u32x4 pack8(f32x4 v0, f32x4 v1) { u32x4 w; w.x = cvt_pk_bf16(v0[0], v0[1]); w.y = cvt_pk_bf16(v0[2], v0[3]); w.z = cvt_pk_bf16(v1[0], v1[1]); w.w = cvt_pk_bf16(v1[2], v1[3]); return w; }

struct EpiBf16 {
    static constexpr bool PERM = true;
    bf16_t* O; int ldc; int pm_sub; float s;
    __device__ __forceinline__ void operator()(const Acc& acc, const Unit& u, int wr, int wc, int fr, int fq) const {
        const int row0 = (u.pm - pm_sub) * BM + wr * 64 + fr, col0 = u.pn * BM + wc * 32 + 8 * fq;
#pragma unroll
        for (int ai = 0; ai < 2; ++ai)
#pragma unroll
            for (int m = 0; m < 4; ++m) { bf16_t* rowp = O + (size_t)(row0 + ai * HALF + m * 16) * ldc + col0;
#pragma unroll
                for (int bj = 0; bj < 2; ++bj) *(u32x4*)(rowp + bj * HALF) = pack8(acc[ai][bj][m][0] * s, acc[ai][bj][m][1] * s); }
    }
};
template <int ACT> struct EpiGated {
    static constexpr bool PERM = true;
    bf16_t* O; int ldc; int pn0; int col_base; int pm_sub;
    __device__ __forceinline__ void operator()(const Acc& acc, const Unit& u, int wr, int wc, int fr, int fq) const {
        const int row0 = (u.pm - pm_sub) * BM + wr * 64 + fr;
        if (u.pn < pn0) {
            const int col0 = u.pn * BM + wc * 32 + 8 * fq;
#pragma unroll
            for (int ai = 0; ai < 2; ++ai)
#pragma unroll
                for (int m = 0; m < 4; ++m) { bf16_t* rowp = O + (size_t)(row0 + ai * HALF + m * 16) * ldc + col0;
#pragma unroll
                    for (int bj = 0; bj < 2; ++bj) *(u32x4*)(rowp + bj * HALF) = pack8(acc[ai][bj][m][0], acc[ai][bj][m][1]); }
        } else {
            const int col0 = col_base + (u.pn - pn0) * HALF + wc * 32 + 8 * fq;
#pragma unroll
            for (int ai = 0; ai < 2; ++ai)
#pragma unroll
                for (int m = 0; m < 4; ++m) { bf16_t* rowp = O + (size_t)(row0 + ai * HALF + m * 16) * ldc + col0;
                    f32x4 a0 = acc[ai][0][m][0], a1 = acc[ai][0][m][1];
                    if (ACT == 1) {
#pragma unroll
                        for (int e = 0; e < 4; ++e) { a0[e] = silu_f(a0[e]); a1[e] = silu_f(a1[e]); } }
                    *(u32x4*)rowp = pack8(a0 * acc[ai][1][m][0], a1 * acc[ai][1][m][1]); }
        }
    }
};
struct EpiGated8 {
    static constexpr bool PERM = true;
    unsigned char* O; int ldc; float s;
    __device__ __forceinline__ void operator()(const Acc& acc, const Unit& u, int wr, int wc, int fr, int fq) const {
        const int row0 = u.pm * BM + wr * 64 + fr, col0 = u.pn * HALF + wc * 32 + 8 * fq;
#pragma unroll
        for (int ai = 0; ai < 2; ++ai)
#pragma unroll
            for (int m = 0; m < 4; ++m) { unsigned char* rowp = O + (size_t)(row0 + ai * HALF + m * 16) * ldc + col0;
                f32x4 a0 = acc[ai][0][m][0] * s, a1 = acc[ai][0][m][1] * s; const f32x4 b0 = acc[ai][1][m][0] * s, b1 = acc[ai][1][m][1] * s;
#pragma unroll
                for (int e = 0; e < 4; ++e) { a0[e] = silu_f(a0[e]) * b0[e]; a1[e] = silu_f(a1[e]) * b1[e]; }
                u32x2 w; w.x = cvt4_fp8(a0[0], a0[1], a0[2], a0[3]); w.y = cvt4_fp8(a1[0], a1[1], a1[2], a1[3]);
                *(u32x2*)rowp = w; }
    }
};
struct EpiResid {
    static constexpr bool PERM = false;
    xel_t* X; const float* gate;
    const float* xin; const float* cin;
    float s;
    __device__ __forceinline__ void operator()(const Acc& acc, const Unit& u, int wr, int wc, int fr, int fq) const {
        const int row0 = u.pm * BM + wr * 64 + fr, col0 = u.pn * BM + wc * 32 + 4 * fq;
        const float* gp = gate + tile_cond(u.pm) * 6144 + col0;
        const int bq = u.pm / TPB, tq = u.pm - bq * TPB;
        const float* srcin = xin ? (tq == 0 ? cin + (size_t)bq * CTXL * DM : xin + ((size_t)bq * SEQ + (size_t)(tq - 1) * 256) * DM) - (size_t)u.pm * BM * DM : nullptr;
        f32x4 gv[2][2];
#pragma unroll
        for (int bj = 0; bj < 2; ++bj)
#pragma unroll
            for (int n = 0; n < 2; ++n) gv[bj][n] = *(const f32x4*)(gp + bj * HALF + n * 16);
#pragma unroll
        for (int ai = 0; ai < 2; ++ai)
#pragma unroll
            for (int m = 0; m < 4; ++m) { const size_t off = (size_t)(row0 + ai * HALF + m * 16) * DM + col0;
#pragma unroll
                for (int bj = 0; bj < 2; ++bj)
#pragma unroll
                    for (int n = 0; n < 2; ++n) { const size_t o2 = off + bj * HALF + n * 16; const f32x4 xv = srcin ? *(const f32x4*)(srcin + o2) : x_ld4(X + o2); x_st4(X + o2, xv + gv[bj][n] * (acc[ai][bj][m][n] * s)); }
                if (m & 1) asm volatile("" ::: "memory"); }
    }
};
struct EpiGlu {
    static constexpr bool PERM = false;
    xel_t* X; const float* gate; float s;
    __device__ __forceinline__ void operator()(const Acc& acc, const Unit& u, int wr, int wc, int fr, int fq) const {
        const int row0 = u.pm * BM + wr * 64 + fr, col0 = u.pn * HALF + wc * 32 + 4 * fq;
        const float* gp = gate + tile_cond(u.pm) * 6144 + col0;
        f32x4 gv[2];
#pragma unroll
        for (int n = 0; n < 2; ++n) gv[n] = *(const f32x4*)(gp + n * 16);
#pragma unroll
        for (int ai = 0; ai < 2; ++ai)
#pragma unroll
            for (int m = 0; m < 4; ++m) { xel_t* rowp = X + (size_t)(row0 + ai * HALF + m * 16) * DM + col0;
#pragma unroll
                for (int n = 0; n < 2; ++n) { f32x4 sg = acc[ai][1][m][n] * s;
#pragma unroll
                    for (int e = 0; e < 4; ++e) sg[e] = fast_sigmoid(sg[e]);
                    xel_t* p = rowp + n * 16; x_st4(p, x_ld4(p) + gv[n] * ((acc[ai][0][m][n] * s) * sg)); }
                if (m & 1) asm volatile("" ::: "memory"); }
    }
};
template <bool OUT8, bool W8> struct EpiQkv {
    static constexpr bool PERM = true;
    unsigned char* big; const float* cosT;
    __device__ __forceinline__ void operator()(const Acc& acc, const Unit& u, int wr, int wc, int fr, int fq) const {
        const float s = W8 ? W8INV : 1.f; const float* sinT = cosT + 128 * 16;
        const int row0 = u.pm * BM + wr * 64 + fr;
        const int bq = u.pm / TPB, tq = u.pm - bq * TPB;
        const bool rope = (u.pn < 8) && (tq != 0);
        const int sect = u.pn >> 2;
        const int cs0 = (u.pn & 3) * BM + wc * 32 + 8 * fq;
#pragma unroll
        for (int ai = 0; ai < 2; ++ai)
#pragma unroll
            for (int m = 0; m < 4; ++m) { const int row = row0 + ai * HALF + m * 16; const int j = row - bq * RPB;
                f32x4 c4 = (f32x4){1.f, 1.f, 1.f, 1.f}, s4 = (f32x4){0.f, 0.f, 0.f, 0.f};
                if (rope) { const int t = j - CTXL; const int pos = (wc & 1) ? (t & 63) : (t >> 6);
                    c4 = *(const f32x4*)(cosT + pos * 16 + 4 * fq); s4 = *(const f32x4*)(sinT + pos * 16 + 4 * fq); }
#pragma unroll
                for (int bj = 0; bj < 2; ++bj) { const f32x4 v0 = acc[ai][bj][m][0] * s, v1 = acc[ai][bj][m][1] * s; f32x4 o0, o1;
                    o0[0] = v0[0] * c4[0] - v0[1] * s4[0]; o0[1] = v0[1] * c4[0] + v0[0] * s4[0];
                    o0[2] = v0[2] * c4[1] - v0[3] * s4[1]; o0[3] = v0[3] * c4[1] + v0[2] * s4[1];
                    o1[0] = v1[0] * c4[2] - v1[1] * s4[2]; o1[1] = v1[1] * c4[2] + v1[0] * s4[2];
                    o1[2] = v1[2] * c4[3] - v1[3] * s4[3]; o1[3] = v1[3] * c4[3] + v1[2] * s4[3];
                    const int cs = cs0 + bj * HALF;
                    if constexpr (OUT8) {
                        size_t off8; float sc8 = 1.f;
                        if (sect == 0) { sc8 = QSCALE * 16.f; off8 = BIG_Q8 + (size_t)row * DM + cs; }
                        else if (sect == 1) off8 = BIG_K8 + ((size_t)(bq * 16 + (cs >> 6)) * RPB + j) * 64 + (cs & 63);
                        else off8 = BIG_V8 + ((size_t)(bq * 8 + (cs >> 7)) * RPB + j) * 128 + (cs & 127);
                        u32x2 w8; w8.x = cvt4_fp8(o0[0] * sc8, o0[1] * sc8, o0[2] * sc8, o0[3] * sc8); w8.y = cvt4_fp8(o1[0] * sc8, o1[1] * sc8, o1[2] * sc8, o1[3] * sc8);
                        *(u32x2*)(big + off8) = w8;
                    } else { size_t offb;
                        if (sect == 0) { o0 = o0 * QSCALE; o1 = o1 * QSCALE; offb = BIG_QKV + ((size_t)row * DM + cs) * 2; }
                        else if (sect == 1) offb = BIG_KH + (((size_t)(bq * 16 + (cs >> 6)) * RPB + j) * 64 + (cs & 63)) * 2;
                        else offb = BIG_VH + (((size_t)(bq * 8 + (cs >> 7)) * RPB + j) * 128 + (cs & 127)) * 2;
                        *(u32x4*)(big + offb) = pack8(o0, o1); } } }
    }
};
struct EpiS1 {
    static constexpr bool PERM = false;
    float* H;
    __device__ __forceinline__ void operator()(const Acc& acc, const Unit& u, int wr, int wc, int fr, int fq) const {
        const int row0 = u.pm * BM + wr * 64 + fr, col0 = wc * 32 + 4 * fq;
#pragma unroll
        for (int ai = 0; ai < 2; ++ai)
#pragma unroll
            for (int m = 0; m < 4; ++m) { float* rowp = H + ((size_t)(row0 + ai * HALF + m * 16) * 64 + u.pn) * 256 + col0;
#pragma unroll
                for (int bj = 0; bj < 2; ++bj)
#pragma unroll
                    for (int n = 0; n < 2; ++n) *(f32x4*)(rowp + bj * HALF + n * 16) = acc[ai][bj][m][n]; }
    }
};
struct EpiS3 {
    static constexpr bool PERM = true;
    bf16_t* YG; bool out8;
    __device__ __forceinline__ void operator()(const Acc& acc, const Unit& u, int wr, int wc, int fr, int fq) const {
        const size_t tb = (size_t)(u.pm >> 1) * RPB + CTXL + (size_t)(u.pm & 1) * 4096;
        const int r0 = wr * 64 + fr;
#pragma unroll
        for (int ai = 0; ai < 2; ++ai)
#pragma unroll
            for (int m = 0; m < 4; ++m) { const int R = r0 + ai * HALF + m * 16;
#pragma unroll
                for (int bj = 0; bj < 2; ++bj) { const int t = 8 * bj + 2 * wc + (fq >> 1), s0 = 8 * (fq & 1);
                    f32x4 v0 = acc[ai][bj][m][0], v1 = acc[ai][bj][m][1];
#pragma unroll
                    for (int e = 0; e < 4; ++e) { v0[e] = gelu_tanh_f(v0[e]); v1[e] = gelu_tanh_f(v1[e]); }
                    const size_t eoff = (tb + (size_t)R * 16 + t) * DM + u.pn * 16 + s0;
                    if (out8) { u32x2 w; w.x = cvt4_fp8(v0[0], v0[1], v0[2], v0[3]); w.y = cvt4_fp8(v1[0], v1[1], v1[2], v1[3]); *(u32x2*)((unsigned char*)YG + eoff) = w; }
                    else *(u32x4*)(YG + eoff) = pack8(v0, v1); } }
    }
};
}

namespace att {
using bf16x8 = __attribute__((ext_vector_type(8))) short;
using s16x4  = __attribute__((ext_vector_type(4))) short;
using f32x16 = __attribute__((ext_vector_type(16))) float;
constexpr int NW = 8, QBLK = 32, KVBLK = 64;
constexpr float SCALE = 0.125f, THR = 8.f;
constexpr int KROW = 144;
constexpr int SHM_V = KVBLK * 128 * 2, SHM_K = KVBLK * KROW;
constexpr int OFF_V = 0, OFF_K = 2 * SHM_V, OFF_WS = OFF_K + 2 * SHM_K, OFF_OST = OFF_WS + NW * 64 * 4, ATT_LDS = OFF_OST + NW * 8192;
constexpr int LDQ = 3072;
#define SBAR() __builtin_amdgcn_sched_barrier(0)
__device__ __forceinline__ int crow(int r, int hi) { return (r & 3) + 8 * (r >> 2) + 4 * hi; }
__device__ __forceinline__ void partialSM(f32x16& p0, f32x16& p1, float& m_reg, float& mn, float& alpha) {
  constexpr float C = SCALE * 1.4426950408889634f;
  float pmax = p0[0];
#pragma unroll
  for (int r = 1; r < 16; ++r) pmax = fmaxf(pmax, p0[r]);
#pragma unroll
  for (int r = 0; r < 16; ++r) pmax = fmaxf(pmax, p1[r]);
  { auto rr = __builtin_amdgcn_permlane32_swap(__float_as_uint(pmax), __float_as_uint(pmax), false, false);
    pmax = fmaxf(__uint_as_float(rr[0]), __uint_as_float(rr[1])); }
  if (__builtin_expect(__all(pmax - m_reg <= THR / SCALE), 1)) { mn = m_reg; alpha = 1.f; }
  else { mn = fmaxf(m_reg, pmax); alpha = __builtin_amdgcn_exp2f((m_reg - mn) * C); m_reg = mn; }
  float mnC = -mn * C;
#pragma unroll
  for (int r = 0; r < 16; ++r) p0[r] = fmaf(p0[r], C, mnC);
#pragma unroll
  for (int r = 0; r < 16; ++r) p1[r] = fmaf(p1[r], C, mnC);
#pragma unroll
  for (int r = 0; r < 16; ++r) p0[r] = __builtin_amdgcn_exp2f(p0[r]);
}
__device__ __forceinline__ void finishSM(f32x16& p0, f32x16& p1, float alpha, float& l_reg, bf16x8& pa0, bf16x8& pa1, bf16x8& pa2, bf16x8& pa3) {
#pragma unroll
  for (int r = 0; r < 16; ++r) p1[r] = __builtin_amdgcn_exp2f(p1[r]);
  float ps = 0;
#pragma unroll
  for (int r = 0; r < 16; ++r) ps += p0[r];
#pragma unroll
  for (int r = 0; r < 16; ++r) ps += p1[r];
  { auto rr = __builtin_amdgcn_permlane32_swap(__float_as_uint(ps), __float_as_uint(ps), false, false);
    ps = __uint_as_float(rr[0]) + __uint_as_float(rr[1]); }
  l_reg = l_reg * alpha + ps;
#define PK4(P, BASE, OUT) do { u32x4 w = {cvt_pk_bf16(P[BASE + 0], P[BASE + 1]), cvt_pk_bf16(P[BASE + 2], P[BASE + 3]), cvt_pk_bf16(P[BASE + 4], P[BASE + 5]), cvt_pk_bf16(P[BASE + 6], P[BASE + 7])}; \
    OUT = *reinterpret_cast<bf16x8*>(&w); } while (0)
  PK4(p0, 0, pa0); PK4(p0, 8, pa1); PK4(p1, 0, pa2); PK4(p1, 8, pa3);
#undef PK4
}
__device__ __forceinline__ void qkt(f32x16& p0, f32x16& p1, const char* Ks, const bf16x8* qr, int r32, int hi) {
  p0 = f32x16{}; p1 = f32x16{};
#pragma unroll
  for (int d0 = 0; d0 < 4; ++d0) { const int cb = (d0 * 16 + hi * 8) * 2;
    bf16x8 b0 = *reinterpret_cast<const bf16x8*>(Ks + r32 * KROW + cb);
    bf16x8 b1 = *reinterpret_cast<const bf16x8*>(Ks + (32 + r32) * KROW + cb);
    p0 = __builtin_amdgcn_mfma_f32_32x32x16_bf16(b0, qr[d0], p0, 0, 0, 0);
    p1 = __builtin_amdgcn_mfma_f32_32x32x16_bf16(b1, qr[d0], p1, 0, 0, 0); }
}
__device__ __forceinline__ int v_st(int k, int c) { const int kk = k; return ((kk >> 3) * 4 + (c >> 5)) * 512 + ((kk & 7) * 32 + (c & 31)) * 2; }
__device__ __forceinline__ int v_rd_base(int lane) { return ((lane & 3) << 3) | (((lane >> 2) & 3) << 6) | (((lane >> 4) & 1) << 5) | (((lane >> 5) & 1) << 8); }
constexpr int v_rd_off(int d0, int ks, int half) { return d0 * 512 + ks * 4096 + half * 2048; }
template <int OFF> __device__ __forceinline__ s16x4 tr_read(int vb) {
  s16x4 r; asm volatile("ds_read_b64_tr_b16 %0, %1 offset:%2" : "=&v"(r) : "v"(vb), "i"(OFF) : "memory"); return r;
}
template <int D0> __device__ __forceinline__ void pv_one(f32x16& od, int vb, bf16x8 pa0, bf16x8 pa1, bf16x8 pa2, bf16x8 pa3) {
  const s16x4 l0 = tr_read<v_rd_off(D0, 0, 0)>(vb), h0 = tr_read<v_rd_off(D0, 0, 1)>(vb), l1 = tr_read<v_rd_off(D0, 1, 0)>(vb), h1 = tr_read<v_rd_off(D0, 1, 1)>(vb);
  const s16x4 l2 = tr_read<v_rd_off(D0, 2, 0)>(vb), h2 = tr_read<v_rd_off(D0, 2, 1)>(vb), l3 = tr_read<v_rd_off(D0, 3, 0)>(vb), h3 = tr_read<v_rd_off(D0, 3, 1)>(vb);
  asm volatile("s_waitcnt lgkmcnt(0)" ::: "memory"); SBAR();
#define PK(L, H) (bf16x8){L[0], L[1], L[2], L[3], H[0], H[1], H[2], H[3]}
  od = __builtin_amdgcn_mfma_f32_32x32x16_bf16(pa0, PK(l0, h0), od, 0, 0, 0);
  od = __builtin_amdgcn_mfma_f32_32x32x16_bf16(pa1, PK(l1, h1), od, 0, 0, 0);
  od = __builtin_amdgcn_mfma_f32_32x32x16_bf16(pa2, PK(l2, h2), od, 0, 0, 0);
  od = __builtin_amdgcn_mfma_f32_32x32x16_bf16(pa3, PK(l3, h3), od, 0, 0, 0);
#undef PK
}
__device__ __forceinline__ void pv_d0(f32x16* o, int vb, bf16x8 pa0, bf16x8 pa1, bf16x8 pa2, bf16x8 pa3) {
  pv_one<0>(o[0], vb, pa0, pa1, pa2, pa3); pv_one<1>(o[1], vb, pa0, pa1, pa2, pa3); pv_one<2>(o[2], vb, pa0, pa1, pa2, pa3); pv_one<3>(o[3], vb, pa0, pa1, pa2, pa3);
}
__device__ __forceinline__ void attn_unit(const bf16_t* __restrict__ Qb, const bf16_t* __restrict__ Kh, const bf16_t* __restrict__ Vh, bf16_t* __restrict__ Ob, int ldo, int seq, char* lds, const int tid) {
  const int wid = tid >> 6, lane = tid & 63, r32 = lane & 31, hi = lane >> 5;
  char* V_lds = lds + OFF_V; char* K_lds = lds + OFF_K;
  float* ws = (float*)(lds + OFF_WS) + wid * 64; float* li_l = ws; float* al_l = ws + 32;
  float m_reg = -1e30f, l_reg = 0; f32x16 o[4] = {}; bf16x8 qr[4];
  const bf16_t* Qw = Qb + (long)(wid * QBLK + r32) * LDQ + hi * 8;
#pragma unroll
  for (int d0 = 0; d0 < 4; ++d0) qr[d0] = *reinterpret_cast<const bf16x8*>(Qw + d0 * 16);
  const int sr = tid >> 4, sc = (tid & 15) * 8, vst0 = v_st(sr, sc), vst1 = v_st(32 + sr, sc);
  const int kr = tid >> 3, kc = (tid & 7) * 8, kst = kr * KROW + kc * 2;
  const int vb0 = (int)(uintptr_t)V_lds + v_rd_base(lane);
  struct { bf16x8 vs0, vs1, ks0; } sr_[2];
#define SLOAD(i, k0) do { sr_[i].vs0 = *reinterpret_cast<const bf16x8*>(&Vh[(long)((k0) + sr) * LDQ + sc]); sr_[i].vs1 = *reinterpret_cast<const bf16x8*>(&Vh[(long)((k0) + 32 + sr) * LDQ + sc]); \
    sr_[i].ks0 = *reinterpret_cast<const bf16x8*>(&Kh[(long)((k0) + kr) * LDQ + kc]); } while (0)
#define SWRITE(b, i) do { *(bf16x8*)(V_lds + (b) * SHM_V + vst0) = sr_[i].vs0; *(bf16x8*)(V_lds + (b) * SHM_V + vst1) = sr_[i].vs1; \
    *(bf16x8*)(K_lds + (b) * SHM_K + kst) = sr_[i].ks0; } while (0)
#define SWAIT() asm volatile("s_waitcnt vmcnt(3)" ::: "memory")
#define RESC(a) do { if (__any((a) < 1.f)) { if (hi == 0) al_l[r32] = (a); asm volatile("s_waitcnt lgkmcnt(0)" ::: "memory"); \
    _Pragma("unroll") for (int d = 0; d < 4; ++d) _Pragma("unroll") for (int r = 0; r < 16; ++r) o[d][r] *= al_l[crow(r, hi)]; } } while (0)
  f32x16 pA0, pA1, pB0, pB1; float mnA, mnB, alA, alB; bf16x8 pa0, pa1, pa2, pa3; const int NT = seq / KVBLK;
  constexpr int SE = 0, SO = 1;
  SLOAD(SE, 0); asm volatile("s_waitcnt vmcnt(0)" ::: "memory"); SWRITE(0, SE); __syncthreads();
  qkt(pA0, pA1, K_lds, qr, r32, hi); partialSM(pA0, pA1, m_reg, mnA, alA);
  SLOAD(SO, KVBLK); if (2 < NT) SLOAD(SE, 2 * KVBLK);
  SWAIT(); SWRITE(1, SO); __syncthreads();
  for (int j = 1; j + 1 < NT; j += 2) {
    SBAR(); qkt(pB0, pB1, K_lds + SHM_K, qr, r32, hi);
    finishSM(pA0, pA1, alA, l_reg, pa0, pa1, pa2, pa3); SBAR();
    SLOAD(SO, (j + 2) * KVBLK); SBAR();
    pv_d0(o, vb0, pa0, pa1, pa2, pa3); partialSM(pB0, pB1, m_reg, mnB, alB);
    __syncthreads(); SWAIT(); SWRITE(0, SE);
    RESC(alB); __syncthreads();
    SBAR(); qkt(pA0, pA1, K_lds, qr, r32, hi);
    finishSM(pB0, pB1, alB, l_reg, pa0, pa1, pa2, pa3); SBAR();
    if (j + 3 < NT) SLOAD(SE, (j + 3) * KVBLK); SBAR();
    pv_d0(o, vb0 + SHM_V, pa0, pa1, pa2, pa3); partialSM(pA0, pA1, m_reg, mnA, alA);
    __syncthreads(); SWAIT(); SWRITE(1, SO);
    RESC(alA); __syncthreads();
  }
  SBAR(); qkt(pB0, pB1, K_lds + SHM_K, qr, r32, hi);
  finishSM(pA0, pA1, alA, l_reg, pa0, pa1, pa2, pa3); SBAR();
  pv_d0(o, vb0, pa0, pa1, pa2, pa3); partialSM(pB0, pB1, m_reg, mnB, alB);
  __syncthreads(); RESC(alB);
  finishSM(pB0, pB1, alB, l_reg, pa0, pa1, pa2, pa3); SBAR();
  pv_d0(o, vb0 + SHM_V, pa0, pa1, pa2, pa3);
  if (hi == 0) li_l[r32] = l_reg; asm volatile("s_waitcnt lgkmcnt(0)" ::: "memory");
  float rli[16];
#pragma unroll
  for (int r = 0; r < 16; ++r) rli[r] = __builtin_amdgcn_rcpf(li_l[crow(r, hi)]);
  { bf16_t* stg = (bf16_t*)(lds + OFF_OST) + wid * 4096;
#pragma unroll
    for (int r = 0; r < 16; ++r) { const int orow = crow(r, hi);
#pragma unroll
      for (int d0 = 0; d0 < 4; ++d0) stg[orow * 128 + d0 * 32 + r32] = (bf16_t)(cvt_pk_bf16(o[d0][r] * rli[r], 0.f) & 0xffffu); }
    asm volatile("s_waitcnt lgkmcnt(0)" ::: "memory");
    bf16_t* Ow = Ob + (long)(wid * QBLK) * ldo;
#pragma unroll
    for (int i = 0; i < 8; ++i) { const int row = i * 4 + (lane >> 4), ch = lane & 15; const u32x4 v = *(const u32x4*)(stg + row * 128 + ch * 8); *(u32x4*)(Ow + (long)row * ldo + ch * 8) = v; } }
  __syncthreads();
#undef SLOAD
#undef SWRITE
#undef SWAIT
#undef RESC
}
#undef SBAR
}


namespace att2 {
using bf16x8 = __attribute__((ext_vector_type(8))) short;
using s16x4  = __attribute__((ext_vector_type(4))) short;
using f32x16 = __attribute__((ext_vector_type(16))) float;
constexpr int NW = 8, QBLK = 32, KVBLK = 64, LDQ = 1024, LDK = 64, LDV = 128;
constexpr int KSL = 8192, VSL = 16384, K_OFF = 0, V_OFF = 3 * KSL, OFF_WS = V_OFF + 4 * VSL, ATT_LDS = OFF_WS + NW * 64 * 4;
constexpr float THRL = 8.f;
#define SBAR() __builtin_amdgcn_sched_barrier(0)
__device__ __forceinline__ int crow(int r, int hi) { return (r & 3) + 8 * (r >> 2) + 4 * hi; }
__device__ __forceinline__ int v_rd_base(int lane) { return ((lane & 3) << 3) | (((lane >> 2) & 3) << 6) | (((lane >> 4) & 1) << 5) | (((lane >> 5) & 1) << 8); }
constexpr int v_rd_off(int d0, int ks, int half) { return d0 * 512 + ks * 4096 + half * 2048; }
template <int OFF> __device__ __forceinline__ s16x4 tr_read(int vb) {
  s16x4 r; asm volatile("ds_read_b64_tr_b16 %0, %1 offset:%2" : "=&v"(r) : "v"(vb), "i"(OFF) : "memory"); return r;
}
template <int D0> __device__ __forceinline__ void pv_one(f32x16& od, int vb, bf16x8 pa0, bf16x8 pa1, bf16x8 pa2, bf16x8 pa3) {
  const s16x4 l0 = tr_read<v_rd_off(D0, 0, 0)>(vb), h0 = tr_read<v_rd_off(D0, 0, 1)>(vb), l1 = tr_read<v_rd_off(D0, 1, 0)>(vb), h1 = tr_read<v_rd_off(D0, 1, 1)>(vb);
  const s16x4 l2 = tr_read<v_rd_off(D0, 2, 0)>(vb), h2 = tr_read<v_rd_off(D0, 2, 1)>(vb), l3 = tr_read<v_rd_off(D0, 3, 0)>(vb), h3 = tr_read<v_rd_off(D0, 3, 1)>(vb);
  asm volatile("s_waitcnt lgkmcnt(0)" ::: "memory"); SBAR();
#define PK(L, H) (bf16x8){L[0], L[1], L[2], L[3], H[0], H[1], H[2], H[3]}
  od = __builtin_amdgcn_mfma_f32_32x32x16_bf16(pa0, PK(l0, h0), od, 0, 0, 0);
  od = __builtin_amdgcn_mfma_f32_32x32x16_bf16(pa1, PK(l1, h1), od, 0, 0, 0);
  od = __builtin_amdgcn_mfma_f32_32x32x16_bf16(pa2, PK(l2, h2), od, 0, 0, 0);
  od = __builtin_amdgcn_mfma_f32_32x32x16_bf16(pa3, PK(l3, h3), od, 0, 0, 0);
#undef PK
}
struct VFrag { s16x4 l0, h0, l1, h1, l2, h2, l3, h3; };
template <int D0> __device__ __forceinline__ void v_issue(VFrag& f, int vb) {
  f.l0 = tr_read<v_rd_off(D0, 0, 0)>(vb); f.h0 = tr_read<v_rd_off(D0, 0, 1)>(vb); f.l1 = tr_read<v_rd_off(D0, 1, 0)>(vb); f.h1 = tr_read<v_rd_off(D0, 1, 1)>(vb);
  f.l2 = tr_read<v_rd_off(D0, 2, 0)>(vb); f.h2 = tr_read<v_rd_off(D0, 2, 1)>(vb); f.l3 = tr_read<v_rd_off(D0, 3, 0)>(vb); f.h3 = tr_read<v_rd_off(D0, 3, 1)>(vb);
}
template <int WAITN> __device__ __forceinline__ void pv_mma(f32x16& od, const VFrag& f, bf16x8 pa0, bf16x8 pa1, bf16x8 pa2, bf16x8 pa3) {
  if (WAITN == 8) asm volatile("s_waitcnt lgkmcnt(8)" ::: "memory"); else asm volatile("s_waitcnt lgkmcnt(0)" ::: "memory");
  SBAR();
#define PK(L, H) (bf16x8){L[0], L[1], L[2], L[3], H[0], H[1], H[2], H[3]}
  od = __builtin_amdgcn_mfma_f32_32x32x16_bf16(pa0, PK(f.l0, f.h0), od, 0, 0, 0);
  od = __builtin_amdgcn_mfma_f32_32x32x16_bf16(pa1, PK(f.l1, f.h1), od, 0, 0, 0);
  od = __builtin_amdgcn_mfma_f32_32x32x16_bf16(pa2, PK(f.l2, f.h2), od, 0, 0, 0);
  od = __builtin_amdgcn_mfma_f32_32x32x16_bf16(pa3, PK(f.l3, f.h3), od, 0, 0, 0);
#undef PK
}
__device__ __forceinline__ void pv_pipe(f32x16* o, int vb, bf16x8 pa0, bf16x8 pa1, bf16x8 pa2, bf16x8 pa3) {
  VFrag f0, f1;
  v_issue<0>(f0, vb); SBAR();
  v_issue<1>(f1, vb); SBAR(); pv_mma<8>(o[0], f0, pa0, pa1, pa2, pa3); SBAR();
  v_issue<2>(f0, vb); SBAR(); pv_mma<8>(o[1], f1, pa0, pa1, pa2, pa3); SBAR();
  v_issue<3>(f1, vb); SBAR(); pv_mma<8>(o[2], f0, pa0, pa1, pa2, pa3); SBAR();
  pv_mma<0>(o[3], f1, pa0, pa1, pa2, pa3);
}
__device__ __forceinline__ void qkt(f32x16& p0, f32x16& p1, const LAS unsigned char* Ks, const bf16x8* qr, const f32x16& cinit, int r32, int hi) {
  const LAS unsigned char* kb0 = Ks + r32 * 128; const int sw = r32 & 7;
#pragma unroll
  for (int d0 = 0; d0 < 4; ++d0) { const int ch = ((2 * d0 + hi) ^ sw) << 4;
    const bf16x8 b0 = *(const LAS bf16x8*)(kb0 + ch), b1 = *(const LAS bf16x8*)(kb0 + 4096 + ch);
    if (d0 == 0) { p0 = __builtin_amdgcn_mfma_f32_32x32x16_bf16(b0, qr[0], cinit, 0, 0, 0); p1 = __builtin_amdgcn_mfma_f32_32x32x16_bf16(b1, qr[0], cinit, 0, 0, 0); }
    else { p0 = __builtin_amdgcn_mfma_f32_32x32x16_bf16(b0, qr[d0], p0, 0, 0, 0); p1 = __builtin_amdgcn_mfma_f32_32x32x16_bf16(b1, qr[d0], p1, 0, 0, 0); } }
}
__device__ __forceinline__ float rowmax(const f32x16& p0, const f32x16& p1) {
  float a = fmaxf(fmaxf(p0[0], p0[1]), p1[0]), b = fmaxf(fmaxf(p0[2], p0[3]), p1[1]); a = fmaxf(fmaxf(a, p1[2]), p1[3]);
#pragma unroll
  for (int r = 4; r < 16; r += 4) { a = fmaxf(fmaxf(a, p0[r]), p0[r + 1]); b = fmaxf(fmaxf(b, p0[r + 2]), p0[r + 3]); a = fmaxf(fmaxf(a, p1[r]), p1[r + 1]); b = fmaxf(fmaxf(b, p1[r + 2]), p1[r + 3]); }
  const float m = fmaxf(a, b);
  auto rr = __builtin_amdgcn_permlane32_swap(__float_as_uint(m), __float_as_uint(m), false, false);
  return fmaxf(__uint_as_float(rr[0]), __uint_as_float(rr[1]));
}
#define A2_PK4(P, BASE, OUT) do { u32x4 w_ = {cvt_pk_bf16(P[BASE + 0], P[BASE + 1]), cvt_pk_bf16(P[BASE + 2], P[BASE + 3]), cvt_pk_bf16(P[BASE + 4], P[BASE + 5]), cvt_pk_bf16(P[BASE + 6], P[BASE + 7])}; \
    OUT = *reinterpret_cast<bf16x8*>(&w_); } while (0)

__device__ __forceinline__ void attn_unit(const bf16_t* __restrict__ Qb, const bf16_t* __restrict__ Kh, const bf16_t* __restrict__ Vh, bf16_t* __restrict__ Ob, int ldo, int seq, LAS unsigned char* lds, const int tid) {
  const int wid = __builtin_amdgcn_readfirstlane(tid >> 6), lane = tid & 63, r32 = lane & 31, hi = lane >> 5;
  LAS float* ws = (LAS float*)(lds + OFF_WS) + wid * 64;
  const unsigned koff = (unsigned)(((8 * wid + (lane >> 3)) * LDK + (((lane & 7) ^ (lane >> 3)) * 8)) * 2);
  const unsigned voff = (unsigned)(((8 * wid + ((lane & 31) >> 2)) * LDV + 32 * (lane >> 5) + 8 * (lane & 3)) * 2);
#define A2_DMA(t, ks, vs) do { const char* kb_ = (const char*)Kh + (size_t)(t) * (KVBLK * LDK * 2); const char* vb_ = (const char*)Vh + (size_t)(t) * (KVBLK * LDV * 2); \
    __builtin_amdgcn_global_load_lds((const unsigned*)(kb_ + koff), (LAS unsigned*)(lds + K_OFF + (ks) + wid * 1024), 16, 0, 0); \
    __builtin_amdgcn_global_load_lds((const unsigned*)(vb_ + voff), (LAS unsigned*)(lds + V_OFF + (vs) + wid * 2048), 16, 0, 0); \
    __builtin_amdgcn_global_load_lds((const unsigned*)(vb_ + voff + 128), (LAS unsigned*)(lds + V_OFF + (vs) + wid * 2048 + 1024), 16, 0, 0); } while (0)
#define A2_WAITBAR() do { asm volatile("s_waitcnt vmcnt(0) lgkmcnt(0)" ::: "memory"); __builtin_amdgcn_s_barrier(); asm volatile("" ::: "memory"); } while (0)
  const int NT = seq / KVBLK;
  const bool trail = wid >= 4;
  A2_DMA(0, 0, 0); A2_DMA(1, KSL, VSL);
  bf16x8 qr[4];
  { const bf16_t* Qw = Qb + (long)(wid * QBLK + r32) * LDQ + hi * 8;
#pragma unroll
    for (int d0 = 0; d0 < 4; ++d0) qr[d0] = *reinterpret_cast<const bf16x8*>(Qw + d0 * 16); }
  float mhat = 0.f, l_reg = 0.f; f32x16 o[4] = {}; f32x16 negm = {};
  const int vbase = (int)(uintptr_t)(lds + V_OFF) + v_rd_base(lane);
  A2_WAITBAR();
  if (NT > 2) A2_DMA(2, 2 * KSL, 2 * VSL);
  f32x16 pA0, pA1, pB0, pB1; bf16x8 pa0, pa1, pa2, pa3;
  qkt(pA0, pA1, lds + K_OFF, qr, negm, r32, hi);
  { const float rm = rowmax(pA0, pA1); mhat = rm;
#pragma unroll
    for (int r = 0; r < 16; ++r) { pA0[r] -= rm; pA1[r] -= rm; negm[r] = -rm; }
#pragma unroll
    for (int r = 0; r < 16; ++r) { pA0[r] = __builtin_amdgcn_exp2f(pA0[r]); pA1[r] = __builtin_amdgcn_exp2f(pA1[r]); } }
  int k_cur = KSL, k_dma = 0;
  int v_prev = 0, v_dma = 3 * VSL;
#define A2_ROT() do { k_cur = (k_cur == 2 * KSL) ? 0 : k_cur + KSL; k_dma = (k_dma == 2 * KSL) ? 0 : k_dma + KSL; v_prev = (v_prev == 3 * VSL) ? 0 : v_prev + VSL; v_dma = (v_dma == 3 * VSL) ? 0 : v_dma + VSL; } while (0)
#define A2_SEAM(t) do { A2_WAITBAR(); if ((t) + 2 < NT) A2_DMA((t) + 2, k_dma, v_dma); } while (0)
#define A2_EXP(X, i) X[i] = __builtin_amdgcn_exp2f(X[i])
#define A2_SG(mask, n) __builtin_amdgcn_sched_group_barrier(mask, n, 0)
#define A2_STEP(C0, C1, P0, P1, t) do { bool resc_ = false; \
    SBAR(); \
      \
    qkt(C0, C1, lds + K_OFF + k_cur, qr, negm, r32, hi); \
    { float sa_ = 0.f, sb_ = 0.f; _Pragma("unroll") for (int r = 0; r < 16; ++r) { sa_ += P0[r]; sb_ += P1[r]; } l_reg += sa_ + sb_; } \
    A2_PK4(P0, 0, pa0); A2_PK4(P0, 8, pa1); A2_PK4(P1, 0, pa2); A2_PK4(P1, 8, pa3); \
    A2_SG(0x100, 2); A2_SG(0x100, 2); A2_SG(0x8, 1); A2_SG(0x402, 6); A2_SG(0x8, 1); A2_SG(0x402, 6); A2_SG(0x100, 2); A2_SG(0x8, 1); A2_SG(0x402, 6); A2_SG(0x8, 1); A2_SG(0x402, 6); \
    A2_SG(0x100, 2); A2_SG(0x8, 1); A2_SG(0x402, 6); A2_SG(0x8, 1); A2_SG(0x402, 6); A2_SG(0x8, 1); A2_SG(0x402, 6); A2_SG(0x8, 1); A2_SG(0x402, 6); \
    if (MK_ATT_XMFMA) { f32x16 dz_ = negm; _Pragma("unroll") for (int x_ = 0; x_ < 8; ++x_) asm volatile("v_mfma_f32_32x32x16_bf16 %0, %1, %2, %0" : "+v"(dz_) : "v"(qr[x_ & 3]), "v"(qr[(x_ + 1) & 3])); asm volatile("" :: "v"(dz_)); } \
    if (MK_ATT_XEXP) { float dx_ = mhat; _Pragma("unroll") for (int x_ = 0; x_ < 32; ++x_) asm volatile("v_exp_f32 %0, %0" : "+v"(dx_)); asm volatile("" :: "v"(dx_)); } \
    asm volatile("" : "+v"(l_reg), "+v"(pa0), "+v"(pa1), "+v"(pa2), "+v"(pa3)); SBAR(); \
    if (trail) A2_SEAM(t); \
    { const int vb_ = vbase + v_prev; VFrag f0_, f1_; \
        \
      v_issue<0>(f0_, vb_); v_issue<1>(f1_, vb_); SBAR(); \
      pv_mma<8>(o[0], f0_, pa0, pa1, pa2, pa3); \
      { const float rm_ = rowmax(C0, C1); \
        if (__builtin_expect(__any(rm_ > THRL), 0)) { const float dl_ = fmaxf(rm_, 0.f); mhat += dl_; \
          _Pragma("unroll") for (int r = 0; r < 16; ++r) { C0[r] -= dl_; C1[r] -= dl_; negm[r] = -mhat; } \
          const float f_ = __builtin_amdgcn_exp2f(-dl_); l_reg *= f_; if (hi == 0) ws[r32] = f_; resc_ = true; } } \
      SBAR(); \
        \
      v_issue<2>(f0_, vb_); SBAR(); pv_mma<8>(o[1], f1_, pa0, pa1, pa2, pa3); \
      A2_EXP(C0, 0); A2_EXP(C0, 1); A2_EXP(C0, 2); A2_EXP(C0, 3); A2_EXP(C0, 4); A2_EXP(C0, 5); A2_EXP(C0, 6); A2_EXP(C0, 7); A2_EXP(C0, 8); A2_EXP(C0, 9); A2_EXP(C0, 10); \
      A2_SG(0x8, 1); A2_SG(0x402, 3); A2_SG(0x8, 1); A2_SG(0x402, 3); A2_SG(0x8, 1); A2_SG(0x402, 3); A2_SG(0x8, 1); A2_SG(0x402, 3); \
      asm volatile("" : "+v"(C0)); SBAR(); \
      v_issue<3>(f1_, vb_); SBAR(); pv_mma<8>(o[2], f0_, pa0, pa1, pa2, pa3); \
      A2_EXP(C0, 11); A2_EXP(C0, 12); A2_EXP(C0, 13); A2_EXP(C0, 14); A2_EXP(C0, 15); A2_EXP(C1, 0); A2_EXP(C1, 1); A2_EXP(C1, 2); A2_EXP(C1, 3); A2_EXP(C1, 4); A2_EXP(C1, 5); \
      A2_SG(0x8, 1); A2_SG(0x402, 3); A2_SG(0x8, 1); A2_SG(0x402, 3); A2_SG(0x8, 1); A2_SG(0x402, 3); A2_SG(0x8, 1); A2_SG(0x402, 3); \
      asm volatile("" : "+v"(C0), "+v"(C1)); SBAR(); \
      pv_mma<0>(o[3], f1_, pa0, pa1, pa2, pa3); \
      A2_EXP(C1, 6); A2_EXP(C1, 7); A2_EXP(C1, 8); A2_EXP(C1, 9); A2_EXP(C1, 10); A2_EXP(C1, 11); A2_EXP(C1, 12); A2_EXP(C1, 13); A2_EXP(C1, 14); A2_EXP(C1, 15); \
      A2_SG(0x8, 1); A2_SG(0x402, 3); A2_SG(0x8, 1); A2_SG(0x402, 3); A2_SG(0x8, 1); A2_SG(0x402, 3); A2_SG(0x8, 1); A2_SG(0x402, 3); \
      asm volatile("" : "+v"(C1)); SBAR(); } \
    if (resc_) { asm volatile("s_waitcnt lgkmcnt(0)" ::: "memory"); \
      _Pragma("unroll") for (int d_ = 0; d_ < 4; ++d_) _Pragma("unroll") for (int r = 0; r < 16; ++r) o[d_][r] *= ws[crow(r, hi)]; } \
    if (!trail) A2_SEAM(t); \
    A2_ROT(); } while (0)
  int t = 1;
  for (; t + 1 < NT; t += 2) { A2_STEP(pB0, pB1, pA0, pA1, t); A2_STEP(pA0, pA1, pB0, pB1, t + 1); }
  A2_STEP(pB0, pB1, pA0, pA1, t);
  { float sa_ = 0.f, sb_ = 0.f;
#pragma unroll
    for (int r = 0; r < 16; ++r) { sa_ += pB0[r]; sb_ += pB1[r]; }
    l_reg += sa_ + sb_;
    A2_PK4(pB0, 0, pa0); A2_PK4(pB0, 8, pa1); A2_PK4(pB1, 0, pa2); A2_PK4(pB1, 8, pa3);
    SBAR(); const int vb_ = vbase + v_prev;
    pv_pipe(o, vb_, pa0, pa1, pa2, pa3); }
  { auto rr = __builtin_amdgcn_permlane32_swap(__float_as_uint(l_reg), __float_as_uint(l_reg), false, false); l_reg = __uint_as_float(rr[0]) + __uint_as_float(rr[1]); }
  if (hi == 0) ws[32 + r32] = l_reg;
  A2_WAITBAR();
  float rli[16];
#pragma unroll
  for (int r = 0; r < 16; ++r) rli[r] = __builtin_amdgcn_rcpf(ws[32 + crow(r, hi)]);
  { LAS bf16_t* stg = (LAS bf16_t*)lds + wid * 4096;
#pragma unroll
    for (int r = 0; r < 16; ++r) { const int orow = crow(r, hi);
#pragma unroll
      for (int d0 = 0; d0 < 4; ++d0) stg[orow * 128 + d0 * 32 + r32] = (bf16_t)(cvt_pk_bf16(o[d0][r] * rli[r], 0.f) & 0xffffu); }
    asm volatile("s_waitcnt lgkmcnt(0)" ::: "memory");
    bf16_t* Ow = Ob + (long)(wid * QBLK) * ldo;
#pragma unroll
    for (int i = 0; i < 8; ++i) { const int row = i * 4 + (lane >> 4), ch = lane & 15; const u32x4 v = *(const LAS u32x4*)(stg + row * 128 + ch * 8); *(u32x4*)(Ow + (long)row * ldo + ch * 8) = v; } }
  A2_WAITBAR();
#undef A2_DMA
#undef A2_WAITBAR
#undef A2_ROT
#undef A2_SEAM
#undef A2_STEP
#undef A2_EXP
#undef A2_SG
}
#undef A2_PK4
#undef SBAR
}


namespace att3 {
using f32x16 = __attribute__((ext_vector_type(16))) float;
typedef int v8i __attribute__((ext_vector_type(8)));
typedef int v4i __attribute__((ext_vector_type(4)));
constexpr int NW = 8, QBLK = 32, KVBLK = 64;
constexpr int KSL = 4096, VSL = 8192, K_OFF = 0, V_OFF = 4 * KSL, OFF_WS = 49152, OFF_O0 = 65536, ATT_LDS = OFF_O0 + 65536;
constexpr float THRL = 8.f;
constexpr int SC_ONE = 0x7f7f7f7f, SC_Q = 0x7b7b7b7b;
#define SBAR() __builtin_amdgcn_sched_barrier(0)
__device__ __forceinline__ int crow(int r, int hi) { return (r & 3) + 8 * (r >> 2) + 4 * hi; }
__host__ __device__ __forceinline__ int slot_key(int s) { const int hi = s >> 5, j = s & 31, jj = j & 15; return (j >> 4) * 32 + (jj & 3) + 8 * (jj >> 2) + 4 * hi; }
__device__ __forceinline__ v8i ld32(const LAS unsigned char* rowp, int c0, int sw) {
    const v4i a = *(const LAS v4i*)(rowp + ((c0 ^ sw) << 4)), b = *(const LAS v4i*)(rowp + (((c0 + 1) ^ sw) << 4));
    return (v8i){a[0], a[1], a[2], a[3], b[0], b[1], b[2], b[3]};
}
__device__ __forceinline__ void qkt(f32x16& p0, f32x16& p1, const LAS unsigned char* Ks, const v8i& qf, const f32x16& cinit, int r32, int hi) {
    const int sw = (r32 >> 2) & 3;
    const v8i k0 = ld32(Ks + r32 * 64, 2 * hi, sw), k1 = ld32(Ks + (32 + r32) * 64, 2 * hi, sw);
    p0 = __builtin_amdgcn_mfma_scale_f32_32x32x64_f8f6f4(k0, qf, cinit, 0, 0, 0, SC_ONE, 0, SC_Q);
    p1 = __builtin_amdgcn_mfma_scale_f32_32x32x64_f8f6f4(k1, qf, cinit, 0, 0, 0, SC_ONE, 0, SC_Q);
}
__device__ __forceinline__ float rowmax(const f32x16& p0, const f32x16& p1) {
  float a = fmaxf(fmaxf(p0[0], p0[1]), p1[0]), b = fmaxf(fmaxf(p0[2], p0[3]), p1[1]); a = fmaxf(fmaxf(a, p1[2]), p1[3]);
#pragma unroll
  for (int r = 4; r < 16; r += 4) { a = fmaxf(fmaxf(a, p0[r]), p0[r + 1]); b = fmaxf(fmaxf(b, p0[r + 2]), p0[r + 3]); a = fmaxf(fmaxf(a, p1[r]), p1[r + 1]); b = fmaxf(fmaxf(b, p1[r + 2]), p1[r + 3]); }
  const float m = fmaxf(a, b);
  auto rr = __builtin_amdgcn_permlane32_swap(__float_as_uint(m), __float_as_uint(m), false, false);
  return fmaxf(__uint_as_float(rr[0]), __uint_as_float(rr[1]));
}
__device__ __forceinline__ v8i pack_p(const f32x16& p0, const f32x16& p1) {
    v8i w;
    w[0] = (int)cvt4_fp8_nc(p0[0], p0[1], p0[2], p0[3]); w[1] = (int)cvt4_fp8_nc(p0[4], p0[5], p0[6], p0[7]); w[2] = (int)cvt4_fp8_nc(p0[8], p0[9], p0[10], p0[11]); w[3] = (int)cvt4_fp8_nc(p0[12], p0[13], p0[14], p0[15]);
    w[4] = (int)cvt4_fp8_nc(p1[0], p1[1], p1[2], p1[3]); w[5] = (int)cvt4_fp8_nc(p1[4], p1[5], p1[6], p1[7]); w[6] = (int)cvt4_fp8_nc(p1[8], p1[9], p1[10], p1[11]); w[7] = (int)cvt4_fp8_nc(p1[12], p1[13], p1[14], p1[15]);
    return w;
}
__device__ __forceinline__ void qk1(f32x16& d, const v8i& kop, const v8i& qf, const f32x16& c) {
    asm volatile("s_nop 1\n\tv_mfma_scale_f32_32x32x64_f8f6f4 %0, %1, %2, %3, %4, %5 op_sel_hi:[0,0,0]" : "=&v"(d) : "v"(kop), "v"(qf), "v"(c), "v"(SC_ONE), "v"(SC_Q));
}
__device__ __forceinline__ void pv1(f32x16& od, const v8i& pf, const v8i& vf) {
    asm volatile("s_nop 1\n\tv_mfma_scale_f32_32x32x64_f8f6f4 %0, %1, %2, %0, %3, %3 op_sel_hi:[0,0,0]" : "+v"(od) : "v"(pf), "v"(vf), "v"(SC_ONE));
}

__device__ __forceinline__ void attn_unit(const unsigned char* __restrict__ Q8b, const unsigned char* __restrict__ K8h0, size_t kmap_stride, const unsigned char* __restrict__ VT8h, bf16_t* __restrict__ AOb, int ldo, int seq,
                                          float lam, float osc, const float* __restrict__ subln, LAS unsigned char* lds, const int tid) {
  const int wid = __builtin_amdgcn_readfirstlane(tid >> 6), lane = tid & 63, r32 = lane & 31, hi = lane >> 5;
  LAS float* ws = (LAS float*)(lds + OFF_WS) + wid * 64;
  const int prow = 16 * wid + (lane >> 2); const unsigned poff = (unsigned)(prow * 64 + (((lane & 3) ^ ((prow >> 2) & 3)) << 4));
#define A3_MFMA_FENCE() asm volatile("s_nop 15\n\ts_nop 15" : "+v"(o[0]), "+v"(o[1]), "+v"(o[2]), "+v"(o[3]), "+v"(osum))
#define A3_WAITBAR() do { asm volatile("s_waitcnt vmcnt(0) lgkmcnt(0)" ::: "memory"); __builtin_amdgcn_s_barrier(); asm volatile("" ::: "memory"); } while (0)
  const int NT = seq / KVBLK;
  const int half = wid >> 2;
#define A3_DMAK(t) do { if (wid < 4) __builtin_amdgcn_global_load_lds((const unsigned*)(K8h + (size_t)(t) * 4096 + poff), (LAS unsigned*)(lds + K_OFF + ((t) & 3) * KSL + wid * 1024), 16, 0, 0); } while (0)
#define A3_DMAV(t) __builtin_amdgcn_global_load_lds((const unsigned*)(VT8h + (size_t)(t) * 8192 + poff), (LAS unsigned*)(lds + V_OFF + ((t) & 3) * VSL + wid * 1024), 16, 0, 0)
  f32x16 o[4]; f32x16 osum;
  for (int mp = 0; mp < 2; ++mp) {
  const unsigned char* K8h = K8h0 + (size_t)mp * kmap_stride;
  A3_DMAK(0); A3_DMAK(1); A3_DMAV(0); if (NT > 2) A3_DMAK(2); A3_DMAV(1);
  v8i qf;
  { const unsigned char* Qw = Q8b + mp * 64 + (size_t)(wid * QBLK + r32) * 1024 + hi * 32; const v4i a = *(const v4i*)Qw, b = *(const v4i*)(Qw + 16); qf = (v8i){a[0], a[1], a[2], a[3], b[0], b[1], b[2], b[3]}; }
  float mhat = 0.f; f32x16 negm = {};
#pragma unroll
  for (int r = 0; r < 16; ++r) { o[0][r] = 0.f; o[1][r] = 0.f; o[2][r] = 0.f; o[3][r] = 0.f; osum[r] = 0.f; }
  int one8_; asm volatile("v_mov_b32 %0, 0x38383838" : "=v"(one8_));
  v8i ones8 = {one8_, one8_, one8_, one8_, one8_, one8_, one8_, one8_};
  asm volatile("" : "+v"(ones8));
  const int swv = (r32 >> 2) & 3;
  A3_WAITBAR();
  if (NT > 3) A3_DMAK(3);
  if (NT > 2) A3_DMAV(2);
  f32x16 C0 = negm, C1 = negm; v8i pf = ones8;
#define A3_BAR_ODD() do { asm volatile("s_waitcnt lgkmcnt(0)" ::: "memory"); __builtin_amdgcn_s_barrier(); asm volatile("" ::: "memory"); } while (0)
#define A3_BAR_EVEN(m, NV) do { if ((m) + 2 < NT) asm volatile("s_waitcnt vmcnt(" #NV ") lgkmcnt(0)" ::: "memory"); else asm volatile("s_waitcnt vmcnt(0) lgkmcnt(0)" ::: "memory"); \
    __builtin_amdgcn_s_barrier(); asm volatile("" ::: "memory"); if ((m) + 3 < NT) A3_DMAK((m) + 3); if ((m) + 2 < NT) A3_DMAV((m) + 2); } while (0)
#define A3_A_FIRST() do { const LAS unsigned char* Ks_ = lds + K_OFF + r32 * 64; const v8i b0_ = ld32(Ks_, 2 * hi, swv), b1_ = ld32(Ks_ + 2048, 2 * hi, swv); \
    asm volatile("s_waitcnt lgkmcnt(0)" ::: "memory"); SBAR(); qk1(C0, b0_, qf, negm); qk1(C1, b1_, qf, negm); SBAR(); } while (0)
#define A3_A_MID(k) do { \
    const LAS unsigned char* Ks_ = lds + K_OFF + (((k) + 1) & 3) * KSL + r32 * 64; \
    const LAS unsigned char* vt_ = lds + V_OFF + ((k) & 3) * VSL + r32 * 64; \
    __builtin_amdgcn_s_setprio(1);                                   \
    v8i b0_ = ld32(Ks_, 2 * hi, swv), b1_ = ld32(Ks_ + 2048, 2 * hi, swv), b2_ = ld32(vt_, 2 * hi, swv), b3_ = ld32(vt_ + 2048, 2 * hi, swv), b4_ = ld32(vt_ + 4096, 2 * hi, swv); \
    asm volatile("s_waitcnt lgkmcnt(8)" ::: "memory"); SBAR(); \
    qk1(C0, b0_, qf, negm); \
    SBAR(); b0_ = ld32(vt_ + 6144, 2 * hi, swv); \
    asm volatile("s_waitcnt lgkmcnt(8)" ::: "memory"); SBAR(); \
    qk1(C1, b1_, qf, negm); \
    asm volatile("s_waitcnt lgkmcnt(6)\n\ts_nop 1" ::: "memory"); SBAR(); \
    pv1(o[0], pf, b2_); pv1(osum, pf, ones8); \
    asm volatile("s_waitcnt lgkmcnt(4)" ::: "memory"); SBAR(); \
    pv1(o[1], pf, b3_); \
    asm volatile("s_waitcnt lgkmcnt(2)" ::: "memory"); SBAR(); \
    pv1(o[2], pf, b4_); \
    asm volatile("s_waitcnt lgkmcnt(0)" ::: "memory"); SBAR(); \
    pv1(o[3], pf, b0_); \
    __builtin_amdgcn_s_setprio(0); \
    SBAR(); } while (0)
#define A3_A_LAST(k) do { \
    const LAS unsigned char* vt_ = lds + V_OFF + ((k) & 3) * VSL + r32 * 64; \
    const v8i v0_ = ld32(vt_, 2 * hi, swv), v1_ = ld32(vt_ + 2048, 2 * hi, swv), v2_ = ld32(vt_ + 4096, 2 * hi, swv), v3_ = ld32(vt_ + 6144, 2 * hi, swv); \
    asm volatile("s_waitcnt lgkmcnt(0)\n\ts_nop 1" ::: "memory"); SBAR(); \
    pv1(o[0], pf, v0_); pv1(o[1], pf, v1_); pv1(o[2], pf, v2_); pv1(o[3], pf, v3_); pv1(osum, pf, ones8); \
    SBAR(); } while (0)
#define A3_B(FIRST) do { \
    asm volatile("s_nop 7" : "+v"(C0), "+v"(C1));                    \
    const float rm_ = rowmax(C0, C1); \
    if (FIRST) { mhat = rm_;                                        \
      _Pragma("unroll") for (int r = 0; r < 16; ++r) { C0[r] -= rm_; C1[r] -= rm_; negm[r] = -rm_; } } \
    else if (__builtin_expect(__any(rm_ > THRL), 0)) {              \
      const float dl_ = fmaxf(rm_, 0.f); mhat += dl_; \
      _Pragma("unroll") for (int r = 0; r < 16; ++r) { C0[r] -= dl_; C1[r] -= dl_; negm[r] = -mhat; } \
      const float f_ = __builtin_amdgcn_exp2f(-dl_); if (hi == 0) ws[r32] = f_; \
      asm volatile("s_waitcnt lgkmcnt(0)" ::: "memory"); A3_MFMA_FENCE(); \
      _Pragma("unroll") for (int r = 0; r < 16; ++r) { const float fr_ = ws[crow(r, hi)]; osum[r] *= fr_; _Pragma("unroll") for (int d_ = 0; d_ < 4; ++d_) o[d_][r] *= fr_; } } \
    _Pragma("unroll") for (int r = 0; r < 16; ++r) { C0[r] = __builtin_amdgcn_exp2f(C0[r]); C1[r] = __builtin_amdgcn_exp2f(C1[r]); } \
    pf = pack_p(C0, C1); \
    asm volatile("" : "+v"(pf)); SBAR(); } while (0)
  if (half == 0) {
    A3_A_FIRST();
    A3_BAR_ODD(); A3_B(true);
    int k = 0;
    for (; k + 1 < NT; ++k) { A3_BAR_EVEN(k + 1, 4); A3_A_MID(k); A3_BAR_ODD(); A3_B(false); }
    A3_BAR_EVEN(k + 1, 4); A3_A_LAST(k);
    A3_BAR_ODD();
  } else {
    A3_BAR_ODD(); A3_A_FIRST();
    A3_BAR_EVEN(1, 2); A3_B(true);
    int k = 0;
    for (; k + 1 < NT; ++k) { A3_BAR_ODD(); A3_A_MID(k); A3_BAR_EVEN(k + 2, 2); A3_B(false); }
    A3_BAR_ODD(); A3_A_LAST(k);
  }
  A3_MFMA_FENCE();
  A3_WAITBAR();
  if (mp == 0) {
    LAS u32x4* o0s = (LAS u32x4*)(lds + OFF_O0 + wid * 8192) + lane;
#pragma unroll
    for (int d0 = 0; d0 < 4; ++d0) {
#pragma unroll
      for (int r = 0; r < 16; r += 8) { u32x4 w;
        w.x = cvt_pk_bf16(o[d0][r] * __builtin_amdgcn_rcpf(osum[r]), o[d0][r + 1] * __builtin_amdgcn_rcpf(osum[r + 1]));
        w.y = cvt_pk_bf16(o[d0][r + 2] * __builtin_amdgcn_rcpf(osum[r + 2]), o[d0][r + 3] * __builtin_amdgcn_rcpf(osum[r + 3]));
        w.z = cvt_pk_bf16(o[d0][r + 4] * __builtin_amdgcn_rcpf(osum[r + 4]), o[d0][r + 5] * __builtin_amdgcn_rcpf(osum[r + 5]));
        w.w = cvt_pk_bf16(o[d0][r + 6] * __builtin_amdgcn_rcpf(osum[r + 6]), o[d0][r + 7] * __builtin_amdgcn_rcpf(osum[r + 7]));
        o0s[(d0 * 2 + (r >> 3)) * 64] = w; } }
  }
  }
  { LAS bf16_t* stg = (LAS bf16_t*)lds + wid * 4096;
    u32x4 o0w[8];
    { const LAS u32x4* o0s = (const LAS u32x4*)(lds + OFF_O0 + wid * 8192) + lane;
#pragma unroll
      for (int j = 0; j < 8; ++j) o0w[j] = o0s[j * 64]; }
#pragma unroll
    for (int r = 0; r < 16; r += 2) { const float i0 = __builtin_amdgcn_rcpf(osum[r]), i1 = __builtin_amdgcn_rcpf(osum[r + 1]); const int or0 = crow(r, hi), or1 = crow(r + 1, hi);
#pragma unroll
      for (int d0 = 0; d0 < 4; ++d0) { const unsigned pk = o0w[d0 * 2 + (r >> 3)][(r >> 1) & 3];
        const float v0 = bf_lo(pk) - lam * (o[d0][r] * i0), v1 = bf_hi(pk) - lam * (o[d0][r + 1] * i1);
        stg[or0 * 128 + d0 * 32 + r32] = (bf16_t)(cvt_pk_bf16(v0, 0.f) & 0xffffu); stg[or1 * 128 + d0 * 32 + r32] = (bf16_t)(cvt_pk_bf16(v1, 0.f) & 0xffffu); } }
    asm volatile("s_waitcnt lgkmcnt(0)" ::: "memory");
    bf16_t* Ow = AOb + (long)(wid * QBLK) * ldo;
    int lane_e; asm volatile("v_mbcnt_lo_u32_b32 %0, -1, 0\n\tv_mbcnt_hi_u32_b32 %0, -1, %0" : "=v"(lane_e));
    const int ch = lane_e & 15; const f32x4 g0 = *(const f32x4*)(subln + ch * 8), g1 = *(const f32x4*)(subln + ch * 8 + 4);
#pragma unroll
    for (int i = 0; i < 8; ++i) { const int row = i * 4 + (lane_e >> 4); const u32x4 v = *(const LAS u32x4*)(stg + row * 128 + ch * 8);
      float e[8] = {bf_lo(v.x), bf_hi(v.x), bf_lo(v.y), bf_hi(v.y), bf_lo(v.z), bf_hi(v.z), bf_lo(v.w), bf_hi(v.w)};
      float ss = 0.f;
#pragma unroll
      for (int q = 0; q < 8; ++q) ss += e[q] * e[q];
      ss = row16_sum(ss);
      const float rn = osc / sqrtf(ss * (1.0f / 128.0f) + EPS);
      u32x4 w; w.x = cvt_pk_bf16(e[0] * rn * g0[0], e[1] * rn * g0[1]); w.y = cvt_pk_bf16(e[2] * rn * g0[2], e[3] * rn * g0[3]);
      w.z = cvt_pk_bf16(e[4] * rn * g1[0], e[5] * rn * g1[1]); w.w = cvt_pk_bf16(e[6] * rn * g1[2], e[7] * rn * g1[3]);
      *(u32x4*)(Ow + (long)row * ldo + ch * 8) = w; } }
  A3_WAITBAR();
#undef A3_WAITBAR
#undef A3_DMAK
#undef A3_DMAV
#undef A3_BAR_ODD
#undef A3_BAR_EVEN
#undef A3_A_FIRST
#undef A3_A_MID
#undef A3_A_LAST
#undef A3_B
#undef A3_MFMA_FENCE
}
#undef SBAR
}

constexpr int RING_BYTES = 131072, MISC_OFF = RING_BYTES + 320, INTAB_OFF = RING_BYTES + 1024, LDS_BYTES = 147456;
struct Args { const float* in[50]; float* out; unsigned char* ws; int ph_lo, ph_hi; };

struct Ctx {
    LAS unsigned char* lds;
    int tid, lane, wave, G, bid;
    unsigned char* ws; float* out;
    __device__ __forceinline__ const float* inp(int idx) const {
        const LAS unsigned* t = (const LAS unsigned*)(lds + INTAB_OFF) + 2 * idx;
        const unsigned lo_ = __builtin_amdgcn_readfirstlane(t[0]), hi_ = __builtin_amdgcn_readfirstlane(t[1]);
        typedef __attribute__((address_space(1))) const float* gp_t; return (const float*)(gp_t)(((uintptr_t)hi_ << 32) | (uintptr_t)lo_); }
};

template <class T> __device__ __forceinline__ T* launder_ptr(T* p) { unsigned lo = (unsigned)(uintptr_t)p, hi = (unsigned)((uintptr_t)p >> 32); lo = __builtin_amdgcn_readfirstlane(lo); hi = __builtin_amdgcn_readfirstlane(hi);
    asm volatile("" : "+s"(lo), "+s"(hi)); typedef __attribute__((address_space(1))) T* gp_t; return (T*)(gp_t)(((uintptr_t)hi << 32) | (uintptr_t)lo); }
__device__ __forceinline__ int launder_i(int v) { v = __builtin_amdgcn_readfirstlane(v); asm volatile("" : "+s"(v)); return v; }
__device__ __forceinline__ int map_col(int kind, int n) {
    if (kind == 1) { if (n < 1024) return n; const int w = n - 1024, T = w >> 8, r = w & 255; return 1024 + (r >> 7) * 1024 + T * 128 + (r & 127); }
    if (kind == 2) { const int T = n >> 8, r = n & 255; return (r >> 7) * DFF + T * 128 + (r & 127); }
    if (kind == 3) { const int T = n >> 8, r = n & 255; return (r >> 7) * 1024 + T * 128 + (r & 127); }
    if (kind == 4) { if (n >= 2048) return n; const int blk = n >> 6, w = n & 63, half = w >> 5, ww = w & 31; return blk * 64 + half * 32 + (ww & 1) * 16 + (ww >> 1); }
    return n;
}
__device__ __forceinline__ void transpose_item8(const float* W, int K, int N, unsigned char* WT, int kind, int item, int lane) {
    const int nblk = N / 128, kb = item / nblk, nb = item % nblk, k0 = 128 * kb, n0 = 128 * nb;
    const int d0 = n0 + 2 * lane, s0 = map_col(kind, d0), s1 = map_col(kind, d0 + 1);
    const bool adj = (kind != 4) || (n0 >= 2048);
#pragma unroll
    for (int h = 0; h < 4; ++h) {
        float v0[32], v1[32];
        const float* wp = W + (size_t)(k0 + 32 * h) * N;
        if (adj) {
#pragma unroll
            for (int kk = 0; kk < 32; ++kk) { const f32x2 t = *(const f32x2*)(wp + (size_t)kk * N + s0); v0[kk] = t[0] * pg8::W8SCALE; v1[kk] = t[1] * pg8::W8SCALE; }
        } else {
#pragma unroll
            for (int kk = 0; kk < 32; ++kk) { v0[kk] = wp[(size_t)kk * N + s0] * pg8::W8SCALE; v1[kk] = wp[(size_t)kk * N + s1] * pg8::W8SCALE; }
        }
        unsigned char* o0 = WT + (size_t)d0 * K + k0 + 32 * h; unsigned char* o1 = o0 + K;
#pragma unroll
        for (int j = 0; j < 2; ++j) {
            u32x4 a, b;
            a.x = cvt4_fp8(v0[16 * j + 0], v0[16 * j + 1], v0[16 * j + 2], v0[16 * j + 3]); a.y = cvt4_fp8(v0[16 * j + 4], v0[16 * j + 5], v0[16 * j + 6], v0[16 * j + 7]);
            a.z = cvt4_fp8(v0[16 * j + 8], v0[16 * j + 9], v0[16 * j + 10], v0[16 * j + 11]); a.w = cvt4_fp8(v0[16 * j + 12], v0[16 * j + 13], v0[16 * j + 14], v0[16 * j + 15]);
            b.x = cvt4_fp8(v1[16 * j + 0], v1[16 * j + 1], v1[16 * j + 2], v1[16 * j + 3]); b.y = cvt4_fp8(v1[16 * j + 4], v1[16 * j + 5], v1[16 * j + 6], v1[16 * j + 7]);
            b.z = cvt4_fp8(v1[16 * j + 8], v1[16 * j + 9], v1[16 * j + 10], v1[16 * j + 11]); b.w = cvt4_fp8(v1[16 * j + 12], v1[16 * j + 13], v1[16 * j + 14], v1[16 * j + 15]);
            *(u32x4*)(o0 + 16 * j) = a; *(u32x4*)(o1 + 16 * j) = b; }
    }
}
__device__ __forceinline__ void transpose_item(const float* W, int K, int N, bf16_t* WT, int kind, int item, int lane) {
    const int nblk = N / 128, kb = item / nblk, nb = item % nblk, k0 = 64 * kb, n0 = 128 * nb;
    const int d0 = n0 + 2 * lane, s0 = map_col(kind, d0), s1 = map_col(kind, d0 + 1);
    const bool adj = (kind != 4) || (n0 >= 2048);
#pragma unroll
    for (int h = 0; h < 2; ++h) {
        float v0[32], v1[32];
        const float* wp = W + (size_t)(k0 + 32 * h) * N;
        if (adj) {
#pragma unroll
            for (int kk = 0; kk < 32; ++kk) { const f32x2 t = *(const f32x2*)(wp + (size_t)kk * N + s0); v0[kk] = t[0]; v1[kk] = t[1]; }
        } else {
#pragma unroll
            for (int kk = 0; kk < 32; ++kk) { v0[kk] = wp[(size_t)kk * N + s0]; v1[kk] = wp[(size_t)kk * N + s1]; }
        }
        bf16_t* o0 = WT + (size_t)d0 * K + k0 + 32 * h; bf16_t* o1 = o0 + K;
#pragma unroll
        for (int j = 0; j < 4; ++j) {
            u32x4 a, b;
            a.x = cvt_pk_bf16(v0[8 * j + 0], v0[8 * j + 1]); a.y = cvt_pk_bf16(v0[8 * j + 2], v0[8 * j + 3]); a.z = cvt_pk_bf16(v0[8 * j + 4], v0[8 * j + 5]); a.w = cvt_pk_bf16(v0[8 * j + 6], v0[8 * j + 7]);
            b.x = cvt_pk_bf16(v1[8 * j + 0], v1[8 * j + 1]); b.y = cvt_pk_bf16(v1[8 * j + 2], v1[8 * j + 3]); b.z = cvt_pk_bf16(v1[8 * j + 4], v1[8 * j + 5]); b.w = cvt_pk_bf16(v1[8 * j + 6], v1[8 * j + 7]);
            *(u32x4*)(o0 + 8 * j) = a; *(u32x4*)(o1 + 8 * j) = b; }
    }
}
struct WDesc { int in_idx, K, N, nb, kind, f8; unsigned long long off; };
__constant__ WDesc g_wd[15] = {
    {8, 1024, 3072, 1, 1, 0, WO_L0_CONVIN}, {10, 1024, 1024, 1, 0, 0, WO_L0_CONVOUT}, {11, 1024, 5632, 1, 2, (MK_FP8_FFN >> 0) & 1, WO_L0_GU}, {12, 2816, 1024, 1, 0, (MK_FP8_FFN >> 0) & 1, WO_L0_DOWN},
    {17, 1024, 3072, 1, 4, MK_FP8_QKV, WO_L1_QKV}, {20, 1024, 1024, 1, 0, 0, WO_L1_WO}, {22, 1024, 5632, 8, 2, 1, WO_L1_MGU}, {23, 2816, 1024, 8, 0, 1, WO_L1_MDOWN},
    {36, 1024, 2048, 1, 3, MK_FP8_GLU, WO_L2_GLU}, {37, 1024, 5632, 1, 2, (MK_FP8_FFN >> 2) & 1, WO_L2_GU}, {38, 2816, 1024, 1, 0, (MK_FP8_FFN >> 2) & 1, WO_L2_DOWN},
    {43, 1024, 3072, 1, 1, 0, WO_L3_CONVIN}, {45, 1024, 1024, 1, 0, 0, WO_L3_CONVOUT}, {47, 1024, 5632, 8, 2, 1, WO_L3_MGU}, {48, 2816, 1024, 8, 0, 1, WO_L3_MDOWN}};

__device__ __forceinline__ void p0_weights(Ctx& F) {
    unsigned* ctr = (unsigned*)(F.ws + WS_CTL) + 64;
    for (;;) {
        unsigned it = 0;
        if (F.lane == 0) it = __hip_atomic_fetch_add(ctr, 1u, __ATOMIC_RELAXED, __HIP_MEMORY_SCOPE_AGENT);
        it = (unsigned)__builtin_amdgcn_readfirstlane((int)it);
        int base = 0, d = 0; bool found = false;
        for (; d < 15; ++d) { const int tot = (g_wd[d].K / (g_wd[d].f8 ? 128 : 64)) * (g_wd[d].N / 128) * g_wd[d].nb; if ((int)it < base + tot) { found = true; break; } base += tot; }
        if (!found) break;
        const int K = g_wd[d].K, N = g_wd[d].N, kind = g_wd[d].kind; const int per = (K / (g_wd[d].f8 ? 128 : 64)) * (N / 128);
        const float* W = F.inp(g_wd[d].in_idx); bf16_t* WT = (bf16_t*)(F.ws + WS_W + g_wd[d].off);
        const int li = (int)it - base, e = li / per, r = li - e * per;
        if (g_wd[d].f8) transpose_item8(W + (size_t)e * K * N, K, N, (unsigned char*)WT + (size_t)e * K * N, kind, r, F.lane);
        else transpose_item(W + (size_t)e * K * N, K, N, WT + (size_t)e * K * N, kind, r, F.lane);
    }
}
__device__ __forceinline__ void p0_adaln(Ctx& F, const int item0) {
    LAS float* scond = (LAS float*)(F.lds);
    LAS float* red = (LAS float*)(F.lds + 20480);
    bool have = false;
    for (int item = item0; item < 96; item += 1 << 20) {
        if (!have) {
            for (int i = F.tid; i < 5 * 1024; i += NTHREADS) { const int cnd = i >> 10, k = i & 1023; const float v = cnd < 4 ? F.inp(IN_C)[cnd * 1024 + k] : F.inp(IN_CCTX)[k]; scond[i] = silu_f(v); }
            have = true; __syncthreads();
        }
        const int L = item / 24, cg = item % 24, col0 = cg * 256 + 4 * F.lane;
        const float* W = F.inp(lbase(L)) + col0; const float* bias = F.inp(lbase(L) + 1);
        f32x4 acc[5];
#pragma unroll
        for (int c = 0; c < 5; ++c) acc[c] = (f32x4){0.f, 0.f, 0.f, 0.f};
        const int kb = F.wave * 128;
#pragma unroll 8
        for (int k = 0; k < 128; ++k) { const f32x4 w = *(const f32x4*)(W + (size_t)(kb + k) * 6144);
#pragma unroll
            for (int c = 0; c < 5; ++c) acc[c] += scond[c * 1024 + kb + k] * w; }
#pragma unroll
        for (int c = 0; c < 5; ++c) *(f32x4*)(red + (F.wave * 5 + c) * 256 + 4 * F.lane) = acc[c];
        __syncthreads();
        float* MOD = (float*)(F.ws + WS_MOD) + (size_t)L * 5 * 6144;
        for (int i = F.tid; i < 5 * 256; i += NTHREADS) { const int c = i >> 8, j = i & 255; float s = bias[cg * 256 + j];
#pragma unroll
            for (int w = 0; w < 8; ++w) s += red[(w * 5 + c) * 256 + j];
            MOD[c * 6144 + cg * 256 + j] = s; }
        __syncthreads();
    }
}
__device__ __forceinline__ void p0_misc(Ctx& F) {
    { float* cosT = (float*)(F.ws + WS_ROPE); float* sinT = cosT + 128 * 16;
        for (int i = F.tid; i < 128 * 16; i += NTHREADS) { const int pos = i >> 4, f = i & 15; const float inv = powf(10000.0f, -(float)f / 16.0f); const float ang = (float)pos * inv; cosT[i] = cosf(ang); sinT[i] = sinf(ang); } }
}
__device__ __forceinline__ void p0_s5mats(Ctx& F, const int g0) {
    const int LB = lbase(2);
    const float* a_re = F.inp(LB + 4); const float* a_im = F.inp(LB + 5); const float* log_dt = F.inp(LB + 6); const float* b_re = F.inp(LB + 7); const float* b_im = F.inp(LB + 8);
    const float* c_re = F.inp(LB + 9); const float* c_im = F.inp(LB + 10); const float* dsk = F.inp(LB + 11);
    LAS float* AP = (LAS float*)F.lds;
    LAS float* BB = AP + 2 * 17 * 64 * 2;
    LAS float* CC = BB + 2 * 64 * 16 * 2;
    LAS float* KK = CC + 2 * 16 * 64 * 2;
    for (int g = g0; g < 64; g += 1 << 20) {
        __syncthreads();
        for (int i = F.tid; i < 2 * 17 * 64; i += NTHREADS) { const int d = i / (17 * 64), r = i % (17 * 64), j = r / 64, p = r % 64;
            const float dt = expf(log_dt[d * 64 + g]); const float ar = a_re[(d * 64 + g) * 64 + p], ai = a_im[(d * 64 + g) * 64 + p];
            const float mag = expf((float)j * dt * ar), ph = (float)j * dt * ai; AP[i * 2] = mag * cosf(ph); AP[i * 2 + 1] = mag * sinf(ph); }
        for (int i = F.tid; i < 2 * 64 * 16; i += NTHREADS) { const int d = i / 1024, r = i % 1024, p = r / 16, s = r % 16;
            const float dt = expf(log_dt[d * 64 + g]); const float ar = a_re[(d * 64 + g) * 64 + p], ai = a_im[(d * 64 + g) * 64 + p];
            const float mag = expf(dt * ar), abr = mag * cosf(dt * ai), abi = mag * sinf(dt * ai), den = ar * ar + ai * ai, nr = abr - 1.0f;
            const float cor = (nr * ar + abi * ai) / den, coi = (abi * ar - nr * ai) / den;
            const float br = b_re[((size_t)(d * 64 + g) * 64 + p) * 16 + s], bi = b_im[((size_t)(d * 64 + g) * 64 + p) * 16 + s];
            BB[i * 2] = cor * br - coi * bi; BB[i * 2 + 1] = cor * bi + coi * br;
            const int s2 = r / 64, p2 = r % 64;
            CC[i * 2] = c_re[((size_t)(d * 64 + g) * 16 + s2) * 64 + p2]; CC[i * 2 + 1] = c_im[((size_t)(d * 64 + g) * 16 + s2) * 64 + p2]; }
        __syncthreads();
        for (int i = F.tid; i < 2 * 16 * 256; i += NTHREADS) { const int d = i >> 12, j = (i >> 8) & 15, so = (i >> 4) & 15, si = i & 15; float s = 0.f;
            for (int p = 0; p < 64; ++p) { const float cr = CC[((d * 16 + so) * 64 + p) * 2], ci = CC[((d * 16 + so) * 64 + p) * 2 + 1];
                const float pr = AP[((d * 17 + j) * 64 + p) * 2], pi = AP[((d * 17 + j) * 64 + p) * 2 + 1];
                const float br = BB[((d * 64 + p) * 16 + si) * 2], bi = BB[((d * 64 + p) * 16 + si) * 2 + 1];
                const float wr_ = cr * pr - ci * pi, wi_ = cr * pi + ci * pr; s += wr_ * br - wi_ * bi; }
            KK[i] = s; }
        __syncthreads();
        bf16_t* M1 = (bf16_t*)(F.ws + WS_S5M1) + (size_t)g * 256 * 256; bf16_t* M3 = (bf16_t*)(F.ws + WS_S5M3) + (size_t)g * 256 * 512;
        for (int i = F.tid; i < 256 * 256; i += NTHREADS) { const int n = i >> 8, k = i & 255, d = n >> 7, p = (n & 127) >> 1, c = n & 1, tp = k >> 4, si = k & 15; const int e = d ? tp : 15 - tp;
            const float pr = AP[((d * 17 + e) * 64 + p) * 2], pi = AP[((d * 17 + e) * 64 + p) * 2 + 1], br = BB[((d * 64 + p) * 16 + si) * 2], bi = BB[((d * 64 + p) * 16 + si) * 2 + 1];
            const float v = c ? (pr * bi + pi * br) : (pr * br - pi * bi); M1[i] = (bf16_t)(cvt_pk_bf16(v, 0.f) & 0xffffu); }
        for (int i = F.tid; i < 256 * 512; i += NTHREADS) { const int n = i >> 9, k = i & 511, t = n >> 4, so = n & 15; float v;
            if (k < 256) { const int tp = k >> 4, si = k & 15;
                if (t > tp) v = KK[((0 * 16 + (t - tp)) * 16 + so) * 16 + si];
                else if (t < tp) v = KK[((1 * 16 + (tp - t)) * 16 + so) * 16 + si];
                else { v = KK[((0 * 16 + 0) * 16 + so) * 16 + si] + KK[((1 * 16 + 0) * 16 + so) * 16 + si]; if (si == so) v += dsk[g * 16 + si]; } }
            else { const int q = k - 256, d = q >> 7, p = (q & 127) >> 1, c = q & 1; const int e = d ? 16 - t : t + 1;
                const float cr = CC[((d * 16 + so) * 64 + p) * 2], ci = CC[((d * 16 + so) * 64 + p) * 2 + 1], pr = AP[((d * 17 + e) * 64 + p) * 2], pi = AP[((d * 17 + e) * 64 + p) * 2 + 1];
                v = c ? -(cr * pi + ci * pr) : (cr * pr - ci * pi); }
            M3[i] = (bf16_t)(cvt_pk_bf16(v, 0.f) & 0xffffu); }
    }
    __syncthreads();
}

__device__ __forceinline__ void p0_prologue(Ctx& F, volatile LAS unsigned* MISC) {
    unsigned* ctr = (unsigned*)(F.ws + WS_CTL) + 128;
    for (;;) {
        __syncthreads();
        if (F.tid == 0) MISC[16] = __hip_atomic_fetch_add(ctr, 1u, __ATOMIC_RELAXED, __HIP_MEMORY_SCOPE_AGENT);
        __syncthreads();
        const int item = (int)MISC[16];
        if (item >= 161) break;
        if (item < 96) p0_adaln(F, item); else if (item < 160) p0_s5mats(F, item - 96); else p0_misc(F);
    }
    __syncthreads();
    p0_weights(F);
}
template <int MODE, bool COMB, bool FROM_IN = false>
__device__ __forceinline__ void row_pass(Ctx& F, int L, bool latent_only, int jsh  , int Lprev, bool out8 = false) {
    xel_t* X = (xel_t*)(F.ws + WS_X); bf16_t* HL = (bf16_t*)(F.ws + WS_HL);
    const float* MOD = (const float*)(F.ws + WS_MOD) + (size_t)L * 5 * 6144; const float* MODP = (const float*)(F.ws + WS_MOD) + (size_t)Lprev * 5 * 6144;
    const float* gain = MODE == 2 ? F.inp(IN_FINAL) : F.inp(lbase(L) + (jsh ? 3 : 2));
    const int nrows = latent_only ? NB * SEQ : MALL;
    const int rpw = (nrows + F.G - 1) / F.G;
    const int r0 = F.bid * rpw, r1 = min(nrows, r0 + rpw);
    LAS float* wrl = (LAS float*)F.lds;
    LAS int* hist = (LAS int*)(F.lds + 32768);
    if (MODE == 1) { const float* wrt = F.inp(lbase(L) + (L == 1 ? 8 : 7));
        for (int i = F.tid; i < 8192; i += NTHREADS) wrl[i] = wrt[i];
        if (F.tid < 8) hist[F.tid] = 0;
        __syncthreads(); }
    const bf16_t* OP = (const bf16_t*)(F.ws + WS_BIG + BIG_APERM);
    const int4* SEL = (const int4*)(F.ws + WS_SEL); const int2* SLOT = (const int2*)(F.ws + WS_SLOT);
    int cur_cond = -1; f32x4 ca[4], cb[4], gp[4];
    for (int lr = r0 + F.wave; lr < r1; lr += NWAVES) {
        const int row = latent_only ? (lr >> 13) * RPB + CTXL + (lr & 8191) : lr;
        const int cond = row_cond(row);
        if (cond != cur_cond) { cur_cond = cond;
#pragma unroll
            for (int q = 0; q < 4; ++q) { const int col = 4 * F.lane + 256 * q; const f32x4 g4 = *(const f32x4*)(gain + col);
                if (MODE == 2) { ca[q] = g4; cb[q] = (f32x4){0.f, 0.f, 0.f, 0.f}; }
                else { const f32x4 sh = *(const f32x4*)(MOD + cond * 6144 + jsh * 1024 + col), sc = *(const f32x4*)(MOD + cond * 6144 + (jsh + 1) * 1024 + col); ca[q] = g4 * (1.0f + sc); cb[q] = sh; }
                if (COMB) gp[q] = *(const f32x4*)(MODP + cond * 6144 + 5 * 1024 + col); } }
        xel_t* xr = X + (size_t)row * DM + 4 * F.lane;
        f32x4 v[4];
        if (FROM_IN) { const int b_ = row / RPB, j_ = row - b_ * RPB; const f32x4* xi = (const f32x4*)(j_ < CTXL ? F.inp(IN_CTX) + ((size_t)b_ * CTXL + j_) * DM : F.inp(IN_X) + ((size_t)b_ * SEQ + (j_ - CTXL)) * DM) + F.lane;
#pragma unroll
            for (int q = 0; q < 4; ++q) v[q] = xi[64 * q];
        } else {
#pragma unroll
            for (int q = 0; q < 4; ++q) v[q] = x_ld4(xr + 256 * q); }
        if (COMB && !((MK_DBG_NOMOE >> (Lprev == 1 ? 0 : 1)) & 1)) {
            const int4 sel = SEL[row]; const int2 sl = SLOT[row]; const float w0 = __int_as_float(sel.z), w1 = __int_as_float(sel.w);
            const u32x2* o0 = (const u32x2*)(OP + (size_t)sl.x * DM) + F.lane; const u32x2* o1 = (const u32x2*)(OP + (size_t)sl.y * DM) + F.lane;
#pragma unroll
            for (int q = 0; q < 4; ++q) { const u32x2 a = o0[64 * q], b = o1[64 * q];
                f32x4 m; m[0] = w0 * bf_lo(a.x) + w1 * bf_lo(b.x); m[1] = w0 * bf_hi(a.x) + w1 * bf_hi(b.x); m[2] = w0 * bf_lo(a.y) + w1 * bf_lo(b.y); m[3] = w0 * bf_hi(a.y) + w1 * bf_hi(b.y);
                v[q] = v[q] + gp[q] * m; if (MODE != 2) x_st4(xr + 256 * q, v[q]); }
        }
        float ss = 0.f;
#pragma unroll
        for (int q = 0; q < 4; ++q) ss += (v[q][0] * v[q][0] + v[q][1] * v[q][1]) + (v[q][2] * v[q][2] + v[q][3] * v[q][3]);
        const float rstd = 1.0f / sqrtf(wave_sum(ss) * (1.0f / DM) + EPS);
        f32x4 h[4];
#pragma unroll
        for (int q = 0; q < 4; ++q) h[q] = (v[q] * rstd) * ca[q] + cb[q];
        if (MODE == 2) { const int b = row / RPB, t = row - b * RPB - CTXL; f32x4* o4 = (f32x4*)(F.out + ((size_t)b * SEQ + t) * DM) + F.lane;
#pragma unroll
            for (int q = 0; q < 4; ++q) o4[64 * q] = h[q];
        } else {
            if (out8) { unsigned* o4 = (unsigned*)((unsigned char*)HL + (size_t)row * DM) + F.lane;
#pragma unroll
                for (int q = 0; q < 4; ++q) o4[64 * q] = cvt4_fp8(h[q][0], h[q][1], h[q][2], h[q][3]);
            } else {
            u32x2* o8 = (u32x2*)(HL + (size_t)row * DM) + F.lane;
#pragma unroll
            for (int q = 0; q < 4; ++q) { u32x2 w; w.x = cvt_pk_bf16(h[q][0], h[q][1]); w.y = cvt_pk_bf16(h[q][2], h[q][3]); o8[64 * q] = w; } }
        }
        if (MODE == 1) {
            float lg[8];
#pragma unroll
            for (int e = 0; e < 8; ++e) lg[e] = 0.f;
#pragma unroll
            for (int q = 0; q < 4; ++q)
#pragma unroll
                for (int i = 0; i < 4; ++i) { const int k = 4 * F.lane + 256 * q + i; const f32x4 wa = *(const LAS f32x4*)(wrl + k * 8), wb = *(const LAS f32x4*)(wrl + k * 8 + 4); const float hv = h[q][i];
                    lg[0] += hv * wa[0]; lg[1] += hv * wa[1]; lg[2] += hv * wa[2]; lg[3] += hv * wa[3]; lg[4] += hv * wb[0]; lg[5] += hv * wb[1]; lg[6] += hv * wb[2]; lg[7] += hv * wb[3]; }
#pragma unroll
            for (int e = 0; e < 8; ++e) lg[e] = wave_sum(lg[e]);
            int e0 = 0; float v0 = lg[0];
#pragma unroll
            for (int e = 1; e < 8; ++e) if (lg[e] > v0) { v0 = lg[e]; e0 = e; }
            int e1 = -1; float v1 = -INFINITY;
#pragma unroll
            for (int e = 0; e < 8; ++e) if (e != e0 && lg[e] > v1) { v1 = lg[e]; e1 = e; }
            const float ex = __expf(v1 - v0), w0 = 1.0f / (1.0f + ex), w1 = ex * w0;
            if (F.lane == 0) { ((int4*)(F.ws + WS_SEL))[row] = make_int4(e0, e1, __float_as_int(w0), __float_as_int(w1)); atomicAdd((int*)(hist + e0), 1); atomicAdd((int*)(hist + e1), 1); }
        }
    }
    if (MODE == 1) { __syncthreads(); if (F.tid < 8) ((int*)(F.ws + WS_CNT))[F.bid * 8 + F.tid] = hist[F.tid]; __syncthreads(); }
}

__device__ __forceinline__ void conv_pass(Ctx& F, int L, bool latent_only) {
    const bf16_t* BZ = (const bf16_t*)(F.ws + WS_BIG + BIG_BZ); bf16_t* U = (bf16_t*)(F.ws + WS_BIG + BIG_U);
    const float* cw = F.inp(lbase(L) + 5);
    const int nrows = latent_only ? NB * SEQ : MALL;
    const long nitems = (long)nrows * 128;
    for (long it = (long)F.bid * NTHREADS + F.tid; it < nitems; it += (long)F.G * NTHREADS) {
        const int lr = (int)(it >> 7), cgp = (int)(it & 127), col = cgp * 8;
        const int row = latent_only ? (lr >> 13) * RPB + CTXL + (lr & 8191) : lr;
        const int j = row % RPB; const bool first = (j == 0) || (j == CTXL), lastr = (j == CTXL - 1) || (j == RPB - 1);
        const u32x4 bb = *(const u32x4*)(BZ + (size_t)row * 2048 + col);
        const u32x4 zc = *(const u32x4*)(BZ + (size_t)row * 2048 + 1024 + col);
        u32x4 zp = (u32x4){0u, 0u, 0u, 0u}, zn = (u32x4){0u, 0u, 0u, 0u};
        if (!first) zp = *(const u32x4*)(BZ + (size_t)(row - 1) * 2048 + 1024 + col);
        if (!lastr) zn = *(const u32x4*)(BZ + (size_t)(row + 1) * 2048 + 1024 + col);
        const f32x4 w0a = *(const f32x4*)(cw + col), w0b = *(const f32x4*)(cw + col + 4), w1a = *(const f32x4*)(cw + 1024 + col), w1b = *(const f32x4*)(cw + 1024 + col + 4), w2a = *(const f32x4*)(cw + 2048 + col), w2b = *(const f32x4*)(cw + 2048 + col + 4);
        float y[8];
#define CV(i, W0, W1, W2, ZP, ZC, ZN, LO) y[i] = (W0) * (LO ? bf_lo(ZP) : bf_hi(ZP)) + (W1) * (LO ? bf_lo(ZC) : bf_hi(ZC)) + (W2) * (LO ? bf_lo(ZN) : bf_hi(ZN))
        CV(0, w0a[0], w1a[0], w2a[0], zp.x, zc.x, zn.x, 1); CV(1, w0a[1], w1a[1], w2a[1], zp.x, zc.x, zn.x, 0);
        CV(2, w0a[2], w1a[2], w2a[2], zp.y, zc.y, zn.y, 1); CV(3, w0a[3], w1a[3], w2a[3], zp.y, zc.y, zn.y, 0);
        CV(4, w0b[0], w1b[0], w2b[0], zp.z, zc.z, zn.z, 1); CV(5, w0b[1], w1b[1], w2b[1], zp.z, zc.z, zn.z, 0);
        CV(6, w0b[2], w1b[2], w2b[2], zp.w, zc.w, zn.w, 1); CV(7, w0b[3], w1b[3], w2b[3], zp.w, zc.w, zn.w, 0);
#undef CV
        u32x4 o; o.x = cvt_pk_bf16(bf_lo(bb.x) * y[0], bf_hi(bb.x) * y[1]); o.y = cvt_pk_bf16(bf_lo(bb.y) * y[2], bf_hi(bb.y) * y[3]);
        o.z = cvt_pk_bf16(bf_lo(bb.z) * y[4], bf_hi(bb.z) * y[5]); o.w = cvt_pk_bf16(bf_lo(bb.w) * y[6], bf_hi(bb.w) * y[7]);
        *(u32x4*)(U + (size_t)row * DM + col) = o;
    }
}

__device__ __forceinline__ void attn_combine(Ctx& F, int L) {
    const float* lamv = F.inp(lbase(L) + 5); const float* subln = F.inp(lbase(L) + 6);
    const float lam_init = 0.8f - 0.6f * expf(-0.3f * (float)L);
    float s01 = 0.f, s23 = 0.f;
    for (int i = 0; i < 64; ++i) { s01 += lamv[i] * lamv[64 + i]; s23 += lamv[128 + i] * lamv[192 + i]; }
    const float lam = expf(s01) - expf(s23) + lam_init, osc = 1.0f - lam_init;
    bf16_t* O0 = (bf16_t*)(F.ws + WS_BIG + BIG_O0); const bf16_t* O1 = (const bf16_t*)(F.ws + WS_HL);
    const int sub = F.lane & 15;
    const f32x4 g0 = *(const f32x4*)(subln + sub * 8), g1 = *(const f32x4*)(subln + sub * 8 + 4);
    const long nit = (long)MALL * NHEAD;
    for (long it = ((long)F.bid * NTHREADS + F.tid) >> 4; it < nit; it += ((long)F.G * NTHREADS) >> 4) {
        const size_t off = (size_t)it * 128 + sub * 8;
        const u32x4 a = *(const u32x4*)(O0 + off), b = *(const u32x4*)(O1 + off);
        float o[8];
        o[0] = bf_lo(a.x) - lam * bf_lo(b.x); o[1] = bf_hi(a.x) - lam * bf_hi(b.x); o[2] = bf_lo(a.y) - lam * bf_lo(b.y); o[3] = bf_hi(a.y) - lam * bf_hi(b.y);
        o[4] = bf_lo(a.z) - lam * bf_lo(b.z); o[5] = bf_hi(a.z) - lam * bf_hi(b.z); o[6] = bf_lo(a.w) - lam * bf_lo(b.w); o[7] = bf_hi(a.w) - lam * bf_hi(b.w);
        float ss = 0.f;
#pragma unroll
        for (int i = 0; i < 8; ++i) ss += o[i] * o[i];
        ss = row16_sum(ss);
        const float r = osc / sqrtf(ss * (1.0f / 128.0f) + EPS);
        u32x4 w; w.x = cvt_pk_bf16(o[0] * r * g0[0], o[1] * r * g0[1]); w.y = cvt_pk_bf16(o[2] * r * g0[2], o[3] * r * g0[3]);
        w.z = cvt_pk_bf16(o[4] * r * g1[0], o[5] * r * g1[1]); w.w = cvt_pk_bf16(o[6] * r * g1[2], o[7] * r * g1[3]);
        *(u32x4*)(O0 + off) = w;
    }
}

__device__ __forceinline__ void attn_phase(Ctx& F) {
    const bf16_t* Q = (const bf16_t*)(F.ws + WS_BIG + BIG_QKV); const bf16_t* KH = (const bf16_t*)(F.ws + WS_BIG + BIG_KH); const bf16_t* VH = (const bf16_t*)(F.ws + WS_BIG + BIG_VH);
    bf16_t* O0 = (bf16_t*)(F.ws + WS_BIG + BIG_O0); bf16_t* O1 = (bf16_t*)(F.ws + WS_HL);
    const int vcu = (F.G % 8 == 0) ? (F.bid % 8) * (F.G / 8) + F.bid / 8 : F.bid;
    for (int u = vcu; u < 2048 + 64; u += F.G) {
        int bh, qb; bool isctx = u >= 2048;
        if (!isctx) { bh = u >> 5; qb = u & 31; } else { bh = u - 2048; qb = 0; }
        const int b = bh >> 4, vh = bh & 15, h = vh >> 1, m = vh & 1;
        const size_t rowb = (size_t)b * RPB;
        const size_t qrow = isctx ? rowb : rowb + CTXL + (size_t)qb * 256;
        const bf16_t* Qb = Q + qrow * DM + h * 128 + m * 64;
        const bf16_t* Kh = KH + (size_t)(b * 16 + vh) * RPB * 64;
        const bf16_t* Vh = VH + (size_t)(b * 8 + h) * RPB * 128;
        bf16_t* Ob = (m ? O1 : O0) + qrow * DM + h * 128;
        att2::attn_unit(Qb, Kh, Vh, Ob, DM, isctx ? CTXL : RPB, F.lds, F.tid);
    }
}

__device__ __forceinline__ void v_transpose(Ctx& F) {
    const unsigned char* V8 = F.ws + WS_BIG + BIG_V8; unsigned char* VT8 = F.ws + WS_BIG + BIG_VT8;
    LAS unsigned char* buf = F.lds + F.wave * 8192;
    const int gw = F.bid * NWAVES + F.wave, NGW = F.G * NWAVES;
    for (int it = gw; it < NB * NHEAD * (RPB / 64); it += NGW) {
        const size_t tb = (size_t)it * 8192;
#pragma unroll
        for (int t = 0; t < 8; ++t) *(LAS u32x4*)(buf + (F.lane + 64 * t) * 16) = *(const u32x4*)(V8 + tb + (size_t)(F.lane + 64 * t) * 16);
        LDS_WAIT();
#pragma unroll
        for (int u = 0; u < 2; ++u) { const int d = F.lane + 64 * u;
#pragma unroll
            for (int q = 0; q < 4; ++q) { u32x4 w;
#pragma unroll
                for (int e = 0; e < 4; ++e) { unsigned x = 0;
#pragma unroll
                    for (int b = 0; b < 4; ++b) x |= (unsigned)buf[att3::slot_key(q * 16 + e * 4 + b) * 128 + d] << (8 * b);
                    w[e] = x; }
                *(u32x4*)(VT8 + tb + (size_t)d * 64 + q * 16) = w; } }
        LDS_WAIT();
    }
}
__device__ __forceinline__ void attn_phase3(Ctx& F, int L) {
    const unsigned char* Q8 = F.ws + WS_BIG + BIG_Q8; const unsigned char* K8 = F.ws + WS_BIG + BIG_K8; const unsigned char* VT8 = F.ws + WS_BIG + BIG_VT8;
    bf16_t* AO = (bf16_t*)(F.ws + WS_BIG + BIG_O0);
    const float* lamv = F.inp(lbase(L) + 5); const float* subln = F.inp(lbase(L) + 6);
    const float lam_init = 0.8f - 0.6f * expf(-0.3f * (float)L);
    float s01 = 0.f, s23 = 0.f;
    for (int i = 0; i < 64; ++i) { s01 += lamv[i] * lamv[64 + i]; s23 += lamv[128 + i] * lamv[192 + i]; }
    const float lam = expf(s01) - expf(s23) + lam_init, osc = 1.0f - lam_init;
    const int vcu = (F.G % 8 == 0) ? (F.bid % 8) * (F.G / 8) + F.bid / 8 : F.bid;
    for (int u = vcu; u < 1024 + 32; u += F.G) {
        int bh, qb; const bool isctx = u >= 1024;
        if (!isctx) { bh = u >> 5; qb = u & 31; } else { bh = u - 1024; qb = 0; }
        const int b = bh >> 3, h = bh & 7;
        const size_t rowb = (size_t)b * RPB;
        const size_t qrow = isctx ? rowb : rowb + CTXL + (size_t)qb * 256;
        att3::attn_unit(Q8 + qrow * DM + h * 128, K8 + (size_t)(b * 16 + 2 * h) * RPB * 64, (size_t)RPB * 64, VT8 + (size_t)(b * 8 + h) * RPB * 128, AO + qrow * DM + h * 128, DM, isctx ? CTXL : RPB,
                        lam, osc, subln, F.lds, F.tid);
    }
}

__device__ __forceinline__ void moe_scatter(Ctx& F, bool latent_only) {
    const int nrows = latent_only ? NB * SEQ : MALL;
    const int rpw = (nrows + F.G - 1) / F.G, r0 = F.bid * rpw, r1 = min(nrows, r0 + rpw);
    LAS int* tot = (LAS int*)F.lds; LAS int* pre = tot + 8; LAS int* base = tot + 16; LAS int* offs = tot + 24;
    LAS int* selc = tot + 64;
    LAS int* slc = selc + 1024;
    const int* CNT = (const int*)(F.ws + WS_CNT); const int4* SEL = (const int4*)(F.ws + WS_SEL); int2* SLOT = (int2*)(F.ws + WS_SLOT); int* TEXP = (int*)(F.ws + WS_TEXP);
    if (F.tid < 8) { int t = 0, p = 0; for (int w = 0; w < F.G; ++w) { const int c = CNT[w * 8 + F.tid]; t += c; if (w < F.bid) p += c; } tot[F.tid] = t; pre[F.tid] = p; }
    for (int i = F.tid; i < r1 - r0; i += NTHREADS) { const int lr = r0 + i; const int row = latent_only ? (lr >> 13) * RPB + CTXL + (lr & 8191) : lr; const int4 s = SEL[row]; selc[i] = s.x | (s.y << 8); }
    __syncthreads();
    if (F.tid == 0) { int o = 0; for (int e = 0; e < 8; ++e) { offs[e] = o; base[e] = o + pre[e]; o += (tot[e] + 255) & ~255; } offs[8] = o;
        for (int i = 0; i < r1 - r0; ++i) { const int s = selc[i], e0 = s & 255, e1 = s >> 8; slc[2 * i] = base[e0]++; slc[2 * i + 1] = base[e1]++; } }
    __syncthreads();
    if (F.bid == 0) { const int nT = offs[8] >> 8; for (int t = F.tid; t < nT; t += NTHREADS) { int e = 0; while (e < 7 && t * 256 >= offs[e + 1]) ++e; TEXP[t] = e; } if (F.tid == 0) TEXP[500] = nT; }
    const bf16_t* HL = (const bf16_t*)(F.ws + WS_HL); unsigned char* AP8 = (unsigned char*)(F.ws + WS_BIG + BIG_APERM);
    for (int i = F.wave; i < r1 - r0; i += NWAVES) { const int lr = r0 + i; const int row = latent_only ? (lr >> 13) * RPB + CTXL + (lr & 8191) : lr;
        const int s0 = slc[2 * i], s1 = slc[2 * i + 1];
        if (F.lane == 0) SLOT[row] = make_int2(s0, s1);
        const u32x4* src = (const u32x4*)(HL + (size_t)row * DM) + F.lane; const u32x4 a = src[0], b = src[64];
        u32x2 qa, qb; qa.x = cvt4_fp8(bf_lo(a.x), bf_hi(a.x), bf_lo(a.y), bf_hi(a.y)); qa.y = cvt4_fp8(bf_lo(a.z), bf_hi(a.z), bf_lo(a.w), bf_hi(a.w));
        qb.x = cvt4_fp8(bf_lo(b.x), bf_hi(b.x), bf_lo(b.y), bf_hi(b.y)); qb.y = cvt4_fp8(bf_lo(b.z), bf_hi(b.z), bf_lo(b.w), bf_hi(b.w));
        u32x2* d0 = (u32x2*)(AP8 + (size_t)s0 * DM) + F.lane; u32x2* d1 = (u32x2*)(AP8 + (size_t)s1 * DM) + F.lane;
        d0[0] = qa; d0[64] = qb; d1[0] = qa; d1[64] = qb; }
    __syncthreads();
}

__device__ __forceinline__ void s5_scan(Ctx& F) {
    const int LB = lbase(2);
    const float* a_re = F.inp(LB + 4); const float* a_im = F.inp(LB + 5); const float* log_dt = F.inp(LB + 6);
    const float* H = (const float*)(F.ws + WS_BIG + BIG_H); bf16_t* SB = (bf16_t*)(F.ws + WS_BIG + BIG_SBUF);
    LAS float* ex = (LAS float*)F.lds;
    constexpr int QS = CPB / 4;
    for (int pair = F.bid; pair < 256; pair += F.G) {
        const int task = 2 * pair + (F.wave >> 2), seg = F.wave & 3;
        const int b = task >> 7, d = (task >> 6) & 1, g = task & 63, p = F.lane;
        const float dt = expf(log_dt[d * 64 + g]); const float ar = a_re[(d * 64 + g) * 64 + p], ai = a_im[(d * 64 + g) * 64 + p];
        const float mag = expf(16.0f * dt * ar), ph = 16.0f * dt * ai, Ar = mag * cosf(ph), Ai = mag * sinf(ph);
        const float magq = expf((16.0f * QS) * dt * ar), phq = (16.0f * QS) * dt * ai, Qr = magq * cosf(phq), Qi = magq * sinf(phq);
        const int v = d * 128 + 2 * p, tt = v >> 4, ss = v & 15;
        const float* Hb = H + ((size_t)b * CPB * 64 + g) * 256 + v;
        bf16_t* Sb = SB + ((size_t)b * RPB + tt) * DM + g * 16 + ss;
        float er = 0.f, ei = 0.f;
        for (int s0 = seg * QS; s0 < (seg + 1) * QS; s0 += 4) {
            f32x2 hv[4];
#pragma unroll
            for (int i = 0; i < 4; ++i) { const int st = s0 + i; const int c = d ? (st < 16 ? 15 - st : CPB - 1 - (st - 16)) : st; hv[i] = *(const f32x2*)(Hb + (size_t)c * 64 * 256); }
#pragma unroll
            for (int i = 0; i < 4; ++i) { const float nr = Ar * er - Ai * ei + hv[i][0], ni = Ar * ei + Ai * er + hv[i][1]; er = nr; ei = ni; }
        }
        __syncthreads();
        ex[(F.wave * 64 + p) * 2] = er; ex[(F.wave * 64 + p) * 2 + 1] = ei;
        __syncthreads();
        er = 0.f; ei = 0.f;
        for (int q = 0; q < seg; ++q) { const int w = (F.wave & 4) + q; const float xr_ = ex[(w * 64 + p) * 2], xi_ = ex[(w * 64 + p) * 2 + 1];
            const float nr = Qr * er - Qi * ei + xr_, ni = Qr * ei + Qi * er + xi_; er = nr; ei = ni; }
        for (int s0 = seg * QS; s0 < (seg + 1) * QS; s0 += 4) {
            f32x2 hv[4]; int cc[4];
#pragma unroll
            for (int i = 0; i < 4; ++i) { const int st = s0 + i; cc[i] = d ? (st < 16 ? 15 - st : CPB - 1 - (st - 16)) : st; hv[i] = *(const f32x2*)(Hb + (size_t)cc[i] * 64 * 256); }
#pragma unroll
            for (int i = 0; i < 4; ++i) { *(unsigned*)(Sb + (size_t)cc[i] * 16 * DM) = cvt_pk_bf16(er, ei);
                const float nr = Ar * er - Ai * ei + hv[i][0], ni = Ar * ei + Ai * er + hv[i][1]; er = nr; ei = ni; }
        }
    }
}

__global__ void __launch_bounds__(NTHREADS, 2) mk_fwd(Args args) {
    extern __shared__ __attribute__((aligned(16))) unsigned char lds[];
    Ctx F;
    F.lds = (LAS unsigned char*)lds;
    F.tid = threadIdx.x; F.lane = F.tid & 63; F.wave = __builtin_amdgcn_readfirstlane(F.tid >> 6);
    F.G = gridDim.x; F.bid = blockIdx.x; F.ws = args.ws; F.out = args.out;
    volatile LAS unsigned* MISC = (volatile LAS unsigned*)(F.lds + MISC_OFF);
    if (F.tid < 32) MISC[F.tid] = 0u;
    if (F.tid == 0) {
#pragma unroll
        for (int i = 0; i < 50; ++i) *(LAS unsigned long long*)(F.lds + INTAB_OFF + 8 * i) = (unsigned long long)(uintptr_t)args.in[i]; }
    __syncthreads();
    const int lo = args.ph_lo, hi = args.ph_hi;
    XcdBarrier bar; bar.bar = (unsigned*)(F.ws + WS_CTL) + 1024; bar.x = 0; bar.st = nullptr;
    if (hi - lo > 1) bar = xcd_barrier_post((unsigned*)(F.ws + WS_CTL) + 1024, MISC + 8);
    int ph = 0;
#define LAUNDER() do { F.ws = launder_ptr(F.ws); F.out = launder_ptr(F.out); F.wave = launder_i(F.wave); asm volatile("v_mbcnt_lo_u32_b32 %0, -1, 0\n\tv_mbcnt_hi_u32_b32 %0, -1, %0" : "=v"(F.lane));     F.tid = F.wave * 64 + F.lane; \
    F.G = launder_i(F.G); F.bid = launder_i(F.bid); } while (0)
#define PHASE(id, ...) do { if (lo <= ph && ph < hi) { LAUNDER(); if ((MK_SITEMASK >> (id)) & 1u) { __VA_ARGS__; } if ((id) == MK_REPEAT_SITE) { __syncthreads(); LAUNDER(); __VA_ARGS__; } if (ph + 1 < hi) xcd_barrier(bar); } ++ph; } while (0)

#define WSB (F.ws)
#define XPTR ((xel_t*)(F.ws + WS_X))
#define HLPTR ((bf16_t*)(F.ws + WS_HL))
#define VBID (F.bid)
#define MODPTR ((const float*)(F.ws + WS_MOD) + (size_t)L * 5 * 6144)

    PHASE(0, p0_prologue(F, MISC));
#if MK_EXTRA_BARS
    if (hi - lo > 1) for (int eb = 0; eb < MK_EXTRA_BARS; ++eb) xcd_barrier(bar);
#endif

    for (int L = 0; L < 4; ++L) {
        const int kind = L % 3; const bool moe = (L & 1) != 0;
        const bool lat = (L >= 2);
        if (L == 2) PHASE(1, (row_pass<0, true>(F, L, false, 0, L - 1)));
        else if (L == 0) PHASE(2, (row_pass<0, false, true>(F, L, false, 0, 0)));
        else PHASE(3, (row_pass<0, false>(F, L, lat, 0, 0, L == 1 && MK_FP8_QKV)));
        if (kind == 0) {
            const size_t wo_in = (L == 0) ? WO_L0_CONVIN : WO_L3_CONVIN, wo_out = (L == 0) ? WO_L0_CONVOUT : WO_L3_CONVOUT;
            PHASE(4, { pg8::ProbPlain P{(const char*)HLPTR, (const char*)(WSB + WS_W + wo_in), 2048, 2048, 16, lat ? NT_LAT : NT_ALL, 12, F.G, VBID, lat};
                    pg8::EpiGated<0> E{(bf16_t*)(WSB + WS_BIG + BIG_BZ), 2048, 4, 1024, 0};
                    pg8::gemm_phase<pg8::EpiGated<0>, pg8::ProbPlain, true>(F.lds, P, E, F.tid); });
            PHASE(5, conv_pass(F, L, lat));
            PHASE(6, { pg8::ProbPlain P{(const char*)(WSB + WS_BIG + BIG_U), (const char*)(WSB + WS_W + wo_out), 2048, 2048, 16, lat ? NT_LAT : NT_ALL, 4, F.G, VBID, lat};
                    pg8::EpiResid E{XPTR, MODPTR + 2 * 1024, L == 0 ? F.inp(IN_X) : nullptr, L == 0 ? F.inp(IN_CTX) : nullptr, 1.f};
                    pg8::gemm_phase<pg8::EpiResid, pg8::ProbPlain, true>(F.lds, P, E, F.tid); });
        } else if (kind == 1) {
            if (MK_FP8_QKV) {
            PHASE(25, { pg8::ProbPlain P{(const char*)HLPTR, (const char*)(WSB + WS_W + WO_L1_QKV), 1024, 1024, 8, NT_ALL, 12, F.G, VBID, false};
                    pg8::EpiQkv<MK_ATT3 != 0, true> E{WSB + WS_BIG, (const float*)(WSB + WS_ROPE)};
                    pg8::gemm_phase<pg8::EpiQkv<MK_ATT3 != 0, true>, pg8::ProbPlain, true, true>(F.lds, P, E, F.tid); });
            } else {
            PHASE(7, { pg8::ProbPlain P{(const char*)HLPTR, (const char*)(WSB + WS_W + WO_L1_QKV), 2048, 2048, 16, NT_ALL, 12, F.G, VBID, false};
                    pg8::EpiQkv<MK_ATT3 != 0, false> E{WSB + WS_BIG, (const float*)(WSB + WS_ROPE)};
                    pg8::gemm_phase<pg8::EpiQkv<MK_ATT3 != 0, false>, pg8::ProbPlain, true>(F.lds, P, E, F.tid); });
            }
            if (MK_ATT3) { PHASE(27, v_transpose(F)); PHASE(28, attn_phase3(F, L)); }
            else { PHASE(8, attn_phase(F)); PHASE(9, attn_combine(F, L)); }
            PHASE(10, { pg8::ProbPlain P{(const char*)(WSB + WS_BIG + BIG_O0), (const char*)(WSB + WS_W + WO_L1_WO), 2048, 2048, 16, NT_ALL, 4, F.G, VBID, false};
                    pg8::EpiResid E{XPTR, MODPTR + 2 * 1024, nullptr, nullptr, 1.f};
                    pg8::gemm_phase<pg8::EpiResid, pg8::ProbPlain, true>(F.lds, P, E, F.tid); });
        } else {
            PHASE(11, { pg8::ProbS5 P{(const char*)HLPTR, (const char*)HLPTR, (const char*)(WSB + WS_S5M1), 4, 4, 9, F.G, VBID, (size_t)256 * 256 * 2, false};
                    pg8::EpiS1 E{(float*)(WSB + WS_BIG + BIG_H)};
                    pg8::gemm_phase<pg8::EpiS1, pg8::ProbS5, true>(F.lds, P, E, F.tid); });
            PHASE(12, s5_scan(F));
            PHASE(13, { pg8::ProbS5 P{(const char*)HLPTR, (const char*)(WSB + WS_BIG + BIG_SBUF), (const char*)(WSB + WS_S5M3), 8, 4, 8, F.G, VBID, (size_t)256 * 512 * 2, true};
                    pg8::EpiS3 E{(bf16_t*)(WSB + WS_BIG + BIG_YG), MK_FP8_GLU != 0};
                    pg8::gemm_phase<pg8::EpiS3, pg8::ProbS5, true>(F.lds, P, E, F.tid); });
            if (MK_FP8_GLU) {
            PHASE(26, { pg8::ProbPlain P{(const char*)(WSB + WS_BIG + BIG_YG), (const char*)(WSB + WS_W + WO_L2_GLU), 1024, 1024, 8, NT_LAT, 8, F.G, VBID, true};
                    pg8::EpiGlu E{XPTR, MODPTR + 2 * 1024, pg8::W8INV};
                    pg8::gemm_phase<pg8::EpiGlu, pg8::ProbPlain, true, true>(F.lds, P, E, F.tid); });
            } else {
            PHASE(14, { pg8::ProbPlain P{(const char*)(WSB + WS_BIG + BIG_YG), (const char*)(WSB + WS_W + WO_L2_GLU), 2048, 2048, 16, NT_LAT, 8, F.G, VBID, true};
                    pg8::EpiGlu E{XPTR, MODPTR + 2 * 1024, 1.f};
                    pg8::gemm_phase<pg8::EpiGlu, pg8::ProbPlain, true>(F.lds, P, E, F.tid); });
            }
        }
        if (moe) PHASE(15, (row_pass<1, false>(F, L, lat, 3, 0)));
        else PHASE(16, (row_pass<0, false>(F, L, lat, 3, 0, ((MK_FP8_FFN >> L) & 1) != 0)));
        if (!moe) {
            const size_t wo_gu = (L == 0) ? WO_L0_GU : WO_L2_GU, wo_dn = (L == 0) ? WO_L0_DOWN : WO_L2_DOWN;
            if ((MK_FP8_FFN >> L) & 1) {
                PHASE(23, { pg8::ProbPlain P{(const char*)HLPTR, (const char*)(WSB + WS_W + wo_gu), 1024, 1024, 8, lat ? NT_LAT : NT_ALL, 22, F.G, VBID, lat};
                        pg8::EpiGated8 E{(unsigned char*)(WSB + WS_BIG + BIG_HID), DFF, pg8::W8INV};
                        pg8::gemm_phase<pg8::EpiGated8, pg8::ProbPlain, true, true>(F.lds, P, E, F.tid); });
                PHASE(24, { pg8::ProbPlain P{(const char*)(WSB + WS_BIG + BIG_HID), (const char*)(WSB + WS_W + wo_dn), DFF, DFF, 22, lat ? NT_LAT : NT_ALL, 4, F.G, VBID, lat};
                        pg8::EpiResid E{XPTR, MODPTR + 5 * 1024, nullptr, nullptr, pg8::W8INV};
                        pg8::gemm_phase<pg8::EpiResid, pg8::ProbPlain, true, true>(F.lds, P, E, F.tid); });
            } else {
            PHASE(17, { pg8::ProbPlain P{(const char*)HLPTR, (const char*)(WSB + WS_W + wo_gu), 2048, 2048, 16, lat ? NT_LAT : NT_ALL, 22, F.G, VBID, lat};
                    pg8::EpiGated<1> E{(bf16_t*)(WSB + WS_BIG + BIG_HID), DFF, 0, 0, 0};
                    pg8::gemm_phase<pg8::EpiGated<1>, pg8::ProbPlain, true>(F.lds, P, E, F.tid); });
            PHASE(18, { pg8::ProbPlain P{(const char*)(WSB + WS_BIG + BIG_HID), (const char*)(WSB + WS_W + wo_dn), DFF * 2, DFF * 2, 44, lat ? NT_LAT : NT_ALL, 4, F.G, VBID, lat};
                    pg8::EpiResid E{XPTR, MODPTR + 5 * 1024, nullptr, nullptr, 1.f};
                    pg8::gemm_phase<pg8::EpiResid, pg8::ProbPlain, true>(F.lds, P, E, F.tid); });
            }
        } else {
            const size_t wo_gu = (L == 1) ? WO_L1_MGU : WO_L3_MGU, wo_dn = (L == 1) ? WO_L1_MDOWN : WO_L3_MDOWN;
            PHASE(19, moe_scatter(F, lat));
#define TEXPP ((const int*)(F.ws + WS_TEXP))
            PHASE(20, { const int nT = __builtin_amdgcn_readfirstlane(TEXPP[500]);
                    pg8::ProbMoe P{(const char*)(WSB + WS_BIG + BIG_APERM), (const char*)(WSB + WS_W + wo_gu), 1024, 1024, 8, 22, F.G, VBID, WSZ_GU / 2, TEXPP, 0, nT, 0};
                    pg8::EpiGated8 E{(unsigned char*)(WSB + WS_BIG + BIG_MHID), DFF, pg8::W8INV};
                    pg8::gemm_phase<pg8::EpiGated8, pg8::ProbMoe, true, true>(F.lds, P, E, F.tid); });
            PHASE(21, { const int nT = __builtin_amdgcn_readfirstlane(TEXPP[500]);
                    pg8::ProbMoe P{(const char*)(WSB + WS_BIG + BIG_MHID), (const char*)(WSB + WS_W + wo_dn), DFF, DFF, 22, 4, F.G, VBID, WSZ_DOWN / 2, TEXPP, 0, nT, 0};
                    pg8::EpiBf16 E{(bf16_t*)(WSB + WS_BIG + BIG_APERM), DM, 0, pg8::W8INV};
                    pg8::gemm_phase<pg8::EpiBf16, pg8::ProbMoe, true, true>(F.lds, P, E, F.tid); });
        }
    }
    PHASE(22, (row_pass<2, true>(F, 3, true, 0, 3)));
#undef PHASE
#undef WSB
#undef XPTR
#undef HLPTR
#undef VBID
#undef MODPTR
#undef TEXPP
}
constexpr int N_PHASES = 1 + (1 + 3 + 1 + 2) + (1 + 4 + 1 + 1 + 2) + (1 + 4 + 1 + 2) + (1 + 3 + 1 + 1 + 2) + 1;

extern "C" void kernel_launch(void* const* d_in, const int* in_sizes, int n_in, void* d_out, int out_size, void* d_ws, size_t ws_size, hipStream_t stream) {
    static int grid = 0;
    if (grid == 0) {
        if (n_in != 50 || in_sizes[0] != NB * SEQ * DM || out_size != NB * SEQ * DM || ws_size < WS_END) {
            fprintf(stderr, "kernel_launch: unexpected shapes (n_in %d, in0 %d, out %d, ws %zu < %zu)\n", n_in, n_in > 0 ? in_sizes[0] : -1, out_size, ws_size, (size_t)WS_END); grid = -1; return; }
        int dev = 0, cus = 0, per_cu = 0;
        if (hipGetDevice(&dev) != hipSuccess || hipDeviceGetAttribute(&cus, hipDeviceAttributeMultiprocessorCount, dev) != hipSuccess) { grid = -1; return; }
        if (hipFuncSetAttribute((const void*)mk_fwd, hipFuncAttributeMaxDynamicSharedMemorySize, LDS_BYTES) != hipSuccess) { fprintf(stderr, "kernel_launch: hipFuncSetAttribute failed\n"); grid = -1; return; }
        if (hipOccupancyMaxActiveBlocksPerMultiprocessor(&per_cu, (const void*)mk_fwd, NTHREADS, LDS_BYTES) != hipSuccess || per_cu < 1) { fprintf(stderr, "kernel_launch: occupancy query says %d\n", per_cu); }
        (void)hipGetLastError();
        grid = cus;
    }
    if (grid < 0) return;
    (void)hipMemsetAsync((char*)d_ws + WS_CTL, 0, CTL_ZERO_BYTES, stream);
    Args a{};
    for (int i = 0; i < 50; ++i) a.in[i] = (const float*)d_in[i];
    a.out = (float*)d_out; a.ws = (unsigned char*)d_ws;
#if MK_ONE_LAUNCH
    a.ph_lo = 0; a.ph_hi = N_PHASES;
    hipLaunchKernelGGL(mk_fwd, dim3(grid), dim3(NTHREADS), LDS_BYTES, stream, a);
#else
    for (int p = 0; p < N_PHASES; ++p) { a.ph_lo = p; a.ph_hi = p + 1; hipLaunchKernelGGL(mk_fwd, dim3(grid), dim3(NTHREADS), LDS_BYTES, stream, a); }
#endif
    const hipError_t le = hipPeekAtLastError();
    if (le != hipSuccess) fprintf(stderr, "kernel_launch: launch failed: %s\n", hipGetErrorName(le));
}
```

```cpp
#include <hip/hip_runtime.h>
#include <hip/hip_bf16.h>
#include <cstdio>
#include <cstdint>
#include <cmath>

#ifndef MK_SITEMASK
#define MK_SITEMASK 0xffffffffu
#endif
#ifndef MK_REPEAT_SITE
#define MK_REPEAT_SITE -1
#endif
#ifndef MK_DBG_NOMOE
#define MK_DBG_NOMOE 0
#endif
#ifndef MK_EXTRA_BARS
#define MK_EXTRA_BARS 0
#endif
#ifndef MK_FP8_FFN
#define MK_FP8_FFN 0x4
#endif
#ifndef MK_FP8_QKV
#define MK_FP8_QKV 1
#endif
#ifndef MK_FP8_GLU
#define MK_FP8_GLU 1
#endif
#ifndef MK_ATT_XMFMA
#define MK_ATT_XMFMA 0
#endif
#ifndef MK_ATT_XEXP
#define MK_ATT_XEXP 0
#endif
#ifndef MK_ATT3
#define MK_ATT3 1
#endif
#ifndef MK_XBF16
#define MK_XBF16 1
#endif
#ifndef MK_ATT2
#define MK_ATT2 1
#endif
#ifndef MK_ONE_LAUNCH
#define MK_ONE_LAUNCH 1
#endif

constexpr int DM = 1024, NB = 4, SEQ = 8192, CTXL = 256, RPB = CTXL + SEQ, MALL = NB * RPB;
constexpr int TPB = RPB / 256, NT_ALL = MALL / 256, NT_LAT = NB * SEQ / 256;
constexpr int DFF = 2816, NE = 8, NHEAD = 8;
constexpr float EPS = 1e-6f;
constexpr int NWAVES = 8, NTHREADS = 512;
constexpr int CPB = RPB / 16;
constexpr int MOE_MAXT = 272;

constexpr size_t MiB = 1u << 20;
constexpr size_t WS_CTL = 0, CTL_ZERO_BYTES = 64 * 1024;
constexpr size_t WS_MOD = 1 * MiB;
constexpr size_t WS_ROPE = WS_MOD + 512 * 1024;
constexpr size_t WS_SEL = 2 * MiB;
constexpr size_t WS_SLOT = WS_SEL + (size_t)MALL * 16;
constexpr size_t WS_CNT = WS_SLOT + (size_t)MALL * 8;
constexpr size_t WS_TEXP = WS_CNT + 1024 * 8 * 4;
constexpr size_t WS_S5M3 = 8 * MiB;
constexpr size_t WS_S5M1 = 24 * MiB;
constexpr size_t WS_W = 32 * MiB;
constexpr size_t WS_X = 357 * MiB;
constexpr size_t WS_HL = 489 * MiB;
constexpr size_t WS_BIG = 555 * MiB;
constexpr size_t WS_END = 879 * MiB;
static_assert(WS_TEXP + 4096 <= WS_S5M3, "ws map");
constexpr size_t BIG_BZ = 0, BIG_U = 132 * MiB;
constexpr size_t BIG_Q8 = 0, BIG_K8 = 33 * MiB, BIG_V8 = 66 * MiB, BIG_VT8 = 99 * MiB;
constexpr size_t BIG_QKV = 0, BIG_KH = 66 * MiB, BIG_VH = 132 * MiB, BIG_O0 = 198 * MiB;
constexpr size_t BIG_HID = 0;
constexpr size_t BIG_APERM = 0, BIG_MHID = 136 * MiB;
constexpr size_t BIG_H = 0, BIG_SBUF = 144 * MiB, BIG_YG = 210 * MiB;
static_assert(BIG_MHID + (size_t)MOE_MAXT * 256 * DFF <= WS_END - WS_BIG && BIG_YG + 66 * MiB <= WS_END - WS_BIG && BIG_O0 + 66 * MiB <= WS_END - WS_BIG, "big map");

constexpr size_t WSZ_CONVIN = (size_t)3072 * 1024 * 2, WSZ_SQ = (size_t)1024 * 1024 * 2, WSZ_GU = (size_t)5632 * 1024 * 2, WSZ_DOWN = (size_t)1024 * 2816 * 2, WSZ_GLU = (size_t)2048 * 1024 * 2;
constexpr size_t WO_L0_CONVIN = 0, WO_L0_CONVOUT = WO_L0_CONVIN + WSZ_CONVIN, WO_L0_GU = WO_L0_CONVOUT + WSZ_SQ, WO_L0_DOWN = WO_L0_GU + WSZ_GU;
constexpr size_t WO_L1_QKV = WO_L0_DOWN + WSZ_DOWN, WO_L1_WO = WO_L1_QKV + WSZ_CONVIN, WO_L1_MGU = WO_L1_WO + WSZ_SQ, WO_L1_MDOWN = WO_L1_MGU + 8 * WSZ_GU;
constexpr size_t WO_L2_GLU = WO_L1_MDOWN + 8 * WSZ_DOWN, WO_L2_GU = WO_L2_GLU + WSZ_GLU, WO_L2_DOWN = WO_L2_GU + WSZ_GU;
constexpr size_t WO_L3_CONVIN = WO_L2_DOWN + WSZ_DOWN, WO_L3_CONVOUT = WO_L3_CONVIN + WSZ_CONVIN, WO_L3_MGU = WO_L3_CONVOUT + WSZ_SQ, WO_L3_MDOWN = WO_L3_MGU + 8 * WSZ_GU;
constexpr size_t WO_END = WO_L3_MDOWN + 8 * WSZ_DOWN;
static_assert(WS_W + WO_END <= WS_X, "weights fit");

enum { IN_X = 0, IN_C = 1, IN_CTX = 2, IN_CCTX = 3, IN_FINAL = 49 };
__host__ __device__ constexpr int lbase(int L) { return L == 0 ? 4 : L == 1 ? 13 : L == 2 ? 24 : 39; }

#define LAS __attribute__((address_space(3)))
typedef unsigned short bf16_t;
typedef short bf16x8 __attribute__((ext_vector_type(8)));
typedef float f32x4 __attribute__((ext_vector_type(4)));
typedef float f32x2 __attribute__((ext_vector_type(2)));
typedef unsigned u32x4 __attribute__((ext_vector_type(4)));
typedef unsigned u32x2 __attribute__((ext_vector_type(2)));
#define LDS_WAIT() asm volatile("s_waitcnt lgkmcnt(0)" ::: "memory")
#define VM_WAIT() asm volatile("s_waitcnt vmcnt(0)" ::: "memory")
__device__ __forceinline__ unsigned cvt_pk_bf16(float lo, float hi) { unsigned r; asm volatile("v_cvt_pk_bf16_f32 %0, %1, %2" : "=v"(r) : "v"(lo), "v"(hi)); return r; }
__device__ __forceinline__ float clamp8(float v) { return __builtin_amdgcn_fmed3f(v, -448.f, 448.f); }
__device__ __forceinline__ unsigned cvt4_fp8(float a, float b, float c, float d) {
    unsigned w = 0; w = __builtin_amdgcn_cvt_pk_fp8_f32(clamp8(a), clamp8(b), w, false); w = __builtin_amdgcn_cvt_pk_fp8_f32(clamp8(c), clamp8(d), w, true); return w; }
__device__ __forceinline__ unsigned cvt4_fp8_nc(float a, float b, float c, float d) {
    unsigned w = 0; w = __builtin_amdgcn_cvt_pk_fp8_f32(a, b, w, false); w = __builtin_amdgcn_cvt_pk_fp8_f32(c, d, w, true); return w; }
__device__ __forceinline__ float bf_lo(unsigned w) { return __uint_as_float(w << 16); }
__device__ __forceinline__ float bf_hi(unsigned w) { return __uint_as_float(w & 0xffff0000u); }
#if MK_XBF16
typedef bf16_t xel_t;
__device__ __forceinline__ f32x4 x_ld4(const xel_t* p) { const u32x2 w = *(const u32x2*)p; return (f32x4){bf_lo(w.x), bf_hi(w.x), bf_lo(w.y), bf_hi(w.y)}; }
__device__ __forceinline__ void x_st4(xel_t* p, f32x4 v) { u32x2 w; w.x = cvt_pk_bf16(v[0], v[1]); w.y = cvt_pk_bf16(v[2], v[3]); *(u32x2*)p = w; }
#else
typedef float xel_t;
__device__ __forceinline__ f32x4 x_ld4(const xel_t* p) { return *(const f32x4*)p; }
__device__ __forceinline__ void x_st4(xel_t* p, f32x4 v) { *(f32x4*)p = v; }
#endif
__device__ __forceinline__ float row16_sum(float v) {
    v += __int_as_float(__builtin_amdgcn_mov_dpp(__float_as_int(v), 0xB1, 0xf, 0xf, true));
    v += __int_as_float(__builtin_amdgcn_mov_dpp(__float_as_int(v), 0x4E, 0xf, 0xf, true));
    v += __int_as_float(__builtin_amdgcn_mov_dpp(__float_as_int(v), 0x141, 0xf, 0xf, true));
    v += __int_as_float(__builtin_amdgcn_mov_dpp(__float_as_int(v), 0x140, 0xf, 0xf, true));
    return v;
}
__device__ __forceinline__ float wave_sum(float v) {
    v = row16_sum(v);
    const int vi = __float_as_int(v);
    const float a = __int_as_float(__builtin_amdgcn_readlane(vi, 0)), b = __int_as_float(__builtin_amdgcn_readlane(vi, 16)), c = __int_as_float(__builtin_amdgcn_readlane(vi, 32)), d = __int_as_float(__builtin_amdgcn_readlane(vi, 48));
    return (a + b) + (c + d);
}
__device__ __forceinline__ float fast_sigmoid(float x) { return __builtin_amdgcn_rcpf(1.0f + __builtin_amdgcn_exp2f(-1.4426950408889634f * x)); }
__device__ __forceinline__ float silu_f(float x) { return x * fast_sigmoid(x); }
__device__ __forceinline__ float gelu_tanh_f(float x) { const float u = 0.7978845608028654f * (x + 0.044715f * x * x * x); return x * fast_sigmoid(2.0f * u); }
__device__ __forceinline__ int row_cond(int row) { const int b = row / RPB; return (row - b * RPB) < CTXL ? 4 : b; }
__device__ __forceinline__ int tile_cond(int pm) { const int b = pm / TPB; return (pm - b * TPB) == 0 ? 4 : b; }

#define XB_TMO      128
#define XB_XCNT(j)  (256  + 64 * (j))
#define XB_XSUB(j)  (1280 + 64 * (j))
#define XB_XGEN(j)  (2304 + 64 * (j))
#define XB_TOP      3328
#define XB_TOPGEN   3392
#define XCD_BAR_WORDS 3456
#define XB_SPIN_CAP (1u << 18)
__device__ __forceinline__ unsigned xb_ld(unsigned* p)              { return __hip_atomic_load(p, __ATOMIC_RELAXED, __HIP_MEMORY_SCOPE_AGENT); }
__device__ __forceinline__ unsigned xb_add(unsigned* p, unsigned v) { return __hip_atomic_fetch_add(p, v, __ATOMIC_RELAXED, __HIP_MEMORY_SCOPE_AGENT); }
__device__ __forceinline__ unsigned xb_xcc_id() { return (unsigned)__builtin_amdgcn_s_getreg((3 << 11) | 20) & 0xFu; }
#define XB_SPIN(cond, bar) do { unsigned _sp = 0; while (cond) { __builtin_amdgcn_s_sleep(1); \
    if ((++_sp & 255u) == 0u) { if (xb_ld(&(bar)[XB_TMO])) break; if (_sp > XB_SPIN_CAP) { atomicAdd(&(bar)[XB_TMO], 1u); break; } } } } while (0)
struct XcdBarrier { unsigned* bar; unsigned x; volatile LAS unsigned* st; };
__device__ __forceinline__ XcdBarrier xcd_barrier_post(unsigned* bar, volatile LAS unsigned* st) {
    XcdBarrier b; b.bar = bar; b.x = xb_xcc_id(); b.st = st;
    if (threadIdx.x == 0) (void)xb_add(&bar[XB_XCNT(b.x)], 1u);
    return b;
}
__device__ __forceinline__ void xcd_barrier_complete(unsigned* bar, unsigned x, unsigned& nloc, unsigned& nx) {
    const unsigned G = gridDim.x * gridDim.y * gridDim.z;
    unsigned sum, cnt, mine, sp = 0u;
    for (;;) {
        sum = 0u; cnt = 0u; mine = 0u;
#pragma unroll
        for (unsigned j = 0; j < 16; ++j) { const unsigned c = xb_ld(&bar[XB_XCNT(j)]); sum += c; cnt += (c > 0u) ? 1u : 0u; mine = (j == x) ? c : mine; }
        if (sum == G) break;
        __builtin_amdgcn_s_sleep(1);
        if ((++sp & 255u) == 0u) { if (xb_ld(&bar[XB_TMO])) break; if (sp > XB_SPIN_CAP) { atomicAdd(&bar[XB_TMO], 1u); break; } }
    }
    nloc = mine > 0u ? mine : 1u; nx = cnt > 0u ? cnt : 1u;
}
__device__ __forceinline__ void xcd_barrier(const XcdBarrier& b) {
    asm volatile("s_waitcnt vmcnt(0)" ::: "memory");
    __syncthreads();
    if (threadIdx.x == 0) {
        unsigned* bar = b.bar;
        __builtin_amdgcn_s_waitcnt(0);
        unsigned nloc = b.st[0], nx = b.st[1];
        if (nloc == 0u) { xcd_barrier_complete(bar, b.x, nloc, nx); b.st[0] = nloc; b.st[1] = nx; }
        const unsigned old = xb_add(&bar[XB_XSUB(b.x)], 1u);
        const unsigned gen = old / nloc;
        if (old + 1u == (gen + 1u) * nloc) {
            __builtin_amdgcn_fence(__ATOMIC_RELEASE, "agent");
            asm volatile("s_waitcnt vmcnt(0)" ::: "memory");
            const unsigned og = xb_add(&bar[XB_TOP], 1u);
            const unsigned tg = og / nx;
            if (og + 1u == (tg + 1u) * nx) xb_add(&bar[XB_TOPGEN], 1u);
            else XB_SPIN(xb_ld(&bar[XB_TOPGEN]) == tg, bar);
            __builtin_amdgcn_fence(__ATOMIC_ACQUIRE, "agent");
            xb_add(&bar[XB_XGEN(b.x)], 1u);
            asm volatile("s_waitcnt vmcnt(0)" ::: "memory");
        } else {
            XB_SPIN(xb_ld(&bar[XB_XGEN(b.x)]) == gen, bar);
            __builtin_amdgcn_fence(__ATOMIC_ACQUIRE, "agent");
            asm volatile("s_waitcnt vmcnt(0)" ::: "memory");
        }
    }
    __syncthreads();
}

namespace pg8 {
constexpr int BM = 256, BK = 64, HALF = 128, HTB = HALF * BK * 2, STAGE_BYTES = 8 * HTB, NXCD = 8, WGM = 8;
__host__ __device__ __forceinline__ int lds_byte(int r, int c) { const int st = (r >> 4) * 2 + (c >> 5), rr = r & 15, cc = c & 31, ob = rr * 64 + cc * 2; return st * 1024 + (ob ^ (((ob >> 9) & 1) << 5)); }
__host__ __device__ __forceinline__ void stage_rc(int b, int& R, int& C) { const int st = b / 1024, sb = b % 1024, swz = sb ^ (((sb >> 9) & 1) << 5); R = (st >> 1) * 16 + swz / 64; C = (st & 1) * 32 + (swz % 64) / 2; }
__host__ __device__ __forceinline__ int perm32(int rho) { const int n = rho >> 4, i = rho & 15; return 8 * (i >> 2) + 4 * n + (i & 3); }
struct Unit { int pm, pn, aux; };
__device__ __forceinline__ void order_map(int L, int nM, int nN, int& tm, int& tn) {
    const int nwg = nM * nN; int wgid = L; { const int q = nwg / NXCD, r = nwg % NXCD, xcd = wgid % NXCD, off = wgid / NXCD; wgid = (xcd < r ? xcd * (q + 1) : r * (q + 1) + (xcd - r) * q) + off; }
    const int nig = WGM * nN, gid = wgid / nig, fm = gid * WGM, gsz = (nM - fm) < WGM ? (nM - fm) : WGM;
    tm = fm + ((wgid % nig) % gsz); tn = (wgid % nig) / gsz;
}

template <class Epi, class Prob, bool ALIGN_EPI, bool FP8 = false>
__device__ __forceinline__ void gemm_phase(LAS unsigned char* lds, const Prob& P, const Epi& E, const int tid) {
    const int wid = __builtin_amdgcn_readfirstlane(tid >> 6), lane = tid & 63, wr = wid >> 2, wc = wid & 3, fr = lane & 15, fq = lane >> 4;
    const int nt = P.nt;
    unsigned voffA[2], voffB[2];
#pragma unroll
    for (int i = 0; i < 2; ++i) { int R, C; stage_rc(tid * 16 + i * 8192, R, C); const int Rb = Epi::PERM ? ((R & ~31) + perm32(R & 31)) : R;
        voffA[i] = P.lane_off_a(R, C); voffB[i] = P.lane_off_b(Rb, C); }
    const size_t hsA = P.hstep_a(), hsB = P.hstep_b();
    const unsigned ldsw = (unsigned)wid * 1024u;
    const int aoff = lds_byte(wr * 64 + fr, fq * 8), boff = lds_byte(wc * 32 + fr, fq * 8);
#define PG8_SA(b, h) (((b) * 2 + (h)) * HTB)
#define PG8_SB(b, h) ((4 + (b) * 2 + (h)) * HTB)
#define PG8_STAGE(bufoff, gbase, voff) do { _Pragma("unroll") for (int _i = 0; _i < 2; ++_i) \
        __builtin_amdgcn_global_load_lds((const unsigned*)((const char*)(gbase) + (voff)[_i]), (LAS unsigned*)(lds + (bufoff) + ldsw + _i * 8192), 16, 0, 0); } while (0)
#define PG8_LDA(dst, b, h) do { _Pragma("unroll") for (int m = 0; m < 4; ++m) _Pragma("unroll") for (int k = 0; k < 2; ++k) dst[m][k] = *(const LAS bf16x8*)(lds + PG8_SA(b, h) + aoff + m * 2048 + k * 1024); } while (0)
#define PG8_LDB(dst, b, h) do { _Pragma("unroll") for (int n = 0; n < 2; ++n) _Pragma("unroll") for (int k = 0; k < 2; ++k) dst[n][k] = *(const LAS bf16x8*)(lds + PG8_SB(b, h) + boff + n * 2048 + k * 1024); } while (0)
#define PG8_MMA(ai, bj, At, Bt) do { __builtin_amdgcn_s_setprio(1); _Pragma("unroll") for (int m = 0; m < 4; ++m) _Pragma("unroll") for (int n = 0; n < 2; ++n) { \
        if constexpr (FP8) { typedef int v4i_ __attribute__((ext_vector_type(4))); typedef int v8i_ __attribute__((ext_vector_type(8))); \
            const v4i_ b0_ = __builtin_bit_cast(v4i_, Bt[n][0]), b1_ = __builtin_bit_cast(v4i_, Bt[n][1]), a0_ = __builtin_bit_cast(v4i_, At[m][0]), a1_ = __builtin_bit_cast(v4i_, At[m][1]); \
            const v8i_ bb_ = {b0_[0], b0_[1], b0_[2], b0_[3], b1_[0], b1_[1], b1_[2], b1_[3]}, aa_ = {a0_[0], a0_[1], a0_[2], a0_[3], a1_[0], a1_[1], a1_[2], a1_[3]}; \
              \
            asm volatile("v_mfma_scale_f32_16x16x128_f8f6f4 %0, %1, %2, %0, %3, %3 op_sel_hi:[0,0,0]" : "+v"(acc[ai][bj][m][n]) : "v"(bb_), "v"(aa_), "v"(0x7f7f7f7f)); } \
        else { _Pragma("unroll") for (int k = 0; k < 2; ++k) acc[ai][bj][m][n] = __builtin_amdgcn_mfma_f32_16x16x32_bf16(Bt[n][k], At[m][k], acc[ai][bj][m][n], 0, 0, 0); } } \
        __builtin_amdgcn_s_setprio(0); } while (0)
#define PG8_WAIT_V(n) asm volatile("s_waitcnt vmcnt(" #n ")" ::: "memory")
#define PG8_WAIT_L(n) asm volatile("s_waitcnt lgkmcnt(" #n ")" ::: "memory")
#define PG8_BAR __builtin_amdgcn_s_barrier()
#define PG8_SCHED __builtin_amdgcn_sched_barrier(0)
    Unit cur, nxt; int ui = 0;
    if (!P.next(0, cur)) return;
    f32x4 acc[2][2][4][2];
#pragma unroll
    for (int a = 0; a < 2; ++a)
#pragma unroll
        for (int b = 0; b < 2; ++b)
#pragma unroll
            for (int m = 0; m < 4; ++m)
#pragma unroll
                for (int n = 0; n < 2; ++n) acc[a][b][m][n] = (f32x4){0.f, 0.f, 0.f, 0.f};
    bf16x8 At[4][2], B0[2][2], B1[2][2];
    {
        const char* cA = P.a_ptr(cur, 0); const char* cB = P.b_ptr(cur, 0); const char* cA1 = P.a_ptr(cur, 1); const char* cB1 = P.b_ptr(cur, 1);
        PG8_STAGE(PG8_SB(0, 0), cB, voffB); PG8_STAGE(PG8_SB(0, 1), cB + hsB, voffB); PG8_STAGE(PG8_SA(0, 0), cA, voffA); PG8_STAGE(PG8_SA(0, 1), cA + hsA, voffA);
        if (wr == 1) PG8_BAR;
        PG8_WAIT_V(2); PG8_BAR;
        PG8_STAGE(PG8_SB(1, 0), cB1, voffB); PG8_STAGE(PG8_SA(1, 0), cA1, voffA); PG8_STAGE(PG8_SB(1, 1), cB1 + hsB, voffB);
        PG8_WAIT_V(6); PG8_BAR;
    }
    for (;;) {
        const bool has_next = P.next(ui + 1, nxt);
        const Unit nu = has_next ? nxt : cur;
        for (int t = 0; t < nt; t += 2) {
            const bool last = (t == nt - 2);
            const char* a1 = P.a_ptr(cur, t + 1);
            const char* a2 = last ? P.a_ptr(nu, 0) : P.a_ptr(cur, t + 2); const char* b2 = last ? P.b_ptr(nu, 0) : P.b_ptr(cur, t + 2);
            const char* a3 = last ? P.a_ptr(nu, 1) : P.a_ptr(cur, t + 3); const char* b3 = last ? P.b_ptr(nu, 1) : P.b_ptr(cur, t + 3);
            PG8_LDB(B0, 0, 0); PG8_LDB(B1, 0, 1); PG8_SCHED; PG8_LDA(At, 0, 0); PG8_STAGE(PG8_SA(1, 1), a1 + hsA, voffA);
            PG8_WAIT_V(8); PG8_WAIT_L(0); PG8_BAR; PG8_MMA(0, 0, At, B0); PG8_MMA(0, 1, At, B1); PG8_BAR; PG8_SCHED;
            PG8_LDA(At, 0, 1); PG8_STAGE(PG8_SB(0, 0), b2, voffB); PG8_STAGE(PG8_SB(0, 1), b2 + hsB, voffB); PG8_STAGE(PG8_SA(0, 0), a2, voffA);
            PG8_WAIT_V(8); PG8_WAIT_L(0); PG8_BAR; PG8_MMA(1, 0, At, B0); PG8_MMA(1, 1, At, B1); PG8_BAR; PG8_SCHED;
            PG8_LDB(B0, 1, 0); PG8_LDB(B1, 1, 1); PG8_SCHED; PG8_LDA(At, 1, 0); PG8_STAGE(PG8_SA(0, 1), a2 + hsA, voffA);
            PG8_WAIT_V(8); PG8_WAIT_L(0); PG8_BAR; PG8_MMA(0, 0, At, B0); PG8_MMA(0, 1, At, B1); PG8_BAR; PG8_SCHED;
            PG8_LDA(At, 1, 1); PG8_STAGE(PG8_SB(1, 0), b3, voffB); PG8_STAGE(PG8_SB(1, 1), b3 + hsB, voffB); PG8_STAGE(PG8_SA(1, 0), a3, voffA);
            PG8_WAIT_V(8); PG8_WAIT_L(0); PG8_BAR; PG8_MMA(1, 0, At, B0); PG8_MMA(1, 1, At, B1); PG8_BAR; PG8_SCHED;
        }
        if constexpr (ALIGN_EPI) { if (wr == 0) PG8_BAR; }
        if constexpr (FP8) { asm volatile("s_nop 15\n\ts_nop 15" ::: "memory");
#pragma unroll
            for (int a_ = 0; a_ < 2; ++a_)
#pragma unroll
                for (int b_ = 0; b_ < 2; ++b_)
#pragma unroll
                    for (int m_ = 0; m_ < 4; ++m_) asm volatile("" : "+v"(acc[a_][b_][m_][0]), "+v"(acc[a_][b_][m_][1])); }
        { int l_e; asm volatile("v_mbcnt_lo_u32_b32 %0, -1, 0\n\tv_mbcnt_hi_u32_b32 %0, -1, %0" : "=v"(l_e)); E(acc, cur, wr, wc, l_e & 15, l_e >> 4); }
        if (!has_next) break;
#pragma unroll
        for (int a = 0; a < 2; ++a)
#pragma unroll
            for (int b = 0; b < 2; ++b)
#pragma unroll
                for (int m = 0; m < 4; ++m)
#pragma unroll
                    for (int n = 0; n < 2; ++n) acc[a][b][m][n] = (f32x4){0.f, 0.f, 0.f, 0.f};
        cur = nxt; ++ui;
        if constexpr (ALIGN_EPI) { if (wr == 1) PG8_BAR; }
    }
    PG8_WAIT_V(0);
    if constexpr (!ALIGN_EPI) { if (wr == 0) PG8_BAR; }
    PG8_BAR;
#undef PG8_SA
#undef PG8_SB
#undef PG8_STAGE
#undef PG8_LDA
#undef PG8_LDB
#undef PG8_MMA
#undef PG8_WAIT_V
#undef PG8_WAIT_L
#undef PG8_BAR
#undef PG8_SCHED
}

struct ProbPlain {
    const char* A; const char* Bt; int lda_b, ldb_b, nt, nM, nN, G, c; bool latent;
    __device__ __forceinline__ bool next(int i, Unit& u) const {
        const long L = (long)i * G + c; if (L >= (long)nM * nN) return false;
        int tm, tn; order_map((int)L, nM, nN, tm, tn); u.pm = latent ? tm + (tm >> 5) + 1 : tm; u.pn = tn; u.aux = 0; return true; }
    __device__ __forceinline__ const char* a_ptr(const Unit& u, int kt) const { return A + (size_t)u.pm * 256 * lda_b + (size_t)kt * 128; }
    __device__ __forceinline__ const char* b_ptr(const Unit& u, int kt) const { return Bt + (size_t)u.pn * 256 * ldb_b + (size_t)kt * 128; }
    __device__ __forceinline__ size_t hstep_a() const { return (size_t)128 * lda_b; }
    __device__ __forceinline__ size_t hstep_b() const { return (size_t)128 * ldb_b; }
    __device__ __forceinline__ unsigned lane_off_a(int R, int C) const { return (unsigned)(R * lda_b + C * 2); }
    __device__ __forceinline__ unsigned lane_off_b(int R, int C) const { return (unsigned)(R * ldb_b + C * 2); }
};
struct ProbMoe {
    const char* A; const char* Bt; int lda_b, ldb_b, nt, nN, G, c; size_t bstride_e; const int* texp; int tile0, ntile, a_rel;
    __device__ __forceinline__ bool next(int i, Unit& u) const {
        const long L = (long)i * G + c; if (L >= (long)ntile * nN) return false;
        int tm, tn; order_map((int)L, ntile, nN, tm, tn); u.pm = tile0 + tm; u.pn = tn; u.aux = __builtin_amdgcn_readfirstlane(texp[u.pm]); return true; }
    __device__ __forceinline__ const char* a_ptr(const Unit& u, int kt) const { return A + (size_t)(u.pm - a_rel) * 256 * lda_b + (size_t)kt * 128; }
    __device__ __forceinline__ const char* b_ptr(const Unit& u, int kt) const { return Bt + (size_t)u.aux * bstride_e + (size_t)u.pn * 256 * ldb_b + (size_t)kt * 128; }
    __device__ __forceinline__ size_t hstep_a() const { return (size_t)128 * lda_b; }
    __device__ __forceinline__ size_t hstep_b() const { return (size_t)128 * ldb_b; }
    __device__ __forceinline__ unsigned lane_off_a(int R, int C) const { return (unsigned)(R * lda_b + C * 2); }
    __device__ __forceinline__ unsigned lane_off_b(int R, int C) const { return (unsigned)(R * ldb_b + C * 2); }
};
struct ProbS5 {
    const char* A0; const char* A1; const char* Bt; int nt, nt0, ntile, G, c; size_t bstride_g; bool s3;
    __device__ __forceinline__ bool next(int i, Unit& u) const {
        const int vcu = (G % 8 == 0) ? (c % 8) * (G / 8) + c / 8 : c;
        const long L = (long)i * G + vcu; if (L >= (long)ntile * 64) return false;
        u.pm = (int)(L >> 6); u.pn = (int)(L & 63); u.aux = 0; return true; }
    __device__ __forceinline__ size_t tokbase(int pm) const { return s3 ? (size_t)(pm >> 1) * RPB + CTXL + (size_t)(pm & 1) * 4096 : (size_t)pm * 4096; }
    __device__ __forceinline__ const char* a_ptr(const Unit& u, int kt) const { return (kt < nt0 ? A0 + (size_t)kt * 8192 : A1 + (size_t)(kt - nt0) * 8192) + tokbase(u.pm) * 2048 + (size_t)u.pn * 32; }
    __device__ __forceinline__ const char* b_ptr(const Unit& u, int kt) const { return Bt + (size_t)u.pn * bstride_g + (size_t)kt * 128; }
    __device__ __forceinline__ size_t hstep_a() const { return (size_t)128 * 16 * 2048; }
    __device__ __forceinline__ size_t hstep_b() const { return (size_t)128 * nt * 128; }
    __device__ __forceinline__ unsigned lane_off_a(int R, int C) const { return (unsigned)(R * 32768 + (C >> 4) * 2048 + (C & 15) * 2); }
    __device__ __forceinline__ unsigned lane_off_b(int R, int C) const { return (unsigned)(R * nt * 128 + C * 2); }
};

typedef f32x4 Acc[2][2][4][2];
constexpr float W8SCALE = 64.f, W8INV = 1.f / 64.f;
constexpr float QSCALE = 0.125f * 1.4426950408889634f;
__device__ __forceinline__ u32x4 pack8(f32x4 v0, f32x4 v1) { u32x4 w; w.x = cvt_pk_bf16(v0[0], v0[1]); w.y = cvt_pk_bf16(v0[2], v0[3]); w.z = cvt_pk_bf16(v1[0], v1[1]); w.w = cvt_pk_bf16(v1[2], v1[3]); return w; }

struct EpiBf16 {
    static constexpr bool PERM = true;
    bf16_t* O; int ldc; int pm_sub; float s;
    __device__ __forceinline__ void operator()(const Acc& acc, const Unit& u, int wr, int wc, int fr, int fq) const {
        const int row0 = (u.pm - pm_sub) * BM + wr * 64 + fr, col0 = u.pn * BM + wc * 32 + 8 * fq;
#pragma unroll
        for (int ai = 0; ai < 2; ++ai)
#pragma unroll
            for (int m = 0; m < 4; ++m) { bf16_t* rowp = O + (size_t)(row0 + ai * HALF + m * 16) * ldc + col0;
#pragma unroll
                for (int bj = 0; bj < 2; ++bj) *(u32x4*)(rowp + bj * HALF) = pack8(acc[ai][bj][m][0] * s, acc[ai][bj][m][1] * s); }
    }
};
template <int ACT> struct EpiGated {
    static constexpr bool PERM = true;
    bf16_t* O; int ldc; int pn0; int col_base; int pm_sub;
    __device__ __forceinline__ void operator()(const Acc& acc, const Unit& u, int wr, int wc, int fr, int fq) const {
        const int row0 = (u.pm - pm_sub) * BM + wr * 64 + fr;
        if (u.pn < pn0) {
            const int col0 = u.pn * BM + wc * 32 + 8 * fq;
#pragma unroll
            for (int ai = 0; ai < 2; ++ai)
#pragma unroll
                for (int m = 0; m < 4; ++m) { bf16_t* rowp = O + (size_t)(row0 + ai * HALF + m * 16) * ldc + col0;
#pragma unroll
                    for (int bj = 0; bj < 2; ++bj) *(u32x4*)(rowp + bj * HALF) = pack8(acc[ai][bj][m][0], acc[ai][bj][m][1]); }
        } else {
            const int col0 = col_base + (u.pn - pn0) * HALF + wc * 32 + 8 * fq;
#pragma unroll
            for (int ai = 0; ai < 2; ++ai)
#pragma unroll
                for (int m = 0; m < 4; ++m) { bf16_t* rowp = O + (size_t)(row0 + ai * HALF + m * 16) * ldc + col0;
                    f32x4 a0 = acc[ai][0][m][0], a1 = acc[ai][0][m][1];
                    if (ACT == 1) {
#pragma unroll
                        for (int e = 0; e < 4; ++e) { a0[e] = silu_f(a0[e]); a1[e] = silu_f(a1[e]); } }
                    *(u32x4*)rowp = pack8(a0 * acc[ai][1][m][0], a1 * acc[ai][1][m][1]); }
        }
    }
};
struct EpiGated8 {
    static constexpr bool PERM = true;
    unsigned char* O; int ldc; float s;
    __device__ __forceinline__ void operator()(const Acc& acc, const Unit& u, int wr, int wc, int fr, int fq) const {
        const int row0 = u.pm * BM + wr * 64 + fr, col0 = u.pn * HALF + wc * 32 + 8 * fq;
#pragma unroll
        for (int ai = 0; ai < 2; ++ai)
#pragma unroll
            for (int m = 0; m < 4; ++m) { unsigned char* rowp = O + (size_t)(row0 + ai * HALF + m * 16) * ldc + col0;
                f32x4 a0 = acc[ai][0][m][0] * s, a1 = acc[ai][0][m][1] * s; const f32x4 b0 = acc[ai][1][m][0] * s, b1 = acc[ai][1][m][1] * s;
#pragma unroll
                for (int e = 0; e < 4; ++e) { a0[e] = silu_f(a0[e]) * b0[e]; a1[e] = silu_f(a1[e]) * b1[e]; }
                u32x2 w; w.x = cvt4_fp8(a0[0], a0[1], a0[2], a0[3]); w.y = cvt4_fp8(a1[0], a1[1], a1[2], a1[3]);
                *(u32x2*)rowp = w; }
    }
};
struct EpiResid {
    static constexpr bool PERM = false;
    xel_t* X; const float* gate;
    const float* xin; const float* cin;
    float s;
    __device__ __forceinline__ void operator()(const Acc& acc, const Unit& u, int wr, int wc, int fr, int fq) const {
        const int row0 = u.pm * BM + wr * 64 + fr, col0 = u.pn * BM + wc * 32 + 4 * fq;
        const float* gp = gate + tile_cond(u.pm) * 6144 + col0;
        const int bq = u.pm / TPB, tq = u.pm - bq * TPB;
        const float* srcin = xin ? (tq == 0 ? cin + (size_t)bq * CTXL * DM : xin + ((size_t)bq * SEQ + (size_t)(tq - 1) * 256) * DM) - (size_t)u.pm * BM * DM : nullptr;
        f32x4 gv[2][2];
#pragma unroll
        for (int bj = 0; bj < 2; ++bj)
#pragma unroll
            for (int n = 0; n < 2; ++n) gv[bj][n] = *(const f32x4*)(gp + bj * HALF + n * 16);
#pragma unroll
        for (int ai = 0; ai < 2; ++ai)
#pragma unroll
            for (int m = 0; m < 4; ++m) { const size_t off = (size_t)(row0 + ai * HALF + m * 16) * DM + col0;
#pragma unroll
                for (int bj = 0; bj < 2; ++bj)
#pragma unroll
                    for (int n = 0; n < 2; ++n) { const size_t o2 = off + bj * HALF + n * 16; const f32x4 xv = srcin ? *(const f32x4*)(srcin + o2) : x_ld4(X + o2); x_st4(X + o2, xv + gv[bj][n] * (acc[ai][bj][m][n] * s)); }
                if (m & 1) asm volatile("" ::: "memory"); }
    }
};
struct EpiGlu {
    static constexpr bool PERM = false;
    xel_t* X; const float* gate; float s;
    __device__ __forceinline__ void operator()(const Acc& acc, const Unit& u, int wr, int wc, int fr, int fq) const {
        const int row0 = u.pm * BM + wr * 64 + fr, col0 = u.pn * HALF + wc * 32 + 4 * fq;
        const float* gp = gate + tile_cond(u.pm) * 6144 + col0;
        f32x4 gv[2];
#pragma unroll
        for (int n = 0; n < 2; ++n) gv[n] = *(const f32x4*)(gp + n * 16);
#pragma unroll
        for (int ai = 0; ai < 2; ++ai)
#pragma unroll
            for (int m = 0; m < 4; ++m) { xel_t* rowp = X + (size_t)(row0 + ai * HALF + m * 16) * DM + col0;
#pragma unroll
                for (int n = 0; n < 2; ++n) { f32x4 sg = acc[ai][1][m][n] * s;
#pragma unroll
                    for (int e = 0; e < 4; ++e) sg[e] = fast_sigmoid(sg[e]);
                    xel_t* p = rowp + n * 16; x_st4(p, x_ld4(p) + gv[n] * ((acc[ai][0][m][n] * s) * sg)); }
                if (m & 1) asm volatile("" ::: "memory"); }
    }
};
template <bool OUT8, bool W8> struct EpiQkv {
    static constexpr bool PERM = true;
    unsigned char* big; const float* cosT;
    __device__ __forceinline__ void operator()(const Acc& acc, const Unit& u, int wr, int wc, int fr, int fq) const {
        const float s = W8 ? W8INV : 1.f; const float* sinT = cosT + 128 * 16;
        const int row0 = u.pm * BM + wr * 64 + fr;
        const int bq = u.pm / TPB, tq = u.pm - bq * TPB;
        const bool rope = (u.pn < 8) && (tq != 0);
        const int sect = u.pn >> 2;
        const int cs0 = (u.pn & 3) * BM + wc * 32 + 8 * fq;
#pragma unroll
        for (int ai = 0; ai < 2; ++ai)
#pragma unroll
            for (int m = 0; m < 4; ++m) { const int row = row0 + ai * HALF + m * 16; const int j = row - bq * RPB;
                f32x4 c4 = (f32x4){1.f, 1.f, 1.f, 1.f}, s4 = (f32x4){0.f, 0.f, 0.f, 0.f};
                if (rope) { const int t = j - CTXL; const int pos = (wc & 1) ? (t & 63) : (t >> 6);
                    c4 = *(const f32x4*)(cosT + pos * 16 + 4 * fq); s4 = *(const f32x4*)(sinT + pos * 16 + 4 * fq); }
#pragma unroll
                for (int bj = 0; bj < 2; ++bj) { const f32x4 v0 = acc[ai][bj][m][0] * s, v1 = acc[ai][bj][m][1] * s; f32x4 o0, o1;
                    o0[0] = v0[0] * c4[0] - v0[1] * s4[0]; o0[1] = v0[1] * c4[0] + v0[0] * s4[0];
                    o0[2] = v0[2] * c4[1] - v0[3] * s4[1]; o0[3] = v0[3] * c4[1] + v0[2] * s4[1];
                    o1[0] = v1[0] * c4[2] - v1[1] * s4[2]; o1[1] = v1[1] * c4[2] + v1[0] * s4[2];
                    o1[2] = v1[2] * c4[3] - v1[3] * s4[3]; o1[3] = v1[3] * c4[3] + v1[2] * s4[3];
                    const int cs = cs0 + bj * HALF;
                    if constexpr (OUT8) {
                        size_t off8; float sc8 = 1.f;
                        if (sect == 0) { sc8 = QSCALE * 16.f; off8 = BIG_Q8 + (size_t)row * DM + cs; }
                        else if (sect == 1) off8 = BIG_K8 + ((size_t)(bq * 16 + (cs >> 6)) * RPB + j) * 64 + (cs & 63);
                        else off8 = BIG_V8 + ((size_t)(bq * 8 + (cs >> 7)) * RPB + j) * 128 + (cs & 127);
                        u32x2 w8; w8.x = cvt4_fp8(o0[0] * sc8, o0[1] * sc8, o0[2] * sc8, o0[3] * sc8); w8.y = cvt4_fp8(o1[0] * sc8, o1[1] * sc8, o1[2] * sc8, o1[3] * sc8);
                        *(u32x2*)(big + off8) = w8;
                    } else { size_t offb;
                        if (sect == 0) { o0 = o0 * QSCALE; o1 = o1 * QSCALE; offb = BIG_QKV + ((size_t)row * DM + cs) * 2; }
                        else if (sect == 1) offb = BIG_KH + (((size_t)(bq * 16 + (cs >> 6)) * RPB + j) * 64 + (cs & 63)) * 2;
                        else offb = BIG_VH + (((size_t)(bq * 8 + (cs >> 7)) * RPB + j) * 128 + (cs & 127)) * 2;
                        *(u32x4*)(big + offb) = pack8(o0, o1); } } }
    }
};
struct EpiS1 {
    static constexpr bool PERM = false;
    float* H;
    __device__ __forceinline__ void operator()(const Acc& acc, const Unit& u, int wr, int wc, int fr, int fq) const {
        const int row0 = u.pm * BM + wr * 64 + fr, col0 = wc * 32 + 4 * fq;
#pragma unroll
        for (int ai = 0; ai < 2; ++ai)
#pragma unroll
            for (int m = 0; m < 4; ++m) { float* rowp = H + ((size_t)(row0 + ai * HALF + m * 16) * 64 + u.pn) * 256 + col0;
#pragma unroll
                for (int bj = 0; bj < 2; ++bj)
#pragma unroll
                    for (int n = 0; n < 2; ++n) *(f32x4*)(rowp + bj * HALF + n * 16) = acc[ai][bj][m][n]; }
    }
};
struct EpiS3 {
    static constexpr bool PERM = true;
    bf16_t* YG; bool out8;
    __device__ __forceinline__ void operator()(const Acc& acc, const Unit& u, int wr, int wc, int fr, int fq) const {
        const size_t tb = (size_t)(u.pm >> 1) * RPB + CTXL + (size_t)(u.pm & 1) * 4096;
        const int r0 = wr * 64 + fr;
#pragma unroll
        for (int ai = 0; ai < 2; ++ai)
#pragma unroll
            for (int m = 0; m < 4; ++m) { const int R = r0 + ai * HALF + m * 16;
#pragma unroll
                for (int bj = 0; bj < 2; ++bj) { const int t = 8 * bj + 2 * wc + (fq >> 1), s0 = 8 * (fq & 1);
                    f32x4 v0 = acc[ai][bj][m][0], v1 = acc[ai][bj][m][1];
#pragma unroll
                    for (int e = 0; e < 4; ++e) { v0[e] = gelu_tanh_f(v0[e]); v1[e] = gelu_tanh_f(v1[e]); }
                    const size_t eoff = (tb + (size_t)R * 16 + t) * DM + u.pn * 16 + s0;
                    if (out8) { u32x2 w; w.x = cvt4_fp8(v0[0], v0[1], v0[2], v0[3]); w.y = cvt4_fp8(v1[0], v1[1], v1[2], v1[3]); *(u32x2*)((unsigned char*)YG + eoff) = w; }
                    else *(u32x4*)(YG + eoff) = pack8(v0, v1); } }
    }
};
}

namespace att {
using bf16x8 = __attribute__((ext_vector_type(8))) short;
using s16x4  = __attribute__((ext_vector_type(4))) short;
using f32x16 = __attribute__((ext_vector_type(16))) float;
constexpr int NW = 8, QBLK = 32, KVBLK = 64;
constexpr float SCALE = 0.125f, THR = 8.f;
constexpr int KROW = 144;
constexpr int SHM_V = KVBLK * 128 * 2, SHM_K = KVBLK * KROW;
constexpr int OFF_V = 0, OFF_K = 2 * SHM_V, OFF_WS = OFF_K + 2 * SHM_K, OFF_OST = OFF_WS + NW * 64 * 4, ATT_LDS = OFF_OST + NW * 8192;
constexpr int LDQ = 3072;
#define SBAR() __builtin_amdgcn_sched_barrier(0)
__device__ __forceinline__ int crow(int r, int hi) { return (r & 3) + 8 * (r >> 2) + 4 * hi; }
__device__ __forceinline__ void partialSM(f32x16& p0, f32x16& p1, float& m_reg, float& mn, float& alpha) {
  constexpr float C = SCALE * 1.4426950408889634f;
  float pmax = p0[0];
#pragma unroll
  for (int r = 1; r < 16; ++r) pmax = fmaxf(pmax, p0[r]);
#pragma unroll
  for (int r = 0; r < 16; ++r) pmax = fmaxf(pmax, p1[r]);
  { auto rr = __builtin_amdgcn_permlane32_swap(__float_as_uint(pmax), __float_as_uint(pmax), false, false);
    pmax = fmaxf(__uint_as_float(rr[0]), __uint_as_float(rr[1])); }
  if (__builtin_expect(__all(pmax - m_reg <= THR / SCALE), 1)) { mn = m_reg; alpha = 1.f; }
  else { mn = fmaxf(m_reg, pmax); alpha = __builtin_amdgcn_exp2f((m_reg - mn) * C); m_reg = mn; }
  float mnC = -mn * C;
#pragma unroll
  for (int r = 0; r < 16; ++r) p0[r] = fmaf(p0[r], C, mnC);
#pragma unroll
  for (int r = 0; r < 16; ++r) p1[r] = fmaf(p1[r], C, mnC);
#pragma unroll
  for (int r = 0; r < 16; ++r) p0[r] = __builtin_amdgcn_exp2f(p0[r]);
}
__device__ __forceinline__ void finishSM(f32x16& p0, f32x16& p1, float alpha, float& l_reg, bf16x8& pa0, bf16x8& pa1, bf16x8& pa2, bf16x8& pa3) {
#pragma unroll
  for (int r = 0; r < 16; ++r) p1[r] = __builtin_amdgcn_exp2f(p1[r]);
  float ps = 0;
#pragma unroll
  for (int r = 0; r < 16; ++r) ps += p0[r];
#pragma unroll
  for (int r = 0; r < 16; ++r) ps += p1[r];
  { auto rr = __builtin_amdgcn_permlane32_swap(__float_as_uint(ps), __float_as_uint(ps), false, false);
    ps = __uint_as_float(rr[0]) + __uint_as_float(rr[1]); }
  l_reg = l_reg * alpha + ps;
#define PK4(P, BASE, OUT) do { u32x4 w = {cvt_pk_bf16(P[BASE + 0], P[BASE + 1]), cvt_pk_bf16(P[BASE + 2], P[BASE + 3]), cvt_pk_bf16(P[BASE + 4], P[BASE + 5]), cvt_pk_bf16(P[BASE + 6], P[BASE + 7])}; \
    OUT = *reinterpret_cast<bf16x8*>(&w); } while (0)
  PK4(p0, 0, pa0); PK4(p0, 8, pa1); PK4(p1, 0, pa2); PK4(p1, 8, pa3);
#undef PK4
}
__device__ __forceinline__ void qkt(f32x16& p0, f32x16& p1, const char* Ks, const bf16x8* qr, int r32, int hi) {
  p0 = f32x16{}; p1 = f32x16{};
#pragma unroll
  for (int d0 = 0; d0 < 4; ++d0) { const int cb = (d0 * 16 + hi * 8) * 2;
    bf16x8 b0 = *reinterpret_cast<const bf16x8*>(Ks + r32 * KROW + cb);
    bf16x8 b1 = *reinterpret_cast<const bf16x8*>(Ks + (32 + r32) * KROW + cb);
    p0 = __builtin_amdgcn_mfma_f32_32x32x16_bf16(b0, qr[d0], p0, 0, 0, 0);
    p1 = __builtin_amdgcn_mfma_f32_32x32x16_bf16(b1, qr[d0], p1, 0, 0, 0); }
}
__device__ __forceinline__ int v_st(int k, int c) { const int kk = k; return ((kk >> 3) * 4 + (c >> 5)) * 512 + ((kk & 7) * 32 + (c & 31)) * 2; }
__device__ __forceinline__ int v_rd_base(int lane) { return ((lane & 3) << 3) | (((lane >> 2) & 3) << 6) | (((lane >> 4) & 1) << 5) | (((lane >> 5) & 1) << 8); }
constexpr int v_rd_off(int d0, int ks, int half) { return d0 * 512 + ks * 4096 + half * 2048; }
template <int OFF> __device__ __forceinline__ s16x4 tr_read(int vb) {
  s16x4 r; asm volatile("ds_read_b64_tr_b16 %0, %1 offset:%2" : "=&v"(r) : "v"(vb), "i"(OFF) : "memory"); return r;
}
template <int D0> __device__ __forceinline__ void pv_one(f32x16& od, int vb, bf16x8 pa0, bf16x8 pa1, bf16x8 pa2, bf16x8 pa3) {
  const s16x4 l0 = tr_read<v_rd_off(D0, 0, 0)>(vb), h0 = tr_read<v_rd_off(D0, 0, 1)>(vb), l1 = tr_read<v_rd_off(D0, 1, 0)>(vb), h1 = tr_read<v_rd_off(D0, 1, 1)>(vb);
  const s16x4 l2 = tr_read<v_rd_off(D0, 2, 0)>(vb), h2 = tr_read<v_rd_off(D0, 2, 1)>(vb), l3 = tr_read<v_rd_off(D0, 3, 0)>(vb), h3 = tr_read<v_rd_off(D0, 3, 1)>(vb);
  asm volatile("s_waitcnt lgkmcnt(0)" ::: "memory"); SBAR();
#define PK(L, H) (bf16x8){L[0], L[1], L[2], L[3], H[0], H[1], H[2], H[3]}
  od = __builtin_amdgcn_mfma_f32_32x32x16_bf16(pa0, PK(l0, h0), od, 0, 0, 0);
  od = __builtin_amdgcn_mfma_f32_32x32x16_bf16(pa1, PK(l1, h1), od, 0, 0, 0);
  od = __builtin_amdgcn_mfma_f32_32x32x16_bf16(pa2, PK(l2, h2), od, 0, 0, 0);
  od = __builtin_amdgcn_mfma_f32_32x32x16_bf16(pa3, PK(l3, h3), od, 0, 0, 0);
#undef PK
}
__device__ __forceinline__ void pv_d0(f32x16* o, int vb, bf16x8 pa0, bf16x8 pa1, bf16x8 pa2, bf16x8 pa3) {
  pv_one<0>(o[0], vb, pa0, pa1, pa2, pa3); pv_one<1>(o[1], vb, pa0, pa1, pa2, pa3); pv_one<2>(o[2], vb, pa0, pa1, pa2, pa3); pv_one<3>(o[3], vb, pa0, pa1, pa2, pa3);
}
__device__ __forceinline__ void attn_unit(const bf16_t* __restrict__ Qb, const bf16_t* __restrict__ Kh, const bf16_t* __restrict__ Vh, bf16_t* __restrict__ Ob, int ldo, int seq, char* lds, const int tid) {
  const int wid = tid >> 6, lane = tid & 63, r32 = lane & 31, hi = lane >> 5;
  char* V_lds = lds + OFF_V; char* K_lds = lds + OFF_K;
  float* ws = (float*)(lds + OFF_WS) + wid * 64; float* li_l = ws; float* al_l = ws + 32;
  float m_reg = -1e30f, l_reg = 0; f32x16 o[4] = {}; bf16x8 qr[4];
  const bf16_t* Qw = Qb + (long)(wid * QBLK + r32) * LDQ + hi * 8;
#pragma unroll
  for (int d0 = 0; d0 < 4; ++d0) qr[d0] = *reinterpret_cast<const bf16x8*>(Qw + d0 * 16);
  const int sr = tid >> 4, sc = (tid & 15) * 8, vst0 = v_st(sr, sc), vst1 = v_st(32 + sr, sc);
  const int kr = tid >> 3, kc = (tid & 7) * 8, kst = kr * KROW + kc * 2;
  const int vb0 = (int)(uintptr_t)V_lds + v_rd_base(lane);
  struct { bf16x8 vs0, vs1, ks0; } sr_[2];
#define SLOAD(i, k0) do { sr_[i].vs0 = *reinterpret_cast<const bf16x8*>(&Vh[(long)((k0) + sr) * LDQ + sc]); sr_[i].vs1 = *reinterpret_cast<const bf16x8*>(&Vh[(long)((k0) + 32 + sr) * LDQ + sc]); \
    sr_[i].ks0 = *reinterpret_cast<const bf16x8*>(&Kh[(long)((k0) + kr) * LDQ + kc]); } while (0)
#define SWRITE(b, i) do { *(bf16x8*)(V_lds + (b) * SHM_V + vst0) = sr_[i].vs0; *(bf16x8*)(V_lds + (b) * SHM_V + vst1) = sr_[i].vs1; \
    *(bf16x8*)(K_lds + (b) * SHM_K + kst) = sr_[i].ks0; } while (0)
#define SWAIT() asm volatile("s_waitcnt vmcnt(3)" ::: "memory")
#define RESC(a) do { if (__any((a) < 1.f)) { if (hi == 0) al_l[r32] = (a); asm volatile("s_waitcnt lgkmcnt(0)" ::: "memory"); \
    _Pragma("unroll") for (int d = 0; d < 4; ++d) _Pragma("unroll") for (int r = 0; r < 16; ++r) o[d][r] *= al_l[crow(r, hi)]; } } while (0)
  f32x16 pA0, pA1, pB0, pB1; float mnA, mnB, alA, alB; bf16x8 pa0, pa1, pa2, pa3; const int NT = seq / KVBLK;
  constexpr int SE = 0, SO = 1;
  SLOAD(SE, 0); asm volatile("s_waitcnt vmcnt(0)" ::: "memory"); SWRITE(0, SE); __syncthreads();
  qkt(pA0, pA1, K_lds, qr, r32, hi); partialSM(pA0, pA1, m_reg, mnA, alA);
  SLOAD(SO, KVBLK); if (2 < NT) SLOAD(SE, 2 * KVBLK);
  SWAIT(); SWRITE(1, SO); __syncthreads();
  for (int j = 1; j + 1 < NT; j += 2) {
    SBAR(); qkt(pB0, pB1, K_lds + SHM_K, qr, r32, hi);
    finishSM(pA0, pA1, alA, l_reg, pa0, pa1, pa2, pa3); SBAR();
    SLOAD(SO, (j + 2) * KVBLK); SBAR();
    pv_d0(o, vb0, pa0, pa1, pa2, pa3); partialSM(pB0, pB1, m_reg, mnB, alB);
    __syncthreads(); SWAIT(); SWRITE(0, SE);
    RESC(alB); __syncthreads();
    SBAR(); qkt(pA0, pA1, K_lds, qr, r32, hi);
    finishSM(pB0, pB1, alB, l_reg, pa0, pa1, pa2, pa3); SBAR();
    if (j + 3 < NT) SLOAD(SE, (j + 3) * KVBLK); SBAR();
    pv_d0(o, vb0 + SHM_V, pa0, pa1, pa2, pa3); partialSM(pA0, pA1, m_reg, mnA, alA);
    __syncthreads(); SWAIT(); SWRITE(1, SO);
    RESC(alA); __syncthreads();
  }
  SBAR(); qkt(pB0, pB1, K_lds + SHM_K, qr, r32, hi);
  finishSM(pA0, pA1, alA, l_reg, pa0, pa1, pa2, pa3); SBAR();
  pv_d0(o, vb0, pa0, pa1, pa2, pa3); partialSM(pB0, pB1, m_reg, mnB, alB);
  __syncthreads(); RESC(alB);
  finishSM(pB0, pB1, alB, l_reg, pa0, pa1, pa2, pa3); SBAR();
  pv_d0(o, vb0 + SHM_V, pa0, pa1, pa2, pa3);
  if (hi == 0) li_l[r32] = l_reg; asm volatile("s_waitcnt lgkmcnt(0)" ::: "memory");
  float rli[16];
#pragma unroll
  for (int r = 0; r < 16; ++r) rli[r] = __builtin_amdgcn_rcpf(li_l[crow(r, hi)]);
  { bf16_t* stg = (bf16_t*)(lds + OFF_OST) + wid * 4096;
#pragma unroll
    for (int r = 0; r < 16; ++r) { const int orow = crow(r, hi);
#pragma unroll
      for (int d0 = 0; d0 < 4; ++d0) stg[orow * 128 + d0 * 32 + r32] = (bf16_t)(cvt_pk_bf16(o[d0][r] * rli[r], 0.f) & 0xffffu); }
    asm volatile("s_waitcnt lgkmcnt(0)" ::: "memory");
    bf16_t* Ow = Ob + (long)(wid * QBLK) * ldo;
#pragma unroll
    for (int i = 0; i < 8; ++i) { const int row = i * 4 + (lane >> 4), ch = lane & 15; const u32x4 v = *(const u32x4*)(stg + row * 128 + ch * 8); *(u32x4*)(Ow + (long)row * ldo + ch * 8) = v; } }
  __syncthreads();
#undef SLOAD
#undef SWRITE
#undef SWAIT
#undef RESC
}
#undef SBAR
}


namespace att2 {
using bf16x8 = __attribute__((ext_vector_type(8))) short;
using s16x4  = __attribute__((ext_vector_type(4))) short;
using f32x16 = __attribute__((ext_vector_type(16))) float;
constexpr int NW = 8, QBLK = 32, KVBLK = 64, LDQ = 1024, LDK = 64, LDV = 128;
constexpr int KSL = 8192, VSL = 16384, K_OFF = 0, V_OFF = 3 * KSL, OFF_WS = V_OFF + 4 * VSL, ATT_LDS = OFF_WS + NW * 64 * 4;
constexpr float THRL = 8.f;
#define SBAR() __builtin_amdgcn_sched_barrier(0)
__device__ __forceinline__ int crow(int r, int hi) { return (r & 3) + 8 * (r >> 2) + 4 * hi; }
__device__ __forceinline__ int v_rd_base(int lane) { return ((lane & 3) << 3) | (((lane >> 2) & 3) << 6) | (((lane >> 4) & 1) << 5) | (((lane >> 5) & 1) << 8); }
constexpr int v_rd_off(int d0, int ks, int half) { return d0 * 512 + ks * 4096 + half * 2048; }
template <int OFF> __device__ __forceinline__ s16x4 tr_read(int vb) {
  s16x4 r; asm volatile("ds_read_b64_tr_b16 %0, %1 offset:%2" : "=&v"(r) : "v"(vb), "i"(OFF) : "memory"); return r;
}
template <int D0> __device__ __forceinline__ void pv_one(f32x16& od, int vb, bf16x8 pa0, bf16x8 pa1, bf16x8 pa2, bf16x8 pa3) {
  const s16x4 l0 = tr_read<v_rd_off(D0, 0, 0)>(vb), h0 = tr_read<v_rd_off(D0, 0, 1)>(vb), l1 = tr_read<v_rd_off(D0, 1, 0)>(vb), h1 = tr_read<v_rd_off(D0, 1, 1)>(vb);
  const s16x4 l2 = tr_read<v_rd_off(D0, 2, 0)>(vb), h2 = tr_read<v_rd_off(D0, 2, 1)>(vb), l3 = tr_read<v_rd_off(D0, 3, 0)>(vb), h3 = tr_read<v_rd_off(D0, 3, 1)>(vb);
  asm volatile("s_waitcnt lgkmcnt(0)" ::: "memory"); SBAR();
#define PK(L, H) (bf16x8){L[0], L[1], L[2], L[3], H[0], H[1], H[2], H[3]}
  od = __builtin_amdgcn_mfma_f32_32x32x16_bf16(pa0, PK(l0, h0), od, 0, 0, 0);
  od = __builtin_amdgcn_mfma_f32_32x32x16_bf16(pa1, PK(l1, h1), od, 0, 0, 0);
  od = __builtin_amdgcn_mfma_f32_32x32x16_bf16(pa2, PK(l2, h2), od, 0, 0, 0);
  od = __builtin_amdgcn_mfma_f32_32x32x16_bf16(pa3, PK(l3, h3), od, 0, 0, 0);
#undef PK
}
struct VFrag { s16x4 l0, h0, l1, h1, l2, h2, l3, h3; };
template <int D0> __device__ __forceinline__ void v_issue(VFrag& f, int vb) {
  f.l0 = tr_read<v_rd_off(D0, 0, 0)>(vb); f.h0 = tr_read<v_rd_off(D0, 0, 1)>(vb); f.l1 = tr_read<v_rd_off(D0, 1, 0)>(vb); f.h1 = tr_read<v_rd_off(D0, 1, 1)>(vb);
  f.l2 = tr_read<v_rd_off(D0, 2, 0)>(vb); f.h2 = tr_read<v_rd_off(D0, 2, 1)>(vb); f.l3 = tr_read<v_rd_off(D0, 3, 0)>(vb); f.h3 = tr_read<v_rd_off(D0, 3, 1)>(vb);
}
template <int WAITN> __device__ __forceinline__ void pv_mma(f32x16& od, const VFrag& f, bf16x8 pa0, bf16x8 pa1, bf16x8 pa2, bf16x8 pa3) {
  if (WAITN == 8) asm volatile("s_waitcnt lgkmcnt(8)" ::: "memory"); else asm volatile("s_waitcnt lgkmcnt(0)" ::: "memory");
  SBAR();
#define PK(L, H) (bf16x8){L[0], L[1], L[2], L[3], H[0], H[1], H[2], H[3]}
  od = __builtin_amdgcn_mfma_f32_32x32x16_bf16(pa0, PK(f.l0, f.h0), od, 0, 0, 0);
  od = __builtin_amdgcn_mfma_f32_32x32x16_bf16(pa1, PK(f.l1, f.h1), od, 0, 0, 0);
  od = __builtin_amdgcn_mfma_f32_32x32x16_bf16(pa2, PK(f.l2, f.h2), od, 0, 0, 0);
  od = __builtin_amdgcn_mfma_f32_32x32x16_bf16(pa3, PK(f.l3, f.h3), od, 0, 0, 0);
#undef PK
}
__device__ __forceinline__ void pv_pipe(f32x16* o, int vb, bf16x8 pa0, bf16x8 pa1, bf16x8 pa2, bf16x8 pa3) {
  VFrag f0, f1;
  v_issue<0>(f0, vb); SBAR();
  v_issue<1>(f1, vb); SBAR(); pv_mma<8>(o[0], f0, pa0, pa1, pa2, pa3); SBAR();
  v_issue<2>(f0, vb); SBAR(); pv_mma<8>(o[1], f1, pa0, pa1, pa2, pa3); SBAR();
  v_issue<3>(f1, vb); SBAR(); pv_mma<8>(o[2], f0, pa0, pa1, pa2, pa3); SBAR();
  pv_mma<0>(o[3], f1, pa0, pa1, pa2, pa3);
}
__device__ __forceinline__ void qkt(f32x16& p0, f32x16& p1, const LAS unsigned char* Ks, const bf16x8* qr, const f32x16& cinit, int r32, int hi) {
  const LAS unsigned char* kb0 = Ks + r32 * 128; const int sw = r32 & 7;
#pragma unroll
  for (int d0 = 0; d0 < 4; ++d0) { const int ch = ((2 * d0 + hi) ^ sw) << 4;
    const bf16x8 b0 = *(const LAS bf16x8*)(kb0 + ch), b1 = *(const LAS bf16x8*)(kb0 + 4096 + ch);
    if (d0 == 0) { p0 = __builtin_amdgcn_mfma_f32_32x32x16_bf16(b0, qr[0], cinit, 0, 0, 0); p1 = __builtin_amdgcn_mfma_f32_32x32x16_bf16(b1, qr[0], cinit, 0, 0, 0); }
    else { p0 = __builtin_amdgcn_mfma_f32_32x32x16_bf16(b0, qr[d0], p0, 0, 0, 0); p1 = __builtin_amdgcn_mfma_f32_32x32x16_bf16(b1, qr[d0], p1, 0, 0, 0); } }
}
__device__ __forceinline__ float rowmax(const f32x16& p0, const f32x16& p1) {
  float a = fmaxf(fmaxf(p0[0], p0[1]), p1[0]), b = fmaxf(fmaxf(p0[2], p0[3]), p1[1]); a = fmaxf(fmaxf(a, p1[2]), p1[3]);
#pragma unroll
  for (int r = 4; r < 16; r += 4) { a = fmaxf(fmaxf(a, p0[r]), p0[r + 1]); b = fmaxf(fmaxf(b, p0[r + 2]), p0[r + 3]); a = fmaxf(fmaxf(a, p1[r]), p1[r + 1]); b = fmaxf(fmaxf(b, p1[r + 2]), p1[r + 3]); }
  const float m = fmaxf(a, b);
  auto rr = __builtin_amdgcn_permlane32_swap(__float_as_uint(m), __float_as_uint(m), false, false);
  return fmaxf(__uint_as_float(rr[0]), __uint_as_float(rr[1]));
}
#define A2_PK4(P, BASE, OUT) do { u32x4 w_ = {cvt_pk_bf16(P[BASE + 0], P[BASE + 1]), cvt_pk_bf16(P[BASE + 2], P[BASE + 3]), cvt_pk_bf16(P[BASE + 4], P[BASE + 5]), cvt_pk_bf16(P[BASE + 6], P[BASE + 7])}; \
    OUT = *reinterpret_cast<bf16x8*>(&w_); } while (0)

__device__ __forceinline__ void attn_unit(const bf16_t* __restrict__ Qb, const bf16_t* __restrict__ Kh, const bf16_t* __restrict__ Vh, bf16_t* __restrict__ Ob, int ldo, int seq, LAS unsigned char* lds, const int tid) {
  const int wid = __builtin_amdgcn_readfirstlane(tid >> 6), lane = tid & 63, r32 = lane & 31, hi = lane >> 5;
  LAS float* ws = (LAS float*)(lds + OFF_WS) + wid * 64;
  const unsigned koff = (unsigned)(((8 * wid + (lane >> 3)) * LDK + (((lane & 7) ^ (lane >> 3)) * 8)) * 2);
  const unsigned voff = (unsigned)(((8 * wid + ((lane & 31) >> 2)) * LDV + 32 * (lane >> 5) + 8 * (lane & 3)) * 2);
#define A2_DMA(t, ks, vs) do { const char* kb_ = (const char*)Kh + (size_t)(t) * (KVBLK * LDK * 2); const char* vb_ = (const char*)Vh + (size_t)(t) * (KVBLK * LDV * 2); \
    __builtin_amdgcn_global_load_lds((const unsigned*)(kb_ + koff), (LAS unsigned*)(lds + K_OFF + (ks) + wid * 1024), 16, 0, 0); \
    __builtin_amdgcn_global_load_lds((const unsigned*)(vb_ + voff), (LAS unsigned*)(lds + V_OFF + (vs) + wid * 2048), 16, 0, 0); \
    __builtin_amdgcn_global_load_lds((const unsigned*)(vb_ + voff + 128), (LAS unsigned*)(lds + V_OFF + (vs) + wid * 2048 + 1024), 16, 0, 0); } while (0)
#define A2_WAITBAR() do { asm volatile("s_waitcnt vmcnt(0) lgkmcnt(0)" ::: "memory"); __builtin_amdgcn_s_barrier(); asm volatile("" ::: "memory"); } while (0)
  const int NT = seq / KVBLK;
  const bool trail = wid >= 4;
  A2_DMA(0, 0, 0); A2_DMA(1, KSL, VSL);
  bf16x8 qr[4];
  { const bf16_t* Qw = Qb + (long)(wid * QBLK + r32) * LDQ + hi * 8;
#pragma unroll
    for (int d0 = 0; d0 < 4; ++d0) qr[d0] = *reinterpret_cast<const bf16x8*>(Qw + d0 * 16); }
  float mhat = 0.f, l_reg = 0.f; f32x16 o[4] = {}; f32x16 negm = {};
  const int vbase = (int)(uintptr_t)(lds + V_OFF) + v_rd_base(lane);
  A2_WAITBAR();
  if (NT > 2) A2_DMA(2, 2 * KSL, 2 * VSL);
  f32x16 pA0, pA1, pB0, pB1; bf16x8 pa0, pa1, pa2, pa3;
  qkt(pA0, pA1, lds + K_OFF, qr, negm, r32, hi);
  { const float rm = rowmax(pA0, pA1); mhat = rm;
#pragma unroll
    for (int r = 0; r < 16; ++r) { pA0[r] -= rm; pA1[r] -= rm; negm[r] = -rm; }
#pragma unroll
    for (int r = 0; r < 16; ++r) { pA0[r] = __builtin_amdgcn_exp2f(pA0[r]); pA1[r] = __builtin_amdgcn_exp2f(pA1[r]); } }
  int k_cur = KSL, k_dma = 0;
  int v_prev = 0, v_dma = 3 * VSL;
#define A2_ROT() do { k_cur = (k_cur == 2 * KSL) ? 0 : k_cur + KSL; k_dma = (k_dma == 2 * KSL) ? 0 : k_dma + KSL; v_prev = (v_prev == 3 * VSL) ? 0 : v_prev + VSL; v_dma = (v_dma == 3 * VSL) ? 0 : v_dma + VSL; } while (0)
#define A2_SEAM(t) do { A2_WAITBAR(); if ((t) + 2 < NT) A2_DMA((t) + 2, k_dma, v_dma); } while (0)
#define A2_EXP(X, i) X[i] = __builtin_amdgcn_exp2f(X[i])
#define A2_SG(mask, n) __builtin_amdgcn_sched_group_barrier(mask, n, 0)
#define A2_STEP(C0, C1, P0, P1, t) do { bool resc_ = false; \
    SBAR(); \
      \
    qkt(C0, C1, lds + K_OFF + k_cur, qr, negm, r32, hi); \
    { float sa_ = 0.f, sb_ = 0.f; _Pragma("unroll") for (int r = 0; r < 16; ++r) { sa_ += P0[r]; sb_ += P1[r]; } l_reg += sa_ + sb_; } \
    A2_PK4(P0, 0, pa0); A2_PK4(P0, 8, pa1); A2_PK4(P1, 0, pa2); A2_PK4(P1, 8, pa3); \
    A2_SG(0x100, 2); A2_SG(0x100, 2); A2_SG(0x8, 1); A2_SG(0x402, 6); A2_SG(0x8, 1); A2_SG(0x402, 6); A2_SG(0x100, 2); A2_SG(0x8, 1); A2_SG(0x402, 6); A2_SG(0x8, 1); A2_SG(0x402, 6); \
    A2_SG(0x100, 2); A2_SG(0x8, 1); A2_SG(0x402, 6); A2_SG(0x8, 1); A2_SG(0x402, 6); A2_SG(0x8, 1); A2_SG(0x402, 6); A2_SG(0x8, 1); A2_SG(0x402, 6); \
    if (MK_ATT_XMFMA) { f32x16 dz_ = negm; _Pragma("unroll") for (int x_ = 0; x_ < 8; ++x_) asm volatile("v_mfma_f32_32x32x16_bf16 %0, %1, %2, %0" : "+v"(dz_) : "v"(qr[x_ & 3]), "v"(qr[(x_ + 1) & 3])); asm volatile("" :: "v"(dz_)); } \
    if (MK_ATT_XEXP) { float dx_ = mhat; _Pragma("unroll") for (int x_ = 0; x_ < 32; ++x_) asm volatile("v_exp_f32 %0, %0" : "+v"(dx_)); asm volatile("" :: "v"(dx_)); } \
    asm volatile("" : "+v"(l_reg), "+v"(pa0), "+v"(pa1), "+v"(pa2), "+v"(pa3)); SBAR(); \
    if (trail) A2_SEAM(t); \
    { const int vb_ = vbase + v_prev; VFrag f0_, f1_; \
        \
      v_issue<0>(f0_, vb_); v_issue<1>(f1_, vb_); SBAR(); \
      pv_mma<8>(o[0], f0_, pa0, pa1, pa2, pa3); \
      { const float rm_ = rowmax(C0, C1); \
        if (__builtin_expect(__any(rm_ > THRL), 0)) { const float dl_ = fmaxf(rm_, 0.f); mhat += dl_; \
          _Pragma("unroll") for (int r = 0; r < 16; ++r) { C0[r] -= dl_; C1[r] -= dl_; negm[r] = -mhat; } \
          const float f_ = __builtin_amdgcn_exp2f(-dl_); l_reg *= f_; if (hi == 0) ws[r32] = f_; resc_ = true; } } \
      SBAR(); \
        \
      v_issue<2>(f0_, vb_); SBAR(); pv_mma<8>(o[1], f1_, pa0, pa1, pa2, pa3); \
      A2_EXP(C0, 0); A2_EXP(C0, 1); A2_EXP(C0, 2); A2_EXP(C0, 3); A2_EXP(C0, 4); A2_EXP(C0, 5); A2_EXP(C0, 6); A2_EXP(C0, 7); A2_EXP(C0, 8); A2_EXP(C0, 9); A2_EXP(C0, 10); \
      A2_SG(0x8, 1); A2_SG(0x402, 3); A2_SG(0x8, 1); A2_SG(0x402, 3); A2_SG(0x8, 1); A2_SG(0x402, 3); A2_SG(0x8, 1); A2_SG(0x402, 3); \
      asm volatile("" : "+v"(C0)); SBAR(); \
      v_issue<3>(f1_, vb_); SBAR(); pv_mma<8>(o[2], f0_, pa0, pa1, pa2, pa3); \
      A2_EXP(C0, 11); A2_EXP(C0, 12); A2_EXP(C0, 13); A2_EXP(C0, 14); A2_EXP(C0, 15); A2_EXP(C1, 0); A2_EXP(C1, 1); A2_EXP(C1, 2); A2_EXP(C1, 3); A2_EXP(C1, 4); A2_EXP(C1, 5); \
      A2_SG(0x8, 1); A2_SG(0x402, 3); A2_SG(0x8, 1); A2_SG(0x402, 3); A2_SG(0x8, 1); A2_SG(0x402, 3); A2_SG(0x8, 1); A2_SG(0x402, 3); \
      asm volatile("" : "+v"(C0), "+v"(C1)); SBAR(); \
      pv_mma<0>(o[3], f1_, pa0, pa1, pa2, pa3); \
      A2_EXP(C1, 6); A2_EXP(C1, 7); A2_EXP(C1, 8); A2_EXP(C1, 9); A2_EXP(C1, 10); A2_EXP(C1, 11); A2_EXP(C1, 12); A2_EXP(C1, 13); A2_EXP(C1, 14); A2_EXP(C1, 15); \
      A2_SG(0x8, 1); A2_SG(0x402, 3); A2_SG(0x8, 1); A2_SG(0x402, 3); A2_SG(0x8, 1); A2_SG(0x402, 3); A2_SG(0x8, 1); A2_SG(0x402, 3); \
      asm volatile("" : "+v"(C1)); SBAR(); } \
    if (resc_) { asm volatile("s_waitcnt lgkmcnt(0)" ::: "memory"); \
      _Pragma("unroll") for (int d_ = 0; d_ < 4; ++d_) _Pragma("unroll") for (int r = 0; r < 16; ++r) o[d_][r] *= ws[crow(r, hi)]; } \
    if (!trail) A2_SEAM(t); \
    A2_ROT(); } while (0)
  int t = 1;
  for (; t + 1 < NT; t += 2) { A2_STEP(pB0, pB1, pA0, pA1, t); A2_STEP(pA0, pA1, pB0, pB1, t + 1); }
  A2_STEP(pB0, pB1, pA0, pA1, t);
  { float sa_ = 0.f, sb_ = 0.f;
#pragma unroll
    for (int r = 0; r < 16; ++r) { sa_ += pB0[r]; sb_ += pB1[r]; }
    l_reg += sa_ + sb_;
    A2_PK4(pB0, 0, pa0); A2_PK4(pB0, 8, pa1); A2_PK4(pB1, 0, pa2); A2_PK4(pB1, 8, pa3);
    SBAR(); const int vb_ = vbase + v_prev;
    pv_pipe(o, vb_, pa0, pa1, pa2, pa3); }
  { auto rr = __builtin_amdgcn_permlane32_swap(__float_as_uint(l_reg), __float_as_uint(l_reg), false, false); l_reg = __uint_as_float(rr[0]) + __uint_as_float(rr[1]); }
  if (hi == 0) ws[32 + r32] = l_reg;
  A2_WAITBAR();
  float rli[16];
#pragma unroll
  for (int r = 0; r < 16; ++r) rli[r] = __builtin_amdgcn_rcpf(ws[32 + crow(r, hi)]);
  { LAS bf16_t* stg = (LAS bf16_t*)lds + wid * 4096;
#pragma unroll
    for (int r = 0; r < 16; ++r) { const int orow = crow(r, hi);
#pragma unroll
      for (int d0 = 0; d0 < 4; ++d0) stg[orow * 128 + d0 * 32 + r32] = (bf16_t)(cvt_pk_bf16(o[d0][r] * rli[r], 0.f) & 0xffffu); }
    asm volatile("s_waitcnt lgkmcnt(0)" ::: "memory");
    bf16_t* Ow = Ob + (long)(wid * QBLK) * ldo;
#pragma unroll
    for (int i = 0; i < 8; ++i) { const int row = i * 4 + (lane >> 4), ch = lane & 15; const u32x4 v = *(const LAS u32x4*)(stg + row * 128 + ch * 8); *(u32x4*)(Ow + (long)row * ldo + ch * 8) = v; } }
  A2_WAITBAR();
#undef A2_DMA
#undef A2_WAITBAR
#undef A2_ROT
#undef A2_SEAM
#undef A2_STEP
#undef A2_EXP
#undef A2_SG
}
#undef A2_PK4
#undef SBAR
}


namespace att3 {
using f32x16 = __attribute__((ext_vector_type(16))) float;
typedef int v8i __attribute__((ext_vector_type(8)));
typedef int v4i __attribute__((ext_vector_type(4)));
constexpr int NW = 8, QBLK = 32, KVBLK = 64;
constexpr int KSL = 8192, VSL = 16384, K_OFF = 0, V_OFF = 3 * KSL, OFF_WS = V_OFF + 3 * VSL, OFF_Q = OFF_WS + NW * 64 * 4, OFF_ONES = OFF_Q + NW * 2048, ATT_LDS = OFF_ONES + 64;
constexpr float THRL = 8.f;
constexpr int SC_ONE = 0x7f7f7f7f, SC_Q = 0x7b7b7b7b;
#define SBAR() __builtin_amdgcn_sched_barrier(0)
__device__ __forceinline__ int crow(int r, int hi) { return (r & 3) + 8 * (r >> 2) + 4 * hi; }
__host__ __device__ __forceinline__ int slot_key(int s) { const int hi = s >> 5, j = s & 31, jj = j & 15; return (j >> 4) * 32 + (jj & 3) + 8 * (jj >> 2) + 4 * hi; }
__device__ __forceinline__ v8i ld32(const LAS unsigned char* rowp, int c0, int sw) {
    const v4i a = *(const LAS v4i*)(rowp + ((c0 ^ sw) << 4)), b = *(const LAS v4i*)(rowp + (((c0 + 1) ^ sw) << 4));
    return (v8i){a[0], a[1], a[2], a[3], b[0], b[1], b[2], b[3]};
}
__device__ __forceinline__ void qkt(f32x16& p0, f32x16& p1, const LAS unsigned char* Ks, const v8i& qf, const f32x16& cinit, int r32, int hi) {
    const int sw = (r32 >> 2) & 3;
    const v8i k0 = ld32(Ks + r32 * 64, 2 * hi, sw), k1 = ld32(Ks + (32 + r32) * 64, 2 * hi, sw);
    p0 = __builtin_amdgcn_mfma_scale_f32_32x32x64_f8f6f4(k0, qf, cinit, 0, 0, 0, SC_ONE, 0, SC_Q);
    p1 = __builtin_amdgcn_mfma_scale_f32_32x32x64_f8f6f4(k1, qf, cinit, 0, 0, 0, SC_ONE, 0, SC_Q);
}
__device__ __forceinline__ float lanemax(const f32x16& p0, const f32x16& p1) {
  float a = fmaxf(fmaxf(p0[0], p0[1]), p1[0]), b = fmaxf(fmaxf(p0[2], p0[3]), p1[1]); a = fmaxf(fmaxf(a, p1[2]), p1[3]);
#pragma unroll
  for (int r = 4; r < 16; r += 4) { a = fmaxf(fmaxf(a, p0[r]), p0[r + 1]); b = fmaxf(fmaxf(b, p0[r + 2]), p0[r + 3]); a = fmaxf(fmaxf(a, p1[r]), p1[r + 1]); b = fmaxf(fmaxf(b, p1[r + 2]), p1[r + 3]); }
  return fmaxf(a, b);
}
__device__ __forceinline__ float rowmax4(const f32x16& p0, const f32x16& p1, const f32x16& p2, const f32x16& p3) {
  const float m = fmaxf(lanemax(p0, p1), lanemax(p2, p3));
  auto rr = __builtin_amdgcn_permlane32_swap(__float_as_uint(m), __float_as_uint(m), false, false);
  return fmaxf(__uint_as_float(rr[0]), __uint_as_float(rr[1]));
}
__device__ __forceinline__ v8i pack_p(const f32x16& p0, const f32x16& p1) {
    v8i w;
    w[0] = (int)cvt4_fp8_nc(p0[0], p0[1], p0[2], p0[3]); w[1] = (int)cvt4_fp8_nc(p0[4], p0[5], p0[6], p0[7]); w[2] = (int)cvt4_fp8_nc(p0[8], p0[9], p0[10], p0[11]); w[3] = (int)cvt4_fp8_nc(p0[12], p0[13], p0[14], p0[15]);
    w[4] = (int)cvt4_fp8_nc(p1[0], p1[1], p1[2], p1[3]); w[5] = (int)cvt4_fp8_nc(p1[4], p1[5], p1[6], p1[7]); w[6] = (int)cvt4_fp8_nc(p1[8], p1[9], p1[10], p1[11]); w[7] = (int)cvt4_fp8_nc(p1[12], p1[13], p1[14], p1[15]);
    return w;
}
__device__ __forceinline__ void qk1(f32x16& d, const v8i& kop, const v8i& qf, const f32x16& c) {
    asm volatile("s_nop 1\n\tv_mfma_scale_f32_32x32x64_f8f6f4 %0, %1, %2, %3, %4, %5 op_sel_hi:[0,0,0]" : "=&v"(d) : "v"(kop), "v"(qf), "v"(c), "v"(SC_ONE), "v"(SC_Q));
}
__device__ __forceinline__ void pv1(f32x16& od, const v8i& pf, const v8i& vf) {
    asm volatile("s_nop 1\n\tv_mfma_scale_f32_32x32x64_f8f6f4 %0, %1, %2, %0, %3, %3 op_sel_hi:[0,0,0]" : "+v"(od) : "v"(pf), "v"(vf), "v"(SC_ONE));
}

__device__ __forceinline__ void attn_unit(const unsigned char* __restrict__ Q8b, const unsigned char* __restrict__ K8h0, size_t kmap_stride, const unsigned char* __restrict__ VT8h, bf16_t* __restrict__ AOb, int ldo, int seq,
                                          float lam, float osc, const float* __restrict__ subln, u32x4* __restrict__ o0g, LAS unsigned char* lds, const int tid) {
  const int wid = __builtin_amdgcn_readfirstlane(tid >> 6), lane = tid & 63, r32 = lane & 31, hi = lane >> 5;
  LAS float* ws = (LAS float*)(lds + OFF_WS) + wid * 64;
  const int prow = 16 * wid + (lane >> 2); const unsigned poff = (unsigned)(prow * 64 + (((lane & 3) ^ ((prow >> 2) & 3)) << 4));
#define A3_MFMA_FENCE() asm volatile("s_nop 15\n\ts_nop 15" : "+v"(o[0]), "+v"(o[1]), "+v"(o[2]), "+v"(o[3]), "+v"(osum))
#define A3_WAITBAR() do { asm volatile("s_waitcnt vmcnt(0) lgkmcnt(0)" ::: "memory"); __builtin_amdgcn_s_barrier(); asm volatile("" ::: "memory"); } while (0)
  const int NT2 = seq / 128;
  const int half = wid >> 2;
#define A3_DMAK(t) __builtin_amdgcn_global_load_lds((const unsigned*)(K8h + (size_t)(t) * 8192 + poff), (LAS unsigned*)(lds + K_OFF + ((t) % 3) * KSL + wid * 1024), 16, 0, 0)
#define A3_DMAV(t) do { __builtin_amdgcn_global_load_lds((const unsigned*)(VT8h + (size_t)(t) * 16384 + poff), (LAS unsigned*)(lds + V_OFF + ((t) % 3) * VSL + wid * 1024), 16, 0, 0); \
    __builtin_amdgcn_global_load_lds((const unsigned*)(VT8h + (size_t)(t) * 16384 + 8192 + poff), (LAS unsigned*)(lds + V_OFF + ((t) % 3) * VSL + 8192 + wid * 1024), 16, 0, 0); } while (0)
  f32x16 o[4]; f32x16 osum;
  for (int mp = 0; mp < 2; ++mp) {
  const unsigned char* K8h = K8h0 + (size_t)mp * kmap_stride;
  A3_DMAK(0); A3_DMAK(1); A3_DMAV(0);
  LAS v4i* qs = (LAS v4i*)(lds + OFF_Q + wid * 2048) + lane;
  { int lq_; asm volatile("v_mbcnt_lo_u32_b32 %0, -1, 0\n\tv_mbcnt_hi_u32_b32 %0, -1, %0" : "=v"(lq_));
    const unsigned char* Qw = Q8b + mp * 64 + (size_t)(wid * QBLK + (lq_ & 31)) * 1024 + (lq_ >> 5) * 32; const v4i a = *(const v4i*)Qw, b = *(const v4i*)(Qw + 16); qs[0] = a; qs[64] = b; }
#define A3_LDQ(buf) do { const v4i qa_ = qs[0], qb_ = qs[64]; buf = (v8i){qa_[0], qa_[1], qa_[2], qa_[3], qb_[0], qb_[1], qb_[2], qb_[3]}; } while (0)
  f32x16 negm = {};
#pragma unroll
  for (int r = 0; r < 16; ++r) { o[0][r] = 0.f; o[1][r] = 0.f; o[2][r] = 0.f; o[3][r] = 0.f; osum[r] = 0.f; }
  if (wid == 0 && lane < 8) *(LAS unsigned*)(lds + OFF_ONES + 4 * lane) = 0x38383838u;
#define A3_LD1(buf) do { const v4i oa_ = *(const LAS v4i*)(lds + OFF_ONES), ob_ = *(const LAS v4i*)(lds + OFF_ONES + 16); buf = (v8i){oa_[0], oa_[1], oa_[2], oa_[3], ob_[0], ob_[1], ob_[2], ob_[3]}; } while (0)
  const int swv = (r32 >> 2) & 3;
  A3_WAITBAR();
  if (NT2 > 2) A3_DMAK(2);
  A3_DMAV(1);
  f32x16 C0 = negm, C1 = negm, C2 = negm, C3 = negm; v8i pf0 = {}, pf1 = {};
#define A3_BAR_ODD() do { asm volatile("s_waitcnt lgkmcnt(0)" ::: "memory"); __builtin_amdgcn_s_barrier(); asm volatile("" ::: "memory"); } while (0)
#define A3_BAR_EVEN(m) do { if ((m) + 1 < NT2) asm volatile("s_waitcnt vmcnt(3) lgkmcnt(0)" ::: "memory"); else asm volatile("s_waitcnt vmcnt(0) lgkmcnt(0)" ::: "memory"); \
    __builtin_amdgcn_s_barrier(); asm volatile("" ::: "memory"); if ((m) + 2 < NT2) A3_DMAK((m) + 2); if ((m) + 1 < NT2) A3_DMAV((m) + 1); } while (0)
#define A3_LD(buf, p) buf = ld32((p), 2 * hi, swv)
#define A3_W(n) asm volatile("s_waitcnt lgkmcnt(" #n ")" ::: "memory"); SBAR()
#define A3_A_FIRST() do { const LAS unsigned char* Ks_ = lds + K_OFF + r32 * 64; v8i b0_, b1_, b2_; A3_LDQ(b2_); A3_LD(b0_, Ks_); A3_LD(b1_, Ks_ + 2048); \
    A3_W(0); qk1(C0, b0_, b2_, negm); qk1(C1, b1_, b2_, negm); SBAR(); A3_LD(b0_, Ks_ + 4096); A3_LD(b1_, Ks_ + 6144); A3_W(0); qk1(C2, b0_, b2_, negm); qk1(C3, b1_, b2_, negm); SBAR(); } while (0)
#define A3_A_MID(k) do { \
    const LAS unsigned char* Ks_ = lds + K_OFF + (((k) + 1) % 3) * KSL + r32 * 64; \
    const LAS unsigned char* vt_ = lds + V_OFF + ((k) % 3) * VSL + r32 * 64; \
    __builtin_amdgcn_s_setprio(1);                                   \
    v8i b0_, b1_, b2_, b3_; A3_LDQ(b3_); A3_LD(b0_, Ks_); A3_LD(b1_, Ks_ + 2048); A3_LD(b2_, Ks_ + 4096); \
    A3_W(4); qk1(C0, b0_, b3_, negm); SBAR(); A3_LD(b0_, Ks_ + 6144); \
    A3_W(4); qk1(C1, b1_, b3_, negm); SBAR(); A3_LD(b1_, vt_); \
    A3_W(4); qk1(C2, b2_, b3_, negm); SBAR(); A3_LD(b2_, vt_ + 2048); \
    A3_W(4); qk1(C3, b0_, b3_, negm); SBAR(); A3_LD1(b3_); A3_LD(b0_, vt_ + 4096); \
    A3_W(6); pv1(o[0], pf0, b1_); SBAR(); A3_LD(b1_, vt_ + 6144); \
    A3_W(6); pv1(o[1], pf0, b2_); SBAR(); A3_LD(b2_, vt_ + 8192); \
    A3_W(6); pv1(osum, pf0, b3_); SBAR(); A3_LD(b3_, vt_ + 8192 + 2048); \
    A3_W(6); pv1(o[2], pf0, b0_); SBAR(); A3_LD1(b0_); \
    A3_W(6); pv1(o[3], pf0, b1_); SBAR(); A3_LD(b1_, vt_ + 8192 + 4096); \
    A3_W(6); pv1(o[0], pf1, b2_); SBAR(); A3_LD(b2_, vt_ + 8192 + 6144); \
    A3_W(6); pv1(o[1], pf1, b3_); \
    A3_W(4); pv1(osum, pf1, b0_); \
    A3_W(2); pv1(o[2], pf1, b1_); \
    A3_W(0); pv1(o[3], pf1, b2_); \
    __builtin_amdgcn_s_setprio(0); \
    SBAR(); } while (0)
#define A3_A_LAST(k) do { \
    const LAS unsigned char* vt_ = lds + V_OFF + ((k) % 3) * VSL + r32 * 64; \
    v8i b0_, b1_, b2_; \
    _Pragma("unroll") for (int sb_ = 0; sb_ < 2; ++sb_) { const v8i& pfs_ = sb_ ? pf1 : pf0; \
      A3_LD(b0_, vt_ + sb_ * 8192); A3_LD(b1_, vt_ + sb_ * 8192 + 2048); A3_LD1(b2_); \
      asm volatile("s_waitcnt lgkmcnt(0)\n\ts_nop 1" ::: "memory"); SBAR(); \
      pv1(o[0], pfs_, b0_); pv1(o[1], pfs_, b1_); pv1(osum, pfs_, b2_); SBAR(); \
      A3_LD(b0_, vt_ + sb_ * 8192 + 4096); A3_LD(b1_, vt_ + sb_ * 8192 + 6144); \
      asm volatile("s_waitcnt lgkmcnt(0)\n\ts_nop 1" ::: "memory"); SBAR(); \
      pv1(o[2], pfs_, b0_); pv1(o[3], pfs_, b1_); SBAR(); } \
    } while (0)
#define A3_B(FIRST) do { \
    asm volatile("s_nop 7" : "+v"(C0), "+v"(C1), "+v"(C2), "+v"(C3));     \
    const float rm_ = rowmax4(C0, C1, C2, C3); \
    if (FIRST) {                                                    \
      _Pragma("unroll") for (int r = 0; r < 16; ++r) { C0[r] -= rm_; C1[r] -= rm_; C2[r] -= rm_; C3[r] -= rm_; negm[r] = -rm_; } } \
    else if (__builtin_expect(__any(rm_ > THRL), 0)) {              \
      const float dl_ = fmaxf(rm_, 0.f); const float nm_ = negm[0] - dl_; \
      _Pragma("unroll") for (int r = 0; r < 16; ++r) { C0[r] -= dl_; C1[r] -= dl_; C2[r] -= dl_; C3[r] -= dl_; negm[r] = nm_; } \
      int lr_; asm volatile("v_mbcnt_lo_u32_b32 %0, -1, 0\n\tv_mbcnt_hi_u32_b32 %0, -1, %0" : "=v"(lr_));     \
      const int r32r_ = lr_ & 31, hir_ = lr_ >> 5; \
      const float f_ = __builtin_amdgcn_exp2f(-dl_); if (hir_ == 0) ws[r32r_] = f_; \
      asm volatile("s_waitcnt lgkmcnt(0)" ::: "memory"); A3_MFMA_FENCE(); \
      _Pragma("unroll") for (int r = 0; r < 16; ++r) { const float fr_ = ws[crow(r, hir_)]; osum[r] *= fr_; _Pragma("unroll") for (int d_ = 0; d_ < 4; ++d_) o[d_][r] *= fr_; } } \
    _Pragma("unroll") for (int r = 0; r < 16; ++r) { C0[r] = __builtin_amdgcn_exp2f(C0[r]); C1[r] = __builtin_amdgcn_exp2f(C1[r]); } \
    pf0 = pack_p(C0, C1); \
    _Pragma("unroll") for (int r = 0; r < 16; ++r) { C2[r] = __builtin_amdgcn_exp2f(C2[r]); C3[r] = __builtin_amdgcn_exp2f(C3[r]); } \
    pf1 = pack_p(C2, C3); \
    asm volatile("" : "+v"(pf0), "+v"(pf1)); SBAR(); } while (0)
  if (half == 0) {
    A3_A_FIRST();
    A3_BAR_ODD(); A3_B(true);
    int k = 0;
    for (; k + 1 < NT2; ++k) { A3_BAR_EVEN(k + 1); A3_A_MID(k); A3_BAR_ODD(); A3_B(false); }
    A3_BAR_EVEN(k + 1); A3_A_LAST(k);
    A3_BAR_ODD();
  } else {
    A3_BAR_ODD(); A3_A_FIRST();
    A3_BAR_EVEN(1); A3_B(true);
    int k = 0;
    for (; k + 1 < NT2; ++k) { A3_BAR_ODD(); A3_A_MID(k); A3_BAR_EVEN(k + 2); A3_B(false); }
    A3_BAR_ODD(); A3_A_LAST(k);
  }
  A3_MFMA_FENCE();
  A3_WAITBAR();
  if (mp == 0) {
    int lo_; asm volatile("v_mbcnt_lo_u32_b32 %0, -1, 0\n\tv_mbcnt_hi_u32_b32 %0, -1, %0" : "=v"(lo_));
    u32x4* o0s = o0g + wid * 512 + lo_;
#pragma unroll
    for (int d0 = 0; d0 < 4; ++d0) {
#pragma unroll
      for (int r = 0; r < 16; r += 8) { u32x4 w;
        w.x = cvt_pk_bf16(o[d0][r] * __builtin_amdgcn_rcpf(osum[r]), o[d0][r + 1] * __builtin_amdgcn_rcpf(osum[r + 1]));
        w.y = cvt_pk_bf16(o[d0][r + 2] * __builtin_amdgcn_rcpf(osum[r + 2]), o[d0][r + 3] * __builtin_amdgcn_rcpf(osum[r + 3]));
        w.z = cvt_pk_bf16(o[d0][r + 4] * __builtin_amdgcn_rcpf(osum[r + 4]), o[d0][r + 5] * __builtin_amdgcn_rcpf(osum[r + 5]));
        w.w = cvt_pk_bf16(o[d0][r + 6] * __builtin_amdgcn_rcpf(osum[r + 6]), o[d0][r + 7] * __builtin_amdgcn_rcpf(osum[r + 7]));
        o0s[(d0 * 2 + (r >> 3)) * 64] = w; } }
  }
  }
  { LAS bf16_t* stg = (LAS bf16_t*)lds + wid * 4096;
    u32x4 o0w[8];
    { int lo_; asm volatile("v_mbcnt_lo_u32_b32 %0, -1, 0\n\tv_mbcnt_hi_u32_b32 %0, -1, %0" : "=v"(lo_));
      const u32x4* o0s = o0g + wid * 512 + lo_;
#pragma unroll
      for (int j = 0; j < 8; ++j) o0w[j] = o0s[j * 64]; }
#pragma unroll
    for (int r = 0; r < 16; r += 2) { const float i0 = __builtin_amdgcn_rcpf(osum[r]), i1 = __builtin_amdgcn_rcpf(osum[r + 1]); const int or0 = crow(r, hi), or1 = crow(r + 1, hi);
#pragma unroll
      for (int d0 = 0; d0 < 4; ++d0) { const unsigned pk = o0w[d0 * 2 + (r >> 3)][(r >> 1) & 3];
        const float v0 = bf_lo(pk) - lam * (o[d0][r] * i0), v1 = bf_hi(pk) - lam * (o[d0][r + 1] * i1);
        stg[or0 * 128 + d0 * 32 + r32] = (bf16_t)(cvt_pk_bf16(v0, 0.f) & 0xffffu); stg[or1 * 128 + d0 * 32 + r32] = (bf16_t)(cvt_pk_bf16(v1, 0.f) & 0xffffu); } }
    asm volatile("s_waitcnt lgkmcnt(0)" ::: "memory");
    bf16_t* Ow = AOb + (long)(wid * QBLK) * ldo;
    int lane_e; asm volatile("v_mbcnt_lo_u32_b32 %0, -1, 0\n\tv_mbcnt_hi_u32_b32 %0, -1, %0" : "=v"(lane_e));
    const int ch = lane_e & 15; const f32x4 g0 = *(const f32x4*)(subln + ch * 8), g1 = *(const f32x4*)(subln + ch * 8 + 4);
#pragma unroll
    for (int i = 0; i < 8; ++i) { const int row = i * 4 + (lane_e >> 4); const u32x4 v = *(const LAS u32x4*)(stg + row * 128 + ch * 8);
      float e[8] = {bf_lo(v.x), bf_hi(v.x), bf_lo(v.y), bf_hi(v.y), bf_lo(v.z), bf_hi(v.z), bf_lo(v.w), bf_hi(v.w)};
      float ss = 0.f;
#pragma unroll
      for (int q = 0; q < 8; ++q) ss += e[q] * e[q];
      ss = row16_sum(ss);
      const float rn = osc / sqrtf(ss * (1.0f / 128.0f) + EPS);
      u32x4 w; w.x = cvt_pk_bf16(e[0] * rn * g0[0], e[1] * rn * g0[1]); w.y = cvt_pk_bf16(e[2] * rn * g0[2], e[3] * rn * g0[3]);
      w.z = cvt_pk_bf16(e[4] * rn * g1[0], e[5] * rn * g1[1]); w.w = cvt_pk_bf16(e[6] * rn * g1[2], e[7] * rn * g1[3]);
      *(u32x4*)(Ow + (long)row * ldo + ch * 8) = w; } }
  A3_WAITBAR();
#undef A3_WAITBAR
#undef A3_DMAK
#undef A3_DMAV
#undef A3_BAR_ODD
#undef A3_BAR_EVEN
#undef A3_A_FIRST
#undef A3_LD
#undef A3_LDQ
#undef A3_LD1
#undef A3_W
#undef A3_A_MID
#undef A3_A_LAST
#undef A3_B
#undef A3_MFMA_FENCE
}
#undef SBAR
}

constexpr int RING_BYTES = 131072, MISC_OFF = RING_BYTES + 320, INTAB_OFF = RING_BYTES + 1024, LDS_BYTES = 147456;
struct Args { const float* in[50]; float* out; unsigned char* ws; int ph_lo, ph_hi; };

struct Ctx {
    LAS unsigned char* lds;
    int tid, lane, wave, G, bid;
    unsigned char* ws; float* out;
    __device__ __forceinline__ const float* inp(int idx) const {
        const LAS unsigned* t = (const LAS unsigned*)(lds + INTAB_OFF) + 2 * idx;
        const unsigned lo_ = __builtin_amdgcn_readfirstlane(t[0]), hi_ = __builtin_amdgcn_readfirstlane(t[1]);
        typedef __attribute__((address_space(1))) const float* gp_t; return (const float*)(gp_t)(((uintptr_t)hi_ << 32) | (uintptr_t)lo_); }
};

template <class T> __device__ __forceinline__ T* launder_ptr(T* p) { unsigned lo = (unsigned)(uintptr_t)p, hi = (unsigned)((uintptr_t)p >> 32); lo = __builtin_amdgcn_readfirstlane(lo); hi = __builtin_amdgcn_readfirstlane(hi);
    asm volatile("" : "+s"(lo), "+s"(hi)); typedef __attribute__((address_space(1))) T* gp_t; return (T*)(gp_t)(((uintptr_t)hi << 32) | (uintptr_t)lo); }
__device__ __forceinline__ int launder_i(int v) { v = __builtin_amdgcn_readfirstlane(v); asm volatile("" : "+s"(v)); return v; }
__device__ __forceinline__ int map_col(int kind, int n) {
    if (kind == 1) { if (n < 1024) return n; const int w = n - 1024, T = w >> 8, r = w & 255; return 1024 + (r >> 7) * 1024 + T * 128 + (r & 127); }
    if (kind == 2) { const int T = n >> 8, r = n & 255; return (r >> 7) * DFF + T * 128 + (r & 127); }
    if (kind == 3) { const int T = n >> 8, r = n & 255; return (r >> 7) * 1024 + T * 128 + (r & 127); }
    if (kind == 4) { if (n >= 2048) return n; const int blk = n >> 6, w = n & 63, half = w >> 5, ww = w & 31; return blk * 64 + half * 32 + (ww & 1) * 16 + (ww >> 1); }
    return n;
}
__device__ __forceinline__ void transpose_item8(const float* W, int K, int N, unsigned char* WT, int kind, int item, int lane) {
    const int nblk = N / 128, kb = item / nblk, nb = item % nblk, k0 = 128 * kb, n0 = 128 * nb;
    const int d0 = n0 + 2 * lane, s0 = map_col(kind, d0), s1 = map_col(kind, d0 + 1);
    const bool adj = (kind != 4) || (n0 >= 2048);
#pragma unroll
    for (int h = 0; h < 4; ++h) {
        float v0[32], v1[32];
        const float* wp = W + (size_t)(k0 + 32 * h) * N;
        if (adj) {
#pragma unroll
            for (int kk = 0; kk < 32; ++kk) { const f32x2 t = *(const f32x2*)(wp + (size_t)kk * N + s0); v0[kk] = t[0] * pg8::W8SCALE; v1[kk] = t[1] * pg8::W8SCALE; }
        } else {
#pragma unroll
            for (int kk = 0; kk < 32; ++kk) { v0[kk] = wp[(size_t)kk * N + s0] * pg8::W8SCALE; v1[kk] = wp[(size_t)kk * N + s1] * pg8::W8SCALE; }
        }
        unsigned char* o0 = WT + (size_t)d0 * K + k0 + 32 * h; unsigned char* o1 = o0 + K;
#pragma unroll
        for (int j = 0; j < 2; ++j) {
            u32x4 a, b;
            a.x = cvt4_fp8(v0[16 * j + 0], v0[16 * j + 1], v0[16 * j + 2], v0[16 * j + 3]); a.y = cvt4_fp8(v0[16 * j + 4], v0[16 * j + 5], v0[16 * j + 6], v0[16 * j + 7]);
            a.z = cvt4_fp8(v0[16 * j + 8], v0[16 * j + 9], v0[16 * j + 10], v0[16 * j + 11]); a.w = cvt4_fp8(v0[16 * j + 12], v0[16 * j + 13], v0[16 * j + 14], v0[16 * j + 15]);
            b.x = cvt4_fp8(v1[16 * j + 0], v1[16 * j + 1], v1[16 * j + 2], v1[16 * j + 3]); b.y = cvt4_fp8(v1[16 * j + 4], v1[16 * j + 5], v1[16 * j + 6], v1[16 * j + 7]);
            b.z = cvt4_fp8(v1[16 * j + 8], v1[16 * j + 9], v1[16 * j + 10], v1[16 * j + 11]); b.w = cvt4_fp8(v1[16 * j + 12], v1[16 * j + 13], v1[16 * j + 14], v1[16 * j + 15]);
            *(u32x4*)(o0 + 16 * j) = a; *(u32x4*)(o1 + 16 * j) = b; }
    }
}
__device__ __forceinline__ void transpose_item(const float* W, int K, int N, bf16_t* WT, int kind, int item, int lane) {
    const int nblk = N / 128, kb = item / nblk, nb = item % nblk, k0 = 64 * kb, n0 = 128 * nb;
    const int d0 = n0 + 2 * lane, s0 = map_col(kind, d0), s1 = map_col(kind, d0 + 1);
    const bool adj = (kind != 4) || (n0 >= 2048);
#pragma unroll
    for (int h = 0; h < 2; ++h) {
        float v0[32], v1[32];
        const float* wp = W + (size_t)(k0 + 32 * h) * N;
        if (adj) {
#pragma unroll
            for (int kk = 0; kk < 32; ++kk) { const f32x2 t = *(const f32x2*)(wp + (size_t)kk * N + s0); v0[kk] = t[0]; v1[kk] = t[1]; }
        } else {
#pragma unroll
            for (int kk = 0; kk < 32; ++kk) { v0[kk] = wp[(size_t)kk * N + s0]; v1[kk] = wp[(size_t)kk * N + s1]; }
        }
        bf16_t* o0 = WT + (size_t)d0 * K + k0 + 32 * h; bf16_t* o1 = o0 + K;
#pragma unroll
        for (int j = 0; j < 4; ++j) {
            u32x4 a, b;
            a.x = cvt_pk_bf16(v0[8 * j + 0], v0[8 * j + 1]); a.y = cvt_pk_bf16(v0[8 * j + 2], v0[8 * j + 3]); a.z = cvt_pk_bf16(v0[8 * j + 4], v0[8 * j + 5]); a.w = cvt_pk_bf16(v0[8 * j + 6], v0[8 * j + 7]);
            b.x = cvt_pk_bf16(v1[8 * j + 0], v1[8 * j + 1]); b.y = cvt_pk_bf16(v1[8 * j + 2], v1[8 * j + 3]); b.z = cvt_pk_bf16(v1[8 * j + 4], v1[8 * j + 5]); b.w = cvt_pk_bf16(v1[8 * j + 6], v1[8 * j + 7]);
            *(u32x4*)(o0 + 8 * j) = a; *(u32x4*)(o1 + 8 * j) = b; }
    }
}
struct WDesc { int in_idx, K, N, nb, kind, f8; unsigned long long off; };
__constant__ WDesc g_wd[15] = {
    {8, 1024, 3072, 1, 1, 0, WO_L0_CONVIN}, {10, 1024, 1024, 1, 0, 0, WO_L0_CONVOUT}, {11, 1024, 5632, 1, 2, (MK_FP8_FFN >> 0) & 1, WO_L0_GU}, {12, 2816, 1024, 1, 0, (MK_FP8_FFN >> 0) & 1, WO_L0_DOWN},
    {17, 1024, 3072, 1, 4, MK_FP8_QKV, WO_L1_QKV}, {20, 1024, 1024, 1, 0, 0, WO_L1_WO}, {22, 1024, 5632, 8, 2, 1, WO_L1_MGU}, {23, 2816, 1024, 8, 0, 1, WO_L1_MDOWN},
    {36, 1024, 2048, 1, 3, MK_FP8_GLU, WO_L2_GLU}, {37, 1024, 5632, 1, 2, (MK_FP8_FFN >> 2) & 1, WO_L2_GU}, {38, 2816, 1024, 1, 0, (MK_FP8_FFN >> 2) & 1, WO_L2_DOWN},
    {43, 1024, 3072, 1, 1, 0, WO_L3_CONVIN}, {45, 1024, 1024, 1, 0, 0, WO_L3_CONVOUT}, {47, 1024, 5632, 8, 2, 1, WO_L3_MGU}, {48, 2816, 1024, 8, 0, 1, WO_L3_MDOWN}};

__device__ __forceinline__ void p0_weights(Ctx& F) {
    unsigned* ctr = (unsigned*)(F.ws + WS_CTL) + 64;
    for (;;) {
        unsigned it = 0;
        if (F.lane == 0) it = __hip_atomic_fetch_add(ctr, 1u, __ATOMIC_RELAXED, __HIP_MEMORY_SCOPE_AGENT);
        it = (unsigned)__builtin_amdgcn_readfirstlane((int)it);
        int base = 0, d = 0; bool found = false;
        for (; d < 15; ++d) { const int tot = (g_wd[d].K / (g_wd[d].f8 ? 128 : 64)) * (g_wd[d].N / 128) * g_wd[d].nb; if ((int)it < base + tot) { found = true; break; } base += tot; }
        if (!found) break;
        const int K = g_wd[d].K, N = g_wd[d].N, kind = g_wd[d].kind; const int per = (K / (g_wd[d].f8 ? 128 : 64)) * (N / 128);
        const float* W = F.inp(g_wd[d].in_idx); bf16_t* WT = (bf16_t*)(F.ws + WS_W + g_wd[d].off);
        const int li = (int)it - base, e = li / per, r = li - e * per;
        if (g_wd[d].f8) transpose_item8(W + (size_t)e * K * N, K, N, (unsigned char*)WT + (size_t)e * K * N, kind, r, F.lane);
        else transpose_item(W + (size_t)e * K * N, K, N, WT + (size_t)e * K * N, kind, r, F.lane);
    }
}
__device__ __forceinline__ void p0_adaln(Ctx& F, const int item0) {
    LAS float* scond = (LAS float*)(F.lds);
    LAS float* red = (LAS float*)(F.lds + 20480);
    bool have = false;
    for (int item = item0; item < 96; item += 1 << 20) {
        if (!have) {
            for (int i = F.tid; i < 5 * 1024; i += NTHREADS) { const int cnd = i >> 10, k = i & 1023; const float v = cnd < 4 ? F.inp(IN_C)[cnd * 1024 + k] : F.inp(IN_CCTX)[k]; scond[i] = silu_f(v); }
            have = true; __syncthreads();
        }
        const int L = item / 24, cg = item % 24, col0 = cg * 256 + 4 * F.lane;
        const float* W = F.inp(lbase(L)) + col0; const float* bias = F.inp(lbase(L) + 1);
        f32x4 acc[5];
#pragma unroll
        for (int c = 0; c < 5; ++c) acc[c] = (f32x4){0.f, 0.f, 0.f, 0.f};
        const int kb = F.wave * 128;
#pragma unroll 8
        for (int k = 0; k < 128; ++k) { const f32x4 w = *(const f32x4*)(W + (size_t)(kb + k) * 6144);
#pragma unroll
            for (int c = 0; c < 5; ++c) acc[c] += scond[c * 1024 + kb + k] * w; }
#pragma unroll
        for (int c = 0; c < 5; ++c) *(f32x4*)(red + (F.wave * 5 + c) * 256 + 4 * F.lane) = acc[c];
        __syncthreads();
        float* MOD = (float*)(F.ws + WS_MOD) + (size_t)L * 5 * 6144;
        for (int i = F.tid; i < 5 * 256; i += NTHREADS) { const int c = i >> 8, j = i & 255; float s = bias[cg * 256 + j];
#pragma unroll
            for (int w = 0; w < 8; ++w) s += red[(w * 5 + c) * 256 + j];
            MOD[c * 6144 + cg * 256 + j] = s; }
        __syncthreads();
    }
}
__device__ __forceinline__ void p0_misc(Ctx& F) {
    { float* cosT = (float*)(F.ws + WS_ROPE); float* sinT = cosT + 128 * 16;
        for (int i = F.tid; i < 128 * 16; i += NTHREADS) { const int pos = i >> 4, f = i & 15; const float inv = powf(10000.0f, -(float)f / 16.0f); const float ang = (float)pos * inv; cosT[i] = cosf(ang); sinT[i] = sinf(ang); } }
}
__device__ __forceinline__ void p0_s5mats(Ctx& F, const int g0) {
    const int LB = lbase(2);
    const float* a_re = F.inp(LB + 4); const float* a_im = F.inp(LB + 5); const float* log_dt = F.inp(LB + 6); const float* b_re = F.inp(LB + 7); const float* b_im = F.inp(LB + 8);
    const float* c_re = F.inp(LB + 9); const float* c_im = F.inp(LB + 10); const float* dsk = F.inp(LB + 11);
    LAS float* AP = (LAS float*)F.lds;
    LAS float* BB = AP + 2 * 17 * 64 * 2;
    LAS float* CC = BB + 2 * 64 * 16 * 2;
    LAS float* KK = CC + 2 * 16 * 64 * 2;
    for (int g = g0; g < 64; g += 1 << 20) {
        __syncthreads();
        for (int i = F.tid; i < 2 * 17 * 64; i += NTHREADS) { const int d = i / (17 * 64), r = i % (17 * 64), j = r / 64, p = r % 64;
            const float dt = expf(log_dt[d * 64 + g]); const float ar = a_re[(d * 64 + g) * 64 + p], ai = a_im[(d * 64 + g) * 64 + p];
            const float mag = expf((float)j * dt * ar), ph = (float)j * dt * ai; AP[i * 2] = mag * cosf(ph); AP[i * 2 + 1] = mag * sinf(ph); }
        for (int i = F.tid; i < 2 * 64 * 16; i += NTHREADS) { const int d = i / 1024, r = i % 1024, p = r / 16, s = r % 16;
            const float dt = expf(log_dt[d * 64 + g]); const float ar = a_re[(d * 64 + g) * 64 + p], ai = a_im[(d * 64 + g) * 64 + p];
            const float mag = expf(dt * ar), abr = mag * cosf(dt * ai), abi = mag * sinf(dt * ai), den = ar * ar + ai * ai, nr = abr - 1.0f;
            const float cor = (nr * ar + abi * ai) / den, coi = (abi * ar - nr * ai) / den;
            const float br = b_re[((size_t)(d * 64 + g) * 64 + p) * 16 + s], bi = b_im[((size_t)(d * 64 + g) * 64 + p) * 16 + s];
            BB[i * 2] = cor * br - coi * bi; BB[i * 2 + 1] = cor * bi + coi * br;
            const int s2 = r / 64, p2 = r % 64;
            CC[i * 2] = c_re[((size_t)(d * 64 + g) * 16 + s2) * 64 + p2]; CC[i * 2 + 1] = c_im[((size_t)(d * 64 + g) * 16 + s2) * 64 + p2]; }
        __syncthreads();
        for (int i = F.tid; i < 2 * 16 * 256; i += NTHREADS) { const int d = i >> 12, j = (i >> 8) & 15, so = (i >> 4) & 15, si = i & 15; float s = 0.f;
            for (int p = 0; p < 64; ++p) { const float cr = CC[((d * 16 + so) * 64 + p) * 2], ci = CC[((d * 16 + so) * 64 + p) * 2 + 1];
                const float pr = AP[((d * 17 + j) * 64 + p) * 2], pi = AP[((d * 17 + j) * 64 + p) * 2 + 1];
                const float br = BB[((d * 64 + p) * 16 + si) * 2], bi = BB[((d * 64 + p) * 16 + si) * 2 + 1];
                const float wr_ = cr * pr - ci * pi, wi_ = cr * pi + ci * pr; s += wr_ * br - wi_ * bi; }
            KK[i] = s; }
        __syncthreads();
        bf16_t* M1 = (bf16_t*)(F.ws + WS_S5M1) + (size_t)g * 256 * 256; bf16_t* M3 = (bf16_t*)(F.ws + WS_S5M3) + (size_t)g * 256 * 512;
        for (int i = F.tid; i < 256 * 256; i += NTHREADS) { const int n = i >> 8, k = i & 255, d = n >> 7, p = (n & 127) >> 1, c = n & 1, tp = k >> 4, si = k & 15; const int e = d ? tp : 15 - tp;
            const float pr = AP[((d * 17 + e) * 64 + p) * 2], pi = AP[((d * 17 + e) * 64 + p) * 2 + 1], br = BB[((d * 64 + p) * 16 + si) * 2], bi = BB[((d * 64 + p) * 16 + si) * 2 + 1];
            const float v = c ? (pr * bi + pi * br) : (pr * br - pi * bi); M1[i] = (bf16_t)(cvt_pk_bf16(v, 0.f) & 0xffffu); }
        for (int i = F.tid; i < 256 * 512; i += NTHREADS) { const int n = i >> 9, k = i & 511, t = n >> 4, so = n & 15; float v;
            if (k < 256) { const int tp = k >> 4, si = k & 15;
                if (t > tp) v = KK[((0 * 16 + (t - tp)) * 16 + so) * 16 + si];
                else if (t < tp) v = KK[((1 * 16 + (tp - t)) * 16 + so) * 16 + si];
                else { v = KK[((0 * 16 + 0) * 16 + so) * 16 + si] + KK[((1 * 16 + 0) * 16 + so) * 16 + si]; if (si == so) v += dsk[g * 16 + si]; } }
            else { const int q = k - 256, d = q >> 7, p = (q & 127) >> 1, c = q & 1; const int e = d ? 16 - t : t + 1;
                const float cr = CC[((d * 16 + so) * 64 + p) * 2], ci = CC[((d * 16 + so) * 64 + p) * 2 + 1], pr = AP[((d * 17 + e) * 64 + p) * 2], pi = AP[((d * 17 + e) * 64 + p) * 2 + 1];
                v = c ? -(cr * pi + ci * pr) : (cr * pr - ci * pi); }
            M3[i] = (bf16_t)(cvt_pk_bf16(v, 0.f) & 0xffffu); }
    }
    __syncthreads();
}

__device__ __forceinline__ void p0_prologue(Ctx& F, volatile LAS unsigned* MISC) {
    unsigned* ctr = (unsigned*)(F.ws + WS_CTL) + 128;
    for (;;) {
        __syncthreads();
        if (F.tid == 0) MISC[16] = __hip_atomic_fetch_add(ctr, 1u, __ATOMIC_RELAXED, __HIP_MEMORY_SCOPE_AGENT);
        __syncthreads();
        const int item = (int)MISC[16];
        if (item >= 161) break;
        if (item < 96) p0_adaln(F, item); else if (item < 160) p0_s5mats(F, item - 96); else p0_misc(F);
    }
    __syncthreads();
    p0_weights(F);
}
template <int MODE, bool COMB, bool FROM_IN = false>
__device__ __forceinline__ void row_pass(Ctx& F, int L, bool latent_only, int jsh  , int Lprev, bool out8 = false) {
    xel_t* X = (xel_t*)(F.ws + WS_X); bf16_t* HL = (bf16_t*)(F.ws + WS_HL);
    const float* MOD = (const float*)(F.ws + WS_MOD) + (size_t)L * 5 * 6144; const float* MODP = (const float*)(F.ws + WS_MOD) + (size_t)Lprev * 5 * 6144;
    const float* gain = MODE == 2 ? F.inp(IN_FINAL) : F.inp(lbase(L) + (jsh ? 3 : 2));
    const int nrows = latent_only ? NB * SEQ : MALL;
    const int rpw = (nrows + F.G - 1) / F.G;
    const int r0 = F.bid * rpw, r1 = min(nrows, r0 + rpw);
    LAS float* wrl = (LAS float*)F.lds;
    LAS int* hist = (LAS int*)(F.lds + 32768);
    if (MODE == 1) { const float* wrt = F.inp(lbase(L) + (L == 1 ? 8 : 7));
        for (int i = F.tid; i < 8192; i += NTHREADS) wrl[i] = wrt[i];
        if (F.tid < 8) hist[F.tid] = 0;
        __syncthreads(); }
    const bf16_t* OP = (const bf16_t*)(F.ws + WS_BIG + BIG_APERM);
    const int4* SEL = (const int4*)(F.ws + WS_SEL); const int2* SLOT = (const int2*)(F.ws + WS_SLOT);
    int cur_cond = -1; f32x4 ca[4], cb[4], gp[4];
    for (int lr = r0 + F.wave; lr < r1; lr += NWAVES) {
        const int row = latent_only ? (lr >> 13) * RPB + CTXL + (lr & 8191) : lr;
        const int cond = row_cond(row);
        if (cond != cur_cond) { cur_cond = cond;
#pragma unroll
            for (int q = 0; q < 4; ++q) { const int col = 4 * F.lane + 256 * q; const f32x4 g4 = *(const f32x4*)(gain + col);
                if (MODE == 2) { ca[q] = g4; cb[q] = (f32x4){0.f, 0.f, 0.f, 0.f}; }
                else { const f32x4 sh = *(const f32x4*)(MOD + cond * 6144 + jsh * 1024 + col), sc = *(const f32x4*)(MOD + cond * 6144 + (jsh + 1) * 1024 + col); ca[q] = g4 * (1.0f + sc); cb[q] = sh; }
                if (COMB) gp[q] = *(const f32x4*)(MODP + cond * 6144 + 5 * 1024 + col); } }
        xel_t* xr = X + (size_t)row * DM + 4 * F.lane;
        f32x4 v[4];
        if (FROM_IN) { const int b_ = row / RPB, j_ = row - b_ * RPB; const f32x4* xi = (const f32x4*)(j_ < CTXL ? F.inp(IN_CTX) + ((size_t)b_ * CTXL + j_) * DM : F.inp(IN_X) + ((size_t)b_ * SEQ + (j_ - CTXL)) * DM) + F.lane;
#pragma unroll
            for (int q = 0; q < 4; ++q) v[q] = xi[64 * q];
        } else {
#pragma unroll
            for (int q = 0; q < 4; ++q) v[q] = x_ld4(xr + 256 * q); }
        if (COMB && !((MK_DBG_NOMOE >> (Lprev == 1 ? 0 : 1)) & 1)) {
            const int4 sel = SEL[row]; const int2 sl = SLOT[row]; const float w0 = __int_as_float(sel.z), w1 = __int_as_float(sel.w);
            const u32x2* o0 = (const u32x2*)(OP + (size_t)sl.x * DM) + F.lane; const u32x2* o1 = (const u32x2*)(OP + (size_t)sl.y * DM) + F.lane;
#pragma unroll
            for (int q = 0; q < 4; ++q) { const u32x2 a = o0[64 * q], b = o1[64 * q];
                f32x4 m; m[0] = w0 * bf_lo(a.x) + w1 * bf_lo(b.x); m[1] = w0 * bf_hi(a.x) + w1 * bf_hi(b.x); m[2] = w0 * bf_lo(a.y) + w1 * bf_lo(b.y); m[3] = w0 * bf_hi(a.y) + w1 * bf_hi(b.y);
                v[q] = v[q] + gp[q] * m; if (MODE != 2) x_st4(xr + 256 * q, v[q]); }
        }
        float ss = 0.f;
#pragma unroll
        for (int q = 0; q < 4; ++q) ss += (v[q][0] * v[q][0] + v[q][1] * v[q][1]) + (v[q][2] * v[q][2] + v[q][3] * v[q][3]);
        const float rstd = 1.0f / sqrtf(wave_sum(ss) * (1.0f / DM) + EPS);
        f32x4 h[4];
#pragma unroll
        for (int q = 0; q < 4; ++q) h[q] = (v[q] * rstd) * ca[q] + cb[q];
        if (MODE == 2) { const int b = row / RPB, t = row - b * RPB - CTXL; f32x4* o4 = (f32x4*)(F.out + ((size_t)b * SEQ + t) * DM) + F.lane;
#pragma unroll
            for (int q = 0; q < 4; ++q) o4[64 * q] = h[q];
        } else {
            if (out8) { unsigned* o4 = (unsigned*)((unsigned char*)HL + (size_t)row * DM) + F.lane;
#pragma unroll
                for (int q = 0; q < 4; ++q) o4[64 * q] = cvt4_fp8(h[q][0], h[q][1], h[q][2], h[q][3]);
            } else {
            u32x2* o8 = (u32x2*)(HL + (size_t)row * DM) + F.lane;
#pragma unroll
            for (int q = 0; q < 4; ++q) { u32x2 w; w.x = cvt_pk_bf16(h[q][0], h[q][1]); w.y = cvt_pk_bf16(h[q][2], h[q][3]); o8[64 * q] = w; } }
        }
        if (MODE == 1) {
            float lg[8];
#pragma unroll
            for (int e = 0; e < 8; ++e) lg[e] = 0.f;
#pragma unroll
            for (int q = 0; q < 4; ++q)
#pragma unroll
                for (int i = 0; i < 4; ++i) { const int k = 4 * F.lane + 256 * q + i; const f32x4 wa = *(const LAS f32x4*)(wrl + k * 8), wb = *(const LAS f32x4*)(wrl + k * 8 + 4); const float hv = h[q][i];
                    lg[0] += hv * wa[0]; lg[1] += hv * wa[1]; lg[2] += hv * wa[2]; lg[3] += hv * wa[3]; lg[4] += hv * wb[0]; lg[5] += hv * wb[1]; lg[6] += hv * wb[2]; lg[7] += hv * wb[3]; }
#pragma unroll
            for (int e = 0; e < 8; ++e) lg[e] = wave_sum(lg[e]);
            int e0 = 0; float v0 = lg[0];
#pragma unroll
            for (int e = 1; e < 8; ++e) if (lg[e] > v0) { v0 = lg[e]; e0 = e; }
            int e1 = -1; float v1 = -INFINITY;
#pragma unroll
            for (int e = 0; e < 8; ++e) if (e != e0 && lg[e] > v1) { v1 = lg[e]; e1 = e; }
            const float ex = __expf(v1 - v0), w0 = 1.0f / (1.0f + ex), w1 = ex * w0;
            if (F.lane == 0) { ((int4*)(F.ws + WS_SEL))[row] = make_int4(e0, e1, __float_as_int(w0), __float_as_int(w1)); atomicAdd((int*)(hist + e0), 1); atomicAdd((int*)(hist + e1), 1); }
        }
    }
    if (MODE == 1) { __syncthreads(); if (F.tid < 8) ((int*)(F.ws + WS_CNT))[F.bid * 8 + F.tid] = hist[F.tid]; __syncthreads(); }
}

__device__ __forceinline__ void conv_pass(Ctx& F, int L, bool latent_only) {
    const bf16_t* BZ = (const bf16_t*)(F.ws + WS_BIG + BIG_BZ); bf16_t* U = (bf16_t*)(F.ws + WS_BIG + BIG_U);
    const float* cw = F.inp(lbase(L) + 5);
    const int nrows = latent_only ? NB * SEQ : MALL;
    const long nitems = (long)nrows * 128;
    for (long it = (long)F.bid * NTHREADS + F.tid; it < nitems; it += (long)F.G * NTHREADS) {
        const int lr = (int)(it >> 7), cgp = (int)(it & 127), col = cgp * 8;
        const int row = latent_only ? (lr >> 13) * RPB + CTXL + (lr & 8191) : lr;
        const int j = row % RPB; const bool first = (j == 0) || (j == CTXL), lastr = (j == CTXL - 1) || (j == RPB - 1);
        const u32x4 bb = *(const u32x4*)(BZ + (size_t)row * 2048 + col);
        const u32x4 zc = *(const u32x4*)(BZ + (size_t)row * 2048 + 1024 + col);
        u32x4 zp = (u32x4){0u, 0u, 0u, 0u}, zn = (u32x4){0u, 0u, 0u, 0u};
        if (!first) zp = *(const u32x4*)(BZ + (size_t)(row - 1) * 2048 + 1024 + col);
        if (!lastr) zn = *(const u32x4*)(BZ + (size_t)(row + 1) * 2048 + 1024 + col);
        const f32x4 w0a = *(const f32x4*)(cw + col), w0b = *(const f32x4*)(cw + col + 4), w1a = *(const f32x4*)(cw + 1024 + col), w1b = *(const f32x4*)(cw + 1024 + col + 4), w2a = *(const f32x4*)(cw + 2048 + col), w2b = *(const f32x4*)(cw + 2048 + col + 4);
        float y[8];
#define CV(i, W0, W1, W2, ZP, ZC, ZN, LO) y[i] = (W0) * (LO ? bf_lo(ZP) : bf_hi(ZP)) + (W1) * (LO ? bf_lo(ZC) : bf_hi(ZC)) + (W2) * (LO ? bf_lo(ZN) : bf_hi(ZN))
        CV(0, w0a[0], w1a[0], w2a[0], zp.x, zc.x, zn.x, 1); CV(1, w0a[1], w1a[1], w2a[1], zp.x, zc.x, zn.x, 0);
        CV(2, w0a[2], w1a[2], w2a[2], zp.y, zc.y, zn.y, 1); CV(3, w0a[3], w1a[3], w2a[3], zp.y, zc.y, zn.y, 0);
        CV(4, w0b[0], w1b[0], w2b[0], zp.z, zc.z, zn.z, 1); CV(5, w0b[1], w1b[1], w2b[1], zp.z, zc.z, zn.z, 0);
        CV(6, w0b[2], w1b[2], w2b[2], zp.w, zc.w, zn.w, 1); CV(7, w0b[3], w1b[3], w2b[3], zp.w, zc.w, zn.w, 0);
#undef CV
        u32x4 o; o.x = cvt_pk_bf16(bf_lo(bb.x) * y[0], bf_hi(bb.x) * y[1]); o.y = cvt_pk_bf16(bf_lo(bb.y) * y[2], bf_hi(bb.y) * y[3]);
        o.z = cvt_pk_bf16(bf_lo(bb.z) * y[4], bf_hi(bb.z) * y[5]); o.w = cvt_pk_bf16(bf_lo(bb.w) * y[6], bf_hi(bb.w) * y[7]);
        *(u32x4*)(U + (size_t)row * DM + col) = o;
    }
}

__device__ __forceinline__ void attn_combine(Ctx& F, int L) {
    const float* lamv = F.inp(lbase(L) + 5); const float* subln = F.inp(lbase(L) + 6);
    const float lam_init = 0.8f - 0.6f * expf(-0.3f * (float)L);
    float s01 = 0.f, s23 = 0.f;
    for (int i = 0; i < 64; ++i) { s01 += lamv[i] * lamv[64 + i]; s23 += lamv[128 + i] * lamv[192 + i]; }
    const float lam = expf(s01) - expf(s23) + lam_init, osc = 1.0f - lam_init;
    bf16_t* O0 = (bf16_t*)(F.ws + WS_BIG + BIG_O0); const bf16_t* O1 = (const bf16_t*)(F.ws + WS_HL);
    const int sub = F.lane & 15;
    const f32x4 g0 = *(const f32x4*)(subln + sub * 8), g1 = *(const f32x4*)(subln + sub * 8 + 4);
    const long nit = (long)MALL * NHEAD;
    for (long it = ((long)F.bid * NTHREADS + F.tid) >> 4; it < nit; it += ((long)F.G * NTHREADS) >> 4) {
        const size_t off = (size_t)it * 128 + sub * 8;
        const u32x4 a = *(const u32x4*)(O0 + off), b = *(const u32x4*)(O1 + off);
        float o[8];
        o[0] = bf_lo(a.x) - lam * bf_lo(b.x); o[1] = bf_hi(a.x) - lam * bf_hi(b.x); o[2] = bf_lo(a.y) - lam * bf_lo(b.y); o[3] = bf_hi(a.y) - lam * bf_hi(b.y);
        o[4] = bf_lo(a.z) - lam * bf_lo(b.z); o[5] = bf_hi(a.z) - lam * bf_hi(b.z); o[6] = bf_lo(a.w) - lam * bf_lo(b.w); o[7] = bf_hi(a.w) - lam * bf_hi(b.w);
        float ss = 0.f;
#pragma unroll
        for (int i = 0; i < 8; ++i) ss += o[i] * o[i];
        ss = row16_sum(ss);
        const float r = osc / sqrtf(ss * (1.0f / 128.0f) + EPS);
        u32x4 w; w.x = cvt_pk_bf16(o[0] * r * g0[0], o[1] * r * g0[1]); w.y = cvt_pk_bf16(o[2] * r * g0[2], o[3] * r * g0[3]);
        w.z = cvt_pk_bf16(o[4] * r * g1[0], o[5] * r * g1[1]); w.w = cvt_pk_bf16(o[6] * r * g1[2], o[7] * r * g1[3]);
        *(u32x4*)(O0 + off) = w;
    }
}

__device__ __forceinline__ void attn_phase(Ctx& F) {
    const bf16_t* Q = (const bf16_t*)(F.ws + WS_BIG + BIG_QKV); const bf16_t* KH = (const bf16_t*)(F.ws + WS_BIG + BIG_KH); const bf16_t* VH = (const bf16_t*)(F.ws + WS_BIG + BIG_VH);
    bf16_t* O0 = (bf16_t*)(F.ws + WS_BIG + BIG_O0); bf16_t* O1 = (bf16_t*)(F.ws + WS_HL);
    const int vcu = (F.G % 8 == 0) ? (F.bid % 8) * (F.G / 8) + F.bid / 8 : F.bid;
    for (int u = vcu; u < 2048 + 64; u += F.G) {
        int bh, qb; bool isctx = u >= 2048;
        if (!isctx) { bh = u >> 5; qb = u & 31; } else { bh = u - 2048; qb = 0; }
        const int b = bh >> 4, vh = bh & 15, h = vh >> 1, m = vh & 1;
        const size_t rowb = (size_t)b * RPB;
        const size_t qrow = isctx ? rowb : rowb + CTXL + (size_t)qb * 256;
        const bf16_t* Qb = Q + qrow * DM + h * 128 + m * 64;
        const bf16_t* Kh = KH + (size_t)(b * 16 + vh) * RPB * 64;
        const bf16_t* Vh = VH + (size_t)(b * 8 + h) * RPB * 128;
        bf16_t* Ob = (m ? O1 : O0) + qrow * DM + h * 128;
        att2::attn_unit(Qb, Kh, Vh, Ob, DM, isctx ? CTXL : RPB, F.lds, F.tid);
    }
}

__device__ __forceinline__ void v_transpose(Ctx& F) {
    const unsigned char* V8 = F.ws + WS_BIG + BIG_V8; unsigned char* VT8 = F.ws + WS_BIG + BIG_VT8;
    LAS unsigned char* buf = F.lds + F.wave * 8192;
    const int gw = F.bid * NWAVES + F.wave, NGW = F.G * NWAVES;
    for (int it = gw; it < NB * NHEAD * (RPB / 64); it += NGW) {
        const size_t tb = (size_t)it * 8192;
#pragma unroll
        for (int t = 0; t < 8; ++t) *(LAS u32x4*)(buf + (F.lane + 64 * t) * 16) = *(const u32x4*)(V8 + tb + (size_t)(F.lane + 64 * t) * 16);
        LDS_WAIT();
#pragma unroll
        for (int u = 0; u < 2; ++u) { const int d = F.lane + 64 * u;
#pragma unroll
            for (int q = 0; q < 4; ++q) { u32x4 w;
#pragma unroll
                for (int e = 0; e < 4; ++e) { unsigned x = 0;
#pragma unroll
                    for (int b = 0; b < 4; ++b) x |= (unsigned)buf[att3::slot_key(q * 16 + e * 4 + b) * 128 + d] << (8 * b);
                    w[e] = x; }
                *(u32x4*)(VT8 + tb + (size_t)d * 64 + q * 16) = w; } }
        LDS_WAIT();
    }
}
__device__ __forceinline__ void attn_phase3(Ctx& F, int L) {
    const unsigned char* Q8 = F.ws + WS_BIG + BIG_Q8; const unsigned char* K8 = F.ws + WS_BIG + BIG_K8; const unsigned char* VT8 = F.ws + WS_BIG + BIG_VT8;
    bf16_t* AO = (bf16_t*)(F.ws + WS_BIG + BIG_O0);
    const float* lamv = F.inp(lbase(L) + 5); const float* subln = F.inp(lbase(L) + 6);
    const float lam_init = 0.8f - 0.6f * expf(-0.3f * (float)L);
    float s01 = 0.f, s23 = 0.f;
    for (int i = 0; i < 64; ++i) { s01 += lamv[i] * lamv[64 + i]; s23 += lamv[128 + i] * lamv[192 + i]; }
    const float lam = expf(s01) - expf(s23) + lam_init, osc = 1.0f - lam_init;
    const int vcu = (F.G % 8 == 0) ? (F.bid % 8) * (F.G / 8) + F.bid / 8 : F.bid;
    for (int u = vcu; u < 1024 + 32; u += F.G) {
        int bh, qb; const bool isctx = u >= 1024;
        if (!isctx) { bh = u >> 5; qb = u & 31; } else { bh = u - 1024; qb = 0; }
        const int b = bh >> 3, h = bh & 7;
        const size_t rowb = (size_t)b * RPB;
        const size_t qrow = isctx ? rowb : rowb + CTXL + (size_t)qb * 256;
        att3::attn_unit(Q8 + qrow * DM + h * 128, K8 + (size_t)(b * 16 + 2 * h) * RPB * 64, (size_t)RPB * 64, VT8 + (size_t)(b * 8 + h) * RPB * 128, AO + qrow * DM + h * 128, DM, isctx ? CTXL : RPB,
                        lam, osc, subln, (u32x4*)(F.ws + WS_BIG + ((size_t)270 << 20)) + (size_t)F.bid * 4096, F.lds, F.tid);
    }
}

__device__ __forceinline__ void moe_scatter(Ctx& F, bool latent_only) {
    const int nrows = latent_only ? NB * SEQ : MALL;
    const int rpw = (nrows + F.G - 1) / F.G, r0 = F.bid * rpw, r1 = min(nrows, r0 + rpw);
    LAS int* tot = (LAS int*)F.lds; LAS int* pre = tot + 8; LAS int* base = tot + 16; LAS int* offs = tot + 24;
    LAS int* selc = tot + 64;
    LAS int* slc = selc + 1024;
    const int* CNT = (const int*)(F.ws + WS_CNT); const int4* SEL = (const int4*)(F.ws + WS_SEL); int2* SLOT = (int2*)(F.ws + WS_SLOT); int* TEXP = (int*)(F.ws + WS_TEXP);
    if (F.tid < 8) { int t = 0, p = 0; for (int w = 0; w < F.G; ++w) { const int c = CNT[w * 8 + F.tid]; t += c; if (w < F.bid) p += c; } tot[F.tid] = t; pre[F.tid] = p; }
    for (int i = F.tid; i < r1 - r0; i += NTHREADS) { const int lr = r0 + i; const int row = latent_only ? (lr >> 13) * RPB + CTXL + (lr & 8191) : lr; const int4 s = SEL[row]; selc[i] = s.x | (s.y << 8); }
    __syncthreads();
    if (F.tid == 0) { int o = 0; for (int e = 0; e < 8; ++e) { offs[e] = o; base[e] = o + pre[e]; o += (tot[e] + 255) & ~255; } offs[8] = o;
        for (int i = 0; i < r1 - r0; ++i) { const int s = selc[i], e0 = s & 255, e1 = s >> 8; slc[2 * i] = base[e0]++; slc[2 * i + 1] = base[e1]++; } }
    __syncthreads();
    if (F.bid == 0) { const int nT = offs[8] >> 8; for (int t = F.tid; t < nT; t += NTHREADS) { int e = 0; while (e < 7 && t * 256 >= offs[e + 1]) ++e; TEXP[t] = e; } if (F.tid == 0) TEXP[500] = nT; }
    const bf16_t* HL = (const bf16_t*)(F.ws + WS_HL); unsigned char* AP8 = (unsigned char*)(F.ws + WS_BIG + BIG_APERM);
    for (int i = F.wave; i < r1 - r0; i += NWAVES) { const int lr = r0 + i; const int row = latent_only ? (lr >> 13) * RPB + CTXL + (lr & 8191) : lr;
        const int s0 = slc[2 * i], s1 = slc[2 * i + 1];
        if (F.lane == 0) SLOT[row] = make_int2(s0, s1);
        const u32x4* src = (const u32x4*)(HL + (size_t)row * DM) + F.lane; const u32x4 a = src[0], b = src[64];
        u32x2 qa, qb; qa.x = cvt4_fp8(bf_lo(a.x), bf_hi(a.x), bf_lo(a.y), bf_hi(a.y)); qa.y = cvt4_fp8(bf_lo(a.z), bf_hi(a.z), bf_lo(a.w), bf_hi(a.w));
        qb.x = cvt4_fp8(bf_lo(b.x), bf_hi(b.x), bf_lo(b.y), bf_hi(b.y)); qb.y = cvt4_fp8(bf_lo(b.z), bf_hi(b.z), bf_lo(b.w), bf_hi(b.w));
        u32x2* d0 = (u32x2*)(AP8 + (size_t)s0 * DM) + F.lane; u32x2* d1 = (u32x2*)(AP8 + (size_t)s1 * DM) + F.lane;
        d0[0] = qa; d0[64] = qb; d1[0] = qa; d1[64] = qb; }
    __syncthreads();
}

__device__ __forceinline__ void s5_scan(Ctx& F) {
    const int LB = lbase(2);
    const float* a_re = F.inp(LB + 4); const float* a_im = F.inp(LB + 5); const float* log_dt = F.inp(LB + 6);
    const float* H = (const float*)(F.ws + WS_BIG + BIG_H); bf16_t* SB = (bf16_t*)(F.ws + WS_BIG + BIG_SBUF);
    LAS float* ex = (LAS float*)F.lds;
    constexpr int QS = CPB / 4;
    for (int pair = F.bid; pair < 256; pair += F.G) {
        const int task = 2 * pair + (F.wave >> 2), seg = F.wave & 3;
        const int b = task >> 7, d = (task >> 6) & 1, g = task & 63, p = F.lane;
        const float dt = expf(log_dt[d * 64 + g]); const float ar = a_re[(d * 64 + g) * 64 + p], ai = a_im[(d * 64 + g) * 64 + p];
        const float mag = expf(16.0f * dt * ar), ph = 16.0f * dt * ai, Ar = mag * cosf(ph), Ai = mag * sinf(ph);
        const float magq = expf((16.0f * QS) * dt * ar), phq = (16.0f * QS) * dt * ai, Qr = magq * cosf(phq), Qi = magq * sinf(phq);
        const int v = d * 128 + 2 * p, tt = v >> 4, ss = v & 15;
        const float* Hb = H + ((size_t)b * CPB * 64 + g) * 256 + v;
        bf16_t* Sb = SB + ((size_t)b * RPB + tt) * DM + g * 16 + ss;
        float er = 0.f, ei = 0.f;
        for (int s0 = seg * QS; s0 < (seg + 1) * QS; s0 += 4) {
            f32x2 hv[4];
#pragma unroll
            for (int i = 0; i < 4; ++i) { const int st = s0 + i; const int c = d ? (st < 16 ? 15 - st : CPB - 1 - (st - 16)) : st; hv[i] = *(const f32x2*)(Hb + (size_t)c * 64 * 256); }
#pragma unroll
            for (int i = 0; i < 4; ++i) { const float nr = Ar * er - Ai * ei + hv[i][0], ni = Ar * ei + Ai * er + hv[i][1]; er = nr; ei = ni; }
        }
        __syncthreads();
        ex[(F.wave * 64 + p) * 2] = er; ex[(F.wave * 64 + p) * 2 + 1] = ei;
        __syncthreads();
        er = 0.f; ei = 0.f;
        for (int q = 0; q < seg; ++q) { const int w = (F.wave & 4) + q; const float xr_ = ex[(w * 64 + p) * 2], xi_ = ex[(w * 64 + p) * 2 + 1];
            const float nr = Qr * er - Qi * ei + xr_, ni = Qr * ei + Qi * er + xi_; er = nr; ei = ni; }
        for (int s0 = seg * QS; s0 < (seg + 1) * QS; s0 += 4) {
            f32x2 hv[4]; int cc[4];
#pragma unroll
            for (int i = 0; i < 4; ++i) { const int st = s0 + i; cc[i] = d ? (st < 16 ? 15 - st : CPB - 1 - (st - 16)) : st; hv[i] = *(const f32x2*)(Hb + (size_t)cc[i] * 64 * 256); }
#pragma unroll
            for (int i = 0; i < 4; ++i) { *(unsigned*)(Sb + (size_t)cc[i] * 16 * DM) = cvt_pk_bf16(er, ei);
                const float nr = Ar * er - Ai * ei + hv[i][0], ni = Ar * ei + Ai * er + hv[i][1]; er = nr; ei = ni; }
        }
    }
}

__global__ void __launch_bounds__(NTHREADS, 2) mk_fwd(Args args) {
    extern __shared__ __attribute__((aligned(16))) unsigned char lds[];
    Ctx F;
    F.lds = (LAS unsigned char*)lds;
    F.tid = threadIdx.x; F.lane = F.tid & 63; F.wave = __builtin_amdgcn_readfirstlane(F.tid >> 6);
    F.G = gridDim.x; F.bid = blockIdx.x; F.ws = args.ws; F.out = args.out;
    volatile LAS unsigned* MISC = (volatile LAS unsigned*)(F.lds + MISC_OFF);
    if (F.tid < 32) MISC[F.tid] = 0u;
    if (F.tid == 0) {
#pragma unroll
        for (int i = 0; i < 50; ++i) *(LAS unsigned long long*)(F.lds + INTAB_OFF + 8 * i) = (unsigned long long)(uintptr_t)args.in[i]; }
    __syncthreads();
    const int lo = args.ph_lo, hi = args.ph_hi;
    XcdBarrier bar; bar.bar = (unsigned*)(F.ws + WS_CTL) + 1024; bar.x = 0; bar.st = nullptr;
    if (hi - lo > 1) bar = xcd_barrier_post((unsigned*)(F.ws + WS_CTL) + 1024, MISC + 8);
    int ph = 0;
#define LAUNDER() do { F.ws = launder_ptr(F.ws); F.out = launder_ptr(F.out); F.wave = launder_i(F.wave); asm volatile("v_mbcnt_lo_u32_b32 %0, -1, 0\n\tv_mbcnt_hi_u32_b32 %0, -1, %0" : "=v"(F.lane));     F.tid = F.wave * 64 + F.lane; \
    F.G = launder_i(F.G); F.bid = launder_i(F.bid); } while (0)
#define PHASE(id, ...) do { if (lo <= ph && ph < hi) { LAUNDER(); if ((MK_SITEMASK >> (id)) & 1u) { __VA_ARGS__; } if ((id) == MK_REPEAT_SITE) { __syncthreads(); LAUNDER(); __VA_ARGS__; } if (ph + 1 < hi) xcd_barrier(bar); } ++ph; } while (0)

#define WSB (F.ws)
#define XPTR ((xel_t*)(F.ws + WS_X))
#define HLPTR ((bf16_t*)(F.ws + WS_HL))
#define VBID (F.bid)
#define MODPTR ((const float*)(F.ws + WS_MOD) + (size_t)L * 5 * 6144)

    PHASE(0, p0_prologue(F, MISC));
#if MK_EXTRA_BARS
    if (hi - lo > 1) for (int eb = 0; eb < MK_EXTRA_BARS; ++eb) xcd_barrier(bar);
#endif

    for (int L = 0; L < 4; ++L) {
        const int kind = L % 3; const bool moe = (L & 1) != 0;
        const bool lat = (L >= 2);
        if (L == 2) PHASE(1, (row_pass<0, true>(F, L, false, 0, L - 1)));
        else if (L == 0) PHASE(2, (row_pass<0, false, true>(F, L, false, 0, 0)));
        else PHASE(3, (row_pass<0, false>(F, L, lat, 0, 0, L == 1 && MK_FP8_QKV)));
        if (kind == 0) {
            const size_t wo_in = (L == 0) ? WO_L0_CONVIN : WO_L3_CONVIN, wo_out = (L == 0) ? WO_L0_CONVOUT : WO_L3_CONVOUT;
            PHASE(4, { pg8::ProbPlain P{(const char*)HLPTR, (const char*)(WSB + WS_W + wo_in), 2048, 2048, 16, lat ? NT_LAT : NT_ALL, 12, F.G, VBID, lat};
                    pg8::EpiGated<0> E{(bf16_t*)(WSB + WS_BIG + BIG_BZ), 2048, 4, 1024, 0};
                    pg8::gemm_phase<pg8::EpiGated<0>, pg8::ProbPlain, true>(F.lds, P, E, F.tid); });
            PHASE(5, conv_pass(F, L, lat));
            PHASE(6, { pg8::ProbPlain P{(const char*)(WSB + WS_BIG + BIG_U), (const char*)(WSB + WS_W + wo_out), 2048, 2048, 16, lat ? NT_LAT : NT_ALL, 4, F.G, VBID, lat};
                    pg8::EpiResid E{XPTR, MODPTR + 2 * 1024, L == 0 ? F.inp(IN_X) : nullptr, L == 0 ? F.inp(IN_CTX) : nullptr, 1.f};
                    pg8::gemm_phase<pg8::EpiResid, pg8::ProbPlain, true>(F.lds, P, E, F.tid); });
        } else if (kind == 1) {
            if (MK_FP8_QKV) {
            PHASE(25, { pg8::ProbPlain P{(const char*)HLPTR, (const char*)(WSB + WS_W + WO_L1_QKV), 1024, 1024, 8, NT_ALL, 12, F.G, VBID, false};
                    pg8::EpiQkv<MK_ATT3 != 0, true> E{WSB + WS_BIG, (const float*)(WSB + WS_ROPE)};
                    pg8::gemm_phase<pg8::EpiQkv<MK_ATT3 != 0, true>, pg8::ProbPlain, true, true>(F.lds, P, E, F.tid); });
            } else {
            PHASE(7, { pg8::ProbPlain P{(const char*)HLPTR, (const char*)(WSB + WS_W + WO_L1_QKV), 2048, 2048, 16, NT_ALL, 12, F.G, VBID, false};
                    pg8::EpiQkv<MK_ATT3 != 0, false> E{WSB + WS_BIG, (const float*)(WSB + WS_ROPE)};
                    pg8::gemm_phase<pg8::EpiQkv<MK_ATT3 != 0, false>, pg8::ProbPlain, true>(F.lds, P, E, F.tid); });
            }
            if (MK_ATT3) { PHASE(27, v_transpose(F)); PHASE(28, attn_phase3(F, L)); }
            else { PHASE(8, attn_phase(F)); PHASE(9, attn_combine(F, L)); }
            PHASE(10, { pg8::ProbPlain P{(const char*)(WSB + WS_BIG + BIG_O0), (const char*)(WSB + WS_W + WO_L1_WO), 2048, 2048, 16, NT_ALL, 4, F.G, VBID, false};
                    pg8::EpiResid E{XPTR, MODPTR + 2 * 1024, nullptr, nullptr, 1.f};
                    pg8::gemm_phase<pg8::EpiResid, pg8::ProbPlain, true>(F.lds, P, E, F.tid); });
        } else {
            PHASE(11, { pg8::ProbS5 P{(const char*)HLPTR, (const char*)HLPTR, (const char*)(WSB + WS_S5M1), 4, 4, 9, F.G, VBID, (size_t)256 * 256 * 2, false};
                    pg8::EpiS1 E{(float*)(WSB + WS_BIG + BIG_H)};
                    pg8::gemm_phase<pg8::EpiS1, pg8::ProbS5, true>(F.lds, P, E, F.tid); });
            PHASE(12, s5_scan(F));
            PHASE(13, { pg8::ProbS5 P{(const char*)HLPTR, (const char*)(WSB + WS_BIG + BIG_SBUF), (const char*)(WSB + WS_S5M3), 8, 4, 8, F.G, VBID, (size_t)256 * 512 * 2, true};
                    pg8::EpiS3 E{(bf16_t*)(WSB + WS_BIG + BIG_YG), MK_FP8_GLU != 0};
                    pg8::gemm_phase<pg8::EpiS3, pg8::ProbS5, true>(F.lds, P, E, F.tid); });
            if (MK_FP8_GLU) {
            PHASE(26, { pg8::ProbPlain P{(const char*)(WSB + WS_BIG + BIG_YG), (const char*)(WSB + WS_W + WO_L2_GLU), 1024, 1024, 8, NT_LAT, 8, F.G, VBID, true};
                    pg8::EpiGlu E{XPTR, MODPTR + 2 * 1024, pg8::W8INV};
                    pg8::gemm_phase<pg8::EpiGlu, pg8::ProbPlain, true, true>(F.lds, P, E, F.tid); });
            } else {
            PHASE(14, { pg8::ProbPlain P{(const char*)(WSB + WS_BIG + BIG_YG), (const char*)(WSB + WS_W + WO_L2_GLU), 2048, 2048, 16, NT_LAT, 8, F.G, VBID, true};
                    pg8::EpiGlu E{XPTR, MODPTR + 2 * 1024, 1.f};
                    pg8::gemm_phase<pg8::EpiGlu, pg8::ProbPlain, true>(F.lds, P, E, F.tid); });
            }
        }
        if (moe) PHASE(15, (row_pass<1, false>(F, L, lat, 3, 0)));
        else PHASE(16, (row_pass<0, false>(F, L, lat, 3, 0, ((MK_FP8_FFN >> L) & 1) != 0)));
        if (!moe) {
            const size_t wo_gu = (L == 0) ? WO_L0_GU : WO_L2_GU, wo_dn = (L == 0) ? WO_L0_DOWN : WO_L2_DOWN;
            if ((MK_FP8_FFN >> L) & 1) {
                PHASE(23, { pg8::ProbPlain P{(const char*)HLPTR, (const char*)(WSB + WS_W + wo_gu), 1024, 1024, 8, lat ? NT_LAT : NT_ALL, 22, F.G, VBID, lat};
                        pg8::EpiGated8 E{(unsigned char*)(WSB + WS_BIG + BIG_HID), DFF, pg8::W8INV};
                        pg8::gemm_phase<pg8::EpiGated8, pg8::ProbPlain, true, true>(F.lds, P, E, F.tid); });
                PHASE(24, { pg8::ProbPlain P{(const char*)(WSB + WS_BIG + BIG_HID), (const char*)(WSB + WS_W + wo_dn), DFF, DFF, 22, lat ? NT_LAT : NT_ALL, 4, F.G, VBID, lat};
                        pg8::EpiResid E{XPTR, MODPTR + 5 * 1024, nullptr, nullptr, pg8::W8INV};
                        pg8::gemm_phase<pg8::EpiResid, pg8::ProbPlain, true, true>(F.lds, P, E, F.tid); });
            } else {
            PHASE(17, { pg8::ProbPlain P{(const char*)HLPTR, (const char*)(WSB + WS_W + wo_gu), 2048, 2048, 16, lat ? NT_LAT : NT_ALL, 22, F.G, VBID, lat};
                    pg8::EpiGated<1> E{(bf16_t*)(WSB + WS_BIG + BIG_HID), DFF, 0, 0, 0};
                    pg8::gemm_phase<pg8::EpiGated<1>, pg8::ProbPlain, true>(F.lds, P, E, F.tid); });
            PHASE(18, { pg8::ProbPlain P{(const char*)(WSB + WS_BIG + BIG_HID), (const char*)(WSB + WS_W + wo_dn), DFF * 2, DFF * 2, 44, lat ? NT_LAT : NT_ALL, 4, F.G, VBID, lat};
                    pg8::EpiResid E{XPTR, MODPTR + 5 * 1024, nullptr, nullptr, 1.f};
                    pg8::gemm_phase<pg8::EpiResid, pg8::ProbPlain, true>(F.lds, P, E, F.tid); });
            }
        } else {
            const size_t wo_gu = (L == 1) ? WO_L1_MGU : WO_L3_MGU, wo_dn = (L == 1) ? WO_L1_MDOWN : WO_L3_MDOWN;
            PHASE(19, moe_scatter(F, lat));
#define TEXPP ((const int*)(F.ws + WS_TEXP))
            PHASE(20, { const int nT = __builtin_amdgcn_readfirstlane(TEXPP[500]);
                    pg8::ProbMoe P{(const char*)(WSB + WS_BIG + BIG_APERM), (const char*)(WSB + WS_W + wo_gu), 1024, 1024, 8, 22, F.G, VBID, WSZ_GU / 2, TEXPP, 0, nT, 0};
                    pg8::EpiGated8 E{(unsigned char*)(WSB + WS_BIG + BIG_MHID), DFF, pg8::W8INV};
                    pg8::gemm_phase<pg8::EpiGated8, pg8::ProbMoe, true, true>(F.lds, P, E, F.tid); });
            PHASE(21, { const int nT = __builtin_amdgcn_readfirstlane(TEXPP[500]);
                    pg8::ProbMoe P{(const char*)(WSB + WS_BIG + BIG_MHID), (const char*)(WSB + WS_W + wo_dn), DFF, DFF, 22, 4, F.G, VBID, WSZ_DOWN / 2, TEXPP, 0, nT, 0};
                    pg8::EpiBf16 E{(bf16_t*)(WSB + WS_BIG + BIG_APERM), DM, 0, pg8::W8INV};
                    pg8::gemm_phase<pg8::EpiBf16, pg8::ProbMoe, true, true>(F.lds, P, E, F.tid); });
        }
    }
    PHASE(22, (row_pass<2, true>(F, 3, true, 0, 3)));
#undef PHASE
#undef WSB
#undef XPTR
#undef HLPTR
#undef VBID
#undef MODPTR
#undef TEXPP
}
constexpr int N_PHASES = 1 + (1 + 3 + 1 + 2) + (1 + 4 + 1 + 1 + 2) + (1 + 4 + 1 + 2) + (1 + 3 + 1 + 1 + 2) + 1;

extern "C" void kernel_launch(void* const* d_in, const int* in_sizes, int n_in, void* d_out, int out_size, void* d_ws, size_t ws_size, hipStream_t stream) {
    static int grid = 0;
    if (grid == 0) {
        if (n_in != 50 || in_sizes[0] != NB * SEQ * DM || out_size != NB * SEQ * DM || ws_size < WS_END) {
            fprintf(stderr, "kernel_launch: unexpected shapes (n_in %d, in0 %d, out %d, ws %zu < %zu)\n", n_in, n_in > 0 ? in_sizes[0] : -1, out_size, ws_size, (size_t)WS_END); grid = -1; return; }
        int dev = 0, cus = 0, per_cu = 0;
        if (hipGetDevice(&dev) != hipSuccess || hipDeviceGetAttribute(&cus, hipDeviceAttributeMultiprocessorCount, dev) != hipSuccess) { grid = -1; return; }
        if (hipFuncSetAttribute((const void*)mk_fwd, hipFuncAttributeMaxDynamicSharedMemorySize, LDS_BYTES) != hipSuccess) { fprintf(stderr, "kernel_launch: hipFuncSetAttribute failed\n"); grid = -1; return; }
        if (hipOccupancyMaxActiveBlocksPerMultiprocessor(&per_cu, (const void*)mk_fwd, NTHREADS, LDS_BYTES) != hipSuccess || per_cu < 1) { fprintf(stderr, "kernel_launch: occupancy query says %d\n", per_cu); }
        (void)hipGetLastError();
        grid = cus;
    }
    if (grid < 0) return;
    (void)hipMemsetAsync((char*)d_ws + WS_CTL, 0, CTL_ZERO_BYTES, stream);
    Args a{};
    for (int i = 0; i < 50; ++i) a.in[i] = (const float*)d_in[i];
    a.out = (float*)d_out; a.ws = (unsigned char*)d_ws;
#if MK_ONE_LAUNCH
    a.ph_lo = 0; a.ph_hi = N_PHASES;
    hipLaunchKernelGGL(mk_fwd, dim3(grid), dim3(NTHREADS), LDS_BYTES, stream, a);
#else
    for (int p = 0; p < N_PHASES; ++p) { a.ph_lo = p; a.ph_hi = p + 1; hipLaunchKernelGGL(mk_fwd, dim3(grid), dim3(NTHREADS), LDS_BYTES, stream, a); }
#endif
    const hipError_t le = hipPeekAtLastError();
    if (le != hipSuccess) fprintf(stderr, "kernel_launch: launch failed: %s\n", hipGetErrorName(le));
}
```

```cpp
#include <hip/hip_runtime.h>
#include <hip/hip_bf16.h>
#include <cstdio>
#include <cstdint>
#include <cmath>

#ifndef MK_SITEMASK
#define MK_SITEMASK 0xffffffffu
#endif
#ifndef MK_REPEAT_SITE
#define MK_REPEAT_SITE -1
#endif
#ifndef MK_DBG_NOMOE
#define MK_DBG_NOMOE 0
#endif
#ifndef MK_EXTRA_BARS
#define MK_EXTRA_BARS 0
#endif
#ifndef MK_FP8_FFN
#define MK_FP8_FFN 0x4
#endif
#ifndef MK_FP8_QKV
#define MK_FP8_QKV 1
#endif
#ifndef MK_FP8_GLU
#define MK_FP8_GLU 1
#endif
#ifndef MK_ATT_XMFMA
#define MK_ATT_XMFMA 0
#endif
#ifndef MK_ATT_XEXP
#define MK_ATT_XEXP 0
#endif
#ifndef MK_ATT3
#define MK_ATT3 1
#endif
#ifndef MK_XBF16
#define MK_XBF16 1
#endif
#ifndef MK_ATT2
#define MK_ATT2 1
#endif
#ifndef MK_ONE_LAUNCH
#define MK_ONE_LAUNCH 1
#endif

constexpr int DM = 1024, NB = 4, SEQ = 8192, CTXL = 256, RPB = CTXL + SEQ, MALL = NB * RPB;
constexpr int TPB = RPB / 256, NT_ALL = MALL / 256, NT_LAT = NB * SEQ / 256;
constexpr int DFF = 2816, NE = 8, NHEAD = 8;
constexpr float EPS = 1e-6f;
constexpr int NWAVES = 8, NTHREADS = 512;
constexpr int CPB = RPB / 16;
constexpr int MOE_MAXT = 272;

constexpr size_t MiB = 1u << 20;
constexpr size_t WS_CTL = 0, CTL_ZERO_BYTES = 64 * 1024;
constexpr size_t WS_MOD = 1 * MiB;
constexpr size_t WS_ROPE = WS_MOD + 512 * 1024;
constexpr size_t WS_SEL = 2 * MiB;
constexpr size_t WS_SLOT = WS_SEL + (size_t)MALL * 16;
constexpr size_t WS_CNT = WS_SLOT + (size_t)MALL * 8;
constexpr size_t WS_TEXP = WS_CNT + 1024 * 8 * 4;
constexpr size_t WS_S5M3 = 8 * MiB;
constexpr size_t WS_S5M1 = 24 * MiB;
constexpr size_t WS_W = 32 * MiB;
constexpr size_t WS_X = 357 * MiB;
constexpr size_t WS_HL = 489 * MiB;
constexpr size_t WS_BIG = 555 * MiB;
constexpr size_t WS_END = 879 * MiB;
static_assert(WS_TEXP + 4096 <= WS_S5M3, "ws map");
constexpr size_t BIG_BZ = 0, BIG_U = 132 * MiB;
constexpr size_t BIG_Q8 = 0, BIG_K8 = 33 * MiB, BIG_V8 = 66 * MiB, BIG_VT8 = 99 * MiB;
constexpr size_t BIG_QKV = 0, BIG_KH = 66 * MiB, BIG_VH = 132 * MiB, BIG_O0 = 198 * MiB;
constexpr size_t BIG_HID = 0;
constexpr size_t BIG_APERM = 0, BIG_MHID = 136 * MiB;
constexpr size_t BIG_H = 0, BIG_SBUF = 144 * MiB, BIG_YG = 210 * MiB;
static_assert(BIG_MHID + (size_t)MOE_MAXT * 256 * DFF <= WS_END - WS_BIG && BIG_YG + 66 * MiB <= WS_END - WS_BIG && BIG_O0 + 66 * MiB <= WS_END - WS_BIG, "big map");

constexpr size_t WSZ_CONVIN = (size_t)3072 * 1024 * 2, WSZ_SQ = (size_t)1024 * 1024 * 2, WSZ_GU = (size_t)5632 * 1024 * 2, WSZ_DOWN = (size_t)1024 * 2816 * 2, WSZ_GLU = (size_t)2048 * 1024 * 2;
constexpr size_t WO_L0_CONVIN = 0, WO_L0_CONVOUT = WO_L0_CONVIN + WSZ_CONVIN, WO_L0_GU = WO_L0_CONVOUT + WSZ_SQ, WO_L0_DOWN = WO_L0_GU + WSZ_GU;
constexpr size_t WO_L1_QKV = WO_L0_DOWN + WSZ_DOWN, WO_L1_WO = WO_L1_QKV + WSZ_CONVIN, WO_L1_MGU = WO_L1_WO + WSZ_SQ, WO_L1_MDOWN = WO_L1_MGU + 8 * WSZ_GU;
constexpr size_t WO_L2_GLU = WO_L1_MDOWN + 8 * WSZ_DOWN, WO_L2_GU = WO_L2_GLU + WSZ_GLU, WO_L2_DOWN = WO_L2_GU + WSZ_GU;
constexpr size_t WO_L3_CONVIN = WO_L2_DOWN + WSZ_DOWN, WO_L3_CONVOUT = WO_L3_CONVIN + WSZ_CONVIN, WO_L3_MGU = WO_L3_CONVOUT + WSZ_SQ, WO_L3_MDOWN = WO_L3_MGU + 8 * WSZ_GU;
constexpr size_t WO_END = WO_L3_MDOWN + 8 * WSZ_DOWN;
static_assert(WS_W + WO_END <= WS_X, "weights fit");

enum { IN_X = 0, IN_C = 1, IN_CTX = 2, IN_CCTX = 3, IN_FINAL = 49 };
__host__ __device__ constexpr int lbase(int L) { return L == 0 ? 4 : L == 1 ? 13 : L == 2 ? 24 : 39; }

#define LAS __attribute__((address_space(3)))
typedef unsigned short bf16_t;
typedef short bf16x8 __attribute__((ext_vector_type(8)));
typedef float f32x4 __attribute__((ext_vector_type(4)));
typedef float f32x2 __attribute__((ext_vector_type(2)));
typedef unsigned u32x4 __attribute__((ext_vector_type(4)));
typedef unsigned u32x2 __attribute__((ext_vector_type(2)));
#define LDS_WAIT() asm volatile("s_waitcnt lgkmcnt(0)" ::: "memory")
#define VM_WAIT() asm volatile("s_waitcnt vmcnt(0)" ::: "memory")
__device__ __forceinline__ unsigned cvt_pk_bf16(float lo, float hi) { unsigned r; asm volatile("v_cvt_pk_bf16_f32 %0, %1, %2" : "=v"(r) : "v"(lo), "v"(hi)); return r; }
__device__ __forceinline__ float clamp8(float v) { return __builtin_amdgcn_fmed3f(v, -448.f, 448.f); }
__device__ __forceinline__ unsigned cvt4_fp8(float a, float b, float c, float d) {
    unsigned w = 0; w = __builtin_amdgcn_cvt_pk_fp8_f32(clamp8(a), clamp8(b), w, false); w = __builtin_amdgcn_cvt_pk_fp8_f32(clamp8(c), clamp8(d), w, true); return w; }
__device__ __forceinline__ unsigned cvt4_fp8_nc(float a, float b, float c, float d) {
    unsigned w = 0; w = __builtin_amdgcn_cvt_pk_fp8_f32(a, b, w, false); w = __builtin_amdgcn_cvt_pk_fp8_f32(c, d, w, true); return w; }
__device__ __forceinline__ float bf_lo(unsigned w) { return __uint_as_float(w << 16); }
__device__ __forceinline__ float bf_hi(unsigned w) { return __uint_as_float(w & 0xffff0000u); }
#if MK_XBF16
typedef bf16_t xel_t;
__device__ __forceinline__ f32x4 x_ld4(const xel_t* p) { const u32x2 w = *(const u32x2*)p; return (f32x4){bf_lo(w.x), bf_hi(w.x), bf_lo(w.y), bf_hi(w.y)}; }
__device__ __forceinline__ void x_st4(xel_t* p, f32x4 v) { u32x2 w; w.x = cvt_pk_bf16(v[0], v[1]); w.y = cvt_pk_bf16(v[2], v[3]); *(u32x2*)p = w; }
#else
typedef float xel_t;
__device__ __forceinline__ f32x4 x_ld4(const xel_t* p) { return *(const f32x4*)p; }
__device__ __forceinline__ void x_st4(xel_t* p, f32x4 v) { *(f32x4*)p = v; }
#endif
__device__ __forceinline__ float row16_sum(float v) {
    v += __int_as_float(__builtin_amdgcn_mov_dpp(__float_as_int(v), 0xB1, 0xf, 0xf, true));
    v += __int_as_float(__builtin_amdgcn_mov_dpp(__float_as_int(v), 0x4E, 0xf, 0xf, true));
    v += __int_as_float(__builtin_amdgcn_mov_dpp(__float_as_int(v), 0x141, 0xf, 0xf, true));
    v += __int_as_float(__builtin_amdgcn_mov_dpp(__float_as_int(v), 0x140, 0xf, 0xf, true));
    return v;
}
__device__ __forceinline__ float wave_sum(float v) {
    v = row16_sum(v);
    const int vi = __float_as_int(v);
    const float a = __int_as_float(__builtin_amdgcn_readlane(vi, 0)), b = __int_as_float(__builtin_amdgcn_readlane(vi, 16)), c = __int_as_float(__builtin_amdgcn_readlane(vi, 32)), d = __int_as_float(__builtin_amdgcn_readlane(vi, 48));
    return (a + b) + (c + d);
}
__device__ __forceinline__ float fast_sigmoid(float x) { return __builtin_amdgcn_rcpf(1.0f + __builtin_amdgcn_exp2f(-1.4426950408889634f * x)); }
__device__ __forceinline__ float silu_f(float x) { return x * fast_sigmoid(x); }
__device__ __forceinline__ float gelu_tanh_f(float x) { const float u = 0.7978845608028654f * (x + 0.044715f * x * x * x); return x * fast_sigmoid(2.0f * u); }
__device__ __forceinline__ int row_cond(int row) { const int b = row / RPB; return (row - b * RPB) < CTXL ? 4 : b; }
__device__ __forceinline__ int tile_cond(int pm) { const int b = pm / TPB; return (pm - b * TPB) == 0 ? 4 : b; }

#define XB_TMO      128
#define XB_XCNT(j)  (256  + 64 * (j))
#define XB_XSUB(j)  (1280 + 64 * (j))
#define XB_XGEN(j)  (2304 + 64 * (j))
#define XB_TOP      3328
#define XB_TOPGEN   3392
#define XCD_BAR_WORDS 3456
#define XB_SPIN_CAP (1u << 18)
__device__ __forceinline__ unsigned xb_ld(unsigned* p)              { return __hip_atomic_load(p, __ATOMIC_RELAXED, __HIP_MEMORY_SCOPE_AGENT); }
__device__ __forceinline__ unsigned xb_add(unsigned* p, unsigned v) { return __hip_atomic_fetch_add(p, v, __ATOMIC_RELAXED, __HIP_MEMORY_SCOPE_AGENT); }
__device__ __forceinline__ unsigned xb_xcc_id() { return (unsigned)__builtin_amdgcn_s_getreg((3 << 11) | 20) & 0xFu; }
#define XB_SPIN(cond, bar) do { unsigned _sp = 0; while (cond) { __builtin_amdgcn_s_sleep(1); \
    if ((++_sp & 255u) == 0u) { if (xb_ld(&(bar)[XB_TMO])) break; if (_sp > XB_SPIN_CAP) { atomicAdd(&(bar)[XB_TMO], 1u); break; } } } } while (0)
struct XcdBarrier { unsigned* bar; unsigned x; volatile LAS unsigned* st; };
__device__ __forceinline__ XcdBarrier xcd_barrier_post(unsigned* bar, volatile LAS unsigned* st) {
    XcdBarrier b; b.bar = bar; b.x = xb_xcc_id(); b.st = st;
    if (threadIdx.x == 0) (void)xb_add(&bar[XB_XCNT(b.x)], 1u);
    return b;
}
__device__ __forceinline__ void xcd_barrier_complete(unsigned* bar, unsigned x, unsigned& nloc, unsigned& nx) {
    const unsigned G = gridDim.x * gridDim.y * gridDim.z;
    unsigned sum, cnt, mine, sp = 0u;
    for (;;) {
        sum = 0u; cnt = 0u; mine = 0u;
#pragma unroll
        for (unsigned j = 0; j < 16; ++j) { const unsigned c = xb_ld(&bar[XB_XCNT(j)]); sum += c; cnt += (c > 0u) ? 1u : 0u; mine = (j == x) ? c : mine; }
        if (sum == G) break;
        __builtin_amdgcn_s_sleep(1);
        if ((++sp & 255u) == 0u) { if (xb_ld(&bar[XB_TMO])) break; if (sp > XB_SPIN_CAP) { atomicAdd(&bar[XB_TMO], 1u); break; } }
    }
    nloc = mine > 0u ? mine : 1u; nx = cnt > 0u ? cnt : 1u;
}
__device__ __forceinline__ void xcd_barrier(const XcdBarrier& b) {
    asm volatile("s_waitcnt vmcnt(0)" ::: "memory");
    __syncthreads();
    if (threadIdx.x == 0) {
        unsigned* bar = b.bar;
        __builtin_amdgcn_s_waitcnt(0);
        unsigned nloc = b.st[0], nx = b.st[1];
        if (nloc == 0u) { xcd_barrier_complete(bar, b.x, nloc, nx); b.st[0] = nloc; b.st[1] = nx; }
        const unsigned old = xb_add(&bar[XB_XSUB(b.x)], 1u);
        const unsigned gen = old / nloc;
        if (old + 1u == (gen + 1u) * nloc) {
            __builtin_amdgcn_fence(__ATOMIC_RELEASE, "agent");
            asm volatile("s_waitcnt vmcnt(0)" ::: "memory");
            const unsigned og = xb_add(&bar[XB_TOP], 1u);
            const unsigned tg = og / nx;
            if (og + 1u == (tg + 1u) * nx) xb_add(&bar[XB_TOPGEN], 1u);
            else XB_SPIN(xb_ld(&bar[XB_TOPGEN]) == tg, bar);
            __builtin_amdgcn_fence(__ATOMIC_ACQUIRE, "agent");
            xb_add(&bar[XB_XGEN(b.x)], 1u);
            asm volatile("s_waitcnt vmcnt(0)" ::: "memory");
        } else {
            XB_SPIN(xb_ld(&bar[XB_XGEN(b.x)]) == gen, bar);
            __builtin_amdgcn_fence(__ATOMIC_ACQUIRE, "agent");
            asm volatile("s_waitcnt vmcnt(0)" ::: "memory");
        }
    }
    __syncthreads();
}

namespace pg8 {
constexpr int BM = 256, BK = 64, HALF = 128, HTB = HALF * BK * 2, STAGE_BYTES = 8 * HTB, NXCD = 8, WGM = 8;
__host__ __device__ __forceinline__ int lds_byte(int r, int c) { const int st = (r >> 4) * 2 + (c >> 5), rr = r & 15, cc = c & 31, ob = rr * 64 + cc * 2; return st * 1024 + (ob ^ (((ob >> 9) & 1) << 5)); }
__host__ __device__ __forceinline__ void stage_rc(int b, int& R, int& C) { const int st = b / 1024, sb = b % 1024, swz = sb ^ (((sb >> 9) & 1) << 5); R = (st >> 1) * 16 + swz / 64; C = (st & 1) * 32 + (swz % 64) / 2; }
__host__ __device__ __forceinline__ int perm32(int rho) { const int n = rho >> 4, i = rho & 15; return 8 * (i >> 2) + 4 * n + (i & 3); }
struct Unit { int pm, pn, aux; };
__device__ __forceinline__ void order_map(int L, int nM, int nN, int& tm, int& tn) {
    const int nwg = nM * nN; int wgid = L; { const int q = nwg / NXCD, r = nwg % NXCD, xcd = wgid % NXCD, off = wgid / NXCD; wgid = (xcd < r ? xcd * (q + 1) : r * (q + 1) + (xcd - r) * q) + off; }
    const int nig = WGM * nN, gid = wgid / nig, fm = gid * WGM, gsz = (nM - fm) < WGM ? (nM - fm) : WGM;
    tm = fm + ((wgid % nig) % gsz); tn = (wgid % nig) / gsz;
}

template <class Epi, class Prob, bool ALIGN_EPI, bool FP8 = false>
__device__ __forceinline__ void gemm_phase(LAS unsigned char* lds, const Prob& P, const Epi& E, const int tid) {
    const int wid = __builtin_amdgcn_readfirstlane(tid >> 6), lane = tid & 63, wr = wid >> 2, wc = wid & 3, fr = lane & 15, fq = lane >> 4;
    const int nt = P.nt;
    unsigned voffA[2], voffB[2];
#pragma unroll
    for (int i = 0; i < 2; ++i) { int R, C; stage_rc(tid * 16 + i * 8192, R, C); const int Rb = Epi::PERM ? ((R & ~31) + perm32(R & 31)) : R;
        voffA[i] = P.lane_off_a(R, C); voffB[i] = P.lane_off_b(Rb, C); }
    const size_t hsA = P.hstep_a(), hsB = P.hstep_b();
    const unsigned ldsw = (unsigned)wid * 1024u;
    const int aoff = lds_byte(wr * 64 + fr, fq * 8), boff = lds_byte(wc * 32 + fr, fq * 8);
#define PG8_SA(b, h) (((b) * 2 + (h)) * HTB)
#define PG8_SB(b, h) ((4 + (b) * 2 + (h)) * HTB)
#define PG8_STAGE(bufoff, gbase, voff) do { _Pragma("unroll") for (int _i = 0; _i < 2; ++_i) \
        __builtin_amdgcn_global_load_lds((const unsigned*)((const char*)(gbase) + (voff)[_i]), (LAS unsigned*)(lds + (bufoff) + ldsw + _i * 8192), 16, 0, 0); } while (0)
#define PG8_LDA(dst, b, h) do { _Pragma("unroll") for (int m = 0; m < 4; ++m) _Pragma("unroll") for (int k = 0; k < 2; ++k) dst[m][k] = *(const LAS bf16x8*)(lds + PG8_SA(b, h) + aoff + m * 2048 + k * 1024); } while (0)
#define PG8_LDB(dst, b, h) do { _Pragma("unroll") for (int n = 0; n < 2; ++n) _Pragma("unroll") for (int k = 0; k < 2; ++k) dst[n][k] = *(const LAS bf16x8*)(lds + PG8_SB(b, h) + boff + n * 2048 + k * 1024); } while (0)
#define PG8_MMA(ai, bj, At, Bt) do { __builtin_amdgcn_s_setprio(1); _Pragma("unroll") for (int m = 0; m < 4; ++m) _Pragma("unroll") for (int n = 0; n < 2; ++n) { \
        if constexpr (FP8) { typedef int v4i_ __attribute__((ext_vector_type(4))); typedef int v8i_ __attribute__((ext_vector_type(8))); \
            const v4i_ b0_ = __builtin_bit_cast(v4i_, Bt[n][0]), b1_ = __builtin_bit_cast(v4i_, Bt[n][1]), a0_ = __builtin_bit_cast(v4i_, At[m][0]), a1_ = __builtin_bit_cast(v4i_, At[m][1]); \
            const v8i_ bb_ = {b0_[0], b0_[1], b0_[2], b0_[3], b1_[0], b1_[1], b1_[2], b1_[3]}, aa_ = {a0_[0], a0_[1], a0_[2], a0_[3], a1_[0], a1_[1], a1_[2], a1_[3]}; \
              \
            asm volatile("v_mfma_scale_f32_16x16x128_f8f6f4 %0, %1, %2, %0, %3, %3 op_sel_hi:[0,0,0]" : "+v"(acc[ai][bj][m][n]) : "v"(bb_), "v"(aa_), "v"(0x7f7f7f7f)); } \
        else { _Pragma("unroll") for (int k = 0; k < 2; ++k) acc[ai][bj][m][n] = __builtin_amdgcn_mfma_f32_16x16x32_bf16(Bt[n][k], At[m][k], acc[ai][bj][m][n], 0, 0, 0); } } \
        __builtin_amdgcn_s_setprio(0); } while (0)
#define PG8_WAIT_V(n) asm volatile("s_waitcnt vmcnt(" #n ")" ::: "memory")
#define PG8_WAIT_L(n) asm volatile("s_waitcnt lgkmcnt(" #n ")" ::: "memory")
#define PG8_BAR __builtin_amdgcn_s_barrier()
#define PG8_SCHED __builtin_amdgcn_sched_barrier(0)
    Unit cur, nxt; int ui = 0;
    if (!P.next(0, cur)) return;
    f32x4 acc[2][2][4][2];
#pragma unroll
    for (int a = 0; a < 2; ++a)
#pragma unroll
        for (int b = 0; b < 2; ++b)
#pragma unroll
            for (int m = 0; m < 4; ++m)
#pragma unroll
                for (int n = 0; n < 2; ++n) acc[a][b][m][n] = (f32x4){0.f, 0.f, 0.f, 0.f};
    bf16x8 At[4][2], B0[2][2], B1[2][2];
    {
        const char* cA = P.a_ptr(cur, 0); const char* cB = P.b_ptr(cur, 0); const char* cA1 = P.a_ptr(cur, 1); const char* cB1 = P.b_ptr(cur, 1);
        PG8_STAGE(PG8_SB(0, 0), cB, voffB); PG8_STAGE(PG8_SB(0, 1), cB + hsB, voffB); PG8_STAGE(PG8_SA(0, 0), cA, voffA); PG8_STAGE(PG8_SA(0, 1), cA + hsA, voffA);
        if (wr == 1) PG8_BAR;
        PG8_WAIT_V(2); PG8_BAR;
        PG8_STAGE(PG8_SB(1, 0), cB1, voffB); PG8_STAGE(PG8_SA(1, 0), cA1, voffA); PG8_STAGE(PG8_SB(1, 1), cB1 + hsB, voffB);
        PG8_WAIT_V(6); PG8_BAR;
    }
    for (;;) {
        const bool has_next = P.next(ui + 1, nxt);
        const Unit nu = has_next ? nxt : cur;
        for (int t = 0; t < nt; t += 2) {
            const bool last = (t == nt - 2);
            const char* a1 = P.a_ptr(cur, t + 1);
            const char* a2 = last ? P.a_ptr(nu, 0) : P.a_ptr(cur, t + 2); const char* b2 = last ? P.b_ptr(nu, 0) : P.b_ptr(cur, t + 2);
            const char* a3 = last ? P.a_ptr(nu, 1) : P.a_ptr(cur, t + 3); const char* b3 = last ? P.b_ptr(nu, 1) : P.b_ptr(cur, t + 3);
            PG8_LDB(B0, 0, 0); PG8_LDB(B1, 0, 1); PG8_SCHED; PG8_LDA(At, 0, 0); PG8_STAGE(PG8_SA(1, 1), a1 + hsA, voffA);
            PG8_WAIT_V(8); PG8_WAIT_L(0); PG8_BAR; PG8_MMA(0, 0, At, B0); PG8_MMA(0, 1, At, B1); PG8_BAR; PG8_SCHED;
            PG8_LDA(At, 0, 1); PG8_STAGE(PG8_SB(0, 0), b2, voffB); PG8_STAGE(PG8_SB(0, 1), b2 + hsB, voffB); PG8_STAGE(PG8_SA(0, 0), a2, voffA);
            PG8_WAIT_V(8); PG8_WAIT_L(0); PG8_BAR; PG8_MMA(1, 0, At, B0); PG8_MMA(1, 1, At, B1); PG8_BAR; PG8_SCHED;
            PG8_LDB(B0, 1, 0); PG8_LDB(B1, 1, 1); PG8_SCHED; PG8_LDA(At, 1, 0); PG8_STAGE(PG8_SA(0, 1), a2 + hsA, voffA);
            PG8_WAIT_V(8); PG8_WAIT_L(0); PG8_BAR; PG8_MMA(0, 0, At, B0); PG8_MMA(0, 1, At, B1); PG8_BAR; PG8_SCHED;
            PG8_LDA(At, 1, 1); PG8_STAGE(PG8_SB(1, 0), b3, voffB); PG8_STAGE(PG8_SB(1, 1), b3 + hsB, voffB); PG8_STAGE(PG8_SA(1, 0), a3, voffA);
            PG8_WAIT_V(8); PG8_WAIT_L(0); PG8_BAR; PG8_MMA(1, 0, At, B0); PG8_MMA(1, 1, At, B1); PG8_BAR; PG8_SCHED;
        }
        if constexpr (ALIGN_EPI) { if (wr == 0) PG8_BAR; }
        if constexpr (FP8) { asm volatile("s_nop 15\n\ts_nop 15" ::: "memory");
#pragma unroll
            for (int a_ = 0; a_ < 2; ++a_)
#pragma unroll
                for (int b_ = 0; b_ < 2; ++b_)
#pragma unroll
                    for (int m_ = 0; m_ < 4; ++m_) asm volatile("" : "+v"(acc[a_][b_][m_][0]), "+v"(acc[a_][b_][m_][1])); }
        { int l_e; asm volatile("v_mbcnt_lo_u32_b32 %0, -1, 0\n\tv_mbcnt_hi_u32_b32 %0, -1, %0" : "=v"(l_e)); E(acc, cur, wr, wc, l_e & 15, l_e >> 4); }
        if (!has_next) break;
#pragma unroll
        for (int a = 0; a < 2; ++a)
#pragma unroll
            for (int b = 0; b < 2; ++b)
#pragma unroll
                for (int m = 0; m < 4; ++m)
#pragma unroll
                    for (int n = 0; n < 2; ++n) acc[a][b][m][n] = (f32x4){0.f, 0.f, 0.f, 0.f};
        cur = nxt; ++ui;
        if constexpr (ALIGN_EPI) { if (wr == 1) PG8_BAR; }
    }
    PG8_WAIT_V(0);
    if constexpr (!ALIGN_EPI) { if (wr == 0) PG8_BAR; }
    PG8_BAR;
#undef PG8_SA
#undef PG8_SB
#undef PG8_STAGE
#undef PG8_LDA
#undef PG8_LDB
#undef PG8_MMA
#undef PG8_WAIT_V
#undef PG8_WAIT_L
#undef PG8_BAR
#undef PG8_SCHED
}

struct ProbPlain {
    const char* A; const char* Bt; int lda_b, ldb_b, nt, nM, nN, G, c; bool latent;
    __device__ __forceinline__ bool next(int i, Unit& u) const {
        const long L = (long)i * G + c; if (L >= (long)nM * nN) return false;
        int tm, tn; order_map((int)L, nM, nN, tm, tn); u.pm = latent ? tm + (tm >> 5) + 1 : tm; u.pn = tn; u.aux = 0; return true; }
    __device__ __forceinline__ const char* a_ptr(const Unit& u, int kt) const { return A + (size_t)u.pm * 256 * lda_b + (size_t)kt * 128; }
    __device__ __forceinline__ const char* b_ptr(const Unit& u, int kt) const { return Bt + (size_t)u.pn * 256 * ldb_b + (size_t)kt * 128; }
    __device__ __forceinline__ size_t hstep_a() const { return (size_t)128 * lda_b; }
    __device__ __forceinline__ size_t hstep_b() const { return (size_t)128 * ldb_b; }
    __device__ __forceinline__ unsigned lane_off_a(int R, int C) const { return (unsigned)(R * lda_b + C * 2); }
    __device__ __forceinline__ unsigned lane_off_b(int R, int C) const { return (unsigned)(R * ldb_b + C * 2); }
};
struct ProbMoe {
    const char* A; const char* Bt; int lda_b, ldb_b, nt, nN, G, c; size_t bstride_e; const int* texp; int tile0, ntile, a_rel;
    __device__ __forceinline__ bool next(int i, Unit& u) const {
        const long L = (long)i * G + c; if (L >= (long)ntile * nN) return false;
        int tm, tn; order_map((int)L, ntile, nN, tm, tn); u.pm = tile0 + tm; u.pn = tn; u.aux = __builtin_amdgcn_readfirstlane(texp[u.pm]); return true; }
    __device__ __forceinline__ const char* a_ptr(const Unit& u, int kt) const { return A + (size_t)(u.pm - a_rel) * 256 * lda_b + (size_t)kt * 128; }
    __device__ __forceinline__ const char* b_ptr(const Unit& u, int kt) const { return Bt + (size_t)u.aux * bstride_e + (size_t)u.pn * 256 * ldb_b + (size_t)kt * 128; }
    __device__ __forceinline__ size_t hstep_a() const { return (size_t)128 * lda_b; }
    __device__ __forceinline__ size_t hstep_b() const { return (size_t)128 * ldb_b; }
    __device__ __forceinline__ unsigned lane_off_a(int R, int C) const { return (unsigned)(R * lda_b + C * 2); }
    __device__ __forceinline__ unsigned lane_off_b(int R, int C) const { return (unsigned)(R * ldb_b + C * 2); }
};
constexpr int S5_ROWS = 4 * 8448;
struct ProbS5 {
    const char* A0; const char* A1; const char* Bt; int nt, nt0, ntile, G, c; size_t bstride_g; bool s3;
    __device__ __forceinline__ bool next(int i, Unit& u) const {
        const int vcu = (G % 8 == 0) ? (c % 8) * (G / 8) + c / 8 : c;
        const long L = (long)i * G + vcu; if (L >= (long)ntile * 64) return false;
        u.pm = (int)(L >> 6); u.pn = (int)(L & 63); u.aux = 0; return true; }
    __device__ __forceinline__ size_t tokbase(int pm) const { return s3 ? (size_t)(pm >> 1) * RPB + CTXL + (size_t)(pm & 1) * 4096 : (size_t)pm * 4096; }
    __device__ __forceinline__ const char* a_ptr(const Unit& u, int kt) const { return kt < nt0 ? A0 + ((size_t)u.pn * S5_ROWS + tokbase(u.pm)) * 32 + (size_t)kt * 128 : A1 + ((size_t)u.pn * (S5_ROWS / 16) + tokbase(u.pm) / 16) * 512 + (size_t)(kt - nt0) * 128; }
    __device__ __forceinline__ const char* b_ptr(const Unit& u, int kt) const { return Bt + (size_t)u.pn * bstride_g + (size_t)kt * 128; }
    __device__ __forceinline__ size_t hstep_a() const { return (size_t)128 * 512; }
    __device__ __forceinline__ size_t hstep_b() const { return (size_t)128 * nt * 128; }
    __device__ __forceinline__ unsigned lane_off_a(int R, int C) const { return (unsigned)(R * 512 + C * 2); }
    __device__ __forceinline__ unsigned lane_off_b(int R, int C) const { return (unsigned)(R * nt * 128 + C * 2); }
};

typedef f32x4 Acc[2][2][4][2];
constexpr float W8SCALE = 64.f, W8INV = 1.f / 64.f;
constexpr float QSCALE = 0.125f * 1.4426950408889634f;
__device__ __forceinline__ u32x4 pack8(f32x4 v0, f32x4 v1) { u32x4 w; w.x = cvt_pk_bf16(v0[0], v0[1]); w.y = cvt_pk_bf16(v0[2], v0[3]); w.z = cvt_pk_bf16(v1[0], v1[1]); w.w = cvt_pk_bf16(v1[2], v1[3]); return w; }

struct EpiBf16 {
    static constexpr bool PERM = true;
    bf16_t* O; int ldc; int pm_sub; float s;
    __device__ __forceinline__ void operator()(const Acc& acc, const Unit& u, int wr, int wc, int fr, int fq) const {
        const int row0 = (u.pm - pm_sub) * BM + wr * 64 + fr, col0 = u.pn * BM + wc * 32 + 8 * fq;
#pragma unroll
        for (int ai = 0; ai < 2; ++ai)
#pragma unroll
            for (int m = 0; m < 4; ++m) { bf16_t* rowp = O + (size_t)(row0 + ai * HALF + m * 16) * ldc + col0;
#pragma unroll
                for (int bj = 0; bj < 2; ++bj) *(u32x4*)(rowp + bj * HALF) = pack8(acc[ai][bj][m][0] * s, acc[ai][bj][m][1] * s); }
    }
};
template <int ACT> struct EpiGated {
    static constexpr bool PERM = true;
    bf16_t* O; int ldc; int pn0; int col_base; int pm_sub;
    __device__ __forceinline__ void operator()(const Acc& acc, const Unit& u, int wr, int wc, int fr, int fq) const {
        const int row0 = (u.pm - pm_sub) * BM + wr * 64 + fr;
        if (u.pn < pn0) {
            const int col0 = u.pn * BM + wc * 32 + 8 * fq;
#pragma unroll
            for (int ai = 0; ai < 2; ++ai)
#pragma unroll
                for (int m = 0; m < 4; ++m) { bf16_t* rowp = O + (size_t)(row0 + ai * HALF + m * 16) * ldc + col0;
#pragma unroll
                    for (int bj = 0; bj < 2; ++bj) *(u32x4*)(rowp + bj * HALF) = pack8(acc[ai][bj][m][0], acc[ai][bj][m][1]); }
        } else {
            const int col0 = col_base + (u.pn - pn0) * HALF + wc * 32 + 8 * fq;
#pragma unroll
            for (int ai = 0; ai < 2; ++ai)
#pragma unroll
                for (int m = 0; m < 4; ++m) { bf16_t* rowp = O + (size_t)(row0 + ai * HALF + m * 16) * ldc + col0;
                    f32x4 a0 = acc[ai][0][m][0], a1 = acc[ai][0][m][1];
                    if (ACT == 1) {
#pragma unroll
                        for (int e = 0; e < 4; ++e) { a0[e] = silu_f(a0[e]); a1[e] = silu_f(a1[e]); } }
                    *(u32x4*)rowp = pack8(a0 * acc[ai][1][m][0], a1 * acc[ai][1][m][1]); }
        }
    }
};
struct EpiGated8 {
    static constexpr bool PERM = true;
    unsigned char* O; int ldc; float s;
    __device__ __forceinline__ void operator()(const Acc& acc, const Unit& u, int wr, int wc, int fr, int fq) const {
        const int row0 = u.pm * BM + wr * 64 + fr, col0 = u.pn * HALF + wc * 32 + 8 * fq;
#pragma unroll
        for (int ai = 0; ai < 2; ++ai)
#pragma unroll
            for (int m = 0; m < 4; ++m) { unsigned char* rowp = O + (size_t)(row0 + ai * HALF + m * 16) * ldc + col0;
                f32x4 a0 = acc[ai][0][m][0] * s, a1 = acc[ai][0][m][1] * s; const f32x4 b0 = acc[ai][1][m][0] * s, b1 = acc[ai][1][m][1] * s;
#pragma unroll
                for (int e = 0; e < 4; ++e) { a0[e] = silu_f(a0[e]) * b0[e]; a1[e] = silu_f(a1[e]) * b1[e]; }
                u32x2 w; w.x = cvt4_fp8(a0[0], a0[1], a0[2], a0[3]); w.y = cvt4_fp8(a1[0], a1[1], a1[2], a1[3]);
                *(u32x2*)rowp = w; }
    }
};
struct EpiResid {
    static constexpr bool PERM = false;
    xel_t* X; const float* gate;
    const float* xin; const float* cin;
    float s;
    __device__ __forceinline__ void operator()(const Acc& acc, const Unit& u, int wr, int wc, int fr, int fq) const {
        const int row0 = u.pm * BM + wr * 64 + fr, col0 = u.pn * BM + wc * 32 + 4 * fq;
        const float* gp = gate + tile_cond(u.pm) * 6144 + col0;
        const int bq = u.pm / TPB, tq = u.pm - bq * TPB;
        const float* srcin = xin ? (tq == 0 ? cin + (size_t)bq * CTXL * DM : xin + ((size_t)bq * SEQ + (size_t)(tq - 1) * 256) * DM) - (size_t)u.pm * BM * DM : nullptr;
        f32x4 gv[2][2];
#pragma unroll
        for (int bj = 0; bj < 2; ++bj)
#pragma unroll
            for (int n = 0; n < 2; ++n) gv[bj][n] = *(const f32x4*)(gp + bj * HALF + n * 16);
#pragma unroll
        for (int ai = 0; ai < 2; ++ai)
#pragma unroll
            for (int m = 0; m < 4; ++m) { const size_t off = (size_t)(row0 + ai * HALF + m * 16) * DM + col0;
#pragma unroll
                for (int bj = 0; bj < 2; ++bj)
#pragma unroll
                    for (int n = 0; n < 2; ++n) { const size_t o2 = off + bj * HALF + n * 16; const f32x4 xv = srcin ? *(const f32x4*)(srcin + o2) : x_ld4(X + o2); x_st4(X + o2, xv + gv[bj][n] * (acc[ai][bj][m][n] * s)); }
                if (m & 1) asm volatile("" ::: "memory"); }
    }
};
struct EpiGlu {
    static constexpr bool PERM = false;
    xel_t* X; const float* gate; float s;
    __device__ __forceinline__ void operator()(const Acc& acc, const Unit& u, int wr, int wc, int fr, int fq) const {
        const int row0 = u.pm * BM + wr * 64 + fr, col0 = u.pn * HALF + wc * 32 + 4 * fq;
        const float* gp = gate + tile_cond(u.pm) * 6144 + col0;
        f32x4 gv[2];
#pragma unroll
        for (int n = 0; n < 2; ++n) gv[n] = *(const f32x4*)(gp + n * 16);
#pragma unroll
        for (int ai = 0; ai < 2; ++ai)
#pragma unroll
            for (int m = 0; m < 4; ++m) { xel_t* rowp = X + (size_t)(row0 + ai * HALF + m * 16) * DM + col0;
#pragma unroll
                for (int n = 0; n < 2; ++n) { f32x4 sg = acc[ai][1][m][n] * s;
#pragma unroll
                    for (int e = 0; e < 4; ++e) sg[e] = fast_sigmoid(sg[e]);
                    xel_t* p = rowp + n * 16; x_st4(p, x_ld4(p) + gv[n] * ((acc[ai][0][m][n] * s) * sg)); }
                if (m & 1) asm volatile("" ::: "memory"); }
    }
};
template <bool OUT8, bool W8> struct EpiQkv {
    static constexpr bool PERM = true;
    unsigned char* big; const float* cosT;
    __device__ __forceinline__ void operator()(const Acc& acc, const Unit& u, int wr, int wc, int fr, int fq) const {
        const float s = W8 ? W8INV : 1.f; const float* sinT = cosT + 128 * 16;
        const int row0 = u.pm * BM + wr * 64 + fr;
        const int bq = u.pm / TPB, tq = u.pm - bq * TPB;
        const bool rope = (u.pn < 8) && (tq != 0);
        const int sect = u.pn >> 2;
        const int cs0 = (u.pn & 3) * BM + wc * 32 + 8 * fq;
#pragma unroll
        for (int ai = 0; ai < 2; ++ai)
#pragma unroll
            for (int m = 0; m < 4; ++m) { const int row = row0 + ai * HALF + m * 16; const int j = row - bq * RPB;
                f32x4 c4 = (f32x4){1.f, 1.f, 1.f, 1.f}, s4 = (f32x4){0.f, 0.f, 0.f, 0.f};
                if (rope) { const int t = j - CTXL; const int pos = (wc & 1) ? (t & 63) : (t >> 6);
                    c4 = *(const f32x4*)(cosT + pos * 16 + 4 * fq); s4 = *(const f32x4*)(sinT + pos * 16 + 4 * fq); }
#pragma unroll
                for (int bj = 0; bj < 2; ++bj) { const f32x4 v0 = acc[ai][bj][m][0] * s, v1 = acc[ai][bj][m][1] * s; f32x4 o0, o1;
                    o0[0] = v0[0] * c4[0] - v0[1] * s4[0]; o0[1] = v0[1] * c4[0] + v0[0] * s4[0];
                    o0[2] = v0[2] * c4[1] - v0[3] * s4[1]; o0[3] = v0[3] * c4[1] + v0[2] * s4[1];
                    o1[0] = v1[0] * c4[2] - v1[1] * s4[2]; o1[1] = v1[1] * c4[2] + v1[0] * s4[2];
                    o1[2] = v1[2] * c4[3] - v1[3] * s4[3]; o1[3] = v1[3] * c4[3] + v1[2] * s4[3];
                    const int cs = cs0 + bj * HALF;
                    if constexpr (OUT8) {
                        size_t off8; float sc8 = 1.f;
                        if (sect == 0) { sc8 = QSCALE * 16.f; off8 = BIG_Q8 + (size_t)row * DM + cs; }
                        else if (sect == 1) off8 = BIG_K8 + ((size_t)(bq * 16 + (cs >> 6)) * RPB + j) * 64 + (cs & 63);
                        else off8 = BIG_V8 + ((size_t)(bq * 8 + (cs >> 7)) * RPB + j) * 128 + (cs & 127);
                        u32x2 w8; w8.x = cvt4_fp8(o0[0] * sc8, o0[1] * sc8, o0[2] * sc8, o0[3] * sc8); w8.y = cvt4_fp8(o1[0] * sc8, o1[1] * sc8, o1[2] * sc8, o1[3] * sc8);
                        *(u32x2*)(big + off8) = w8;
                    } else { size_t offb;
                        if (sect == 0) { o0 = o0 * QSCALE; o1 = o1 * QSCALE; offb = BIG_QKV + ((size_t)row * DM + cs) * 2; }
                        else if (sect == 1) offb = BIG_KH + (((size_t)(bq * 16 + (cs >> 6)) * RPB + j) * 64 + (cs & 63)) * 2;
                        else offb = BIG_VH + (((size_t)(bq * 8 + (cs >> 7)) * RPB + j) * 128 + (cs & 127)) * 2;
                        *(u32x4*)(big + offb) = pack8(o0, o1); } } }
    }
};
struct EpiS1 {
    static constexpr bool PERM = false;
    float* H;
    __device__ __forceinline__ void operator()(const Acc& acc, const Unit& u, int wr, int wc, int fr, int fq) const {
        const int row0 = u.pm * BM + wr * 64 + fr, col0 = wc * 32 + 4 * fq;
#pragma unroll
        for (int ai = 0; ai < 2; ++ai)
#pragma unroll
            for (int m = 0; m < 4; ++m) { float* rowp = H + ((size_t)(row0 + ai * HALF + m * 16) * 64 + u.pn) * 256 + col0;
#pragma unroll
                for (int bj = 0; bj < 2; ++bj)
#pragma unroll
                    for (int n = 0; n < 2; ++n) *(f32x4*)(rowp + bj * HALF + n * 16) = acc[ai][bj][m][n]; }
    }
};
struct EpiS3 {
    static constexpr bool PERM = true;
    bf16_t* YG; bool out8;
    __device__ __forceinline__ void operator()(const Acc& acc, const Unit& u, int wr, int wc, int fr, int fq) const {
        const size_t tb = (size_t)(u.pm >> 1) * RPB + CTXL + (size_t)(u.pm & 1) * 4096;
        const int r0 = wr * 64 + fr;
#pragma unroll
        for (int ai = 0; ai < 2; ++ai)
#pragma unroll
            for (int m = 0; m < 4; ++m) { const int R = r0 + ai * HALF + m * 16;
#pragma unroll
                for (int bj = 0; bj < 2; ++bj) { const int t = 8 * bj + 2 * wc + (fq >> 1), s0 = 8 * (fq & 1);
                    f32x4 v0 = acc[ai][bj][m][0], v1 = acc[ai][bj][m][1];
#pragma unroll
                    for (int e = 0; e < 4; ++e) { v0[e] = gelu_tanh_f(v0[e]); v1[e] = gelu_tanh_f(v1[e]); }
                    const size_t eoff = (tb + (size_t)R * 16 + t) * DM + u.pn * 16 + s0;
                    if (out8) { u32x2 w; w.x = cvt4_fp8(v0[0], v0[1], v0[2], v0[3]); w.y = cvt4_fp8(v1[0], v1[1], v1[2], v1[3]); *(u32x2*)((unsigned char*)YG + eoff) = w; }
                    else *(u32x4*)(YG + eoff) = pack8(v0, v1); } }
    }
};
}

namespace att {
using bf16x8 = __attribute__((ext_vector_type(8))) short;
using s16x4  = __attribute__((ext_vector_type(4))) short;
using f32x16 = __attribute__((ext_vector_type(16))) float;
constexpr int NW = 8, QBLK = 32, KVBLK = 64;
constexpr float SCALE = 0.125f, THR = 8.f;
constexpr int KROW = 144;
constexpr int SHM_V = KVBLK * 128 * 2, SHM_K = KVBLK * KROW;
constexpr int OFF_V = 0, OFF_K = 2 * SHM_V, OFF_WS = OFF_K + 2 * SHM_K, OFF_OST = OFF_WS + NW * 64 * 4, ATT_LDS = OFF_OST + NW * 8192;
constexpr int LDQ = 3072;
#define SBAR() __builtin_amdgcn_sched_barrier(0)
__device__ __forceinline__ int crow(int r, int hi) { return (r & 3) + 8 * (r >> 2) + 4 * hi; }
__device__ __forceinline__ void partialSM(f32x16& p0, f32x16& p1, float& m_reg, float& mn, float& alpha) {
  constexpr float C = SCALE * 1.4426950408889634f;
  float pmax = p0[0];
#pragma unroll
  for (int r = 1; r < 16; ++r) pmax = fmaxf(pmax, p0[r]);
#pragma unroll
  for (int r = 0; r < 16; ++r) pmax = fmaxf(pmax, p1[r]);
  { auto rr = __builtin_amdgcn_permlane32_swap(__float_as_uint(pmax), __float_as_uint(pmax), false, false);
    pmax = fmaxf(__uint_as_float(rr[0]), __uint_as_float(rr[1])); }
  if (__builtin_expect(__all(pmax - m_reg <= THR / SCALE), 1)) { mn = m_reg; alpha = 1.f; }
  else { mn = fmaxf(m_reg, pmax); alpha = __builtin_amdgcn_exp2f((m_reg - mn) * C); m_reg = mn; }
  float mnC = -mn * C;
#pragma unroll
  for (int r = 0; r < 16; ++r) p0[r] = fmaf(p0[r], C, mnC);
#pragma unroll
  for (int r = 0; r < 16; ++r) p1[r] = fmaf(p1[r], C, mnC);
#pragma unroll
  for (int r = 0; r < 16; ++r) p0[r] = __builtin_amdgcn_exp2f(p0[r]);
}
__device__ __forceinline__ void finishSM(f32x16& p0, f32x16& p1, float alpha, float& l_reg, bf16x8& pa0, bf16x8& pa1, bf16x8& pa2, bf16x8& pa3) {
#pragma unroll
  for (int r = 0; r < 16; ++r) p1[r] = __builtin_amdgcn_exp2f(p1[r]);
  float ps = 0;
#pragma unroll
  for (int r = 0; r < 16; ++r) ps += p0[r];
#pragma unroll
  for (int r = 0; r < 16; ++r) ps += p1[r];
  { auto rr = __builtin_amdgcn_permlane32_swap(__float_as_uint(ps), __float_as_uint(ps), false, false);
    ps = __uint_as_float(rr[0]) + __uint_as_float(rr[1]); }
  l_reg = l_reg * alpha + ps;
#define PK4(P, BASE, OUT) do { u32x4 w = {cvt_pk_bf16(P[BASE + 0], P[BASE + 1]), cvt_pk_bf16(P[BASE + 2], P[BASE + 3]), cvt_pk_bf16(P[BASE + 4], P[BASE + 5]), cvt_pk_bf16(P[BASE + 6], P[BASE + 7])}; \
    OUT = *reinterpret_cast<bf16x8*>(&w); } while (0)
  PK4(p0, 0, pa0); PK4(p0, 8, pa1); PK4(p1, 0, pa2); PK4(p1, 8, pa3);
#undef PK4
}
__device__ __forceinline__ void qkt(f32x16& p0, f32x16& p1, const char* Ks, const bf16x8* qr, int r32, int hi) {
  p0 = f32x16{}; p1 = f32x16{};
#pragma unroll
  for (int d0 = 0; d0 < 4; ++d0) { const int cb = (d0 * 16 + hi * 8) * 2;
    bf16x8 b0 = *reinterpret_cast<const bf16x8*>(Ks + r32 * KROW + cb);
    bf16x8 b1 = *reinterpret_cast<const bf16x8*>(Ks + (32 + r32) * KROW + cb);
    p0 = __builtin_amdgcn_mfma_f32_32x32x16_bf16(b0, qr[d0], p0, 0, 0, 0);
    p1 = __builtin_amdgcn_mfma_f32_32x32x16_bf16(b1, qr[d0], p1, 0, 0, 0); }
}
__device__ __forceinline__ int v_st(int k, int c) { const int kk = k; return ((kk >> 3) * 4 + (c >> 5)) * 512 + ((kk & 7) * 32 + (c & 31)) * 2; }
__device__ __forceinline__ int v_rd_base(int lane) { return ((lane & 3) << 3) | (((lane >> 2) & 3) << 6) | (((lane >> 4) & 1) << 5) | (((lane >> 5) & 1) << 8); }
constexpr int v_rd_off(int d0, int ks, int half) { return d0 * 512 + ks * 4096 + half * 2048; }
template <int OFF> __device__ __forceinline__ s16x4 tr_read(int vb) {
  s16x4 r; asm volatile("ds_read_b64_tr_b16 %0, %1 offset:%2" : "=&v"(r) : "v"(vb), "i"(OFF) : "memory"); return r;
}
template <int D0> __device__ __forceinline__ void pv_one(f32x16& od, int vb, bf16x8 pa0, bf16x8 pa1, bf16x8 pa2, bf16x8 pa3) {
  const s16x4 l0 = tr_read<v_rd_off(D0, 0, 0)>(vb), h0 = tr_read<v_rd_off(D0, 0, 1)>(vb), l1 = tr_read<v_rd_off(D0, 1, 0)>(vb), h1 = tr_read<v_rd_off(D0, 1, 1)>(vb);
  const s16x4 l2 = tr_read<v_rd_off(D0, 2, 0)>(vb), h2 = tr_read<v_rd_off(D0, 2, 1)>(vb), l3 = tr_read<v_rd_off(D0, 3, 0)>(vb), h3 = tr_read<v_rd_off(D0, 3, 1)>(vb);
  asm volatile("s_waitcnt lgkmcnt(0)" ::: "memory"); SBAR();
#define PK(L, H) (bf16x8){L[0], L[1], L[2], L[3], H[0], H[1], H[2], H[3]}
  od = __builtin_amdgcn_mfma_f32_32x32x16_bf16(pa0, PK(l0, h0), od, 0, 0, 0);
  od = __builtin_amdgcn_mfma_f32_32x32x16_bf16(pa1, PK(l1, h1), od, 0, 0, 0);
  od = __builtin_amdgcn_mfma_f32_32x32x16_bf16(pa2, PK(l2, h2), od, 0, 0, 0);
  od = __builtin_amdgcn_mfma_f32_32x32x16_bf16(pa3, PK(l3, h3), od, 0, 0, 0);
#undef PK
}
__device__ __forceinline__ void pv_d0(f32x16* o, int vb, bf16x8 pa0, bf16x8 pa1, bf16x8 pa2, bf16x8 pa3) {
  pv_one<0>(o[0], vb, pa0, pa1, pa2, pa3); pv_one<1>(o[1], vb, pa0, pa1, pa2, pa3); pv_one<2>(o[2], vb, pa0, pa1, pa2, pa3); pv_one<3>(o[3], vb, pa0, pa1, pa2, pa3);
}
__device__ __forceinline__ void attn_unit(const bf16_t* __restrict__ Qb, const bf16_t* __restrict__ Kh, const bf16_t* __restrict__ Vh, bf16_t* __restrict__ Ob, int ldo, int seq, char* lds, const int tid) {
  const int wid = tid >> 6, lane = tid & 63, r32 = lane & 31, hi = lane >> 5;
  char* V_lds = lds + OFF_V; char* K_lds = lds + OFF_K;
  float* ws = (float*)(lds + OFF_WS) + wid * 64; float* li_l = ws; float* al_l = ws + 32;
  float m_reg = -1e30f, l_reg = 0; f32x16 o[4] = {}; bf16x8 qr[4];
  const bf16_t* Qw = Qb + (long)(wid * QBLK + r32) * LDQ + hi * 8;
#pragma unroll
  for (int d0 = 0; d0 < 4; ++d0) qr[d0] = *reinterpret_cast<const bf16x8*>(Qw + d0 * 16);
  const int sr = tid >> 4, sc = (tid & 15) * 8, vst0 = v_st(sr, sc), vst1 = v_st(32 + sr, sc);
  const int kr = tid >> 3, kc = (tid & 7) * 8, kst = kr * KROW + kc * 2;
  const int vb0 = (int)(uintptr_t)V_lds + v_rd_base(lane);
  struct { bf16x8 vs0, vs1, ks0; } sr_[2];
#define SLOAD(i, k0) do { sr_[i].vs0 = *reinterpret_cast<const bf16x8*>(&Vh[(long)((k0) + sr) * LDQ + sc]); sr_[i].vs1 = *reinterpret_cast<const bf16x8*>(&Vh[(long)((k0) + 32 + sr) * LDQ + sc]); \
    sr_[i].ks0 = *reinterpret_cast<const bf16x8*>(&Kh[(long)((k0) + kr) * LDQ + kc]); } while (0)
#define SWRITE(b, i) do { *(bf16x8*)(V_lds + (b) * SHM_V + vst0) = sr_[i].vs0; *(bf16x8*)(V_lds + (b) * SHM_V + vst1) = sr_[i].vs1; \
    *(bf16x8*)(K_lds + (b) * SHM_K + kst) = sr_[i].ks0; } while (0)
#define SWAIT() asm volatile("s_waitcnt vmcnt(3)" ::: "memory")
#define RESC(a) do { if (__any((a) < 1.f)) { if (hi == 0) al_l[r32] = (a); asm volatile("s_waitcnt lgkmcnt(0)" ::: "memory"); \
    _Pragma("unroll") for (int d = 0; d < 4; ++d) _Pragma("unroll") for (int r = 0; r < 16; ++r) o[d][r] *= al_l[crow(r, hi)]; } } while (0)
  f32x16 pA0, pA1, pB0, pB1; float mnA, mnB, alA, alB; bf16x8 pa0, pa1, pa2, pa3; const int NT = seq / KVBLK;
  constexpr int SE = 0, SO = 1;
  SLOAD(SE, 0); asm volatile("s_waitcnt vmcnt(0)" ::: "memory"); SWRITE(0, SE); __syncthreads();
  qkt(pA0, pA1, K_lds, qr, r32, hi); partialSM(pA0, pA1, m_reg, mnA, alA);
  SLOAD(SO, KVBLK); if (2 < NT) SLOAD(SE, 2 * KVBLK);
  SWAIT(); SWRITE(1, SO); __syncthreads();
  for (int j = 1; j + 1 < NT; j += 2) {
    SBAR(); qkt(pB0, pB1, K_lds + SHM_K, qr, r32, hi);
    finishSM(pA0, pA1, alA, l_reg, pa0, pa1, pa2, pa3); SBAR();
    SLOAD(SO, (j + 2) * KVBLK); SBAR();
    pv_d0(o, vb0, pa0, pa1, pa2, pa3); partialSM(pB0, pB1, m_reg, mnB, alB);
    __syncthreads(); SWAIT(); SWRITE(0, SE);
    RESC(alB); __syncthreads();
    SBAR(); qkt(pA0, pA1, K_lds, qr, r32, hi);
    finishSM(pB0, pB1, alB, l_reg, pa0, pa1, pa2, pa3); SBAR();
    if (j + 3 < NT) SLOAD(SE, (j + 3) * KVBLK); SBAR();
    pv_d0(o, vb0 + SHM_V, pa0, pa1, pa2, pa3); partialSM(pA0, pA1, m_reg, mnA, alA);
    __syncthreads(); SWAIT(); SWRITE(1, SO);
    RESC(alA); __syncthreads();
  }
  SBAR(); qkt(pB0, pB1, K_lds + SHM_K, qr, r32, hi);
  finishSM(pA0, pA1, alA, l_reg, pa0, pa1, pa2, pa3); SBAR();
  pv_d0(o, vb0, pa0, pa1, pa2, pa3); partialSM(pB0, pB1, m_reg, mnB, alB);
  __syncthreads(); RESC(alB);
  finishSM(pB0, pB1, alB, l_reg, pa0, pa1, pa2, pa3); SBAR();
  pv_d0(o, vb0 + SHM_V, pa0, pa1, pa2, pa3);
  if (hi == 0) li_l[r32] = l_reg; asm volatile("s_waitcnt lgkmcnt(0)" ::: "memory");
  float rli[16];
#pragma unroll
  for (int r = 0; r < 16; ++r) rli[r] = __builtin_amdgcn_rcpf(li_l[crow(r, hi)]);
  { bf16_t* stg = (bf16_t*)(lds + OFF_OST) + wid * 4096;
#pragma unroll
    for (int r = 0; r < 16; ++r) { const int orow = crow(r, hi);
#pragma unroll
      for (int d0 = 0; d0 < 4; ++d0) stg[orow * 128 + d0 * 32 + r32] = (bf16_t)(cvt_pk_bf16(o[d0][r] * rli[r], 0.f) & 0xffffu); }
    asm volatile("s_waitcnt lgkmcnt(0)" ::: "memory");
    bf16_t* Ow = Ob + (long)(wid * QBLK) * ldo;
#pragma unroll
    for (int i = 0; i < 8; ++i) { const int row = i * 4 + (lane >> 4), ch = lane & 15; const u32x4 v = *(const u32x4*)(stg + row * 128 + ch * 8); *(u32x4*)(Ow + (long)row * ldo + ch * 8) = v; } }
  __syncthreads();
#undef SLOAD
#undef SWRITE
#undef SWAIT
#undef RESC
}
#undef SBAR
}


namespace att2 {
using bf16x8 = __attribute__((ext_vector_type(8))) short;
using s16x4  = __attribute__((ext_vector_type(4))) short;
using f32x16 = __attribute__((ext_vector_type(16))) float;
constexpr int NW = 8, QBLK = 32, KVBLK = 64, LDQ = 1024, LDK = 64, LDV = 128;
constexpr int KSL = 8192, VSL = 16384, K_OFF = 0, V_OFF = 3 * KSL, OFF_WS = V_OFF + 4 * VSL, ATT_LDS = OFF_WS + NW * 64 * 4;
constexpr float THRL = 8.f;
#define SBAR() __builtin_amdgcn_sched_barrier(0)
__device__ __forceinline__ int crow(int r, int hi) { return (r & 3) + 8 * (r >> 2) + 4 * hi; }
__device__ __forceinline__ int v_rd_base(int lane) { return ((lane & 3) << 3) | (((lane >> 2) & 3) << 6) | (((lane >> 4) & 1) << 5) | (((lane >> 5) & 1) << 8); }
constexpr int v_rd_off(int d0, int ks, int half) { return d0 * 512 + ks * 4096 + half * 2048; }
template <int OFF> __device__ __forceinline__ s16x4 tr_read(int vb) {
  s16x4 r; asm volatile("ds_read_b64_tr_b16 %0, %1 offset:%2" : "=&v"(r) : "v"(vb), "i"(OFF) : "memory"); return r;
}
template <int D0> __device__ __forceinline__ void pv_one(f32x16& od, int vb, bf16x8 pa0, bf16x8 pa1, bf16x8 pa2, bf16x8 pa3) {
  const s16x4 l0 = tr_read<v_rd_off(D0, 0, 0)>(vb), h0 = tr_read<v_rd_off(D0, 0, 1)>(vb), l1 = tr_read<v_rd_off(D0, 1, 0)>(vb), h1 = tr_read<v_rd_off(D0, 1, 1)>(vb);
  const s16x4 l2 = tr_read<v_rd_off(D0, 2, 0)>(vb), h2 = tr_read<v_rd_off(D0, 2, 1)>(vb), l3 = tr_read<v_rd_off(D0, 3, 0)>(vb), h3 = tr_read<v_rd_off(D0, 3, 1)>(vb);
  asm volatile("s_waitcnt lgkmcnt(0)" ::: "memory"); SBAR();
#define PK(L, H) (bf16x8){L[0], L[1], L[2], L[3], H[0], H[1], H[2], H[3]}
  od = __builtin_amdgcn_mfma_f32_32x32x16_bf16(pa0, PK(l0, h0), od, 0, 0, 0);
  od = __builtin_amdgcn_mfma_f32_32x32x16_bf16(pa1, PK(l1, h1), od, 0, 0, 0);
  od = __builtin_amdgcn_mfma_f32_32x32x16_bf16(pa2, PK(l2, h2), od, 0, 0, 0);
  od = __builtin_amdgcn_mfma_f32_32x32x16_bf16(pa3, PK(l3, h3), od, 0, 0, 0);
#undef PK
}
struct VFrag { s16x4 l0, h0, l1, h1, l2, h2, l3, h3; };
template <int D0> __device__ __forceinline__ void v_issue(VFrag& f, int vb) {
  f.l0 = tr_read<v_rd_off(D0, 0, 0)>(vb); f.h0 = tr_read<v_rd_off(D0, 0, 1)>(vb); f.l1 = tr_read<v_rd_off(D0, 1, 0)>(vb); f.h1 = tr_read<v_rd_off(D0, 1, 1)>(vb);
  f.l2 = tr_read<v_rd_off(D0, 2, 0)>(vb); f.h2 = tr_read<v_rd_off(D0, 2, 1)>(vb); f.l3 = tr_read<v_rd_off(D0, 3, 0)>(vb); f.h3 = tr_read<v_rd_off(D0, 3, 1)>(vb);
}
template <int WAITN> __device__ __forceinline__ void pv_mma(f32x16& od, const VFrag& f, bf16x8 pa0, bf16x8 pa1, bf16x8 pa2, bf16x8 pa3) {
  if (WAITN == 8) asm volatile("s_waitcnt lgkmcnt(8)" ::: "memory"); else asm volatile("s_waitcnt lgkmcnt(0)" ::: "memory");
  SBAR();
#define PK(L, H) (bf16x8){L[0], L[1], L[2], L[3], H[0], H[1], H[2], H[3]}
  od = __builtin_amdgcn_mfma_f32_32x32x16_bf16(pa0, PK(f.l0, f.h0), od, 0, 0, 0);
  od = __builtin_amdgcn_mfma_f32_32x32x16_bf16(pa1, PK(f.l1, f.h1), od, 0, 0, 0);
  od = __builtin_amdgcn_mfma_f32_32x32x16_bf16(pa2, PK(f.l2, f.h2), od, 0, 0, 0);
  od = __builtin_amdgcn_mfma_f32_32x32x16_bf16(pa3, PK(f.l3, f.h3), od, 0, 0, 0);
#undef PK
}
__device__ __forceinline__ void pv_pipe(f32x16* o, int vb, bf16x8 pa0, bf16x8 pa1, bf16x8 pa2, bf16x8 pa3) {
  VFrag f0, f1;
  v_issue<0>(f0, vb); SBAR();
  v_issue<1>(f1, vb); SBAR(); pv_mma<8>(o[0], f0, pa0, pa1, pa2, pa3); SBAR();
  v_issue<2>(f0, vb); SBAR(); pv_mma<8>(o[1], f1, pa0, pa1, pa2, pa3); SBAR();
  v_issue<3>(f1, vb); SBAR(); pv_mma<8>(o[2], f0, pa0, pa1, pa2, pa3); SBAR();
  pv_mma<0>(o[3], f1, pa0, pa1, pa2, pa3);
}
__device__ __forceinline__ void qkt(f32x16& p0, f32x16& p1, const LAS unsigned char* Ks, const bf16x8* qr, const f32x16& cinit, int r32, int hi) {
  const LAS unsigned char* kb0 = Ks + r32 * 128; const int sw = r32 & 7;
#pragma unroll
  for (int d0 = 0; d0 < 4; ++d0) { const int ch = ((2 * d0 + hi) ^ sw) << 4;
    const bf16x8 b0 = *(const LAS bf16x8*)(kb0 + ch), b1 = *(const LAS bf16x8*)(kb0 + 4096 + ch);
    if (d0 == 0) { p0 = __builtin_amdgcn_mfma_f32_32x32x16_bf16(b0, qr[0], cinit, 0, 0, 0); p1 = __builtin_amdgcn_mfma_f32_32x32x16_bf16(b1, qr[0], cinit, 0, 0, 0); }
    else { p0 = __builtin_amdgcn_mfma_f32_32x32x16_bf16(b0, qr[d0], p0, 0, 0, 0); p1 = __builtin_amdgcn_mfma_f32_32x32x16_bf16(b1, qr[d0], p1, 0, 0, 0); } }
}
__device__ __forceinline__ float rowmax(const f32x16& p0, const f32x16& p1) {
  float a = fmaxf(fmaxf(p0[0], p0[1]), p1[0]), b = fmaxf(fmaxf(p0[2], p0[3]), p1[1]); a = fmaxf(fmaxf(a, p1[2]), p1[3]);
#pragma unroll
  for (int r = 4; r < 16; r += 4) { a = fmaxf(fmaxf(a, p0[r]), p0[r + 1]); b = fmaxf(fmaxf(b, p0[r + 2]), p0[r + 3]); a = fmaxf(fmaxf(a, p1[r]), p1[r + 1]); b = fmaxf(fmaxf(b, p1[r + 2]), p1[r + 3]); }
  const float m = fmaxf(a, b);
  auto rr = __builtin_amdgcn_permlane32_swap(__float_as_uint(m), __float_as_uint(m), false, false);
  return fmaxf(__uint_as_float(rr[0]), __uint_as_float(rr[1]));
}
#define A2_PK4(P, BASE, OUT) do { u32x4 w_ = {cvt_pk_bf16(P[BASE + 0], P[BASE + 1]), cvt_pk_bf16(P[BASE + 2], P[BASE + 3]), cvt_pk_bf16(P[BASE + 4], P[BASE + 5]), cvt_pk_bf16(P[BASE + 6], P[BASE + 7])}; \
    OUT = *reinterpret_cast<bf16x8*>(&w_); } while (0)

__device__ __forceinline__ void attn_unit(const bf16_t* __restrict__ Qb, const bf16_t* __restrict__ Kh, const bf16_t* __restrict__ Vh, bf16_t* __restrict__ Ob, int ldo, int seq, LAS unsigned char* lds, const int tid) {
  const int wid = __builtin_amdgcn_readfirstlane(tid >> 6), lane = tid & 63, r32 = lane & 31, hi = lane >> 5;
  LAS float* ws = (LAS float*)(lds + OFF_WS) + wid * 64;
  const unsigned koff = (unsigned)(((8 * wid + (lane >> 3)) * LDK + (((lane & 7) ^ (lane >> 3)) * 8)) * 2);
  const unsigned voff = (unsigned)(((8 * wid + ((lane & 31) >> 2)) * LDV + 32 * (lane >> 5) + 8 * (lane & 3)) * 2);
#define A2_DMA(t, ks, vs) do { const char* kb_ = (const char*)Kh + (size_t)(t) * (KVBLK * LDK * 2); const char* vb_ = (const char*)Vh + (size_t)(t) * (KVBLK * LDV * 2); \
    __builtin_amdgcn_global_load_lds((const unsigned*)(kb_ + koff), (LAS unsigned*)(lds + K_OFF + (ks) + wid * 1024), 16, 0, 0); \
    __builtin_amdgcn_global_load_lds((const unsigned*)(vb_ + voff), (LAS unsigned*)(lds + V_OFF + (vs) + wid * 2048), 16, 0, 0); \
    __builtin_amdgcn_global_load_lds((const unsigned*)(vb_ + voff + 128), (LAS unsigned*)(lds + V_OFF + (vs) + wid * 2048 + 1024), 16, 0, 0); } while (0)
#define A2_WAITBAR() do { asm volatile("s_waitcnt vmcnt(0) lgkmcnt(0)" ::: "memory"); __builtin_amdgcn_s_barrier(); asm volatile("" ::: "memory"); } while (0)
  const int NT = seq / KVBLK;
  const bool trail = wid >= 4;
  A2_DMA(0, 0, 0); A2_DMA(1, KSL, VSL);
  bf16x8 qr[4];
  { const bf16_t* Qw = Qb + (long)(wid * QBLK + r32) * LDQ + hi * 8;
#pragma unroll
    for (int d0 = 0; d0 < 4; ++d0) qr[d0] = *reinterpret_cast<const bf16x8*>(Qw + d0 * 16); }
  float mhat = 0.f, l_reg = 0.f; f32x16 o[4] = {}; f32x16 negm = {};
  const int vbase = (int)(uintptr_t)(lds + V_OFF) + v_rd_base(lane);
  A2_WAITBAR();
  if (NT > 2) A2_DMA(2, 2 * KSL, 2 * VSL);
  f32x16 pA0, pA1, pB0, pB1; bf16x8 pa0, pa1, pa2, pa3;
  qkt(pA0, pA1, lds + K_OFF, qr, negm, r32, hi);
  { const float rm = rowmax(pA0, pA1); mhat = rm;
#pragma unroll
    for (int r = 0; r < 16; ++r) { pA0[r] -= rm; pA1[r] -= rm; negm[r] = -rm; }
#pragma unroll
    for (int r = 0; r < 16; ++r) { pA0[r] = __builtin_amdgcn_exp2f(pA0[r]); pA1[r] = __builtin_amdgcn_exp2f(pA1[r]); } }
  int k_cur = KSL, k_dma = 0;
  int v_prev = 0, v_dma = 3 * VSL;
#define A2_ROT() do { k_cur = (k_cur == 2 * KSL) ? 0 : k_cur + KSL; k_dma = (k_dma == 2 * KSL) ? 0 : k_dma + KSL; v_prev = (v_prev == 3 * VSL) ? 0 : v_prev + VSL; v_dma = (v_dma == 3 * VSL) ? 0 : v_dma + VSL; } while (0)
#define A2_SEAM(t) do { A2_WAITBAR(); if ((t) + 2 < NT) A2_DMA((t) + 2, k_dma, v_dma); } while (0)
#define A2_EXP(X, i) X[i] = __builtin_amdgcn_exp2f(X[i])
#define A2_SG(mask, n) __builtin_amdgcn_sched_group_barrier(mask, n, 0)
#define A2_STEP(C0, C1, P0, P1, t) do { bool resc_ = false; \
    SBAR(); \
      \
    qkt(C0, C1, lds + K_OFF + k_cur, qr, negm, r32, hi); \
    { float sa_ = 0.f, sb_ = 0.f; _Pragma("unroll") for (int r = 0; r < 16; ++r) { sa_ += P0[r]; sb_ += P1[r]; } l_reg += sa_ + sb_; } \
    A2_PK4(P0, 0, pa0); A2_PK4(P0, 8, pa1); A2_PK4(P1, 0, pa2); A2_PK4(P1, 8, pa3); \
    A2_SG(0x100, 2); A2_SG(0x100, 2); A2_SG(0x8, 1); A2_SG(0x402, 6); A2_SG(0x8, 1); A2_SG(0x402, 6); A2_SG(0x100, 2); A2_SG(0x8, 1); A2_SG(0x402, 6); A2_SG(0x8, 1); A2_SG(0x402, 6); \
    A2_SG(0x100, 2); A2_SG(0x8, 1); A2_SG(0x402, 6); A2_SG(0x8, 1); A2_SG(0x402, 6); A2_SG(0x8, 1); A2_SG(0x402, 6); A2_SG(0x8, 1); A2_SG(0x402, 6); \
    if (MK_ATT_XMFMA) { f32x16 dz_ = negm; _Pragma("unroll") for (int x_ = 0; x_ < 8; ++x_) asm volatile("v_mfma_f32_32x32x16_bf16 %0, %1, %2, %0" : "+v"(dz_) : "v"(qr[x_ & 3]), "v"(qr[(x_ + 1) & 3])); asm volatile("" :: "v"(dz_)); } \
    if (MK_ATT_XEXP) { float dx_ = mhat; _Pragma("unroll") for (int x_ = 0; x_ < 32; ++x_) asm volatile("v_exp_f32 %0, %0" : "+v"(dx_)); asm volatile("" :: "v"(dx_)); } \
    asm volatile("" : "+v"(l_reg), "+v"(pa0), "+v"(pa1), "+v"(pa2), "+v"(pa3)); SBAR(); \
    if (trail) A2_SEAM(t); \
    { const int vb_ = vbase + v_prev; VFrag f0_, f1_; \
        \
      v_issue<0>(f0_, vb_); v_issue<1>(f1_, vb_); SBAR(); \
      pv_mma<8>(o[0], f0_, pa0, pa1, pa2, pa3); \
      { const float rm_ = rowmax(C0, C1); \
        if (__builtin_expect(__any(rm_ > THRL), 0)) { const float dl_ = fmaxf(rm_, 0.f); mhat += dl_; \
          _Pragma("unroll") for (int r = 0; r < 16; ++r) { C0[r] -= dl_; C1[r] -= dl_; negm[r] = -mhat; } \
          const float f_ = __builtin_amdgcn_exp2f(-dl_); l_reg *= f_; if (hi == 0) ws[r32] = f_; resc_ = true; } } \
      SBAR(); \
        \
      v_issue<2>(f0_, vb_); SBAR(); pv_mma<8>(o[1], f1_, pa0, pa1, pa2, pa3); \
      A2_EXP(C0, 0); A2_EXP(C0, 1); A2_EXP(C0, 2); A2_EXP(C0, 3); A2_EXP(C0, 4); A2_EXP(C0, 5); A2_EXP(C0, 6); A2_EXP(C0, 7); A2_EXP(C0, 8); A2_EXP(C0, 9); A2_EXP(C0, 10); \
      A2_SG(0x8, 1); A2_SG(0x402, 3); A2_SG(0x8, 1); A2_SG(0x402, 3); A2_SG(0x8, 1); A2_SG(0x402, 3); A2_SG(0x8, 1); A2_SG(0x402, 3); \
      asm volatile("" : "+v"(C0)); SBAR(); \
      v_issue<3>(f1_, vb_); SBAR(); pv_mma<8>(o[2], f0_, pa0, pa1, pa2, pa3); \
      A2_EXP(C0, 11); A2_EXP(C0, 12); A2_EXP(C0, 13); A2_EXP(C0, 14); A2_EXP(C0, 15); A2_EXP(C1, 0); A2_EXP(C1, 1); A2_EXP(C1, 2); A2_EXP(C1, 3); A2_EXP(C1, 4); A2_EXP(C1, 5); \
      A2_SG(0x8, 1); A2_SG(0x402, 3); A2_SG(0x8, 1); A2_SG(0x402, 3); A2_SG(0x8, 1); A2_SG(0x402, 3); A2_SG(0x8, 1); A2_SG(0x402, 3); \
      asm volatile("" : "+v"(C0), "+v"(C1)); SBAR(); \
      pv_mma<0>(o[3], f1_, pa0, pa1, pa2, pa3); \
      A2_EXP(C1, 6); A2_EXP(C1, 7); A2_EXP(C1, 8); A2_EXP(C1, 9); A2_EXP(C1, 10); A2_EXP(C1, 11); A2_EXP(C1, 12); A2_EXP(C1, 13); A2_EXP(C1, 14); A2_EXP(C1, 15); \
      A2_SG(0x8, 1); A2_SG(0x402, 3); A2_SG(0x8, 1); A2_SG(0x402, 3); A2_SG(0x8, 1); A2_SG(0x402, 3); A2_SG(0x8, 1); A2_SG(0x402, 3); \
      asm volatile("" : "+v"(C1)); SBAR(); } \
    if (resc_) { asm volatile("s_waitcnt lgkmcnt(0)" ::: "memory"); \
      _Pragma("unroll") for (int d_ = 0; d_ < 4; ++d_) _Pragma("unroll") for (int r = 0; r < 16; ++r) o[d_][r] *= ws[crow(r, hi)]; } \
    if (!trail) A2_SEAM(t); \
    A2_ROT(); } while (0)
  int t = 1;
  for (; t + 1 < NT; t += 2) { A2_STEP(pB0, pB1, pA0, pA1, t); A2_STEP(pA0, pA1, pB0, pB1, t + 1); }
  A2_STEP(pB0, pB1, pA0, pA1, t);
  { float sa_ = 0.f, sb_ = 0.f;
#pragma unroll
    for (int r = 0; r < 16; ++r) { sa_ += pB0[r]; sb_ += pB1[r]; }
    l_reg += sa_ + sb_;
    A2_PK4(pB0, 0, pa0); A2_PK4(pB0, 8, pa1); A2_PK4(pB1, 0, pa2); A2_PK4(pB1, 8, pa3);
    SBAR(); const int vb_ = vbase + v_prev;
    pv_pipe(o, vb_, pa0, pa1, pa2, pa3); }
  { auto rr = __builtin_amdgcn_permlane32_swap(__float_as_uint(l_reg), __float_as_uint(l_reg), false, false); l_reg = __uint_as_float(rr[0]) + __uint_as_float(rr[1]); }
  if (hi == 0) ws[32 + r32] = l_reg;
  A2_WAITBAR();
  float rli[16];
#pragma unroll
  for (int r = 0; r < 16; ++r) rli[r] = __builtin_amdgcn_rcpf(ws[32 + crow(r, hi)]);
  { LAS bf16_t* stg = (LAS bf16_t*)lds + wid * 4096;
#pragma unroll
    for (int r = 0; r < 16; ++r) { const int orow = crow(r, hi);
#pragma unroll
      for (int d0 = 0; d0 < 4; ++d0) stg[orow * 128 + d0 * 32 + r32] = (bf16_t)(cvt_pk_bf16(o[d0][r] * rli[r], 0.f) & 0xffffu); }
    asm volatile("s_waitcnt lgkmcnt(0)" ::: "memory");
    bf16_t* Ow = Ob + (long)(wid * QBLK) * ldo;
#pragma unroll
    for (int i = 0; i < 8; ++i) { const int row = i * 4 + (lane >> 4), ch = lane & 15; const u32x4 v = *(const LAS u32x4*)(stg + row * 128 + ch * 8); *(u32x4*)(Ow + (long)row * ldo + ch * 8) = v; } }
  A2_WAITBAR();
#undef A2_DMA
#undef A2_WAITBAR
#undef A2_ROT
#undef A2_SEAM
#undef A2_STEP
#undef A2_EXP
#undef A2_SG
}
#undef A2_PK4
#undef SBAR
}


namespace att3 {
using f32x16 = __attribute__((ext_vector_type(16))) float;
typedef int v8i __attribute__((ext_vector_type(8)));
typedef int v4i __attribute__((ext_vector_type(4)));
constexpr int NW = 8, QBLK = 32, KVBLK = 64;
constexpr int KSL = 8192, VSL = 16384, K_OFF = 0, V_OFF = 3 * KSL, OFF_WS = V_OFF + 3 * VSL, OFF_Q = OFF_WS + NW * 64 * 4, OFF_ONES = OFF_Q + NW * 2048, ATT_LDS = OFF_ONES + 64;
constexpr float THRL = 8.f;
constexpr int SC_ONE = 0x7f7f7f7f, SC_Q = 0x7b7b7b7b;
#define SBAR() __builtin_amdgcn_sched_barrier(0)
__device__ __forceinline__ int crow(int r, int hi) { return (r & 3) + 8 * (r >> 2) + 4 * hi; }
__host__ __device__ __forceinline__ int slot_key(int s) { const int hi = s >> 5, j = s & 31, jj = j & 15; return (j >> 4) * 32 + (jj & 3) + 8 * (jj >> 2) + 4 * hi; }
__device__ __forceinline__ v8i ld32(const LAS unsigned char* rowp, int c0, int sw) {
    const v4i a = *(const LAS v4i*)(rowp + ((c0 ^ sw) << 4)), b = *(const LAS v4i*)(rowp + (((c0 + 1) ^ sw) << 4));
    return (v8i){a[0], a[1], a[2], a[3], b[0], b[1], b[2], b[3]};
}
__device__ __forceinline__ void qkt(f32x16& p0, f32x16& p1, const LAS unsigned char* Ks, const v8i& qf, const f32x16& cinit, int r32, int hi) {
    const int sw = (r32 >> 2) & 3;
    const v8i k0 = ld32(Ks + r32 * 64, 2 * hi, sw), k1 = ld32(Ks + (32 + r32) * 64, 2 * hi, sw);
    p0 = __builtin_amdgcn_mfma_scale_f32_32x32x64_f8f6f4(k0, qf, cinit, 0, 0, 0, SC_ONE, 0, SC_Q);
    p1 = __builtin_amdgcn_mfma_scale_f32_32x32x64_f8f6f4(k1, qf, cinit, 0, 0, 0, SC_ONE, 0, SC_Q);
}
__device__ __forceinline__ float lanemax(const f32x16& p0, const f32x16& p1) {
  float a = fmaxf(fmaxf(p0[0], p0[1]), p1[0]), b = fmaxf(fmaxf(p0[2], p0[3]), p1[1]); a = fmaxf(fmaxf(a, p1[2]), p1[3]);
#pragma unroll
  for (int r = 4; r < 16; r += 4) { a = fmaxf(fmaxf(a, p0[r]), p0[r + 1]); b = fmaxf(fmaxf(b, p0[r + 2]), p0[r + 3]); a = fmaxf(fmaxf(a, p1[r]), p1[r + 1]); b = fmaxf(fmaxf(b, p1[r + 2]), p1[r + 3]); }
  return fmaxf(a, b);
}
__device__ __forceinline__ float rowmax4(const f32x16& p0, const f32x16& p1, const f32x16& p2, const f32x16& p3) {
  const float m = fmaxf(lanemax(p0, p1), lanemax(p2, p3));
  auto rr = __builtin_amdgcn_permlane32_swap(__float_as_uint(m), __float_as_uint(m), false, false);
  return fmaxf(__uint_as_float(rr[0]), __uint_as_float(rr[1]));
}
__device__ __forceinline__ v8i pack_p(const f32x16& p0, const f32x16& p1) {
    v8i w;
    w[0] = (int)cvt4_fp8_nc(p0[0], p0[1], p0[2], p0[3]); w[1] = (int)cvt4_fp8_nc(p0[4], p0[5], p0[6], p0[7]); w[2] = (int)cvt4_fp8_nc(p0[8], p0[9], p0[10], p0[11]); w[3] = (int)cvt4_fp8_nc(p0[12], p0[13], p0[14], p0[15]);
    w[4] = (int)cvt4_fp8_nc(p1[0], p1[1], p1[2], p1[3]); w[5] = (int)cvt4_fp8_nc(p1[4], p1[5], p1[6], p1[7]); w[6] = (int)cvt4_fp8_nc(p1[8], p1[9], p1[10], p1[11]); w[7] = (int)cvt4_fp8_nc(p1[12], p1[13], p1[14], p1[15]);
    return w;
}
__device__ __forceinline__ void qk1(f32x16& d, const v8i& kop, const v8i& qf, const f32x16& c) {
    asm volatile("s_nop 1\n\tv_mfma_scale_f32_32x32x64_f8f6f4 %0, %1, %2, %3, %4, %5 op_sel_hi:[0,0,0]" : "=&v"(d) : "v"(kop), "v"(qf), "v"(c), "v"(SC_ONE), "v"(SC_Q));
}
__device__ __forceinline__ void pv1(f32x16& od, const v8i& pf, const v8i& vf) {
    asm volatile("s_nop 1\n\tv_mfma_scale_f32_32x32x64_f8f6f4 %0, %1, %2, %0, %3, %3 op_sel_hi:[0,0,0]" : "+v"(od) : "v"(pf), "v"(vf), "v"(SC_ONE));
}

__device__ __forceinline__ void attn_unit(const unsigned char* __restrict__ Q8b, const unsigned char* __restrict__ K8h0, size_t kmap_stride, const unsigned char* __restrict__ VT8h, bf16_t* __restrict__ AOb, int ldo, int seq,
                                          float lam, float osc, const float* __restrict__ subln, u32x4* __restrict__ o0g, LAS unsigned char* lds, const int tid) {
  const int wid = __builtin_amdgcn_readfirstlane(tid >> 6), lane = tid & 63, r32 = lane & 31, hi = lane >> 5;
  LAS float* ws = (LAS float*)(lds + OFF_WS) + wid * 64;
  const int prow = 16 * wid + (lane >> 2); const unsigned poff = (unsigned)(prow * 64 + (((lane & 3) ^ ((prow >> 2) & 3)) << 4));
#define A3_MFMA_FENCE() asm volatile("s_nop 15\n\ts_nop 15" : "+v"(o[0]), "+v"(o[1]), "+v"(o[2]), "+v"(o[3]), "+v"(osum))
#define A3_WAITBAR() do { asm volatile("s_waitcnt vmcnt(0) lgkmcnt(0)" ::: "memory"); __builtin_amdgcn_s_barrier(); asm volatile("" ::: "memory"); } while (0)
  const int NT2 = seq / 128;
  const int half = wid >> 2;
#define A3_DMAK(t) __builtin_amdgcn_global_load_lds((const unsigned*)(K8h + (size_t)(t) * 8192 + poff), (LAS unsigned*)(lds + K_OFF + ((t) % 3) * KSL + wid * 1024), 16, 0, 0)
#define A3_DMAV(t) do { __builtin_amdgcn_global_load_lds((const unsigned*)(VT8h + (size_t)(t) * 16384 + poff), (LAS unsigned*)(lds + V_OFF + ((t) % 3) * VSL + wid * 1024), 16, 0, 0); \
    __builtin_amdgcn_global_load_lds((const unsigned*)(VT8h + (size_t)(t) * 16384 + 8192 + poff), (LAS unsigned*)(lds + V_OFF + ((t) % 3) * VSL + 8192 + wid * 1024), 16, 0, 0); } while (0)
  f32x16 o[4]; f32x16 osum;
  for (int mp = 0; mp < 2; ++mp) {
  const unsigned char* K8h = K8h0 + (size_t)mp * kmap_stride;
  A3_DMAK(0); A3_DMAK(1); A3_DMAV(0);
  LAS v4i* qs = (LAS v4i*)(lds + OFF_Q + wid * 2048) + lane;
  { int lq_; asm volatile("v_mbcnt_lo_u32_b32 %0, -1, 0\n\tv_mbcnt_hi_u32_b32 %0, -1, %0" : "=v"(lq_));
    const unsigned char* Qw = Q8b + mp * 64 + (size_t)(wid * QBLK + (lq_ & 31)) * 1024 + (lq_ >> 5) * 32; const v4i a = *(const v4i*)Qw, b = *(const v4i*)(Qw + 16); qs[0] = a; qs[64] = b; }
#define A3_LDQ(buf) do { const v4i qa_ = qs[0], qb_ = qs[64]; buf = (v8i){qa_[0], qa_[1], qa_[2], qa_[3], qb_[0], qb_[1], qb_[2], qb_[3]}; } while (0)
  f32x16 negm = {};
#pragma unroll
  for (int r = 0; r < 16; ++r) { o[0][r] = 0.f; o[1][r] = 0.f; o[2][r] = 0.f; o[3][r] = 0.f; osum[r] = 0.f; }
  if (wid == 0 && lane < 8) *(LAS unsigned*)(lds + OFF_ONES + 4 * lane) = 0x38383838u;
#define A3_LD1(buf) do { const v4i oa_ = *(const LAS v4i*)(lds + OFF_ONES), ob_ = *(const LAS v4i*)(lds + OFF_ONES + 16); buf = (v8i){oa_[0], oa_[1], oa_[2], oa_[3], ob_[0], ob_[1], ob_[2], ob_[3]}; } while (0)
  const int swv = (r32 >> 2) & 3;
  A3_WAITBAR();
  if (NT2 > 2) A3_DMAK(2);
  A3_DMAV(1);
  f32x16 C0 = negm, C1 = negm, C2 = negm, C3 = negm; v8i pf0 = {}, pf1 = {};
#define A3_BAR_ODD() do { asm volatile("s_waitcnt lgkmcnt(0)" ::: "memory"); __builtin_amdgcn_s_barrier(); asm volatile("" ::: "memory"); } while (0)
#define A3_BAR_EVEN(m) do { if ((m) + 1 < NT2) asm volatile("s_waitcnt vmcnt(3) lgkmcnt(0)" ::: "memory"); else asm volatile("s_waitcnt vmcnt(0) lgkmcnt(0)" ::: "memory"); \
    __builtin_amdgcn_s_barrier(); asm volatile("" ::: "memory"); if ((m) + 2 < NT2) A3_DMAK((m) + 2); if ((m) + 1 < NT2) A3_DMAV((m) + 1); } while (0)
#define A3_LD(buf, p) buf = ld32((p), 2 * hi, swv)
#define A3_W(n) asm volatile("s_waitcnt lgkmcnt(" #n ")" ::: "memory"); SBAR()
#define A3_A_FIRST() do { const LAS unsigned char* Ks_ = lds + K_OFF + r32 * 64; v8i b0_, b1_, b2_; A3_LDQ(b2_); A3_LD(b0_, Ks_); A3_LD(b1_, Ks_ + 2048); \
    A3_W(0); qk1(C0, b0_, b2_, negm); qk1(C1, b1_, b2_, negm); SBAR(); A3_LD(b0_, Ks_ + 4096); A3_LD(b1_, Ks_ + 6144); A3_W(0); qk1(C2, b0_, b2_, negm); qk1(C3, b1_, b2_, negm); SBAR(); } while (0)
#define A3_A_MID(k) do { \
    const LAS unsigned char* Ks_ = lds + K_OFF + (((k) + 1) % 3) * KSL + r32 * 64; \
    const LAS unsigned char* vt_ = lds + V_OFF + ((k) % 3) * VSL + r32 * 64; \
    __builtin_amdgcn_s_setprio(1);                                   \
    v8i b0_, b1_, b2_, b3_; A3_LDQ(b3_); A3_LD(b0_, Ks_); A3_LD(b1_, Ks_ + 2048); A3_LD(b2_, Ks_ + 4096); \
    A3_W(4); qk1(C0, b0_, b3_, negm); SBAR(); A3_LD(b0_, Ks_ + 6144); \
    A3_W(4); qk1(C1, b1_, b3_, negm); SBAR(); A3_LD(b1_, vt_); \
    A3_W(4); qk1(C2, b2_, b3_, negm); SBAR(); A3_LD(b2_, vt_ + 2048); \
    A3_W(4); qk1(C3, b0_, b3_, negm); SBAR(); A3_LD1(b3_); A3_LD(b0_, vt_ + 4096); \
    A3_W(6); pv1(o[0], pf0, b1_); SBAR(); A3_LD(b1_, vt_ + 6144); \
    A3_W(6); pv1(o[1], pf0, b2_); SBAR(); A3_LD(b2_, vt_ + 8192); \
    A3_W(6); pv1(osum, pf0, b3_); SBAR(); A3_LD(b3_, vt_ + 8192 + 2048); \
    A3_W(6); pv1(o[2], pf0, b0_); SBAR(); A3_LD1(b0_); \
    A3_W(6); pv1(o[3], pf0, b1_); SBAR(); A3_LD(b1_, vt_ + 8192 + 4096); \
    A3_W(6); pv1(o[0], pf1, b2_); SBAR(); A3_LD(b2_, vt_ + 8192 + 6144); \
    A3_W(6); pv1(o[1], pf1, b3_); \
    A3_W(4); pv1(osum, pf1, b0_); \
    A3_W(2); pv1(o[2], pf1, b1_); \
    A3_W(0); pv1(o[3], pf1, b2_); \
    __builtin_amdgcn_s_setprio(0); \
    SBAR(); } while (0)
#define A3_A_LAST(k) do { \
    const LAS unsigned char* vt_ = lds + V_OFF + ((k) % 3) * VSL + r32 * 64; \
    v8i b0_, b1_, b2_; \
    _Pragma("unroll") for (int sb_ = 0; sb_ < 2; ++sb_) { const v8i& pfs_ = sb_ ? pf1 : pf0; \
      A3_LD(b0_, vt_ + sb_ * 8192); A3_LD(b1_, vt_ + sb_ * 8192 + 2048); A3_LD1(b2_); \
      asm volatile("s_waitcnt lgkmcnt(0)\n\ts_nop 1" ::: "memory"); SBAR(); \
      pv1(o[0], pfs_, b0_); pv1(o[1], pfs_, b1_); pv1(osum, pfs_, b2_); SBAR(); \
      A3_LD(b0_, vt_ + sb_ * 8192 + 4096); A3_LD(b1_, vt_ + sb_ * 8192 + 6144); \
      asm volatile("s_waitcnt lgkmcnt(0)\n\ts_nop 1" ::: "memory"); SBAR(); \
      pv1(o[2], pfs_, b0_); pv1(o[3], pfs_, b1_); SBAR(); } \
    } while (0)
#define A3_B(FIRST) do { \
    asm volatile("s_nop 7" : "+v"(C0), "+v"(C1), "+v"(C2), "+v"(C3));     \
    const float rm_ = rowmax4(C0, C1, C2, C3); \
    if (FIRST) {                                                    \
      _Pragma("unroll") for (int r = 0; r < 16; ++r) { C0[r] -= rm_; C1[r] -= rm_; C2[r] -= rm_; C3[r] -= rm_; negm[r] = -rm_; } } \
    else if (__builtin_expect(__any(rm_ > THRL), 0)) {              \
      const float dl_ = fmaxf(rm_, 0.f); const float nm_ = negm[0] - dl_; \
      _Pragma("unroll") for (int r = 0; r < 16; ++r) { C0[r] -= dl_; C1[r] -= dl_; C2[r] -= dl_; C3[r] -= dl_; negm[r] = nm_; } \
      int lr_; asm volatile("v_mbcnt_lo_u32_b32 %0, -1, 0\n\tv_mbcnt_hi_u32_b32 %0, -1, %0" : "=v"(lr_));     \
      const int r32r_ = lr_ & 31, hir_ = lr_ >> 5; \
      const float f_ = __builtin_amdgcn_exp2f(-dl_); if (hir_ == 0) ws[r32r_] = f_; \
      asm volatile("s_waitcnt lgkmcnt(0)" ::: "memory"); A3_MFMA_FENCE(); \
      _Pragma("unroll") for (int r = 0; r < 16; ++r) { const float fr_ = ws[crow(r, hir_)]; osum[r] *= fr_; _Pragma("unroll") for (int d_ = 0; d_ < 4; ++d_) o[d_][r] *= fr_; } } \
    _Pragma("unroll") for (int r = 0; r < 16; ++r) { C0[r] = __builtin_amdgcn_exp2f(C0[r]); C1[r] = __builtin_amdgcn_exp2f(C1[r]); } \
    pf0 = pack_p(C0, C1); \
    _Pragma("unroll") for (int r = 0; r < 16; ++r) { C2[r] = __builtin_amdgcn_exp2f(C2[r]); C3[r] = __builtin_amdgcn_exp2f(C3[r]); } \
    pf1 = pack_p(C2, C3); \
    asm volatile("" : "+v"(pf0), "+v"(pf1)); SBAR(); } while (0)
  if (half == 0) {
    A3_A_FIRST();
    A3_BAR_ODD(); A3_B(true);
    int k = 0;
    for (; k + 1 < NT2; ++k) { A3_BAR_EVEN(k + 1); A3_A_MID(k); A3_BAR_ODD(); A3_B(false); }
    A3_BAR_EVEN(k + 1); A3_A_LAST(k);
    A3_BAR_ODD();
  } else {
    A3_BAR_ODD(); A3_A_FIRST();
    A3_BAR_EVEN(1); A3_B(true);
    int k = 0;
    for (; k + 1 < NT2; ++k) { A3_BAR_ODD(); A3_A_MID(k); A3_BAR_EVEN(k + 2); A3_B(false); }
    A3_BAR_ODD(); A3_A_LAST(k);
  }
  A3_MFMA_FENCE();
  A3_WAITBAR();
  if (mp == 0) {
    int lo_; asm volatile("v_mbcnt_lo_u32_b32 %0, -1, 0\n\tv_mbcnt_hi_u32_b32 %0, -1, %0" : "=v"(lo_));
    u32x4* o0s = o0g + wid * 512 + lo_;
#pragma unroll
    for (int d0 = 0; d0 < 4; ++d0) {
#pragma unroll
      for (int r = 0; r < 16; r += 8) { u32x4 w;
        w.x = cvt_pk_bf16(o[d0][r] * __builtin_amdgcn_rcpf(osum[r]), o[d0][r + 1] * __builtin_amdgcn_rcpf(osum[r + 1]));
        w.y = cvt_pk_bf16(o[d0][r + 2] * __builtin_amdgcn_rcpf(osum[r + 2]), o[d0][r + 3] * __builtin_amdgcn_rcpf(osum[r + 3]));
        w.z = cvt_pk_bf16(o[d0][r + 4] * __builtin_amdgcn_rcpf(osum[r + 4]), o[d0][r + 5] * __builtin_amdgcn_rcpf(osum[r + 5]));
        w.w = cvt_pk_bf16(o[d0][r + 6] * __builtin_amdgcn_rcpf(osum[r + 6]), o[d0][r + 7] * __builtin_amdgcn_rcpf(osum[r + 7]));
        o0s[(d0 * 2 + (r >> 3)) * 64] = w; } }
  }
  }
  { LAS bf16_t* stg = (LAS bf16_t*)lds + wid * 4096;
    u32x4 o0w[8];
    { int lo_; asm volatile("v_mbcnt_lo_u32_b32 %0, -1, 0\n\tv_mbcnt_hi_u32_b32 %0, -1, %0" : "=v"(lo_));
      const u32x4* o0s = o0g + wid * 512 + lo_;
#pragma unroll
      for (int j = 0; j < 8; ++j) o0w[j] = o0s[j * 64]; }
#pragma unroll
    for (int r = 0; r < 16; r += 2) { const float i0 = __builtin_amdgcn_rcpf(osum[r]), i1 = __builtin_amdgcn_rcpf(osum[r + 1]); const int or0 = crow(r, hi), or1 = crow(r + 1, hi);
#pragma unroll
      for (int d0 = 0; d0 < 4; ++d0) { const unsigned pk = o0w[d0 * 2 + (r >> 3)][(r >> 1) & 3];
        const float v0 = bf_lo(pk) - lam * (o[d0][r] * i0), v1 = bf_hi(pk) - lam * (o[d0][r + 1] * i1);
        stg[or0 * 128 + d0 * 32 + r32] = (bf16_t)(cvt_pk_bf16(v0, 0.f) & 0xffffu); stg[or1 * 128 + d0 * 32 + r32] = (bf16_t)(cvt_pk_bf16(v1, 0.f) & 0xffffu); } }
    asm volatile("s_waitcnt lgkmcnt(0)" ::: "memory");
    bf16_t* Ow = AOb + (long)(wid * QBLK) * ldo;
    int lane_e; asm volatile("v_mbcnt_lo_u32_b32 %0, -1, 0\n\tv_mbcnt_hi_u32_b32 %0, -1, %0" : "=v"(lane_e));
    const int ch = lane_e & 15; const f32x4 g0 = *(const f32x4*)(subln + ch * 8), g1 = *(const f32x4*)(subln + ch * 8 + 4);
#pragma unroll
    for (int i = 0; i < 8; ++i) { const int row = i * 4 + (lane_e >> 4); const u32x4 v = *(const LAS u32x4*)(stg + row * 128 + ch * 8);
      float e[8] = {bf_lo(v.x), bf_hi(v.x), bf_lo(v.y), bf_hi(v.y), bf_lo(v.z), bf_hi(v.z), bf_lo(v.w), bf_hi(v.w)};
      float ss = 0.f;
#pragma unroll
      for (int q = 0; q < 8; ++q) ss += e[q] * e[q];
      ss = row16_sum(ss);
      const float rn = osc / sqrtf(ss * (1.0f / 128.0f) + EPS);
      u32x4 w; w.x = cvt_pk_bf16(e[0] * rn * g0[0], e[1] * rn * g0[1]); w.y = cvt_pk_bf16(e[2] * rn * g0[2], e[3] * rn * g0[3]);
      w.z = cvt_pk_bf16(e[4] * rn * g1[0], e[5] * rn * g1[1]); w.w = cvt_pk_bf16(e[6] * rn * g1[2], e[7] * rn * g1[3]);
      *(u32x4*)(Ow + (long)row * ldo + ch * 8) = w; } }
  A3_WAITBAR();
#undef A3_WAITBAR
#undef A3_DMAK
#undef A3_DMAV
#undef A3_BAR_ODD
#undef A3_BAR_EVEN
#undef A3_A_FIRST
#undef A3_LD
#undef A3_LDQ
#undef A3_LD1
#undef A3_W
#undef A3_A_MID
#undef A3_A_LAST
#undef A3_B
#undef A3_MFMA_FENCE
}
#undef SBAR
}

constexpr int RING_BYTES = 131072, MISC_OFF = RING_BYTES + 320, INTAB_OFF = RING_BYTES + 1024, LDS_BYTES = 147456;
struct Args { const float* in[50]; float* out; unsigned char* ws; int ph_lo, ph_hi; };

struct Ctx {
    LAS unsigned char* lds;
    int tid, lane, wave, G, bid;
    unsigned char* ws; float* out;
    __device__ __forceinline__ const float* inp(int idx) const {
        const LAS unsigned* t = (const LAS unsigned*)(lds + INTAB_OFF) + 2 * idx;
        const unsigned lo_ = __builtin_amdgcn_readfirstlane(t[0]), hi_ = __builtin_amdgcn_readfirstlane(t[1]);
        typedef __attribute__((address_space(1))) const float* gp_t; return (const float*)(gp_t)(((uintptr_t)hi_ << 32) | (uintptr_t)lo_); }
};

template <class T> __device__ __forceinline__ T* launder_ptr(T* p) { unsigned lo = (unsigned)(uintptr_t)p, hi = (unsigned)((uintptr_t)p >> 32); lo = __builtin_amdgcn_readfirstlane(lo); hi = __builtin_amdgcn_readfirstlane(hi);
    asm volatile("" : "+s"(lo), "+s"(hi)); typedef __attribute__((address_space(1))) T* gp_t; return (T*)(gp_t)(((uintptr_t)hi << 32) | (uintptr_t)lo); }
__device__ __forceinline__ int launder_i(int v) { v = __builtin_amdgcn_readfirstlane(v); asm volatile("" : "+s"(v)); return v; }
__device__ __forceinline__ int map_col(int kind, int n) {
    if (kind == 1) { if (n < 1024) return n; const int w = n - 1024, T = w >> 8, r = w & 255; return 1024 + (r >> 7) * 1024 + T * 128 + (r & 127); }
    if (kind == 2) { const int T = n >> 8, r = n & 255; return (r >> 7) * DFF + T * 128 + (r & 127); }
    if (kind == 3) { const int T = n >> 8, r = n & 255; return (r >> 7) * 1024 + T * 128 + (r & 127); }
    if (kind == 4) { if (n >= 2048) return n; const int blk = n >> 6, w = n & 63, half = w >> 5, ww = w & 31; return blk * 64 + half * 32 + (ww & 1) * 16 + (ww >> 1); }
    return n;
}
__device__ __forceinline__ void transpose_item8(const float* W, int K, int N, unsigned char* WT, int kind, int item, int lane) {
    const int nblk = N / 128, kb = item / nblk, nb = item % nblk, k0 = 128 * kb, n0 = 128 * nb;
    const int d0 = n0 + 2 * lane, s0 = map_col(kind, d0), s1 = map_col(kind, d0 + 1);
    const bool adj = (kind != 4) || (n0 >= 2048);
#pragma unroll
    for (int h = 0; h < 4; ++h) {
        float v0[32], v1[32];
        const float* wp = W + (size_t)(k0 + 32 * h) * N;
        if (adj) {
#pragma unroll
            for (int kk = 0; kk < 32; ++kk) { const f32x2 t = *(const f32x2*)(wp + (size_t)kk * N + s0); v0[kk] = t[0] * pg8::W8SCALE; v1[kk] = t[1] * pg8::W8SCALE; }
        } else {
#pragma unroll
            for (int kk = 0; kk < 32; ++kk) { v0[kk] = wp[(size_t)kk * N + s0] * pg8::W8SCALE; v1[kk] = wp[(size_t)kk * N + s1] * pg8::W8SCALE; }
        }
        unsigned char* o0 = WT + (size_t)d0 * K + k0 + 32 * h; unsigned char* o1 = o0 + K;
#pragma unroll
        for (int j = 0; j < 2; ++j) {
            u32x4 a, b;
            a.x = cvt4_fp8(v0[16 * j + 0], v0[16 * j + 1], v0[16 * j + 2], v0[16 * j + 3]); a.y = cvt4_fp8(v0[16 * j + 4], v0[16 * j + 5], v0[16 * j + 6], v0[16 * j + 7]);
            a.z = cvt4_fp8(v0[16 * j + 8], v0[16 * j + 9], v0[16 * j + 10], v0[16 * j + 11]); a.w = cvt4_fp8(v0[16 * j + 12], v0[16 * j + 13], v0[16 * j + 14], v0[16 * j + 15]);
            b.x = cvt4_fp8(v1[16 * j + 0], v1[16 * j + 1], v1[16 * j + 2], v1[16 * j + 3]); b.y = cvt4_fp8(v1[16 * j + 4], v1[16 * j + 5], v1[16 * j + 6], v1[16 * j + 7]);
            b.z = cvt4_fp8(v1[16 * j + 8], v1[16 * j + 9], v1[16 * j + 10], v1[16 * j + 11]); b.w = cvt4_fp8(v1[16 * j + 12], v1[16 * j + 13], v1[16 * j + 14], v1[16 * j + 15]);
            *(u32x4*)(o0 + 16 * j) = a; *(u32x4*)(o1 + 16 * j) = b; }
    }
}
__device__ __forceinline__ void transpose_item(const float* W, int K, int N, bf16_t* WT, int kind, int item, int lane) {
    const int nblk = N / 128, kb = item / nblk, nb = item % nblk, k0 = 64 * kb, n0 = 128 * nb;
    const int d0 = n0 + 2 * lane, s0 = map_col(kind, d0), s1 = map_col(kind, d0 + 1);
    const bool adj = (kind != 4) || (n0 >= 2048);
#pragma unroll
    for (int h = 0; h < 2; ++h) {
        float v0[32], v1[32];
        const float* wp = W + (size_t)(k0 + 32 * h) * N;
        if (adj) {
#pragma unroll
            for (int kk = 0; kk < 32; ++kk) { const f32x2 t = *(const f32x2*)(wp + (size_t)kk * N + s0); v0[kk] = t[0]; v1[kk] = t[1]; }
        } else {
#pragma unroll
            for (int kk = 0; kk < 32; ++kk) { v0[kk] = wp[(size_t)kk * N + s0]; v1[kk] = wp[(size_t)kk * N + s1]; }
        }
        bf16_t* o0 = WT + (size_t)d0 * K + k0 + 32 * h; bf16_t* o1 = o0 + K;
#pragma unroll
        for (int j = 0; j < 4; ++j) {
            u32x4 a, b;
            a.x = cvt_pk_bf16(v0[8 * j + 0], v0[8 * j + 1]); a.y = cvt_pk_bf16(v0[8 * j + 2], v0[8 * j + 3]); a.z = cvt_pk_bf16(v0[8 * j + 4], v0[8 * j + 5]); a.w = cvt_pk_bf16(v0[8 * j + 6], v0[8 * j + 7]);
            b.x = cvt_pk_bf16(v1[8 * j + 0], v1[8 * j + 1]); b.y = cvt_pk_bf16(v1[8 * j + 2], v1[8 * j + 3]); b.z = cvt_pk_bf16(v1[8 * j + 4], v1[8 * j + 5]); b.w = cvt_pk_bf16(v1[8 * j + 6], v1[8 * j + 7]);
            *(u32x4*)(o0 + 8 * j) = a; *(u32x4*)(o1 + 8 * j) = b; }
    }
}
struct WDesc { int in_idx, K, N, nb, kind, f8; unsigned long long off; };
__constant__ WDesc g_wd[15] = {
    {8, 1024, 3072, 1, 1, 0, WO_L0_CONVIN}, {10, 1024, 1024, 1, 0, 0, WO_L0_CONVOUT}, {11, 1024, 5632, 1, 2, (MK_FP8_FFN >> 0) & 1, WO_L0_GU}, {12, 2816, 1024, 1, 0, (MK_FP8_FFN >> 0) & 1, WO_L0_DOWN},
    {17, 1024, 3072, 1, 4, MK_FP8_QKV, WO_L1_QKV}, {20, 1024, 1024, 1, 0, 0, WO_L1_WO}, {22, 1024, 5632, 8, 2, 1, WO_L1_MGU}, {23, 2816, 1024, 8, 0, 1, WO_L1_MDOWN},
    {36, 1024, 2048, 1, 3, MK_FP8_GLU, WO_L2_GLU}, {37, 1024, 5632, 1, 2, (MK_FP8_FFN >> 2) & 1, WO_L2_GU}, {38, 2816, 1024, 1, 0, (MK_FP8_FFN >> 2) & 1, WO_L2_DOWN},
    {43, 1024, 3072, 1, 1, 0, WO_L3_CONVIN}, {45, 1024, 1024, 1, 0, 0, WO_L3_CONVOUT}, {47, 1024, 5632, 8, 2, 1, WO_L3_MGU}, {48, 2816, 1024, 8, 0, 1, WO_L3_MDOWN}};

__device__ __forceinline__ void p0_weights(Ctx& F) {
    unsigned* ctr = (unsigned*)(F.ws + WS_CTL) + 64;
    for (;;) {
        unsigned it = 0;
        if (F.lane == 0) it = __hip_atomic_fetch_add(ctr, 1u, __ATOMIC_RELAXED, __HIP_MEMORY_SCOPE_AGENT);
        it = (unsigned)__builtin_amdgcn_readfirstlane((int)it);
        int base = 0, d = 0; bool found = false;
        for (; d < 15; ++d) { const int tot = (g_wd[d].K / (g_wd[d].f8 ? 128 : 64)) * (g_wd[d].N / 128) * g_wd[d].nb; if ((int)it < base + tot) { found = true; break; } base += tot; }
        if (!found) break;
        const int K = g_wd[d].K, N = g_wd[d].N, kind = g_wd[d].kind; const int per = (K / (g_wd[d].f8 ? 128 : 64)) * (N / 128);
        const float* W = F.inp(g_wd[d].in_idx); bf16_t* WT = (bf16_t*)(F.ws + WS_W + g_wd[d].off);
        const int li = (int)it - base, e = li / per, r = li - e * per;
        if (g_wd[d].f8) transpose_item8(W + (size_t)e * K * N, K, N, (unsigned char*)WT + (size_t)e * K * N, kind, r, F.lane);
        else transpose_item(W + (size_t)e * K * N, K, N, WT + (size_t)e * K * N, kind, r, F.lane);
    }
}
__device__ __forceinline__ void p0_adaln(Ctx& F, const int item0) {
    LAS float* scond = (LAS float*)(F.lds);
    LAS float* red = (LAS float*)(F.lds + 20480);
    bool have = false;
    for (int item = item0; item < 96; item += 1 << 20) {
        if (!have) {
            for (int i = F.tid; i < 5 * 1024; i += NTHREADS) { const int cnd = i >> 10, k = i & 1023; const float v = cnd < 4 ? F.inp(IN_C)[cnd * 1024 + k] : F.inp(IN_CCTX)[k]; scond[i] = silu_f(v); }
            have = true; __syncthreads();
        }
        const int L = item / 24, cg = item % 24, col0 = cg * 256 + 4 * F.lane;
        const float* W = F.inp(lbase(L)) + col0; const float* bias = F.inp(lbase(L) + 1);
        f32x4 acc[5];
#pragma unroll
        for (int c = 0; c < 5; ++c) acc[c] = (f32x4){0.f, 0.f, 0.f, 0.f};
        const int kb = F.wave * 128;
#pragma unroll 8
        for (int k = 0; k < 128; ++k) { const f32x4 w = *(const f32x4*)(W + (size_t)(kb + k) * 6144);
#pragma unroll
            for (int c = 0; c < 5; ++c) acc[c] += scond[c * 1024 + kb + k] * w; }
#pragma unroll
        for (int c = 0; c < 5; ++c) *(f32x4*)(red + (F.wave * 5 + c) * 256 + 4 * F.lane) = acc[c];
        __syncthreads();
        float* MOD = (float*)(F.ws + WS_MOD) + (size_t)L * 5 * 6144;
        for (int i = F.tid; i < 5 * 256; i += NTHREADS) { const int c = i >> 8, j = i & 255; float s = bias[cg * 256 + j];
#pragma unroll
            for (int w = 0; w < 8; ++w) s += red[(w * 5 + c) * 256 + j];
            MOD[c * 6144 + cg * 256 + j] = s; }
        __syncthreads();
    }
}
__device__ __forceinline__ void p0_misc(Ctx& F) {
    { float* cosT = (float*)(F.ws + WS_ROPE); float* sinT = cosT + 128 * 16;
        for (int i = F.tid; i < 128 * 16; i += NTHREADS) { const int pos = i >> 4, f = i & 15; const float inv = powf(10000.0f, -(float)f / 16.0f); const float ang = (float)pos * inv; cosT[i] = cosf(ang); sinT[i] = sinf(ang); } }
}
__device__ __forceinline__ void p0_s5mats(Ctx& F, const int g0) {
    const int LB = lbase(2);
    const float* a_re = F.inp(LB + 4); const float* a_im = F.inp(LB + 5); const float* log_dt = F.inp(LB + 6); const float* b_re = F.inp(LB + 7); const float* b_im = F.inp(LB + 8);
    const float* c_re = F.inp(LB + 9); const float* c_im = F.inp(LB + 10); const float* dsk = F.inp(LB + 11);
    LAS float* AP = (LAS float*)F.lds;
    LAS float* BB = AP + 2 * 17 * 64 * 2;
    LAS float* CC = BB + 2 * 64 * 16 * 2;
    LAS float* KK = CC + 2 * 16 * 64 * 2;
    for (int g = g0; g < 64; g += 1 << 20) {
        __syncthreads();
        for (int i = F.tid; i < 2 * 17 * 64; i += NTHREADS) { const int d = i / (17 * 64), r = i % (17 * 64), j = r / 64, p = r % 64;
            const float dt = expf(log_dt[d * 64 + g]); const float ar = a_re[(d * 64 + g) * 64 + p], ai = a_im[(d * 64 + g) * 64 + p];
            const float mag = expf((float)j * dt * ar), ph = (float)j * dt * ai; AP[i * 2] = mag * cosf(ph); AP[i * 2 + 1] = mag * sinf(ph); }
        for (int i = F.tid; i < 2 * 64 * 16; i += NTHREADS) { const int d = i / 1024, r = i % 1024, p = r / 16, s = r % 16;
            const float dt = expf(log_dt[d * 64 + g]); const float ar = a_re[(d * 64 + g) * 64 + p], ai = a_im[(d * 64 + g) * 64 + p];
            const float mag = expf(dt * ar), abr = mag * cosf(dt * ai), abi = mag * sinf(dt * ai), den = ar * ar + ai * ai, nr = abr - 1.0f;
            const float cor = (nr * ar + abi * ai) / den, coi = (abi * ar - nr * ai) / den;
            const float br = b_re[((size_t)(d * 64 + g) * 64 + p) * 16 + s], bi = b_im[((size_t)(d * 64 + g) * 64 + p) * 16 + s];
            BB[i * 2] = cor * br - coi * bi; BB[i * 2 + 1] = cor * bi + coi * br;
            const int s2 = r / 64, p2 = r % 64;
            CC[i * 2] = c_re[((size_t)(d * 64 + g) * 16 + s2) * 64 + p2]; CC[i * 2 + 1] = c_im[((size_t)(d * 64 + g) * 16 + s2) * 64 + p2]; }
        __syncthreads();
        for (int i = F.tid; i < 2 * 16 * 256; i += NTHREADS) { const int d = i >> 12, j = (i >> 8) & 15, so = (i >> 4) & 15, si = i & 15; float s = 0.f;
            for (int p = 0; p < 64; ++p) { const float cr = CC[((d * 16 + so) * 64 + p) * 2], ci = CC[((d * 16 + so) * 64 + p) * 2 + 1];
                const float pr = AP[((d * 17 + j) * 64 + p) * 2], pi = AP[((d * 17 + j) * 64 + p) * 2 + 1];
                const float br = BB[((d * 64 + p) * 16 + si) * 2], bi = BB[((d * 64 + p) * 16 + si) * 2 + 1];
                const float wr_ = cr * pr - ci * pi, wi_ = cr * pi + ci * pr; s += wr_ * br - wi_ * bi; }
            KK[i] = s; }
        __syncthreads();
        bf16_t* M1 = (bf16_t*)(F.ws + WS_S5M1) + (size_t)g * 256 * 256; bf16_t* M3 = (bf16_t*)(F.ws + WS_S5M3) + (size_t)g * 256 * 512;
        for (int i = F.tid; i < 256 * 256; i += NTHREADS) { const int n = i >> 8, k = i & 255, d = n >> 7, p = (n & 127) >> 1, c = n & 1, tp = k >> 4, si = k & 15; const int e = d ? tp : 15 - tp;
            const float pr = AP[((d * 17 + e) * 64 + p) * 2], pi = AP[((d * 17 + e) * 64 + p) * 2 + 1], br = BB[((d * 64 + p) * 16 + si) * 2], bi = BB[((d * 64 + p) * 16 + si) * 2 + 1];
            const float v = c ? (pr * bi + pi * br) : (pr * br - pi * bi); M1[i] = (bf16_t)(cvt_pk_bf16(v, 0.f) & 0xffffu); }
        for (int i = F.tid; i < 256 * 512; i += NTHREADS) { const int n = i >> 9, k = i & 511, t = n >> 4, so = n & 15; float v;
            if (k < 256) { const int tp = k >> 4, si = k & 15;
                if (t > tp) v = KK[((0 * 16 + (t - tp)) * 16 + so) * 16 + si];
                else if (t < tp) v = KK[((1 * 16 + (tp - t)) * 16 + so) * 16 + si];
                else { v = KK[((0 * 16 + 0) * 16 + so) * 16 + si] + KK[((1 * 16 + 0) * 16 + so) * 16 + si]; if (si == so) v += dsk[g * 16 + si]; } }
            else { const int q = k - 256, d = q >> 7, p = (q & 127) >> 1, c = q & 1; const int e = d ? 16 - t : t + 1;
                const float cr = CC[((d * 16 + so) * 64 + p) * 2], ci = CC[((d * 16 + so) * 64 + p) * 2 + 1], pr = AP[((d * 17 + e) * 64 + p) * 2], pi = AP[((d * 17 + e) * 64 + p) * 2 + 1];
                v = c ? -(cr * pi + ci * pr) : (cr * pr - ci * pi); }
            M3[i] = (bf16_t)(cvt_pk_bf16(v, 0.f) & 0xffffu); }
    }
    __syncthreads();
}

__device__ __forceinline__ void p0_prologue(Ctx& F, volatile LAS unsigned* MISC) {
    unsigned* ctr = (unsigned*)(F.ws + WS_CTL) + 128;
    for (;;) {
        __syncthreads();
        if (F.tid == 0) MISC[16] = __hip_atomic_fetch_add(ctr, 1u, __ATOMIC_RELAXED, __HIP_MEMORY_SCOPE_AGENT);
        __syncthreads();
        const int item = (int)MISC[16];
        if (item >= 161) break;
        if (item < 96) p0_adaln(F, item); else if (item < 160) p0_s5mats(F, item - 96); else p0_misc(F);
    }
    __syncthreads();
    p0_weights(F);
}
template <int MODE, bool COMB, bool FROM_IN = false>
__device__ __forceinline__ void row_pass(Ctx& F, int L, bool latent_only, int jsh  , int Lprev, bool out8 = false) {
    xel_t* X = (xel_t*)(F.ws + WS_X); bf16_t* HL = (bf16_t*)(F.ws + WS_HL);
    const float* MOD = (const float*)(F.ws + WS_MOD) + (size_t)L * 5 * 6144; const float* MODP = (const float*)(F.ws + WS_MOD) + (size_t)Lprev * 5 * 6144;
    const float* gain = MODE == 2 ? F.inp(IN_FINAL) : F.inp(lbase(L) + (jsh ? 3 : 2));
    const int nrows = latent_only ? NB * SEQ : MALL;
    const int rpw = (nrows + F.G - 1) / F.G;
    const int r0 = F.bid * rpw, r1 = min(nrows, r0 + rpw);
    LAS float* wrl = (LAS float*)F.lds;
    LAS int* hist = (LAS int*)(F.lds + 32768);
    if (MODE == 1) { const float* wrt = F.inp(lbase(L) + (L == 1 ? 8 : 7));
        for (int i = F.tid; i < 8192; i += NTHREADS) wrl[i] = wrt[i];
        if (F.tid < 8) hist[F.tid] = 0;
        __syncthreads(); }
    const bf16_t* OP = (const bf16_t*)(F.ws + WS_BIG + BIG_APERM);
    const int4* SEL = (const int4*)(F.ws + WS_SEL); const int2* SLOT = (const int2*)(F.ws + WS_SLOT);
    int cur_cond = -1; f32x4 ca[4], cb[4], gp[4];
    for (int lr = r0 + F.wave; lr < r1; lr += NWAVES) {
        const int row = latent_only ? (lr >> 13) * RPB + CTXL + (lr & 8191) : lr;
        const int cond = row_cond(row);
        if (cond != cur_cond) { cur_cond = cond;
#pragma unroll
            for (int q = 0; q < 4; ++q) { const int col = 4 * F.lane + 256 * q; const f32x4 g4 = *(const f32x4*)(gain + col);
                if (MODE == 2) { ca[q] = g4; cb[q] = (f32x4){0.f, 0.f, 0.f, 0.f}; }
                else { const f32x4 sh = *(const f32x4*)(MOD + cond * 6144 + jsh * 1024 + col), sc = *(const f32x4*)(MOD + cond * 6144 + (jsh + 1) * 1024 + col); ca[q] = g4 * (1.0f + sc); cb[q] = sh; }
                if (COMB) gp[q] = *(const f32x4*)(MODP + cond * 6144 + 5 * 1024 + col); } }
        xel_t* xr = X + (size_t)row * DM + 4 * F.lane;
        f32x4 v[4];
        if (FROM_IN) { const int b_ = row / RPB, j_ = row - b_ * RPB; const f32x4* xi = (const f32x4*)(j_ < CTXL ? F.inp(IN_CTX) + ((size_t)b_ * CTXL + j_) * DM : F.inp(IN_X) + ((size_t)b_ * SEQ + (j_ - CTXL)) * DM) + F.lane;
#pragma unroll
            for (int q = 0; q < 4; ++q) v[q] = xi[64 * q];
        } else {
#pragma unroll
            for (int q = 0; q < 4; ++q) v[q] = x_ld4(xr + 256 * q); }
        if (COMB && !((MK_DBG_NOMOE >> (Lprev == 1 ? 0 : 1)) & 1)) {
            const int4 sel = SEL[row]; const int2 sl = SLOT[row]; const float w0 = __int_as_float(sel.z), w1 = __int_as_float(sel.w);
            const u32x2* o0 = (const u32x2*)(OP + (size_t)sl.x * DM) + F.lane; const u32x2* o1 = (const u32x2*)(OP + (size_t)sl.y * DM) + F.lane;
#pragma unroll
            for (int q = 0; q < 4; ++q) { const u32x2 a = o0[64 * q], b = o1[64 * q];
                f32x4 m; m[0] = w0 * bf_lo(a.x) + w1 * bf_lo(b.x); m[1] = w0 * bf_hi(a.x) + w1 * bf_hi(b.x); m[2] = w0 * bf_lo(a.y) + w1 * bf_lo(b.y); m[3] = w0 * bf_hi(a.y) + w1 * bf_hi(b.y);
                v[q] = v[q] + gp[q] * m; if (MODE != 2) x_st4(xr + 256 * q, v[q]); }
        }
        float ss = 0.f;
#pragma unroll
        for (int q = 0; q < 4; ++q) ss += (v[q][0] * v[q][0] + v[q][1] * v[q][1]) + (v[q][2] * v[q][2] + v[q][3] * v[q][3]);
        const float rstd = 1.0f / sqrtf(wave_sum(ss) * (1.0f / DM) + EPS);
        f32x4 h[4];
#pragma unroll
        for (int q = 0; q < 4; ++q) h[q] = (v[q] * rstd) * ca[q] + cb[q];
        if (MODE == 2) { const int b = row / RPB, t = row - b * RPB - CTXL; f32x4* o4 = (f32x4*)(F.out + ((size_t)b * SEQ + t) * DM) + F.lane;
#pragma unroll
            for (int q = 0; q < 4; ++q) o4[64 * q] = h[q];
        } else {
            if (out8) { unsigned* o4 = (unsigned*)((unsigned char*)HL + (size_t)row * DM) + F.lane;
#pragma unroll
                for (int q = 0; q < 4; ++q) o4[64 * q] = cvt4_fp8(h[q][0], h[q][1], h[q][2], h[q][3]);
            } else {
            u32x2* o8 = (MODE == 0 && COMB) ? (u32x2*)HL + ((size_t)(F.lane >> 2) * MALL + row) * 4 + (F.lane & 3) : (u32x2*)(HL + (size_t)row * DM) + F.lane;
            const size_t qst = (MODE == 0 && COMB) ? (size_t)16 * MALL * 4 : 64;
#pragma unroll
            for (int q = 0; q < 4; ++q) { u32x2 w; w.x = cvt_pk_bf16(h[q][0], h[q][1]); w.y = cvt_pk_bf16(h[q][2], h[q][3]); o8[qst * q] = w; } }
        }
        if (MODE == 1) {
            float lg[8];
#pragma unroll
            for (int e = 0; e < 8; ++e) lg[e] = 0.f;
#pragma unroll
            for (int q = 0; q < 4; ++q)
#pragma unroll
                for (int i = 0; i < 4; ++i) { const int k = 4 * F.lane + 256 * q + i; const f32x4 wa = *(const LAS f32x4*)(wrl + k * 8), wb = *(const LAS f32x4*)(wrl + k * 8 + 4); const float hv = h[q][i];
                    lg[0] += hv * wa[0]; lg[1] += hv * wa[1]; lg[2] += hv * wa[2]; lg[3] += hv * wa[3]; lg[4] += hv * wb[0]; lg[5] += hv * wb[1]; lg[6] += hv * wb[2]; lg[7] += hv * wb[3]; }
#pragma unroll
            for (int e = 0; e < 8; ++e) lg[e] = wave_sum(lg[e]);
            int e0 = 0; float v0 = lg[0];
#pragma unroll
            for (int e = 1; e < 8; ++e) if (lg[e] > v0) { v0 = lg[e]; e0 = e; }
            int e1 = -1; float v1 = -INFINITY;
#pragma unroll
            for (int e = 0; e < 8; ++e) if (e != e0 && lg[e] > v1) { v1 = lg[e]; e1 = e; }
            const float ex = __expf(v1 - v0), w0 = 1.0f / (1.0f + ex), w1 = ex * w0;
            if (F.lane == 0) { ((int4*)(F.ws + WS_SEL))[row] = make_int4(e0, e1, __float_as_int(w0), __float_as_int(w1)); atomicAdd((int*)(hist + e0), 1); atomicAdd((int*)(hist + e1), 1); }
        }
    }
    if (MODE == 1) { __syncthreads(); if (F.tid < 8) ((int*)(F.ws + WS_CNT))[F.bid * 8 + F.tid] = hist[F.tid]; __syncthreads(); }
}

__device__ __forceinline__ void conv_pass(Ctx& F, int L, bool latent_only) {
    const bf16_t* BZ = (const bf16_t*)(F.ws + WS_BIG + BIG_BZ); bf16_t* U = (bf16_t*)(F.ws + WS_BIG + BIG_U);
    const float* cw = F.inp(lbase(L) + 5);
    const int nrows = latent_only ? NB * SEQ : MALL;
    const long nitems = (long)nrows * 128;
    for (long it = (long)F.bid * NTHREADS + F.tid; it < nitems; it += (long)F.G * NTHREADS) {
        const int lr = (int)(it >> 7), cgp = (int)(it & 127), col = cgp * 8;
        const int row = latent_only ? (lr >> 13) * RPB + CTXL + (lr & 8191) : lr;
        const int j = row % RPB; const bool first = (j == 0) || (j == CTXL), lastr = (j == CTXL - 1) || (j == RPB - 1);
        const u32x4 bb = *(const u32x4*)(BZ + (size_t)row * 2048 + col);
        const u32x4 zc = *(const u32x4*)(BZ + (size_t)row * 2048 + 1024 + col);
        u32x4 zp = (u32x4){0u, 0u, 0u, 0u}, zn = (u32x4){0u, 0u, 0u, 0u};
        if (!first) zp = *(const u32x4*)(BZ + (size_t)(row - 1) * 2048 + 1024 + col);
        if (!lastr) zn = *(const u32x4*)(BZ + (size_t)(row + 1) * 2048 + 1024 + col);
        const f32x4 w0a = *(const f32x4*)(cw + col), w0b = *(const f32x4*)(cw + col + 4), w1a = *(const f32x4*)(cw + 1024 + col), w1b = *(const f32x4*)(cw + 1024 + col + 4), w2a = *(const f32x4*)(cw + 2048 + col), w2b = *(const f32x4*)(cw + 2048 + col + 4);
        float y[8];
#define CV(i, W0, W1, W2, ZP, ZC, ZN, LO) y[i] = (W0) * (LO ? bf_lo(ZP) : bf_hi(ZP)) + (W1) * (LO ? bf_lo(ZC) : bf_hi(ZC)) + (W2) * (LO ? bf_lo(ZN) : bf_hi(ZN))
        CV(0, w0a[0], w1a[0], w2a[0], zp.x, zc.x, zn.x, 1); CV(1, w0a[1], w1a[1], w2a[1], zp.x, zc.x, zn.x, 0);
        CV(2, w0a[2], w1a[2], w2a[2], zp.y, zc.y, zn.y, 1); CV(3, w0a[3], w1a[3], w2a[3], zp.y, zc.y, zn.y, 0);
        CV(4, w0b[0], w1b[0], w2b[0], zp.z, zc.z, zn.z, 1); CV(5, w0b[1], w1b[1], w2b[1], zp.z, zc.z, zn.z, 0);
        CV(6, w0b[2], w1b[2], w2b[2], zp.w, zc.w, zn.w, 1); CV(7, w0b[3], w1b[3], w2b[3], zp.w, zc.w, zn.w, 0);
#undef CV
        u32x4 o; o.x = cvt_pk_bf16(bf_lo(bb.x) * y[0], bf_hi(bb.x) * y[1]); o.y = cvt_pk_bf16(bf_lo(bb.y) * y[2], bf_hi(bb.y) * y[3]);
        o.z = cvt_pk_bf16(bf_lo(bb.z) * y[4], bf_hi(bb.z) * y[5]); o.w = cvt_pk_bf16(bf_lo(bb.w) * y[6], bf_hi(bb.w) * y[7]);
        *(u32x4*)(U + (size_t)row * DM + col) = o;
    }
}

__device__ __forceinline__ void attn_combine(Ctx& F, int L) {
    const float* lamv = F.inp(lbase(L) + 5); const float* subln = F.inp(lbase(L) + 6);
    const float lam_init = 0.8f - 0.6f * expf(-0.3f * (float)L);
    float s01 = 0.f, s23 = 0.f;
    for (int i = 0; i < 64; ++i) { s01 += lamv[i] * lamv[64 + i]; s23 += lamv[128 + i] * lamv[192 + i]; }
    const float lam = expf(s01) - expf(s23) + lam_init, osc = 1.0f - lam_init;
    bf16_t* O0 = (bf16_t*)(F.ws + WS_BIG + BIG_O0); const bf16_t* O1 = (const bf16_t*)(F.ws + WS_HL);
    const int sub = F.lane & 15;
    const f32x4 g0 = *(const f32x4*)(subln + sub * 8), g1 = *(const f32x4*)(subln + sub * 8 + 4);
    const long nit = (long)MALL * NHEAD;
    for (long it = ((long)F.bid * NTHREADS + F.tid) >> 4; it < nit; it += ((long)F.G * NTHREADS) >> 4) {
        const size_t off = (size_t)it * 128 + sub * 8;
        const u32x4 a = *(const u32x4*)(O0 + off), b = *(const u32x4*)(O1 + off);
        float o[8];
        o[0] = bf_lo(a.x) - lam * bf_lo(b.x); o[1] = bf_hi(a.x) - lam * bf_hi(b.x); o[2] = bf_lo(a.y) - lam * bf_lo(b.y); o[3] = bf_hi(a.y) - lam * bf_hi(b.y);
        o[4] = bf_lo(a.z) - lam * bf_lo(b.z); o[5] = bf_hi(a.z) - lam * bf_hi(b.z); o[6] = bf_lo(a.w) - lam * bf_lo(b.w); o[7] = bf_hi(a.w) - lam * bf_hi(b.w);
        float ss = 0.f;
#pragma unroll
        for (int i = 0; i < 8; ++i) ss += o[i] * o[i];
        ss = row16_sum(ss);
        const float r = osc / sqrtf(ss * (1.0f / 128.0f) + EPS);
        u32x4 w; w.x = cvt_pk_bf16(o[0] * r * g0[0], o[1] * r * g0[1]); w.y = cvt_pk_bf16(o[2] * r * g0[2], o[3] * r * g0[3]);
        w.z = cvt_pk_bf16(o[4] * r * g1[0], o[5] * r * g1[1]); w.w = cvt_pk_bf16(o[6] * r * g1[2], o[7] * r * g1[3]);
        *(u32x4*)(O0 + off) = w;
    }
}

__device__ __forceinline__ void attn_phase(Ctx& F) {
    const bf16_t* Q = (const bf16_t*)(F.ws + WS_BIG + BIG_QKV); const bf16_t* KH = (const bf16_t*)(F.ws + WS_BIG + BIG_KH); const bf16_t* VH = (const bf16_t*)(F.ws + WS_BIG + BIG_VH);
    bf16_t* O0 = (bf16_t*)(F.ws + WS_BIG + BIG_O0); bf16_t* O1 = (bf16_t*)(F.ws + WS_HL);
    const int vcu = (F.G % 8 == 0) ? (F.bid % 8) * (F.G / 8) + F.bid / 8 : F.bid;
    for (int u = vcu; u < 2048 + 64; u += F.G) {
        int bh, qb; bool isctx = u >= 2048;
        if (!isctx) { bh = u >> 5; qb = u & 31; } else { bh = u - 2048; qb = 0; }
        const int b = bh >> 4, vh = bh & 15, h = vh >> 1, m = vh & 1;
        const size_t rowb = (size_t)b * RPB;
        const size_t qrow = isctx ? rowb : rowb + CTXL + (size_t)qb * 256;
        const bf16_t* Qb = Q + qrow * DM + h * 128 + m * 64;
        const bf16_t* Kh = KH + (size_t)(b * 16 + vh) * RPB * 64;
        const bf16_t* Vh = VH + (size_t)(b * 8 + h) * RPB * 128;
        bf16_t* Ob = (m ? O1 : O0) + qrow * DM + h * 128;
        att2::attn_unit(Qb, Kh, Vh, Ob, DM, isctx ? CTXL : RPB, F.lds, F.tid);
    }
}

__device__ __forceinline__ void v_transpose(Ctx& F) {
    const unsigned char* V8 = F.ws + WS_BIG + BIG_V8; unsigned char* VT8 = F.ws + WS_BIG + BIG_VT8;
    LAS unsigned char* buf = F.lds + F.wave * 8192;
    const int gw = F.bid * NWAVES + F.wave, NGW = F.G * NWAVES;
    for (int it = gw; it < NB * NHEAD * (RPB / 64); it += NGW) {
        const size_t tb = (size_t)it * 8192;
#pragma unroll
        for (int t = 0; t < 8; ++t) *(LAS u32x4*)(buf + (F.lane + 64 * t) * 16) = *(const u32x4*)(V8 + tb + (size_t)(F.lane + 64 * t) * 16);
        LDS_WAIT();
#pragma unroll
        for (int u = 0; u < 2; ++u) { const int d = F.lane + 64 * u;
#pragma unroll
            for (int q = 0; q < 4; ++q) { u32x4 w;
#pragma unroll
                for (int e = 0; e < 4; ++e) { unsigned x = 0;
#pragma unroll
                    for (int b = 0; b < 4; ++b) x |= (unsigned)buf[att3::slot_key(q * 16 + e * 4 + b) * 128 + d] << (8 * b);
                    w[e] = x; }
                *(u32x4*)(VT8 + tb + (size_t)d * 64 + q * 16) = w; } }
        LDS_WAIT();
    }
}
__device__ __forceinline__ void attn_phase3(Ctx& F, int L) {
    const unsigned char* Q8 = F.ws + WS_BIG + BIG_Q8; const unsigned char* K8 = F.ws + WS_BIG + BIG_K8; const unsigned char* VT8 = F.ws + WS_BIG + BIG_VT8;
    bf16_t* AO = (bf16_t*)(F.ws + WS_BIG + BIG_O0);
    const float* lamv = F.inp(lbase(L) + 5); const float* subln = F.inp(lbase(L) + 6);
    const float lam_init = 0.8f - 0.6f * expf(-0.3f * (float)L);
    float s01 = 0.f, s23 = 0.f;
    for (int i = 0; i < 64; ++i) { s01 += lamv[i] * lamv[64 + i]; s23 += lamv[128 + i] * lamv[192 + i]; }
    const float lam = expf(s01) - expf(s23) + lam_init, osc = 1.0f - lam_init;
    const int vcu = (F.G % 8 == 0) ? (F.bid % 8) * (F.G / 8) + F.bid / 8 : F.bid;
    for (int u = vcu; u < 1024 + 32; u += F.G) {
        int bh, qb; const bool isctx = u >= 1024;
        if (!isctx) { bh = u >> 5; qb = u & 31; } else { bh = u - 1024; qb = 0; }
        const int b = bh >> 3, h = bh & 7;
        const size_t rowb = (size_t)b * RPB;
        const size_t qrow = isctx ? rowb : rowb + CTXL + (size_t)qb * 256;
        att3::attn_unit(Q8 + qrow * DM + h * 128, K8 + (size_t)(b * 16 + 2 * h) * RPB * 64, (size_t)RPB * 64, VT8 + (size_t)(b * 8 + h) * RPB * 128, AO + qrow * DM + h * 128, DM, isctx ? CTXL : RPB,
                        lam, osc, subln, (u32x4*)(F.ws + WS_BIG + ((size_t)270 << 20)) + (size_t)F.bid * 4096, F.lds, F.tid);
    }
}

__device__ __forceinline__ void moe_scatter(Ctx& F, bool latent_only) {
    const int nrows = latent_only ? NB * SEQ : MALL;
    const int rpw = (nrows + F.G - 1) / F.G, r0 = F.bid * rpw, r1 = min(nrows, r0 + rpw);
    LAS int* tot = (LAS int*)F.lds; LAS int* pre = tot + 8; LAS int* base = tot + 16; LAS int* offs = tot + 24;
    LAS int* selc = tot + 64;
    LAS int* slc = selc + 1024;
    const int* CNT = (const int*)(F.ws + WS_CNT); const int4* SEL = (const int4*)(F.ws + WS_SEL); int2* SLOT = (int2*)(F.ws + WS_SLOT); int* TEXP = (int*)(F.ws + WS_TEXP);
    if (F.tid < 8) { int t = 0, p = 0; for (int w = 0; w < F.G; ++w) { const int c = CNT[w * 8 + F.tid]; t += c; if (w < F.bid) p += c; } tot[F.tid] = t; pre[F.tid] = p; }
    for (int i = F.tid; i < r1 - r0; i += NTHREADS) { const int lr = r0 + i; const int row = latent_only ? (lr >> 13) * RPB + CTXL + (lr & 8191) : lr; const int4 s = SEL[row]; selc[i] = s.x | (s.y << 8); }
    __syncthreads();
    if (F.tid == 0) { int o = 0; for (int e = 0; e < 8; ++e) { offs[e] = o; base[e] = o + pre[e]; o += (tot[e] + 255) & ~255; } offs[8] = o;
        for (int i = 0; i < r1 - r0; ++i) { const int s = selc[i], e0 = s & 255, e1 = s >> 8; slc[2 * i] = base[e0]++; slc[2 * i + 1] = base[e1]++; } }
    __syncthreads();
    if (F.bid == 0) { const int nT = offs[8] >> 8; for (int t = F.tid; t < nT; t += NTHREADS) { int e = 0; while (e < 7 && t * 256 >= offs[e + 1]) ++e; TEXP[t] = e; } if (F.tid == 0) TEXP[500] = nT; }
    const bf16_t* HL = (const bf16_t*)(F.ws + WS_HL); unsigned char* AP8 = (unsigned char*)(F.ws + WS_BIG + BIG_APERM);
    for (int i = F.wave; i < r1 - r0; i += NWAVES) { const int lr = r0 + i; const int row = latent_only ? (lr >> 13) * RPB + CTXL + (lr & 8191) : lr;
        const int s0 = slc[2 * i], s1 = slc[2 * i + 1];
        if (F.lane == 0) SLOT[row] = make_int2(s0, s1);
        const u32x4* src = (const u32x4*)(HL + (size_t)row * DM) + F.lane; const u32x4 a = src[0], b = src[64];
        u32x2 qa, qb; qa.x = cvt4_fp8(bf_lo(a.x), bf_hi(a.x), bf_lo(a.y), bf_hi(a.y)); qa.y = cvt4_fp8(bf_lo(a.z), bf_hi(a.z), bf_lo(a.w), bf_hi(a.w));
        qb.x = cvt4_fp8(bf_lo(b.x), bf_hi(b.x), bf_lo(b.y), bf_hi(b.y)); qb.y = cvt4_fp8(bf_lo(b.z), bf_hi(b.z), bf_lo(b.w), bf_hi(b.w));
        u32x2* d0 = (u32x2*)(AP8 + (size_t)s0 * DM) + F.lane; u32x2* d1 = (u32x2*)(AP8 + (size_t)s1 * DM) + F.lane;
        d0[0] = qa; d0[64] = qb; d1[0] = qa; d1[64] = qb; }
    __syncthreads();
}

__device__ __forceinline__ void s5_scan(Ctx& F) {
    const int LB = lbase(2);
    const float* a_re = F.inp(LB + 4); const float* a_im = F.inp(LB + 5); const float* log_dt = F.inp(LB + 6);
    const float* H = (const float*)(F.ws + WS_BIG + BIG_H); bf16_t* SB = (bf16_t*)(F.ws + WS_BIG + BIG_SBUF);
    LAS float* ex = (LAS float*)F.lds;
    constexpr int QS = CPB / 4;
    for (int pair = F.bid; pair < 256; pair += F.G) {
        const int task = 2 * pair + (F.wave >> 2), seg = F.wave & 3;
        const int b = task >> 7, d = (task >> 6) & 1, g = task & 63, p = F.lane;
        const float dt = expf(log_dt[d * 64 + g]); const float ar = a_re[(d * 64 + g) * 64 + p], ai = a_im[(d * 64 + g) * 64 + p];
        const float mag = expf(16.0f * dt * ar), ph = 16.0f * dt * ai, Ar = mag * cosf(ph), Ai = mag * sinf(ph);
        const float magq = expf((16.0f * QS) * dt * ar), phq = (16.0f * QS) * dt * ai, Qr = magq * cosf(phq), Qi = magq * sinf(phq);
        const int v = d * 128 + 2 * p;
        const float* Hb = H + ((size_t)b * CPB * 64 + g) * 256 + v;
        bf16_t* Sb = SB + ((size_t)g * (MALL / 16) + (size_t)b * CPB) * 256 + v;
        float er = 0.f, ei = 0.f;
        for (int s0 = seg * QS; s0 < (seg + 1) * QS; s0 += 4) {
            f32x2 hv[4];
#pragma unroll
            for (int i = 0; i < 4; ++i) { const int st = s0 + i; const int c = d ? (st < 16 ? 15 - st : CPB - 1 - (st - 16)) : st; hv[i] = *(const f32x2*)(Hb + (size_t)c * 64 * 256); }
#pragma unroll
            for (int i = 0; i < 4; ++i) { const float nr = Ar * er - Ai * ei + hv[i][0], ni = Ar * ei + Ai * er + hv[i][1]; er = nr; ei = ni; }
        }
        __syncthreads();
        ex[(F.wave * 64 + p) * 2] = er; ex[(F.wave * 64 + p) * 2 + 1] = ei;
        __syncthreads();
        er = 0.f; ei = 0.f;
        for (int q = 0; q < seg; ++q) { const int w = (F.wave & 4) + q; const float xr_ = ex[(w * 64 + p) * 2], xi_ = ex[(w * 64 + p) * 2 + 1];
            const float nr = Qr * er - Qi * ei + xr_, ni = Qr * ei + Qi * er + xi_; er = nr; ei = ni; }
        for (int s0 = seg * QS; s0 < (seg + 1) * QS; s0 += 4) {
            f32x2 hv[4]; int cc[4];
#pragma unroll
            for (int i = 0; i < 4; ++i) { const int st = s0 + i; cc[i] = d ? (st < 16 ? 15 - st : CPB - 1 - (st - 16)) : st; hv[i] = *(const f32x2*)(Hb + (size_t)cc[i] * 64 * 256); }
#pragma unroll
            for (int i = 0; i < 4; ++i) { *(unsigned*)(Sb + (size_t)cc[i] * 256) = cvt_pk_bf16(er, ei);
                const float nr = Ar * er - Ai * ei + hv[i][0], ni = Ar * ei + Ai * er + hv[i][1]; er = nr; ei = ni; }
        }
    }
}

__global__ void __launch_bounds__(NTHREADS, 2) mk_fwd(Args args) {
    extern __shared__ __attribute__((aligned(16))) unsigned char lds[];
    Ctx F;
    F.lds = (LAS unsigned char*)lds;
    F.tid = threadIdx.x; F.lane = F.tid & 63; F.wave = __builtin_amdgcn_readfirstlane(F.tid >> 6);
    F.G = gridDim.x; F.bid = blockIdx.x; F.ws = args.ws; F.out = args.out;
    volatile LAS unsigned* MISC = (volatile LAS unsigned*)(F.lds + MISC_OFF);
    if (F.tid < 32) MISC[F.tid] = 0u;
    if (F.tid == 0) {
#pragma unroll
        for (int i = 0; i < 50; ++i) *(LAS unsigned long long*)(F.lds + INTAB_OFF + 8 * i) = (unsigned long long)(uintptr_t)args.in[i]; }
    __syncthreads();
    const int lo = args.ph_lo, hi = args.ph_hi;
    XcdBarrier bar; bar.bar = (unsigned*)(F.ws + WS_CTL) + 1024; bar.x = 0; bar.st = nullptr;
    if (hi - lo > 1) bar = xcd_barrier_post((unsigned*)(F.ws + WS_CTL) + 1024, MISC + 8);
    int ph = 0;
#define LAUNDER() do { F.ws = launder_ptr(F.ws); F.out = launder_ptr(F.out); F.wave = launder_i(F.wave); asm volatile("v_mbcnt_lo_u32_b32 %0, -1, 0\n\tv_mbcnt_hi_u32_b32 %0, -1, %0" : "=v"(F.lane));     F.tid = F.wave * 64 + F.lane; \
    F.G = launder_i(F.G); F.bid = launder_i(F.bid); } while (0)
#define PHASE(id, ...) do { if (lo <= ph && ph < hi) { LAUNDER(); if ((MK_SITEMASK >> (id)) & 1u) { __VA_ARGS__; } if ((id) == MK_REPEAT_SITE) { __syncthreads(); LAUNDER(); __VA_ARGS__; } if (ph + 1 < hi) xcd_barrier(bar); } ++ph; } while (0)

#define WSB (F.ws)
#define XPTR ((xel_t*)(F.ws + WS_X))
#define HLPTR ((bf16_t*)(F.ws + WS_HL))
#define VBID (F.bid)
#define MODPTR ((const float*)(F.ws + WS_MOD) + (size_t)L * 5 * 6144)

    PHASE(0, p0_prologue(F, MISC));
#if MK_EXTRA_BARS
    if (hi - lo > 1) for (int eb = 0; eb < MK_EXTRA_BARS; ++eb) xcd_barrier(bar);
#endif

    for (int L = 0; L < 4; ++L) {
        const int kind = L % 3; const bool moe = (L & 1) != 0;
        const bool lat = (L >= 2);
        if (L == 2) PHASE(1, (row_pass<0, true>(F, L, false, 0, L - 1)));
        else if (L == 0) PHASE(2, (row_pass<0, false, true>(F, L, false, 0, 0)));
        else PHASE(3, (row_pass<0, false>(F, L, lat, 0, 0, L == 1 && MK_FP8_QKV)));
        if (kind == 0) {
            const size_t wo_in = (L == 0) ? WO_L0_CONVIN : WO_L3_CONVIN, wo_out = (L == 0) ? WO_L0_CONVOUT : WO_L3_CONVOUT;
            PHASE(4, { pg8::ProbPlain P{(const char*)HLPTR, (const char*)(WSB + WS_W + wo_in), 2048, 2048, 16, lat ? NT_LAT : NT_ALL, 12, F.G, VBID, lat};
                    pg8::EpiGated<0> E{(bf16_t*)(WSB + WS_BIG + BIG_BZ), 2048, 4, 1024, 0};
                    pg8::gemm_phase<pg8::EpiGated<0>, pg8::ProbPlain, true>(F.lds, P, E, F.tid); });
            PHASE(5, conv_pass(F, L, lat));
            PHASE(6, { pg8::ProbPlain P{(const char*)(WSB + WS_BIG + BIG_U), (const char*)(WSB + WS_W + wo_out), 2048, 2048, 16, lat ? NT_LAT : NT_ALL, 4, F.G, VBID, lat};
                    pg8::EpiResid E{XPTR, MODPTR + 2 * 1024, L == 0 ? F.inp(IN_X) : nullptr, L == 0 ? F.inp(IN_CTX) : nullptr, 1.f};
                    pg8::gemm_phase<pg8::EpiResid, pg8::ProbPlain, true>(F.lds, P, E, F.tid); });
        } else if (kind == 1) {
            if (MK_FP8_QKV) {
            PHASE(25, { pg8::ProbPlain P{(const char*)HLPTR, (const char*)(WSB + WS_W + WO_L1_QKV), 1024, 1024, 8, NT_ALL, 12, F.G, VBID, false};
                    pg8::EpiQkv<MK_ATT3 != 0, true> E{WSB + WS_BIG, (const float*)(WSB + WS_ROPE)};
                    pg8::gemm_phase<pg8::EpiQkv<MK_ATT3 != 0, true>, pg8::ProbPlain, true, true>(F.lds, P, E, F.tid); });
            } else {
            PHASE(7, { pg8::ProbPlain P{(const char*)HLPTR, (const char*)(WSB + WS_W + WO_L1_QKV), 2048, 2048, 16, NT_ALL, 12, F.G, VBID, false};
                    pg8::EpiQkv<MK_ATT3 != 0, false> E{WSB + WS_BIG, (const float*)(WSB + WS_ROPE)};
                    pg8::gemm_phase<pg8::EpiQkv<MK_ATT3 != 0, false>, pg8::ProbPlain, true>(F.lds, P, E, F.tid); });
            }
            if (MK_ATT3) { PHASE(27, v_transpose(F)); PHASE(28, attn_phase3(F, L)); }
            else { PHASE(8, attn_phase(F)); PHASE(9, attn_combine(F, L)); }
            PHASE(10, { pg8::ProbPlain P{(const char*)(WSB + WS_BIG + BIG_O0), (const char*)(WSB + WS_W + WO_L1_WO), 2048, 2048, 16, NT_ALL, 4, F.G, VBID, false};
                    pg8::EpiResid E{XPTR, MODPTR + 2 * 1024, nullptr, nullptr, 1.f};
                    pg8::gemm_phase<pg8::EpiResid, pg8::ProbPlain, true>(F.lds, P, E, F.tid); });
        } else {
            PHASE(11, { pg8::ProbS5 P{(const char*)HLPTR, (const char*)HLPTR, (const char*)(WSB + WS_S5M1), 4, 4, 9, F.G, VBID, (size_t)256 * 256 * 2, false};
                    pg8::EpiS1 E{(float*)(WSB + WS_BIG + BIG_H)};
                    pg8::gemm_phase<pg8::EpiS1, pg8::ProbS5, true>(F.lds, P, E, F.tid); });
            PHASE(12, s5_scan(F));
            PHASE(13, { pg8::ProbS5 P{(const char*)HLPTR, (const char*)(WSB + WS_BIG + BIG_SBUF), (const char*)(WSB + WS_S5M3), 8, 4, 8, F.G, VBID, (size_t)256 * 512 * 2, true};
                    pg8::EpiS3 E{(bf16_t*)(WSB + WS_BIG + BIG_YG), MK_FP8_GLU != 0};
                    pg8::gemm_phase<pg8::EpiS3, pg8::ProbS5, true>(F.lds, P, E, F.tid); });
            if (MK_FP8_GLU) {
            PHASE(26, { pg8::ProbPlain P{(const char*)(WSB + WS_BIG + BIG_YG), (const char*)(WSB + WS_W + WO_L2_GLU), 1024, 1024, 8, NT_LAT, 8, F.G, VBID, true};
                    pg8::EpiGlu E{XPTR, MODPTR + 2 * 1024, pg8::W8INV};
                    pg8::gemm_phase<pg8::EpiGlu, pg8::ProbPlain, true, true>(F.lds, P, E, F.tid); });
            } else {
            PHASE(14, { pg8::ProbPlain P{(const char*)(WSB + WS_BIG + BIG_YG), (const char*)(WSB + WS_W + WO_L2_GLU), 2048, 2048, 16, NT_LAT, 8, F.G, VBID, true};
                    pg8::EpiGlu E{XPTR, MODPTR + 2 * 1024, 1.f};
                    pg8::gemm_phase<pg8::EpiGlu, pg8::ProbPlain, true>(F.lds, P, E, F.tid); });
            }
        }
        if (moe) PHASE(15, (row_pass<1, false>(F, L, lat, 3, 0)));
        else PHASE(16, (row_pass<0, false>(F, L, lat, 3, 0, ((MK_FP8_FFN >> L) & 1) != 0)));
        if (!moe) {
            const size_t wo_gu = (L == 0) ? WO_L0_GU : WO_L2_GU, wo_dn = (L == 0) ? WO_L0_DOWN : WO_L2_DOWN;
            if ((MK_FP8_FFN >> L) & 1) {
                PHASE(23, { pg8::ProbPlain P{(const char*)HLPTR, (const char*)(WSB + WS_W + wo_gu), 1024, 1024, 8, lat ? NT_LAT : NT_ALL, 22, F.G, VBID, lat};
                        pg8::EpiGated8 E{(unsigned char*)(WSB + WS_BIG + BIG_HID), DFF, pg8::W8INV};
                        pg8::gemm_phase<pg8::EpiGated8, pg8::ProbPlain, true, true>(F.lds, P, E, F.tid); });
                PHASE(24, { pg8::ProbPlain P{(const char*)(WSB + WS_BIG + BIG_HID), (const char*)(WSB + WS_W + wo_dn), DFF, DFF, 22, lat ? NT_LAT : NT_ALL, 4, F.G, VBID, lat};
                        pg8::EpiResid E{XPTR, MODPTR + 5 * 1024, nullptr, nullptr, pg8::W8INV};
                        pg8::gemm_phase<pg8::EpiResid, pg8::ProbPlain, true, true>(F.lds, P, E, F.tid); });
            } else {
            PHASE(17, { pg8::ProbPlain P{(const char*)HLPTR, (const char*)(WSB + WS_W + wo_gu), 2048, 2048, 16, lat ? NT_LAT : NT_ALL, 22, F.G, VBID, lat};
                    pg8::EpiGated<1> E{(bf16_t*)(WSB + WS_BIG + BIG_HID), DFF, 0, 0, 0};
                    pg8::gemm_phase<pg8::EpiGated<1>, pg8::ProbPlain, true>(F.lds, P, E, F.tid); });
            PHASE(18, { pg8::ProbPlain P{(const char*)(WSB + WS_BIG + BIG_HID), (const char*)(WSB + WS_W + wo_dn), DFF * 2, DFF * 2, 44, lat ? NT_LAT : NT_ALL, 4, F.G, VBID, lat};
                    pg8::EpiResid E{XPTR, MODPTR + 5 * 1024, nullptr, nullptr, 1.f};
                    pg8::gemm_phase<pg8::EpiResid, pg8::ProbPlain, true>(F.lds, P, E, F.tid); });
            }
        } else {
            const size_t wo_gu = (L == 1) ? WO_L1_MGU : WO_L3_MGU, wo_dn = (L == 1) ? WO_L1_MDOWN : WO_L3_MDOWN;
            PHASE(19, moe_scatter(F, lat));
#define TEXPP ((const int*)(F.ws + WS_TEXP))
            PHASE(20, { const int nT = __builtin_amdgcn_readfirstlane(TEXPP[500]);
                    pg8::ProbMoe P{(const char*)(WSB + WS_BIG + BIG_APERM), (const char*)(WSB + WS_W + wo_gu), 1024, 1024, 8, 22, F.G, VBID, WSZ_GU / 2, TEXPP, 0, nT, 0};
                    pg8::EpiGated8 E{(unsigned char*)(WSB + WS_BIG + BIG_MHID), DFF, pg8::W8INV};
                    pg8::gemm_phase<pg8::EpiGated8, pg8::ProbMoe, true, true>(F.lds, P, E, F.tid); });
            PHASE(21, { const int nT = __builtin_amdgcn_readfirstlane(TEXPP[500]);
                    pg8::ProbMoe P{(const char*)(WSB + WS_BIG + BIG_MHID), (const char*)(WSB + WS_W + wo_dn), DFF, DFF, 22, 4, F.G, VBID, WSZ_DOWN / 2, TEXPP, 0, nT, 0};
                    pg8::EpiBf16 E{(bf16_t*)(WSB + WS_BIG + BIG_APERM), DM, 0, pg8::W8INV};
                    pg8::gemm_phase<pg8::EpiBf16, pg8::ProbMoe, true, true>(F.lds, P, E, F.tid); });
        }
    }
    PHASE(22, (row_pass<2, true>(F, 3, true, 0, 3)));
#undef PHASE
#undef WSB
#undef XPTR
#undef HLPTR
#undef VBID
#undef MODPTR
#undef TEXPP
}
constexpr int N_PHASES = 1 + (1 + 3 + 1 + 2) + (1 + 4 + 1 + 1 + 2) + (1 + 4 + 1 + 2) + (1 + 3 + 1 + 1 + 2) + 1;

extern "C" void kernel_launch(void* const* d_in, const int* in_sizes, int n_in, void* d_out, int out_size, void* d_ws, size_t ws_size, hipStream_t stream) {
    static int grid = 0;
    if (grid == 0) {
        if (n_in != 50 || in_sizes[0] != NB * SEQ * DM || out_size != NB * SEQ * DM || ws_size < WS_END) {
            fprintf(stderr, "kernel_launch: unexpected shapes (n_in %d, in0 %d, out %d, ws %zu < %zu)\n", n_in, n_in > 0 ? in_sizes[0] : -1, out_size, ws_size, (size_t)WS_END); grid = -1; return; }
        int dev = 0, cus = 0, per_cu = 0;
        if (hipGetDevice(&dev) != hipSuccess || hipDeviceGetAttribute(&cus, hipDeviceAttributeMultiprocessorCount, dev) != hipSuccess) { grid = -1; return; }
        if (hipFuncSetAttribute((const void*)mk_fwd, hipFuncAttributeMaxDynamicSharedMemorySize, LDS_BYTES) != hipSuccess) { fprintf(stderr, "kernel_launch: hipFuncSetAttribute failed\n"); grid = -1; return; }
        if (hipOccupancyMaxActiveBlocksPerMultiprocessor(&per_cu, (const void*)mk_fwd, NTHREADS, LDS_BYTES) != hipSuccess || per_cu < 1) { fprintf(stderr, "kernel_launch: occupancy query says %d\n", per_cu); }
        (void)hipGetLastError();
        grid = cus;
    }
    if (grid < 0) return;
    (void)hipMemsetAsync((char*)d_ws + WS_CTL, 0, CTL_ZERO_BYTES, stream);
    Args a{};
    for (int i = 0; i < 50; ++i) a.in[i] = (const float*)d_in[i];
    a.out = (float*)d_out; a.ws = (unsigned char*)d_ws;
#if MK_ONE_LAUNCH
    a.ph_lo = 0; a.ph_hi = N_PHASES;
    hipLaunchKernelGGL(mk_fwd, dim3(grid), dim3(NTHREADS), LDS_BYTES, stream, a);
#else
    for (int p = 0; p < N_PHASES; ++p) { a.ph_lo = p; a.ph_hi = p + 1; hipLaunchKernelGGL(mk_fwd, dim3(grid), dim3(NTHREADS), LDS_BYTES, stream, a); }
#endif
    const hipError_t le = hipPeekAtLastError();
    if (le != hipSuccess) fprintf(stderr, "kernel_launch: launch failed: %s\n", hipGetErrorName(le));
}
```

```cpp
#include <hip/hip_runtime.h>
#include <hip/hip_bf16.h>
#include <cstdio>
#include <cstdint>
#include <cmath>

#ifndef MK_SITEMASK
#define MK_SITEMASK 0xffffffffu
#endif
#ifndef MK_REPEAT_SITE
#define MK_REPEAT_SITE -1
#endif
#ifndef MK_DBG_NOMOE
#define MK_DBG_NOMOE 0
#endif
#ifndef MK_EXTRA_BARS
#define MK_EXTRA_BARS 0
#endif
#ifndef MK_FP8_FFN
#define MK_FP8_FFN 0x4
#endif
#ifndef MK_FP8_QKV
#define MK_FP8_QKV 1
#endif
#ifndef MK_FP8_GLU
#define MK_FP8_GLU 1
#endif
#ifndef MK_ATT_XMFMA
#define MK_ATT_XMFMA 0
#endif
#ifndef MK_ATT_XEXP
#define MK_ATT_XEXP 0
#endif
#ifndef MK_ATT3
#define MK_ATT3 1
#endif
#ifndef MK_XBF16
#define MK_XBF16 1
#endif
#ifndef MK_ATT2
#define MK_ATT2 1
#endif
#ifndef MK_ONE_LAUNCH
#define MK_ONE_LAUNCH 1
#endif

constexpr int DM = 1024, NB = 4, SEQ = 8192, CTXL = 256, RPB = CTXL + SEQ, MALL = NB * RPB;
constexpr int TPB = RPB / 256, NT_ALL = MALL / 256, NT_LAT = NB * SEQ / 256;
constexpr int DFF = 2816, NE = 8, NHEAD = 8;
constexpr float EPS = 1e-6f;
constexpr int NWAVES = 8, NTHREADS = 512;
constexpr int CPB = RPB / 16;
constexpr int MOE_MAXT = 272;

constexpr size_t MiB = 1u << 20;
constexpr size_t WS_CTL = 0, CTL_ZERO_BYTES = 64 * 1024;
constexpr size_t WS_MOD = 1 * MiB;
constexpr size_t WS_ROPE = WS_MOD + 512 * 1024;
constexpr size_t WS_SEL = 2 * MiB;
constexpr size_t WS_SLOT = WS_SEL + (size_t)MALL * 16;
constexpr size_t WS_CNT = WS_SLOT + (size_t)MALL * 8;
constexpr size_t WS_TEXP = WS_CNT + 1024 * 8 * 4;
constexpr size_t WS_S5M3 = 8 * MiB;
constexpr size_t WS_S5M1 = 24 * MiB;
constexpr size_t WS_W = 32 * MiB;
constexpr size_t WS_X = 357 * MiB;
constexpr size_t WS_HL = 489 * MiB;
constexpr size_t WS_BIG = 555 * MiB;
constexpr size_t WS_END = 879 * MiB;
static_assert(WS_TEXP + 4096 <= WS_S5M3, "ws map");
constexpr size_t BIG_BZ = 0, BIG_U = 132 * MiB;
constexpr size_t BIG_Q8 = 0, BIG_K8 = 33 * MiB, BIG_V8 = 66 * MiB, BIG_VT8 = 99 * MiB;
constexpr size_t BIG_QKV = 0, BIG_KH = 66 * MiB, BIG_VH = 132 * MiB, BIG_O0 = 198 * MiB;
constexpr size_t BIG_HID = 0;
constexpr size_t BIG_APERM = 0, BIG_MHID = 136 * MiB;
constexpr size_t BIG_H = 0, BIG_SBUF = 144 * MiB, BIG_YG = 210 * MiB;
static_assert(BIG_MHID + (size_t)MOE_MAXT * 256 * DFF <= WS_END - WS_BIG && BIG_YG + 66 * MiB <= WS_END - WS_BIG && BIG_O0 + 66 * MiB <= WS_END - WS_BIG, "big map");

constexpr size_t WSZ_CONVIN = (size_t)3072 * 1024 * 2, WSZ_SQ = (size_t)1024 * 1024 * 2, WSZ_GU = (size_t)5632 * 1024 * 2, WSZ_DOWN = (size_t)1024 * 2816 * 2, WSZ_GLU = (size_t)2048 * 1024 * 2;
constexpr size_t WO_L0_CONVIN = 0, WO_L0_CONVOUT = WO_L0_CONVIN + WSZ_CONVIN, WO_L0_GU = WO_L0_CONVOUT + WSZ_SQ, WO_L0_DOWN = WO_L0_GU + WSZ_GU;
constexpr size_t WO_L1_QKV = WO_L0_DOWN + WSZ_DOWN, WO_L1_WO = WO_L1_QKV + WSZ_CONVIN, WO_L1_MGU = WO_L1_WO + WSZ_SQ, WO_L1_MDOWN = WO_L1_MGU + 8 * WSZ_GU;
constexpr size_t WO_L2_GLU = WO_L1_MDOWN + 8 * WSZ_DOWN, WO_L2_GU = WO_L2_GLU + WSZ_GLU, WO_L2_DOWN = WO_L2_GU + WSZ_GU;
constexpr size_t WO_L3_CONVIN = WO_L2_DOWN + WSZ_DOWN, WO_L3_CONVOUT = WO_L3_CONVIN + WSZ_CONVIN, WO_L3_MGU = WO_L3_CONVOUT + WSZ_SQ, WO_L3_MDOWN = WO_L3_MGU + 8 * WSZ_GU;
constexpr size_t WO_END = WO_L3_MDOWN + 8 * WSZ_DOWN;
static_assert(WS_W + WO_END <= WS_X, "weights fit");

enum { IN_X = 0, IN_C = 1, IN_CTX = 2, IN_CCTX = 3, IN_FINAL = 49 };
__host__ __device__ constexpr int lbase(int L) { return L == 0 ? 4 : L == 1 ? 13 : L == 2 ? 24 : 39; }

#define LAS __attribute__((address_space(3)))
typedef unsigned short bf16_t;
typedef short bf16x8 __attribute__((ext_vector_type(8)));
typedef float f32x4 __attribute__((ext_vector_type(4)));
typedef float f32x2 __attribute__((ext_vector_type(2)));
typedef unsigned u32x4 __attribute__((ext_vector_type(4)));
typedef unsigned u32x2 __attribute__((ext_vector_type(2)));
#define LDS_WAIT() asm volatile("s_waitcnt lgkmcnt(0)" ::: "memory")
#define VM_WAIT() asm volatile("s_waitcnt vmcnt(0)" ::: "memory")
__device__ __forceinline__ unsigned cvt_pk_bf16(float lo, float hi) { unsigned r; asm volatile("v_cvt_pk_bf16_f32 %0, %1, %2" : "=v"(r) : "v"(lo), "v"(hi)); return r; }
__device__ __forceinline__ float clamp8(float v) { return __builtin_amdgcn_fmed3f(v, -448.f, 448.f); }
__device__ __forceinline__ unsigned cvt4_fp8(float a, float b, float c, float d) {
    unsigned w = 0; w = __builtin_amdgcn_cvt_pk_fp8_f32(clamp8(a), clamp8(b), w, false); w = __builtin_amdgcn_cvt_pk_fp8_f32(clamp8(c), clamp8(d), w, true); return w; }
__device__ __forceinline__ unsigned cvt4_fp8_nc(float a, float b, float c, float d) {
    unsigned w = 0; w = __builtin_amdgcn_cvt_pk_fp8_f32(a, b, w, false); w = __builtin_amdgcn_cvt_pk_fp8_f32(c, d, w, true); return w; }
__device__ __forceinline__ float bf_lo(unsigned w) { return __uint_as_float(w << 16); }
__device__ __forceinline__ float bf_hi(unsigned w) { return __uint_as_float(w & 0xffff0000u); }
#if MK_XBF16
typedef bf16_t xel_t;
__device__ __forceinline__ f32x4 x_ld4(const xel_t* p) { const u32x2 w = *(const u32x2*)p; return (f32x4){bf_lo(w.x), bf_hi(w.x), bf_lo(w.y), bf_hi(w.y)}; }
__device__ __forceinline__ void x_st4(xel_t* p, f32x4 v) { u32x2 w; w.x = cvt_pk_bf16(v[0], v[1]); w.y = cvt_pk_bf16(v[2], v[3]); *(u32x2*)p = w; }
#else
typedef float xel_t;
__device__ __forceinline__ f32x4 x_ld4(const xel_t* p) { return *(const f32x4*)p; }
__device__ __forceinline__ void x_st4(xel_t* p, f32x4 v) { *(f32x4*)p = v; }
#endif
__device__ __forceinline__ float row16_sum(float v) {
    v += __int_as_float(__builtin_amdgcn_mov_dpp(__float_as_int(v), 0xB1, 0xf, 0xf, true));
    v += __int_as_float(__builtin_amdgcn_mov_dpp(__float_as_int(v), 0x4E, 0xf, 0xf, true));
    v += __int_as_float(__builtin_amdgcn_mov_dpp(__float_as_int(v), 0x141, 0xf, 0xf, true));
    v += __int_as_float(__builtin_amdgcn_mov_dpp(__float_as_int(v), 0x140, 0xf, 0xf, true));
    return v;
}
__device__ __forceinline__ float wave_sum(float v) {
    v = row16_sum(v);
    const int vi = __float_as_int(v);
    const float a = __int_as_float(__builtin_amdgcn_readlane(vi, 0)), b = __int_as_float(__builtin_amdgcn_readlane(vi, 16)), c = __int_as_float(__builtin_amdgcn_readlane(vi, 32)), d = __int_as_float(__builtin_amdgcn_readlane(vi, 48));
    return (a + b) + (c + d);
}
__device__ __forceinline__ float fast_sigmoid(float x) { return __builtin_amdgcn_rcpf(1.0f + __builtin_amdgcn_exp2f(-1.4426950408889634f * x)); }
__device__ __forceinline__ float silu_f(float x) { return x * fast_sigmoid(x); }
__device__ __forceinline__ float gelu_tanh_f(float x) { const float u = 0.7978845608028654f * (x + 0.044715f * x * x * x); return x * fast_sigmoid(2.0f * u); }
__device__ __forceinline__ int row_cond(int row) { const int b = row / RPB; return (row - b * RPB) < CTXL ? 4 : b; }
__device__ __forceinline__ int tile_cond(int pm) { const int b = pm / TPB; return (pm - b * TPB) == 0 ? 4 : b; }

#define XB_TMO      128
#define XB_XCNT(j)  (256  + 64 * (j))
#define XB_XSUB(j)  (1280 + 64 * (j))
#define XB_XGEN(j)  (2304 + 64 * (j))
#define XB_TOP      3328
#define XB_TOPGEN   3392
#define XCD_BAR_WORDS 3456
#define XB_SPIN_CAP (1u << 18)
__device__ __forceinline__ unsigned xb_ld(unsigned* p)              { return __hip_atomic_load(p, __ATOMIC_RELAXED, __HIP_MEMORY_SCOPE_AGENT); }
__device__ __forceinline__ unsigned xb_add(unsigned* p, unsigned v) { return __hip_atomic_fetch_add(p, v, __ATOMIC_RELAXED, __HIP_MEMORY_SCOPE_AGENT); }
__device__ __forceinline__ unsigned xb_xcc_id() { return (unsigned)__builtin_amdgcn_s_getreg((3 << 11) | 20) & 0xFu; }
#define XB_SPIN(cond, bar) do { unsigned _sp = 0; while (cond) { __builtin_amdgcn_s_sleep(1); \
    if ((++_sp & 255u) == 0u) { if (xb_ld(&(bar)[XB_TMO])) break; if (_sp > XB_SPIN_CAP) { atomicAdd(&(bar)[XB_TMO], 1u); break; } } } } while (0)
struct XcdBarrier { unsigned* bar; unsigned x; volatile LAS unsigned* st; };
__device__ __forceinline__ XcdBarrier xcd_barrier_post(unsigned* bar, volatile LAS unsigned* st) {
    XcdBarrier b; b.bar = bar; b.x = xb_xcc_id(); b.st = st;
    if (threadIdx.x == 0) (void)xb_add(&bar[XB_XCNT(b.x)], 1u);
    return b;
}
__device__ __forceinline__ void xcd_barrier_complete(unsigned* bar, unsigned x, unsigned& nloc, unsigned& nx) {
    const unsigned G = gridDim.x * gridDim.y * gridDim.z;
    unsigned sum, cnt, mine, sp = 0u;
    for (;;) {
        sum = 0u; cnt = 0u; mine = 0u;
#pragma unroll
        for (unsigned j = 0; j < 16; ++j) { const unsigned c = xb_ld(&bar[XB_XCNT(j)]); sum += c; cnt += (c > 0u) ? 1u : 0u; mine = (j == x) ? c : mine; }
        if (sum == G) break;
        __builtin_amdgcn_s_sleep(1);
        if ((++sp & 255u) == 0u) { if (xb_ld(&bar[XB_TMO])) break; if (sp > XB_SPIN_CAP) { atomicAdd(&bar[XB_TMO], 1u); break; } }
    }
    nloc = mine > 0u ? mine : 1u; nx = cnt > 0u ? cnt : 1u;
}
__device__ __forceinline__ void xcd_barrier(const XcdBarrier& b) {
    asm volatile("s_waitcnt vmcnt(0)" ::: "memory");
    __syncthreads();
    if (threadIdx.x == 0) {
        unsigned* bar = b.bar;
        __builtin_amdgcn_s_waitcnt(0);
        unsigned nloc = b.st[0], nx = b.st[1];
        if (nloc == 0u) { xcd_barrier_complete(bar, b.x, nloc, nx); b.st[0] = nloc; b.st[1] = nx; }
        const unsigned old = xb_add(&bar[XB_XSUB(b.x)], 1u);
        const unsigned gen = old / nloc;
        if (old + 1u == (gen + 1u) * nloc) {
            __builtin_amdgcn_fence(__ATOMIC_RELEASE, "agent");
            asm volatile("s_waitcnt vmcnt(0)" ::: "memory");
            const unsigned og = xb_add(&bar[XB_TOP], 1u);
            const unsigned tg = og / nx;
            if (og + 1u == (tg + 1u) * nx) xb_add(&bar[XB_TOPGEN], 1u);
            else XB_SPIN(xb_ld(&bar[XB_TOPGEN]) == tg, bar);
            __builtin_amdgcn_fence(__ATOMIC_ACQUIRE, "agent");
            xb_add(&bar[XB_XGEN(b.x)], 1u);
            asm volatile("s_waitcnt vmcnt(0)" ::: "memory");
        } else {
            XB_SPIN(xb_ld(&bar[XB_XGEN(b.x)]) == gen, bar);
            __builtin_amdgcn_fence(__ATOMIC_ACQUIRE, "agent");
            asm volatile("s_waitcnt vmcnt(0)" ::: "memory");
        }
    }
    __syncthreads();
}

namespace pg8 {
constexpr int BM = 256, BK = 64, HALF = 128, HTB = HALF * BK * 2, STAGE_BYTES = 8 * HTB, NXCD = 8, WGM = 8;
__host__ __device__ __forceinline__ int lds_byte(int r, int c) { const int st = (r >> 4) * 2 + (c >> 5), rr = r & 15, cc = c & 31, ob = rr * 64 + cc * 2; return st * 1024 + (ob ^ (((ob >> 9) & 1) << 5)); }
__host__ __device__ __forceinline__ void stage_rc(int b, int& R, int& C) { const int st = b / 1024, sb = b % 1024, swz = sb ^ (((sb >> 9) & 1) << 5); R = (st >> 1) * 16 + swz / 64; C = (st & 1) * 32 + (swz % 64) / 2; }
__host__ __device__ __forceinline__ int perm32(int rho) { const int n = rho >> 4, i = rho & 15; return 8 * (i >> 2) + 4 * n + (i & 3); }
struct Unit { int pm, pn, aux; };
__device__ __forceinline__ void order_map(int L, int nM, int nN, int& tm, int& tn) {
    const int nwg = nM * nN; int wgid = L; { const int q = nwg / NXCD, r = nwg % NXCD, xcd = wgid % NXCD, off = wgid / NXCD; wgid = (xcd < r ? xcd * (q + 1) : r * (q + 1) + (xcd - r) * q) + off; }
    const int nig = WGM * nN, gid = wgid / nig, fm = gid * WGM, gsz = (nM - fm) < WGM ? (nM - fm) : WGM;
    tm = fm + ((wgid % nig) % gsz); tn = (wgid % nig) / gsz;
}

template <class Epi, class Prob, bool ALIGN_EPI, bool FP8 = false>
__device__ __forceinline__ void gemm_phase(LAS unsigned char* lds, const Prob& P, const Epi& E, const int tid) {
    const int wid = __builtin_amdgcn_readfirstlane(tid >> 6), lane = tid & 63, wr = wid >> 2, wc = wid & 3, fr = lane & 15, fq = lane >> 4;
    const int nt = P.nt;
    unsigned voffA[2], voffB[2];
#pragma unroll
    for (int i = 0; i < 2; ++i) { int R, C; stage_rc(tid * 16 + i * 8192, R, C); const int Rb = Epi::PERM ? ((R & ~31) + perm32(R & 31)) : R;
        voffA[i] = P.lane_off_a(R, C); voffB[i] = P.lane_off_b(Rb, C); }
    const size_t hsA = P.hstep_a(), hsB = P.hstep_b();
    const unsigned ldsw = (unsigned)wid * 1024u;
    const int aoff = lds_byte(wr * 64 + fr, fq * 8), boff = lds_byte(wc * 32 + fr, fq * 8);
#define PG8_SA(b, h) (((b) * 2 + (h)) * HTB)
#define PG8_SB(b, h) ((4 + (b) * 2 + (h)) * HTB)
#define PG8_STAGE(bufoff, gbase, voff) do { _Pragma("unroll") for (int _i = 0; _i < 2; ++_i) \
        __builtin_amdgcn_global_load_lds((const unsigned*)((const char*)(gbase) + (voff)[_i]), (LAS unsigned*)(lds + (bufoff) + ldsw + _i * 8192), 16, 0, 0); } while (0)
#define PG8_LDA(dst, b, h) do { _Pragma("unroll") for (int m = 0; m < 4; ++m) _Pragma("unroll") for (int k = 0; k < 2; ++k) dst[m][k] = *(const LAS bf16x8*)(lds + PG8_SA(b, h) + aoff + m * 2048 + k * 1024); } while (0)
#define PG8_LDB(dst, b, h) do { _Pragma("unroll") for (int n = 0; n < 2; ++n) _Pragma("unroll") for (int k = 0; k < 2; ++k) dst[n][k] = *(const LAS bf16x8*)(lds + PG8_SB(b, h) + boff + n * 2048 + k * 1024); } while (0)
#define PG8_MMA(ai, bj, At, Bt) do { __builtin_amdgcn_s_setprio(1); _Pragma("unroll") for (int m = 0; m < 4; ++m) _Pragma("unroll") for (int n = 0; n < 2; ++n) { \
        if constexpr (FP8) { typedef int v4i_ __attribute__((ext_vector_type(4))); typedef int v8i_ __attribute__((ext_vector_type(8))); \
            const v4i_ b0_ = __builtin_bit_cast(v4i_, Bt[n][0]), b1_ = __builtin_bit_cast(v4i_, Bt[n][1]), a0_ = __builtin_bit_cast(v4i_, At[m][0]), a1_ = __builtin_bit_cast(v4i_, At[m][1]); \
            const v8i_ bb_ = {b0_[0], b0_[1], b0_[2], b0_[3], b1_[0], b1_[1], b1_[2], b1_[3]}, aa_ = {a0_[0], a0_[1], a0_[2], a0_[3], a1_[0], a1_[1], a1_[2], a1_[3]}; \
              \
            asm volatile("v_mfma_scale_f32_16x16x128_f8f6f4 %0, %1, %2, %0, %3, %3 op_sel_hi:[0,0,0]" : "+v"(acc[ai][bj][m][n]) : "v"(bb_), "v"(aa_), "v"(0x7f7f7f7f)); } \
        else { _Pragma("unroll") for (int k = 0; k < 2; ++k) acc[ai][bj][m][n] = __builtin_amdgcn_mfma_f32_16x16x32_bf16(Bt[n][k], At[m][k], acc[ai][bj][m][n], 0, 0, 0); } } \
        __builtin_amdgcn_s_setprio(0); } while (0)
#define PG8_WAIT_V(n) asm volatile("s_waitcnt vmcnt(" #n ")" ::: "memory")
#define PG8_WAIT_L(n) asm volatile("s_waitcnt lgkmcnt(" #n ")" ::: "memory")
#define PG8_BAR __builtin_amdgcn_s_barrier()
#define PG8_SCHED __builtin_amdgcn_sched_barrier(0)
    Unit cur, nxt; int ui = 0;
    if (!P.next(0, cur)) return;
    f32x4 acc[2][2][4][2];
#pragma unroll
    for (int a = 0; a < 2; ++a)
#pragma unroll
        for (int b = 0; b < 2; ++b)
#pragma unroll
            for (int m = 0; m < 4; ++m)
#pragma unroll
                for (int n = 0; n < 2; ++n) acc[a][b][m][n] = (f32x4){0.f, 0.f, 0.f, 0.f};
    bf16x8 At[4][2], B0[2][2], B1[2][2];
    {
        const char* cA = P.a_ptr(cur, 0); const char* cB = P.b_ptr(cur, 0); const char* cA1 = P.a_ptr(cur, 1); const char* cB1 = P.b_ptr(cur, 1);
        PG8_STAGE(PG8_SB(0, 0), cB, voffB); PG8_STAGE(PG8_SB(0, 1), cB + hsB, voffB); PG8_STAGE(PG8_SA(0, 0), cA, voffA); PG8_STAGE(PG8_SA(0, 1), cA + hsA, voffA);
        if (wr == 1) PG8_BAR;
        PG8_WAIT_V(2); PG8_BAR;
        PG8_STAGE(PG8_SB(1, 0), cB1, voffB); PG8_STAGE(PG8_SA(1, 0), cA1, voffA); PG8_STAGE(PG8_SB(1, 1), cB1 + hsB, voffB);
        PG8_WAIT_V(6); PG8_BAR;
    }
    for (;;) {
        const bool has_next = P.next(ui + 1, nxt);
        const Unit nu = has_next ? nxt : cur;
        for (int t = 0; t < nt; t += 2) {
            const bool last = (t == nt - 2);
            const char* a1 = P.a_ptr(cur, t + 1);
            const char* a2 = last ? P.a_ptr(nu, 0) : P.a_ptr(cur, t + 2); const char* b2 = last ? P.b_ptr(nu, 0) : P.b_ptr(cur, t + 2);
            const char* a3 = last ? P.a_ptr(nu, 1) : P.a_ptr(cur, t + 3); const char* b3 = last ? P.b_ptr(nu, 1) : P.b_ptr(cur, t + 3);
            PG8_LDB(B0, 0, 0); PG8_LDB(B1, 0, 1); PG8_SCHED; PG8_LDA(At, 0, 0); PG8_STAGE(PG8_SA(1, 1), a1 + hsA, voffA);
            PG8_WAIT_V(8); PG8_WAIT_L(0); PG8_BAR; PG8_MMA(0, 0, At, B0); PG8_MMA(0, 1, At, B1); PG8_BAR; PG8_SCHED;
            PG8_LDA(At, 0, 1); PG8_STAGE(PG8_SB(0, 0), b2, voffB); PG8_STAGE(PG8_SB(0, 1), b2 + hsB, voffB); PG8_STAGE(PG8_SA(0, 0), a2, voffA);
            PG8_WAIT_V(8); PG8_WAIT_L(0); PG8_BAR; PG8_MMA(1, 0, At, B0); PG8_MMA(1, 1, At, B1); PG8_BAR; PG8_SCHED;
            PG8_LDB(B0, 1, 0); PG8_LDB(B1, 1, 1); PG8_SCHED; PG8_LDA(At, 1, 0); PG8_STAGE(PG8_SA(0, 1), a2 + hsA, voffA);
            PG8_WAIT_V(8); PG8_WAIT_L(0); PG8_BAR; PG8_MMA(0, 0, At, B0); PG8_MMA(0, 1, At, B1); PG8_BAR; PG8_SCHED;
            PG8_LDA(At, 1, 1); PG8_STAGE(PG8_SB(1, 0), b3, voffB); PG8_STAGE(PG8_SB(1, 1), b3 + hsB, voffB); PG8_STAGE(PG8_SA(1, 0), a3, voffA);
            PG8_WAIT_V(8); PG8_WAIT_L(0); PG8_BAR; PG8_MMA(1, 0, At, B0); PG8_MMA(1, 1, At, B1); PG8_BAR; PG8_SCHED;
        }
        if constexpr (ALIGN_EPI) { if (wr == 0) PG8_BAR; }
        if constexpr (FP8) { asm volatile("s_nop 15\n\ts_nop 15" ::: "memory");
#pragma unroll
            for (int a_ = 0; a_ < 2; ++a_)
#pragma unroll
                for (int b_ = 0; b_ < 2; ++b_)
#pragma unroll
                    for (int m_ = 0; m_ < 4; ++m_) asm volatile("" : "+v"(acc[a_][b_][m_][0]), "+v"(acc[a_][b_][m_][1])); }
        { int l_e; asm volatile("v_mbcnt_lo_u32_b32 %0, -1, 0\n\tv_mbcnt_hi_u32_b32 %0, -1, %0" : "=v"(l_e)); E(acc, cur, wr, wc, l_e & 15, l_e >> 4); }
        if (!has_next) break;
#pragma unroll
        for (int a = 0; a < 2; ++a)
#pragma unroll
            for (int b = 0; b < 2; ++b)
#pragma unroll
                for (int m = 0; m < 4; ++m)
#pragma unroll
                    for (int n = 0; n < 2; ++n) acc[a][b][m][n] = (f32x4){0.f, 0.f, 0.f, 0.f};
        cur = nxt; ++ui;
        if constexpr (ALIGN_EPI) { if (wr == 1) PG8_BAR; }
    }
    PG8_WAIT_V(0);
    if constexpr (!ALIGN_EPI) { if (wr == 0) PG8_BAR; }
    PG8_BAR;
#undef PG8_SA
#undef PG8_SB
#undef PG8_STAGE
#undef PG8_LDA
#undef PG8_LDB
#undef PG8_MMA
#undef PG8_WAIT_V
#undef PG8_WAIT_L
#undef PG8_BAR
#undef PG8_SCHED
}

struct ProbPlain {
    const char* A; const char* Bt; int lda_b, ldb_b, nt, nM, nN, G, c; bool latent;
    __device__ __forceinline__ bool next(int i, Unit& u) const {
        const long L = (long)i * G + c; if (L >= (long)nM * nN) return false;
        int tm, tn; order_map((int)L, nM, nN, tm, tn); u.pm = latent ? tm + (tm >> 5) + 1 : tm; u.pn = tn; u.aux = 0; return true; }
    __device__ __forceinline__ const char* a_ptr(const Unit& u, int kt) const { return A + (size_t)u.pm * 256 * lda_b + (size_t)kt * 128; }
    __device__ __forceinline__ const char* b_ptr(const Unit& u, int kt) const { return Bt + (size_t)u.pn * 256 * ldb_b + (size_t)kt * 128; }
    __device__ __forceinline__ size_t hstep_a() const { return (size_t)128 * lda_b; }
    __device__ __forceinline__ size_t hstep_b() const { return (size_t)128 * ldb_b; }
    __device__ __forceinline__ unsigned lane_off_a(int R, int C) const { return (unsigned)(R * lda_b + C * 2); }
    __device__ __forceinline__ unsigned lane_off_b(int R, int C) const { return (unsigned)(R * ldb_b + C * 2); }
};
struct ProbMoe {
    const char* A; const char* Bt; int lda_b, ldb_b, nt, nN, G, c; size_t bstride_e; const int* texp; int tile0, ntile, a_rel;
    __device__ __forceinline__ bool next(int i, Unit& u) const {
        const long L = (long)i * G + c; if (L >= (long)ntile * nN) return false;
        int tm, tn; order_map((int)L, ntile, nN, tm, tn); u.pm = tile0 + tm; u.pn = tn; u.aux = __builtin_amdgcn_readfirstlane(texp[u.pm]); return true; }
    __device__ __forceinline__ const char* a_ptr(const Unit& u, int kt) const { return A + (size_t)(u.pm - a_rel) * 256 * lda_b + (size_t)kt * 128; }
    __device__ __forceinline__ const char* b_ptr(const Unit& u, int kt) const { return Bt + (size_t)u.aux * bstride_e + (size_t)u.pn * 256 * ldb_b + (size_t)kt * 128; }
    __device__ __forceinline__ size_t hstep_a() const { return (size_t)128 * lda_b; }
    __device__ __forceinline__ size_t hstep_b() const { return (size_t)128 * ldb_b; }
    __device__ __forceinline__ unsigned lane_off_a(int R, int C) const { return (unsigned)(R * lda_b + C * 2); }
    __device__ __forceinline__ unsigned lane_off_b(int R, int C) const { return (unsigned)(R * ldb_b + C * 2); }
};
constexpr int S5_ROWS = 4 * 8448;
struct ProbS5 {
    const char* A0; const char* A1; const char* Bt; int nt, nt0, ntile, G, c; size_t bstride_g; bool s3;
    __device__ __forceinline__ bool next(int i, Unit& u) const {
        const int vcu = (G % 8 == 0) ? (c % 8) * (G / 8) + c / 8 : c;
        const long L = (long)i * G + vcu; if (L >= (long)ntile * 64) return false;
        u.pm = (int)(L >> 6); u.pn = (int)(L & 63); u.aux = 0; return true; }
    __device__ __forceinline__ size_t tokbase(int pm) const { return s3 ? (size_t)(pm >> 1) * RPB + CTXL + (size_t)(pm & 1) * 4096 : (size_t)pm * 4096; }
    __device__ __forceinline__ const char* a_ptr(const Unit& u, int kt) const { return kt < nt0 ? A0 + ((size_t)u.pn * S5_ROWS + tokbase(u.pm)) * 32 + (size_t)kt * 128 : A1 + ((size_t)u.pn * (S5_ROWS / 16) + tokbase(u.pm) / 16) * 512 + (size_t)(kt - nt0) * 128; }
    __device__ __forceinline__ const char* b_ptr(const Unit& u, int kt) const { return Bt + (size_t)u.pn * bstride_g + (size_t)kt * 128; }
    __device__ __forceinline__ size_t hstep_a() const { return (size_t)128 * 512; }
    __device__ __forceinline__ size_t hstep_b() const { return (size_t)128 * nt * 128; }
    __device__ __forceinline__ unsigned lane_off_a(int R, int C) const { return (unsigned)(R * 512 + C * 2); }
    __device__ __forceinline__ unsigned lane_off_b(int R, int C) const { return (unsigned)(R * nt * 128 + C * 2); }
};

typedef f32x4 Acc[2][2][4][2];
constexpr float W8SCALE = 64.f, W8INV = 1.f / 64.f;
constexpr float QSCALE = 0.125f * 1.4426950408889634f;
__device__ __forceinline__ u32x4 pack8(f32x4 v0, f32x4 v1) { u32x4 w; w.x = cvt_pk_bf16(v0[0], v0[1]); w.y = cvt_pk_bf16(v0[2], v0[3]); w.z = cvt_pk_bf16(v1[0], v1[1]); w.w = cvt_pk_bf16(v1[2], v1[3]); return w; }

struct EpiBf16 {
    static constexpr bool PERM = true;
    bf16_t* O; int ldc; int pm_sub; float s;
    __device__ __forceinline__ void operator()(const Acc& acc, const Unit& u, int wr, int wc, int fr, int fq) const {
        const int row0 = (u.pm - pm_sub) * BM + wr * 64 + fr, col0 = u.pn * BM + wc * 32 + 8 * fq;
#pragma unroll
        for (int ai = 0; ai < 2; ++ai)
#pragma unroll
            for (int m = 0; m < 4; ++m) { bf16_t* rowp = O + (size_t)(row0 + ai * HALF + m * 16) * ldc + col0;
#pragma unroll
                for (int bj = 0; bj < 2; ++bj) *(u32x4*)(rowp + bj * HALF) = pack8(acc[ai][bj][m][0] * s, acc[ai][bj][m][1] * s); }
    }
};
template <int ACT> struct EpiGated {
    static constexpr bool PERM = true;
    bf16_t* O; int ldc; int pn0; int col_base; int pm_sub;
    __device__ __forceinline__ void operator()(const Acc& acc, const Unit& u, int wr, int wc, int fr, int fq) const {
        const int row0 = (u.pm - pm_sub) * BM + wr * 64 + fr;
        if (u.pn < pn0) {
            const int col0 = u.pn * BM + wc * 32 + 8 * fq;
#pragma unroll
            for (int ai = 0; ai < 2; ++ai)
#pragma unroll
                for (int m = 0; m < 4; ++m) { bf16_t* rowp = O + (size_t)(row0 + ai * HALF + m * 16) * ldc + col0;
#pragma unroll
                    for (int bj = 0; bj < 2; ++bj) *(u32x4*)(rowp + bj * HALF) = pack8(acc[ai][bj][m][0], acc[ai][bj][m][1]); }
        } else {
            const int col0 = col_base + (u.pn - pn0) * HALF + wc * 32 + 8 * fq;
#pragma unroll
            for (int ai = 0; ai < 2; ++ai)
#pragma unroll
                for (int m = 0; m < 4; ++m) { bf16_t* rowp = O + (size_t)(row0 + ai * HALF + m * 16) * ldc + col0;
                    f32x4 a0 = acc[ai][0][m][0], a1 = acc[ai][0][m][1];
                    if (ACT == 1) {
#pragma unroll
                        for (int e = 0; e < 4; ++e) { a0[e] = silu_f(a0[e]); a1[e] = silu_f(a1[e]); } }
                    *(u32x4*)rowp = pack8(a0 * acc[ai][1][m][0], a1 * acc[ai][1][m][1]); }
        }
    }
};
struct EpiGated8 {
    static constexpr bool PERM = true;
    unsigned char* O; int ldc; float s;
    __device__ __forceinline__ void operator()(const Acc& acc, const Unit& u, int wr, int wc, int fr, int fq) const {
        const int row0 = u.pm * BM + wr * 64 + fr, col0 = u.pn * HALF + wc * 32 + 8 * fq;
#pragma unroll
        for (int ai = 0; ai < 2; ++ai)
#pragma unroll
            for (int m = 0; m < 4; ++m) { unsigned char* rowp = O + (size_t)(row0 + ai * HALF + m * 16) * ldc + col0;
                f32x4 a0 = acc[ai][0][m][0] * s, a1 = acc[ai][0][m][1] * s; const f32x4 b0 = acc[ai][1][m][0] * s, b1 = acc[ai][1][m][1] * s;
#pragma unroll
                for (int e = 0; e < 4; ++e) { a0[e] = silu_f(a0[e]) * b0[e]; a1[e] = silu_f(a1[e]) * b1[e]; }
                u32x2 w; w.x = cvt4_fp8(a0[0], a0[1], a0[2], a0[3]); w.y = cvt4_fp8(a1[0], a1[1], a1[2], a1[3]);
                *(u32x2*)rowp = w; }
    }
};
struct EpiResid {
    static constexpr bool PERM = false;
    xel_t* X; const float* gate;
    const float* xin; const float* cin;
    float s;
    __device__ __forceinline__ void operator()(const Acc& acc, const Unit& u, int wr, int wc, int fr, int fq) const {
        const int row0 = u.pm * BM + wr * 64 + fr, col0 = u.pn * BM + wc * 32 + 4 * fq;
        const float* gp = gate + tile_cond(u.pm) * 6144 + col0;
        const int bq = u.pm / TPB, tq = u.pm - bq * TPB;
        const float* srcin = xin ? (tq == 0 ? cin + (size_t)bq * CTXL * DM : xin + ((size_t)bq * SEQ + (size_t)(tq - 1) * 256) * DM) - (size_t)u.pm * BM * DM : nullptr;
        f32x4 gv[2][2];
#pragma unroll
        for (int bj = 0; bj < 2; ++bj)
#pragma unroll
            for (int n = 0; n < 2; ++n) gv[bj][n] = *(const f32x4*)(gp + bj * HALF + n * 16);
#pragma unroll
        for (int ai = 0; ai < 2; ++ai)
#pragma unroll
            for (int m = 0; m < 4; ++m) { const size_t off = (size_t)(row0 + ai * HALF + m * 16) * DM + col0;
#pragma unroll
                for (int bj = 0; bj < 2; ++bj)
#pragma unroll
                    for (int n = 0; n < 2; ++n) { const size_t o2 = off + bj * HALF + n * 16; const f32x4 xv = srcin ? *(const f32x4*)(srcin + o2) : x_ld4(X + o2); x_st4(X + o2, xv + gv[bj][n] * (acc[ai][bj][m][n] * s)); }
                if (m & 1) asm volatile("" ::: "memory"); }
    }
};
struct EpiGlu {
    static constexpr bool PERM = false;
    xel_t* X; const float* gate; float s;
    __device__ __forceinline__ void operator()(const Acc& acc, const Unit& u, int wr, int wc, int fr, int fq) const {
        const int row0 = u.pm * BM + wr * 64 + fr, col0 = u.pn * HALF + wc * 32 + 4 * fq;
        const float* gp = gate + tile_cond(u.pm) * 6144 + col0;
        f32x4 gv[2];
#pragma unroll
        for (int n = 0; n < 2; ++n) gv[n] = *(const f32x4*)(gp + n * 16);
#pragma unroll
        for (int ai = 0; ai < 2; ++ai)
#pragma unroll
            for (int m = 0; m < 4; ++m) { xel_t* rowp = X + (size_t)(row0 + ai * HALF + m * 16) * DM + col0;
#pragma unroll
                for (int n = 0; n < 2; ++n) { f32x4 sg = acc[ai][1][m][n] * s;
#pragma unroll
                    for (int e = 0; e < 4; ++e) sg[e] = fast_sigmoid(sg[e]);
                    xel_t* p = rowp + n * 16; x_st4(p, x_ld4(p) + gv[n] * ((acc[ai][0][m][n] * s) * sg)); }
                if (m & 1) asm volatile("" ::: "memory"); }
    }
};
template <bool OUT8, bool W8> struct EpiQkv {
    static constexpr bool PERM = true;
    unsigned char* big; const float* cosT;
    __device__ __forceinline__ void operator()(const Acc& acc, const Unit& u, int wr, int wc, int fr, int fq) const {
        const float s = W8 ? W8INV : 1.f; const float* sinT = cosT + 128 * 16;
        const int row0 = u.pm * BM + wr * 64 + fr;
        const int bq = u.pm / TPB, tq = u.pm - bq * TPB;
        const bool rope = (u.pn < 8) && (tq != 0);
        const int sect = u.pn >> 2;
        const int cs0 = (u.pn & 3) * BM + wc * 32 + 8 * fq;
#pragma unroll
        for (int ai = 0; ai < 2; ++ai)
#pragma unroll
            for (int m = 0; m < 4; ++m) { const int row = row0 + ai * HALF + m * 16; const int j = row - bq * RPB;
                f32x4 c4 = (f32x4){1.f, 1.f, 1.f, 1.f}, s4 = (f32x4){0.f, 0.f, 0.f, 0.f};
                if (rope) { const int t = j - CTXL; const int pos = (wc & 1) ? (t & 63) : (t >> 6);
                    c4 = *(const f32x4*)(cosT + pos * 16 + 4 * fq); s4 = *(const f32x4*)(sinT + pos * 16 + 4 * fq); }
#pragma unroll
                for (int bj = 0; bj < 2; ++bj) { const f32x4 v0 = acc[ai][bj][m][0] * s, v1 = acc[ai][bj][m][1] * s; f32x4 o0, o1;
                    o0[0] = v0[0] * c4[0] - v0[1] * s4[0]; o0[1] = v0[1] * c4[0] + v0[0] * s4[0];
                    o0[2] = v0[2] * c4[1] - v0[3] * s4[1]; o0[3] = v0[3] * c4[1] + v0[2] * s4[1];
                    o1[0] = v1[0] * c4[2] - v1[1] * s4[2]; o1[1] = v1[1] * c4[2] + v1[0] * s4[2];
                    o1[2] = v1[2] * c4[3] - v1[3] * s4[3]; o1[3] = v1[3] * c4[3] + v1[2] * s4[3];
                    const int cs = cs0 + bj * HALF;
                    if constexpr (OUT8) {
                        size_t off8; float sc8 = 1.f;
                        if (sect == 0) { sc8 = QSCALE * 16.f; off8 = BIG_Q8 + (size_t)row * DM + cs; }
                        else if (sect == 1) off8 = BIG_K8 + ((size_t)(bq * 16 + (cs >> 6)) * RPB + j) * 64 + (cs & 63);
                        else off8 = BIG_V8 + ((size_t)(bq * 8 + (cs >> 7)) * RPB + j) * 128 + (cs & 127);
                        u32x2 w8; w8.x = cvt4_fp8(o0[0] * sc8, o0[1] * sc8, o0[2] * sc8, o0[3] * sc8); w8.y = cvt4_fp8(o1[0] * sc8, o1[1] * sc8, o1[2] * sc8, o1[3] * sc8);
                        *(u32x2*)(big + off8) = w8;
                    } else { size_t offb;
                        if (sect == 0) { o0 = o0 * QSCALE; o1 = o1 * QSCALE; offb = BIG_QKV + ((size_t)row * DM + cs) * 2; }
                        else if (sect == 1) offb = BIG_KH + (((size_t)(bq * 16 + (cs >> 6)) * RPB + j) * 64 + (cs & 63)) * 2;
                        else offb = BIG_VH + (((size_t)(bq * 8 + (cs >> 7)) * RPB + j) * 128 + (cs & 127)) * 2;
                        *(u32x4*)(big + offb) = pack8(o0, o1); } } }
    }
};
struct EpiS1 {
    static constexpr bool PERM = false;
    float* H;
    __device__ __forceinline__ void operator()(const Acc& acc, const Unit& u, int wr, int wc, int fr, int fq) const {
        const int row0 = u.pm * BM + wr * 64 + fr, col0 = wc * 32 + 4 * fq;
#pragma unroll
        for (int ai = 0; ai < 2; ++ai)
#pragma unroll
            for (int m = 0; m < 4; ++m) { float* rowp = H + ((size_t)(row0 + ai * HALF + m * 16) * 64 + u.pn) * 256 + col0;
#pragma unroll
                for (int bj = 0; bj < 2; ++bj)
#pragma unroll
                    for (int n = 0; n < 2; ++n) *(f32x4*)(rowp + bj * HALF + n * 16) = acc[ai][bj][m][n]; }
    }
};
struct EpiS3 {
    static constexpr bool PERM = true;
    bf16_t* YG; bool out8;
    __device__ __forceinline__ void operator()(const Acc& acc, const Unit& u, int wr, int wc, int fr, int fq) const {
        const size_t tb = (size_t)(u.pm >> 1) * RPB + CTXL + (size_t)(u.pm & 1) * 4096;
        const int r0 = wr * 64 + fr;
#pragma unroll
        for (int ai = 0; ai < 2; ++ai)
#pragma unroll
            for (int m = 0; m < 4; ++m) { const int R = r0 + ai * HALF + m * 16;
#pragma unroll
                for (int bj = 0; bj < 2; ++bj) { const int t = 8 * bj + 2 * wc + (fq >> 1), s0 = 8 * (fq & 1);
                    f32x4 v0 = acc[ai][bj][m][0], v1 = acc[ai][bj][m][1];
#pragma unroll
                    for (int e = 0; e < 4; ++e) { v0[e] = gelu_tanh_f(v0[e]); v1[e] = gelu_tanh_f(v1[e]); }
                    const size_t eoff = (tb + (size_t)R * 16 + t) * DM + u.pn * 16 + s0;
                    if (out8) { u32x2 w; w.x = cvt4_fp8(v0[0], v0[1], v0[2], v0[3]); w.y = cvt4_fp8(v1[0], v1[1], v1[2], v1[3]); *(u32x2*)((unsigned char*)YG + eoff) = w; }
                    else *(u32x4*)(YG + eoff) = pack8(v0, v1); } }
    }
};
}

namespace att {
using bf16x8 = __attribute__((ext_vector_type(8))) short;
using s16x4  = __attribute__((ext_vector_type(4))) short;
using f32x16 = __attribute__((ext_vector_type(16))) float;
constexpr int NW = 8, QBLK = 32, KVBLK = 64;
constexpr float SCALE = 0.125f, THR = 8.f;
constexpr int KROW = 144;
constexpr int SHM_V = KVBLK * 128 * 2, SHM_K = KVBLK * KROW;
constexpr int OFF_V = 0, OFF_K = 2 * SHM_V, OFF_WS = OFF_K + 2 * SHM_K, OFF_OST = OFF_WS + NW * 64 * 4, ATT_LDS = OFF_OST + NW * 8192;
constexpr int LDQ = 3072;
#define SBAR() __builtin_amdgcn_sched_barrier(0)
__device__ __forceinline__ int crow(int r, int hi) { return (r & 3) + 8 * (r >> 2) + 4 * hi; }
__device__ __forceinline__ void partialSM(f32x16& p0, f32x16& p1, float& m_reg, float& mn, float& alpha) {
  constexpr float C = SCALE * 1.4426950408889634f;
  float pmax = p0[0];
#pragma unroll
  for (int r = 1; r < 16; ++r) pmax = fmaxf(pmax, p0[r]);
#pragma unroll
  for (int r = 0; r < 16; ++r) pmax = fmaxf(pmax, p1[r]);
  { auto rr = __builtin_amdgcn_permlane32_swap(__float_as_uint(pmax), __float_as_uint(pmax), false, false);
    pmax = fmaxf(__uint_as_float(rr[0]), __uint_as_float(rr[1])); }
  if (__builtin_expect(__all(pmax - m_reg <= THR / SCALE), 1)) { mn = m_reg; alpha = 1.f; }
  else { mn = fmaxf(m_reg, pmax); alpha = __builtin_amdgcn_exp2f((m_reg - mn) * C); m_reg = mn; }
  float mnC = -mn * C;
#pragma unroll
  for (int r = 0; r < 16; ++r) p0[r] = fmaf(p0[r], C, mnC);
#pragma unroll
  for (int r = 0; r < 16; ++r) p1[r] = fmaf(p1[r], C, mnC);
#pragma unroll
  for (int r = 0; r < 16; ++r) p0[r] = __builtin_amdgcn_exp2f(p0[r]);
}
__device__ __forceinline__ void finishSM(f32x16& p0, f32x16& p1, float alpha, float& l_reg, bf16x8& pa0, bf16x8& pa1, bf16x8& pa2, bf16x8& pa3) {
#pragma unroll
  for (int r = 0; r < 16; ++r) p1[r] = __builtin_amdgcn_exp2f(p1[r]);
  float ps = 0;
#pragma unroll
  for (int r = 0; r < 16; ++r) ps += p0[r];
#pragma unroll
  for (int r = 0; r < 16; ++r) ps += p1[r];
  { auto rr = __builtin_amdgcn_permlane32_swap(__float_as_uint(ps), __float_as_uint(ps), false, false);
    ps = __uint_as_float(rr[0]) + __uint_as_float(rr[1]); }
  l_reg = l_reg * alpha + ps;
#define PK4(P, BASE, OUT) do { u32x4 w = {cvt_pk_bf16(P[BASE + 0], P[BASE + 1]), cvt_pk_bf16(P[BASE + 2], P[BASE + 3]), cvt_pk_bf16(P[BASE + 4], P[BASE + 5]), cvt_pk_bf16(P[BASE + 6], P[BASE + 7])}; \
    OUT = *reinterpret_cast<bf16x8*>(&w); } while (0)
  PK4(p0, 0, pa0); PK4(p0, 8, pa1); PK4(p1, 0, pa2); PK4(p1, 8, pa3);
#undef PK4
}
__device__ __forceinline__ void qkt(f32x16& p0, f32x16& p1, const char* Ks, const bf16x8* qr, int r32, int hi) {
  p0 = f32x16{}; p1 = f32x16{};
#pragma unroll
  for (int d0 = 0; d0 < 4; ++d0) { const int cb = (d0 * 16 + hi * 8) * 2;
    bf16x8 b0 = *reinterpret_cast<const bf16x8*>(Ks + r32 * KROW + cb);
    bf16x8 b1 = *reinterpret_cast<const bf16x8*>(Ks + (32 + r32) * KROW + cb);
    p0 = __builtin_amdgcn_mfma_f32_32x32x16_bf16(b0, qr[d0], p0, 0, 0, 0);
    p1 = __builtin_amdgcn_mfma_f32_32x32x16_bf16(b1, qr[d0], p1, 0, 0, 0); }
}
__device__ __forceinline__ int v_st(int k, int c) { const int kk = k; return ((kk >> 3) * 4 + (c >> 5)) * 512 + ((kk & 7) * 32 + (c & 31)) * 2; }
__device__ __forceinline__ int v_rd_base(int lane) { return ((lane & 3) << 3) | (((lane >> 2) & 3) << 6) | (((lane >> 4) & 1) << 5) | (((lane >> 5) & 1) << 8); }
constexpr int v_rd_off(int d0, int ks, int half) { return d0 * 512 + ks * 4096 + half * 2048; }
template <int OFF> __device__ __forceinline__ s16x4 tr_read(int vb) {
  s16x4 r; asm volatile("ds_read_b64_tr_b16 %0, %1 offset:%2" : "=&v"(r) : "v"(vb), "i"(OFF) : "memory"); return r;
}
template <int D0> __device__ __forceinline__ void pv_one(f32x16& od, int vb, bf16x8 pa0, bf16x8 pa1, bf16x8 pa2, bf16x8 pa3) {
  const s16x4 l0 = tr_read<v_rd_off(D0, 0, 0)>(vb), h0 = tr_read<v_rd_off(D0, 0, 1)>(vb), l1 = tr_read<v_rd_off(D0, 1, 0)>(vb), h1 = tr_read<v_rd_off(D0, 1, 1)>(vb);
  const s16x4 l2 = tr_read<v_rd_off(D0, 2, 0)>(vb), h2 = tr_read<v_rd_off(D0, 2, 1)>(vb), l3 = tr_read<v_rd_off(D0, 3, 0)>(vb), h3 = tr_read<v_rd_off(D0, 3, 1)>(vb);
  asm volatile("s_waitcnt lgkmcnt(0)" ::: "memory"); SBAR();
#define PK(L, H) (bf16x8){L[0], L[1], L[2], L[3], H[0], H[1], H[2], H[3]}
  od = __builtin_amdgcn_mfma_f32_32x32x16_bf16(pa0, PK(l0, h0), od, 0, 0, 0);
  od = __builtin_amdgcn_mfma_f32_32x32x16_bf16(pa1, PK(l1, h1), od, 0, 0, 0);
  od = __builtin_amdgcn_mfma_f32_32x32x16_bf16(pa2, PK(l2, h2), od, 0, 0, 0);
  od = __builtin_amdgcn_mfma_f32_32x32x16_bf16(pa3, PK(l3, h3), od, 0, 0, 0);
#undef PK
}
__device__ __forceinline__ void pv_d0(f32x16* o, int vb, bf16x8 pa0, bf16x8 pa1, bf16x8 pa2, bf16x8 pa3) {
  pv_one<0>(o[0], vb, pa0, pa1, pa2, pa3); pv_one<1>(o[1], vb, pa0, pa1, pa2, pa3); pv_one<2>(o[2], vb, pa0, pa1, pa2, pa3); pv_one<3>(o[3], vb, pa0, pa1, pa2, pa3);
}
__device__ __forceinline__ void attn_unit(const bf16_t* __restrict__ Qb, const bf16_t* __restrict__ Kh, const bf16_t* __restrict__ Vh, bf16_t* __restrict__ Ob, int ldo, int seq, char* lds, const int tid) {
  const int wid = tid >> 6, lane = tid & 63, r32 = lane & 31, hi = lane >> 5;
  char* V_lds = lds + OFF_V; char* K_lds = lds + OFF_K;
  float* ws = (float*)(lds + OFF_WS) + wid * 64; float* li_l = ws; float* al_l = ws + 32;
  float m_reg = -1e30f, l_reg = 0; f32x16 o[4] = {}; bf16x8 qr[4];
  const bf16_t* Qw = Qb + (long)(wid * QBLK + r32) * LDQ + hi * 8;
#pragma unroll
  for (int d0 = 0; d0 < 4; ++d0) qr[d0] = *reinterpret_cast<const bf16x8*>(Qw + d0 * 16);
  const int sr = tid >> 4, sc = (tid & 15) * 8, vst0 = v_st(sr, sc), vst1 = v_st(32 + sr, sc);
  const int kr = tid >> 3, kc = (tid & 7) * 8, kst = kr * KROW + kc * 2;
  const int vb0 = (int)(uintptr_t)V_lds + v_rd_base(lane);
  struct { bf16x8 vs0, vs1, ks0; } sr_[2];
#define SLOAD(i, k0) do { sr_[i].vs0 = *reinterpret_cast<const bf16x8*>(&Vh[(long)((k0) + sr) * LDQ + sc]); sr_[i].vs1 = *reinterpret_cast<const bf16x8*>(&Vh[(long)((k0) + 32 + sr) * LDQ + sc]); \
    sr_[i].ks0 = *reinterpret_cast<const bf16x8*>(&Kh[(long)((k0) + kr) * LDQ + kc]); } while (0)
#define SWRITE(b, i) do { *(bf16x8*)(V_lds + (b) * SHM_V + vst0) = sr_[i].vs0; *(bf16x8*)(V_lds + (b) * SHM_V + vst1) = sr_[i].vs1; \
    *(bf16x8*)(K_lds + (b) * SHM_K + kst) = sr_[i].ks0; } while (0)
#define SWAIT() asm volatile("s_waitcnt vmcnt(3)" ::: "memory")
#define RESC(a) do { if (__any((a) < 1.f)) { if (hi == 0) al_l[r32] = (a); asm volatile("s_waitcnt lgkmcnt(0)" ::: "memory"); \
    _Pragma("unroll") for (int d = 0; d < 4; ++d) _Pragma("unroll") for (int r = 0; r < 16; ++r) o[d][r] *= al_l[crow(r, hi)]; } } while (0)
  f32x16 pA0, pA1, pB0, pB1; float mnA, mnB, alA, alB; bf16x8 pa0, pa1, pa2, pa3; const int NT = seq / KVBLK;
  constexpr int SE = 0, SO = 1;
  SLOAD(SE, 0); asm volatile("s_waitcnt vmcnt(0)" ::: "memory"); SWRITE(0, SE); __syncthreads();
  qkt(pA0, pA1, K_lds, qr, r32, hi); partialSM(pA0, pA1, m_reg, mnA, alA);
  SLOAD(SO, KVBLK); if (2 < NT) SLOAD(SE, 2 * KVBLK);
  SWAIT(); SWRITE(1, SO); __syncthreads();
  for (int j = 1; j + 1 < NT; j += 2) {
    SBAR(); qkt(pB0, pB1, K_lds + SHM_K, qr, r32, hi);
    finishSM(pA0, pA1, alA, l_reg, pa0, pa1, pa2, pa3); SBAR();
    SLOAD(SO, (j + 2) * KVBLK); SBAR();
    pv_d0(o, vb0, pa0, pa1, pa2, pa3); partialSM(pB0, pB1, m_reg, mnB, alB);
    __syncthreads(); SWAIT(); SWRITE(0, SE);
    RESC(alB); __syncthreads();
    SBAR(); qkt(pA0, pA1, K_lds, qr, r32, hi);
    finishSM(pB0, pB1, alB, l_reg, pa0, pa1, pa2, pa3); SBAR();
    if (j + 3 < NT) SLOAD(SE, (j + 3) * KVBLK); SBAR();
    pv_d0(o, vb0 + SHM_V, pa0, pa1, pa2, pa3); partialSM(pA0, pA1, m_reg, mnA, alA);
    __syncthreads(); SWAIT(); SWRITE(1, SO);
    RESC(alA); __syncthreads();
  }
  SBAR(); qkt(pB0, pB1, K_lds + SHM_K, qr, r32, hi);
  finishSM(pA0, pA1, alA, l_reg, pa0, pa1, pa2, pa3); SBAR();
  pv_d0(o, vb0, pa0, pa1, pa2, pa3); partialSM(pB0, pB1, m_reg, mnB, alB);
  __syncthreads(); RESC(alB);
  finishSM(pB0, pB1, alB, l_reg, pa0, pa1, pa2, pa3); SBAR();
  pv_d0(o, vb0 + SHM_V, pa0, pa1, pa2, pa3);
  if (hi == 0) li_l[r32] = l_reg; asm volatile("s_waitcnt lgkmcnt(0)" ::: "memory");
  float rli[16];
#pragma unroll
  for (int r = 0; r < 16; ++r) rli[r] = __builtin_amdgcn_rcpf(li_l[crow(r, hi)]);
  { bf16_t* stg = (bf16_t*)(lds + OFF_OST) + wid * 4096;
#pragma unroll
    for (int r = 0; r < 16; ++r) { const int orow = crow(r, hi);
#pragma unroll
      for (int d0 = 0; d0 < 4; ++d0) stg[orow * 128 + d0 * 32 + r32] = (bf16_t)(cvt_pk_bf16(o[d0][r] * rli[r], 0.f) & 0xffffu); }
    asm volatile("s_waitcnt lgkmcnt(0)" ::: "memory");
    bf16_t* Ow = Ob + (long)(wid * QBLK) * ldo;
#pragma unroll
    for (int i = 0; i < 8; ++i) { const int row = i * 4 + (lane >> 4), ch = lane & 15; const u32x4 v = *(const u32x4*)(stg + row * 128 + ch * 8); *(u32x4*)(Ow + (long)row * ldo + ch * 8) = v; } }
  __syncthreads();
#undef SLOAD
#undef SWRITE
#undef SWAIT
#undef RESC
}
#undef SBAR
}


namespace att2 {
using bf16x8 = __attribute__((ext_vector_type(8))) short;
using s16x4  = __attribute__((ext_vector_type(4))) short;
using f32x16 = __attribute__((ext_vector_type(16))) float;
constexpr int NW = 8, QBLK = 32, KVBLK = 64, LDQ = 1024, LDK = 64, LDV = 128;
constexpr int KSL = 8192, VSL = 16384, K_OFF = 0, V_OFF = 3 * KSL, OFF_WS = V_OFF + 4 * VSL, ATT_LDS = OFF_WS + NW * 64 * 4;
constexpr float THRL = 8.f;
#define SBAR() __builtin_amdgcn_sched_barrier(0)
__device__ __forceinline__ int crow(int r, int hi) { return (r & 3) + 8 * (r >> 2) + 4 * hi; }
__device__ __forceinline__ int v_rd_base(int lane) { return ((lane & 3) << 3) | (((lane >> 2) & 3) << 6) | (((lane >> 4) & 1) << 5) | (((lane >> 5) & 1) << 8); }
constexpr int v_rd_off(int d0, int ks, int half) { return d0 * 512 + ks * 4096 + half * 2048; }
template <int OFF> __device__ __forceinline__ s16x4 tr_read(int vb) {
  s16x4 r; asm volatile("ds_read_b64_tr_b16 %0, %1 offset:%2" : "=&v"(r) : "v"(vb), "i"(OFF) : "memory"); return r;
}
template <int D0> __device__ __forceinline__ void pv_one(f32x16& od, int vb, bf16x8 pa0, bf16x8 pa1, bf16x8 pa2, bf16x8 pa3) {
  const s16x4 l0 = tr_read<v_rd_off(D0, 0, 0)>(vb), h0 = tr_read<v_rd_off(D0, 0, 1)>(vb), l1 = tr_read<v_rd_off(D0, 1, 0)>(vb), h1 = tr_read<v_rd_off(D0, 1, 1)>(vb);
  const s16x4 l2 = tr_read<v_rd_off(D0, 2, 0)>(vb), h2 = tr_read<v_rd_off(D0, 2, 1)>(vb), l3 = tr_read<v_rd_off(D0, 3, 0)>(vb), h3 = tr_read<v_rd_off(D0, 3, 1)>(vb);
  asm volatile("s_waitcnt lgkmcnt(0)" ::: "memory"); SBAR();
#define PK(L, H) (bf16x8){L[0], L[1], L[2], L[3], H[0], H[1], H[2], H[3]}
  od = __builtin_amdgcn_mfma_f32_32x32x16_bf16(pa0, PK(l0, h0), od, 0, 0, 0);
  od = __builtin_amdgcn_mfma_f32_32x32x16_bf16(pa1, PK(l1, h1), od, 0, 0, 0);
  od = __builtin_amdgcn_mfma_f32_32x32x16_bf16(pa2, PK(l2, h2), od, 0, 0, 0);
  od = __builtin_amdgcn_mfma_f32_32x32x16_bf16(pa3, PK(l3, h3), od, 0, 0, 0);
#undef PK
}
struct VFrag { s16x4 l0, h0, l1, h1, l2, h2, l3, h3; };
template <int D0> __device__ __forceinline__ void v_issue(VFrag& f, int vb) {
  f.l0 = tr_read<v_rd_off(D0, 0, 0)>(vb); f.h0 = tr_read<v_rd_off(D0, 0, 1)>(vb); f.l1 = tr_read<v_rd_off(D0, 1, 0)>(vb); f.h1 = tr_read<v_rd_off(D0, 1, 1)>(vb);
  f.l2 = tr_read<v_rd_off(D0, 2, 0)>(vb); f.h2 = tr_read<v_rd_off(D0, 2, 1)>(vb); f.l3 = tr_read<v_rd_off(D0, 3, 0)>(vb); f.h3 = tr_read<v_rd_off(D0, 3, 1)>(vb);
}
template <int WAITN> __device__ __forceinline__ void pv_mma(f32x16& od, const VFrag& f, bf16x8 pa0, bf16x8 pa1, bf16x8 pa2, bf16x8 pa3) {
  if (WAITN == 8) asm volatile("s_waitcnt lgkmcnt(8)" ::: "memory"); else asm volatile("s_waitcnt lgkmcnt(0)" ::: "memory");
  SBAR();
#define PK(L, H) (bf16x8){L[0], L[1], L[2], L[3], H[0], H[1], H[2], H[3]}
  od = __builtin_amdgcn_mfma_f32_32x32x16_bf16(pa0, PK(f.l0, f.h0), od, 0, 0, 0);
  od = __builtin_amdgcn_mfma_f32_32x32x16_bf16(pa1, PK(f.l1, f.h1), od, 0, 0, 0);
  od = __builtin_amdgcn_mfma_f32_32x32x16_bf16(pa2, PK(f.l2, f.h2), od, 0, 0, 0);
  od = __builtin_amdgcn_mfma_f32_32x32x16_bf16(pa3, PK(f.l3, f.h3), od, 0, 0, 0);
#undef PK
}
__device__ __forceinline__ void pv_pipe(f32x16* o, int vb, bf16x8 pa0, bf16x8 pa1, bf16x8 pa2, bf16x8 pa3) {
  VFrag f0, f1;
  v_issue<0>(f0, vb); SBAR();
  v_issue<1>(f1, vb); SBAR(); pv_mma<8>(o[0], f0, pa0, pa1, pa2, pa3); SBAR();
  v_issue<2>(f0, vb); SBAR(); pv_mma<8>(o[1], f1, pa0, pa1, pa2, pa3); SBAR();
  v_issue<3>(f1, vb); SBAR(); pv_mma<8>(o[2], f0, pa0, pa1, pa2, pa3); SBAR();
  pv_mma<0>(o[3], f1, pa0, pa1, pa2, pa3);
}
__device__ __forceinline__ void qkt(f32x16& p0, f32x16& p1, const LAS unsigned char* Ks, const bf16x8* qr, const f32x16& cinit, int r32, int hi) {
  const LAS unsigned char* kb0 = Ks + r32 * 128; const int sw = r32 & 7;
#pragma unroll
  for (int d0 = 0; d0 < 4; ++d0) { const int ch = ((2 * d0 + hi) ^ sw) << 4;
    const bf16x8 b0 = *(const LAS bf16x8*)(kb0 + ch), b1 = *(const LAS bf16x8*)(kb0 + 4096 + ch);
    if (d0 == 0) { p0 = __builtin_amdgcn_mfma_f32_32x32x16_bf16(b0, qr[0], cinit, 0, 0, 0); p1 = __builtin_amdgcn_mfma_f32_32x32x16_bf16(b1, qr[0], cinit, 0, 0, 0); }
    else { p0 = __builtin_amdgcn_mfma_f32_32x32x16_bf16(b0, qr[d0], p0, 0, 0, 0); p1 = __builtin_amdgcn_mfma_f32_32x32x16_bf16(b1, qr[d0], p1, 0, 0, 0); } }
}
__device__ __forceinline__ float rowmax(const f32x16& p0, const f32x16& p1) {
  float a = fmaxf(fmaxf(p0[0], p0[1]), p1[0]), b = fmaxf(fmaxf(p0[2], p0[3]), p1[1]); a = fmaxf(fmaxf(a, p1[2]), p1[3]);
#pragma unroll
  for (int r = 4; r < 16; r += 4) { a = fmaxf(fmaxf(a, p0[r]), p0[r + 1]); b = fmaxf(fmaxf(b, p0[r + 2]), p0[r + 3]); a = fmaxf(fmaxf(a, p1[r]), p1[r + 1]); b = fmaxf(fmaxf(b, p1[r + 2]), p1[r + 3]); }
  const float m = fmaxf(a, b);
  auto rr = __builtin_amdgcn_permlane32_swap(__float_as_uint(m), __float_as_uint(m), false, false);
  return fmaxf(__uint_as_float(rr[0]), __uint_as_float(rr[1]));
}
#define A2_PK4(P, BASE, OUT) do { u32x4 w_ = {cvt_pk_bf16(P[BASE + 0], P[BASE + 1]), cvt_pk_bf16(P[BASE + 2], P[BASE + 3]), cvt_pk_bf16(P[BASE + 4], P[BASE + 5]), cvt_pk_bf16(P[BASE + 6], P[BASE + 7])}; \
    OUT = *reinterpret_cast<bf16x8*>(&w_); } while (0)

__device__ __forceinline__ void attn_unit(const bf16_t* __restrict__ Qb, const bf16_t* __restrict__ Kh, const bf16_t* __restrict__ Vh, bf16_t* __restrict__ Ob, int ldo, int seq, LAS unsigned char* lds, const int tid) {
  const int wid = __builtin_amdgcn_readfirstlane(tid >> 6), lane = tid & 63, r32 = lane & 31, hi = lane >> 5;
  LAS float* ws = (LAS float*)(lds + OFF_WS) + wid * 64;
  const unsigned koff = (unsigned)(((8 * wid + (lane >> 3)) * LDK + (((lane & 7) ^ (lane >> 3)) * 8)) * 2);
  const unsigned voff = (unsigned)(((8 * wid + ((lane & 31) >> 2)) * LDV + 32 * (lane >> 5) + 8 * (lane & 3)) * 2);
#define A2_DMA(t, ks, vs) do { const char* kb_ = (const char*)Kh + (size_t)(t) * (KVBLK * LDK * 2); const char* vb_ = (const char*)Vh + (size_t)(t) * (KVBLK * LDV * 2); \
    __builtin_amdgcn_global_load_lds((const unsigned*)(kb_ + koff), (LAS unsigned*)(lds + K_OFF + (ks) + wid * 1024), 16, 0, 0); \
    __builtin_amdgcn_global_load_lds((const unsigned*)(vb_ + voff), (LAS unsigned*)(lds + V_OFF + (vs) + wid * 2048), 16, 0, 0); \
    __builtin_amdgcn_global_load_lds((const unsigned*)(vb_ + voff + 128), (LAS unsigned*)(lds + V_OFF + (vs) + wid * 2048 + 1024), 16, 0, 0); } while (0)
#define A2_WAITBAR() do { asm volatile("s_waitcnt vmcnt(0) lgkmcnt(0)" ::: "memory"); __builtin_amdgcn_s_barrier(); asm volatile("" ::: "memory"); } while (0)
  const int NT = seq / KVBLK;
  const bool trail = wid >= 4;
  A2_DMA(0, 0, 0); A2_DMA(1, KSL, VSL);
  bf16x8 qr[4];
  { const bf16_t* Qw = Qb + (long)(wid * QBLK + r32) * LDQ + hi * 8;
#pragma unroll
    for (int d0 = 0; d0 < 4; ++d0) qr[d0] = *reinterpret_cast<const bf16x8*>(Qw + d0 * 16); }
  float mhat = 0.f, l_reg = 0.f; f32x16 o[4] = {}; f32x16 negm = {};
  const int vbase = (int)(uintptr_t)(lds + V_OFF) + v_rd_base(lane);
  A2_WAITBAR();
  if (NT > 2) A2_DMA(2, 2 * KSL, 2 * VSL);
  f32x16 pA0, pA1, pB0, pB1; bf16x8 pa0, pa1, pa2, pa3;
  qkt(pA0, pA1, lds + K_OFF, qr, negm, r32, hi);
  { const float rm = rowmax(pA0, pA1); mhat = rm;
#pragma unroll
    for (int r = 0; r < 16; ++r) { pA0[r] -= rm; pA1[r] -= rm; negm[r] = -rm; }
#pragma unroll
    for (int r = 0; r < 16; ++r) { pA0[r] = __builtin_amdgcn_exp2f(pA0[r]); pA1[r] = __builtin_amdgcn_exp2f(pA1[r]); } }
  int k_cur = KSL, k_dma = 0;
  int v_prev = 0, v_dma = 3 * VSL;
#define A2_ROT() do { k_cur = (k_cur == 2 * KSL) ? 0 : k_cur + KSL; k_dma = (k_dma == 2 * KSL) ? 0 : k_dma + KSL; v_prev = (v_prev == 3 * VSL) ? 0 : v_prev + VSL; v_dma = (v_dma == 3 * VSL) ? 0 : v_dma + VSL; } while (0)
#define A2_SEAM(t) do { A2_WAITBAR(); if ((t) + 2 < NT) A2_DMA((t) + 2, k_dma, v_dma); } while (0)
#define A2_EXP(X, i) X[i] = __builtin_amdgcn_exp2f(X[i])
#define A2_SG(mask, n) __builtin_amdgcn_sched_group_barrier(mask, n, 0)
#define A2_STEP(C0, C1, P0, P1, t) do { bool resc_ = false; \
    SBAR(); \
      \
    qkt(C0, C1, lds + K_OFF + k_cur, qr, negm, r32, hi); \
    { float sa_ = 0.f, sb_ = 0.f; _Pragma("unroll") for (int r = 0; r < 16; ++r) { sa_ += P0[r]; sb_ += P1[r]; } l_reg += sa_ + sb_; } \
    A2_PK4(P0, 0, pa0); A2_PK4(P0, 8, pa1); A2_PK4(P1, 0, pa2); A2_PK4(P1, 8, pa3); \
    A2_SG(0x100, 2); A2_SG(0x100, 2); A2_SG(0x8, 1); A2_SG(0x402, 6); A2_SG(0x8, 1); A2_SG(0x402, 6); A2_SG(0x100, 2); A2_SG(0x8, 1); A2_SG(0x402, 6); A2_SG(0x8, 1); A2_SG(0x402, 6); \
    A2_SG(0x100, 2); A2_SG(0x8, 1); A2_SG(0x402, 6); A2_SG(0x8, 1); A2_SG(0x402, 6); A2_SG(0x8, 1); A2_SG(0x402, 6); A2_SG(0x8, 1); A2_SG(0x402, 6); \
    if (MK_ATT_XMFMA) { f32x16 dz_ = negm; _Pragma("unroll") for (int x_ = 0; x_ < 8; ++x_) asm volatile("v_mfma_f32_32x32x16_bf16 %0, %1, %2, %0" : "+v"(dz_) : "v"(qr[x_ & 3]), "v"(qr[(x_ + 1) & 3])); asm volatile("" :: "v"(dz_)); } \
    if (MK_ATT_XEXP) { float dx_ = mhat; _Pragma("unroll") for (int x_ = 0; x_ < 32; ++x_) asm volatile("v_exp_f32 %0, %0" : "+v"(dx_)); asm volatile("" :: "v"(dx_)); } \
    asm volatile("" : "+v"(l_reg), "+v"(pa0), "+v"(pa1), "+v"(pa2), "+v"(pa3)); SBAR(); \
    if (trail) A2_SEAM(t); \
    { const int vb_ = vbase + v_prev; VFrag f0_, f1_; \
        \
      v_issue<0>(f0_, vb_); v_issue<1>(f1_, vb_); SBAR(); \
      pv_mma<8>(o[0], f0_, pa0, pa1, pa2, pa3); \
      { const float rm_ = rowmax(C0, C1); \
        if (__builtin_expect(__any(rm_ > THRL), 0)) { const float dl_ = fmaxf(rm_, 0.f); mhat += dl_; \
          _Pragma("unroll") for (int r = 0; r < 16; ++r) { C0[r] -= dl_; C1[r] -= dl_; negm[r] = -mhat; } \
          const float f_ = __builtin_amdgcn_exp2f(-dl_); l_reg *= f_; if (hi == 0) ws[r32] = f_; resc_ = true; } } \
      SBAR(); \
        \
      v_issue<2>(f0_, vb_); SBAR(); pv_mma<8>(o[1], f1_, pa0, pa1, pa2, pa3); \
      A2_EXP(C0, 0); A2_EXP(C0, 1); A2_EXP(C0, 2); A2_EXP(C0, 3); A2_EXP(C0, 4); A2_EXP(C0, 5); A2_EXP(C0, 6); A2_EXP(C0, 7); A2_EXP(C0, 8); A2_EXP(C0, 9); A2_EXP(C0, 10); \
      A2_SG(0x8, 1); A2_SG(0x402, 3); A2_SG(0x8, 1); A2_SG(0x402, 3); A2_SG(0x8, 1); A2_SG(0x402, 3); A2_SG(0x8, 1); A2_SG(0x402, 3); \
      asm volatile("" : "+v"(C0)); SBAR(); \
      v_issue<3>(f1_, vb_); SBAR(); pv_mma<8>(o[2], f0_, pa0, pa1, pa2, pa3); \
      A2_EXP(C0, 11); A2_EXP(C0, 12); A2_EXP(C0, 13); A2_EXP(C0, 14); A2_EXP(C0, 15); A2_EXP(C1, 0); A2_EXP(C1, 1); A2_EXP(C1, 2); A2_EXP(C1, 3); A2_EXP(C1, 4); A2_EXP(C1, 5); \
      A2_SG(0x8, 1); A2_SG(0x402, 3); A2_SG(0x8, 1); A2_SG(0x402, 3); A2_SG(0x8, 1); A2_SG(0x402, 3); A2_SG(0x8, 1); A2_SG(0x402, 3); \
      asm volatile("" : "+v"(C0), "+v"(C1)); SBAR(); \
      pv_mma<0>(o[3], f1_, pa0, pa1, pa2, pa3); \
      A2_EXP(C1, 6); A2_EXP(C1, 7); A2_EXP(C1, 8); A2_EXP(C1, 9); A2_EXP(C1, 10); A2_EXP(C1, 11); A2_EXP(C1, 12); A2_EXP(C1, 13); A2_EXP(C1, 14); A2_EXP(C1, 15); \
      A2_SG(0x8, 1); A2_SG(0x402, 3); A2_SG(0x8, 1); A2_SG(0x402, 3); A2_SG(0x8, 1); A2_SG(0x402, 3); A2_SG(0x8, 1); A2_SG(0x402, 3); \
      asm volatile("" : "+v"(C1)); SBAR(); } \
    if (resc_) { asm volatile("s_waitcnt lgkmcnt(0)" ::: "memory"); \
      _Pragma("unroll") for (int d_ = 0; d_ < 4; ++d_) _Pragma("unroll") for (int r = 0; r < 16; ++r) o[d_][r] *= ws[crow(r, hi)]; } \
    if (!trail) A2_SEAM(t); \
    A2_ROT(); } while (0)
  int t = 1;
  for (; t + 1 < NT; t += 2) { A2_STEP(pB0, pB1, pA0, pA1, t); A2_STEP(pA0, pA1, pB0, pB1, t + 1); }
  A2_STEP(pB0, pB1, pA0, pA1, t);
  { float sa_ = 0.f, sb_ = 0.f;
#pragma unroll
    for (int r = 0; r < 16; ++r) { sa_ += pB0[r]; sb_ += pB1[r]; }
    l_reg += sa_ + sb_;
    A2_PK4(pB0, 0, pa0); A2_PK4(pB0, 8, pa1); A2_PK4(pB1, 0, pa2); A2_PK4(pB1, 8, pa3);
    SBAR(); const int vb_ = vbase + v_prev;
    pv_pipe(o, vb_, pa0, pa1, pa2, pa3); }
  { auto rr = __builtin_amdgcn_permlane32_swap(__float_as_uint(l_reg), __float_as_uint(l_reg), false, false); l_reg = __uint_as_float(rr[0]) + __uint_as_float(rr[1]); }
  if (hi == 0) ws[32 + r32] = l_reg;
  A2_WAITBAR();
  float rli[16];
#pragma unroll
  for (int r = 0; r < 16; ++r) rli[r] = __builtin_amdgcn_rcpf(ws[32 + crow(r, hi)]);
  { LAS bf16_t* stg = (LAS bf16_t*)lds + wid * 4096;
#pragma unroll
    for (int r = 0; r < 16; ++r) { const int orow = crow(r, hi);
#pragma unroll
      for (int d0 = 0; d0 < 4; ++d0) stg[orow * 128 + d0 * 32 + r32] = (bf16_t)(cvt_pk_bf16(o[d0][r] * rli[r], 0.f) & 0xffffu); }
    asm volatile("s_waitcnt lgkmcnt(0)" ::: "memory");
    bf16_t* Ow = Ob + (long)(wid * QBLK) * ldo;
#pragma unroll
    for (int i = 0; i < 8; ++i) { const int row = i * 4 + (lane >> 4), ch = lane & 15; const u32x4 v = *(const LAS u32x4*)(stg + row * 128 + ch * 8); *(u32x4*)(Ow + (long)row * ldo + ch * 8) = v; } }
  A2_WAITBAR();
#undef A2_DMA
#undef A2_WAITBAR
#undef A2_ROT
#undef A2_SEAM
#undef A2_STEP
#undef A2_EXP
#undef A2_SG
}
#undef A2_PK4
#undef SBAR
}


namespace att3 {
using f32x16 = __attribute__((ext_vector_type(16))) float;
typedef int v8i __attribute__((ext_vector_type(8)));
typedef int v4i __attribute__((ext_vector_type(4)));
constexpr int NW = 8, QBLK = 32, KVBLK = 64;
constexpr int KSL = 8192, VSL = 16384, K_OFF = 0, V_OFF = 3 * KSL, OFF_WS = V_OFF + 3 * VSL, OFF_Q = OFF_WS + NW * 64 * 4, OFF_ONES = OFF_Q + NW * 2048, ATT_LDS = OFF_ONES + 64;
constexpr float THRL = 8.f;
constexpr int SC_ONE = 0x7f7f7f7f, SC_Q = 0x7b7b7b7b;
#define SBAR() __builtin_amdgcn_sched_barrier(0)
__device__ __forceinline__ int crow(int r, int hi) { return (r & 3) + 8 * (r >> 2) + 4 * hi; }
__host__ __device__ __forceinline__ int slot_key(int s) { const int hi = s >> 5, j = s & 31, jj = j & 15; return (j >> 4) * 32 + (jj & 3) + 8 * (jj >> 2) + 4 * hi; }
__device__ __forceinline__ v8i ld32(const LAS unsigned char* rowp, int c0, int sw) {
    const v4i a = *(const LAS v4i*)(rowp + ((c0 ^ sw) << 4)), b = *(const LAS v4i*)(rowp + (((c0 + 1) ^ sw) << 4));
    return (v8i){a[0], a[1], a[2], a[3], b[0], b[1], b[2], b[3]};
}
__device__ __forceinline__ void qkt(f32x16& p0, f32x16& p1, const LAS unsigned char* Ks, const v8i& qf, const f32x16& cinit, int r32, int hi) {
    const int sw = (r32 >> 2) & 3;
    const v8i k0 = ld32(Ks + r32 * 64, 2 * hi, sw), k1 = ld32(Ks + (32 + r32) * 64, 2 * hi, sw);
    p0 = __builtin_amdgcn_mfma_scale_f32_32x32x64_f8f6f4(k0, qf, cinit, 0, 0, 0, SC_ONE, 0, SC_Q);
    p1 = __builtin_amdgcn_mfma_scale_f32_32x32x64_f8f6f4(k1, qf, cinit, 0, 0, 0, SC_ONE, 0, SC_Q);
}
__device__ __forceinline__ float lanemax(const f32x16& p0, const f32x16& p1) {
  float a = fmaxf(fmaxf(p0[0], p0[1]), p1[0]), b = fmaxf(fmaxf(p0[2], p0[3]), p1[1]); a = fmaxf(fmaxf(a, p1[2]), p1[3]);
#pragma unroll
  for (int r = 4; r < 16; r += 4) { a = fmaxf(fmaxf(a, p0[r]), p0[r + 1]); b = fmaxf(fmaxf(b, p0[r + 2]), p0[r + 3]); a = fmaxf(fmaxf(a, p1[r]), p1[r + 1]); b = fmaxf(fmaxf(b, p1[r + 2]), p1[r + 3]); }
  return fmaxf(a, b);
}
__device__ __forceinline__ float rowmax4(const f32x16& p0, const f32x16& p1, const f32x16& p2, const f32x16& p3) {
  const float m = fmaxf(lanemax(p0, p1), lanemax(p2, p3));
  auto rr = __builtin_amdgcn_permlane32_swap(__float_as_uint(m), __float_as_uint(m), false, false);
  return fmaxf(__uint_as_float(rr[0]), __uint_as_float(rr[1]));
}
__device__ __forceinline__ v8i pack_p(const f32x16& p0, const f32x16& p1) {
    v8i w;
    w[0] = (int)cvt4_fp8_nc(p0[0], p0[1], p0[2], p0[3]); w[1] = (int)cvt4_fp8_nc(p0[4], p0[5], p0[6], p0[7]); w[2] = (int)cvt4_fp8_nc(p0[8], p0[9], p0[10], p0[11]); w[3] = (int)cvt4_fp8_nc(p0[12], p0[13], p0[14], p0[15]);
    w[4] = (int)cvt4_fp8_nc(p1[0], p1[1], p1[2], p1[3]); w[5] = (int)cvt4_fp8_nc(p1[4], p1[5], p1[6], p1[7]); w[6] = (int)cvt4_fp8_nc(p1[8], p1[9], p1[10], p1[11]); w[7] = (int)cvt4_fp8_nc(p1[12], p1[13], p1[14], p1[15]);
    return w;
}
__device__ __forceinline__ void qk1(f32x16& d, const v8i& kop, const v8i& qf, const f32x16& c) {
    asm volatile("s_nop 1\n\tv_mfma_scale_f32_32x32x64_f8f6f4 %0, %1, %2, %3, %4, %5 op_sel_hi:[0,0,0]" : "=&v"(d) : "v"(kop), "v"(qf), "v"(c), "v"(SC_ONE), "v"(SC_Q));
}
__device__ __forceinline__ void pv1(f32x16& od, const v8i& pf, const v8i& vf) {
    asm volatile("s_nop 1\n\tv_mfma_scale_f32_32x32x64_f8f6f4 %0, %1, %2, %0, %3, %3 op_sel_hi:[0,0,0]" : "+v"(od) : "v"(pf), "v"(vf), "v"(SC_ONE));
}

__device__ __forceinline__ void attn_unit(const unsigned char* __restrict__ Q8b, const unsigned char* __restrict__ K8h0, size_t kmap_stride, const unsigned char* __restrict__ VT8h, bf16_t* __restrict__ AOb, int ldo, int seq,
                                          float lam, float osc, const float* __restrict__ subln, u32x4* __restrict__ o0g, LAS unsigned char* lds, const int tid) {
  const int wid = __builtin_amdgcn_readfirstlane(tid >> 6), lane = tid & 63, r32 = lane & 31, hi = lane >> 5;
  LAS float* ws = (LAS float*)(lds + OFF_WS) + wid * 64;
  const int prow = 16 * wid + (lane >> 2); const unsigned poff = (unsigned)(prow * 64 + (((lane & 3) ^ ((prow >> 2) & 3)) << 4));
#define A3_MFMA_FENCE() asm volatile("s_nop 15\n\ts_nop 15" : "+v"(o[0]), "+v"(o[1]), "+v"(o[2]), "+v"(o[3]), "+v"(osum))
#define A3_WAITBAR() do { asm volatile("s_waitcnt vmcnt(0) lgkmcnt(0)" ::: "memory"); __builtin_amdgcn_s_barrier(); asm volatile("" ::: "memory"); } while (0)
  const int NT2 = seq / 128;
  const int half = wid >> 2;
#define A3_DMAK(t) __builtin_amdgcn_global_load_lds((const unsigned*)(K8h + (size_t)(t) * 8192 + poff), (LAS unsigned*)(lds + K_OFF + ((t) % 3) * KSL + wid * 1024), 16, 0, 0)
#define A3_DMAV(t) do { __builtin_amdgcn_global_load_lds((const unsigned*)(VT8h + (size_t)(t) * 16384 + poff), (LAS unsigned*)(lds + V_OFF + ((t) % 3) * VSL + wid * 1024), 16, 0, 0); \
    __builtin_amdgcn_global_load_lds((const unsigned*)(VT8h + (size_t)(t) * 16384 + 8192 + poff), (LAS unsigned*)(lds + V_OFF + ((t) % 3) * VSL + 8192 + wid * 1024), 16, 0, 0); } while (0)
  f32x16 o[4]; f32x16 osum;
  for (int mp = 0; mp < 2; ++mp) {
  const unsigned char* K8h = K8h0 + (size_t)mp * kmap_stride;
  A3_DMAK(0); A3_DMAK(1); A3_DMAV(0);
  LAS v4i* qs = (LAS v4i*)(lds + OFF_Q + wid * 2048) + lane;
  { int lq_; asm volatile("v_mbcnt_lo_u32_b32 %0, -1, 0\n\tv_mbcnt_hi_u32_b32 %0, -1, %0" : "=v"(lq_));
    const unsigned char* Qw = Q8b + mp * 64 + (size_t)(wid * QBLK + (lq_ & 31)) * 1024 + (lq_ >> 5) * 32; const v4i a = *(const v4i*)Qw, b = *(const v4i*)(Qw + 16); qs[0] = a; qs[64] = b; }
#define A3_LDQ(buf) do { const v4i qa_ = qs[0], qb_ = qs[64]; buf = (v8i){qa_[0], qa_[1], qa_[2], qa_[3], qb_[0], qb_[1], qb_[2], qb_[3]}; } while (0)
  f32x16 negm = {};
#pragma unroll
  for (int r = 0; r < 16; ++r) { o[0][r] = 0.f; o[1][r] = 0.f; o[2][r] = 0.f; o[3][r] = 0.f; osum[r] = 0.f; }
  if (wid == 0 && lane < 8) *(LAS unsigned*)(lds + OFF_ONES + 4 * lane) = 0x38383838u;
#define A3_LD1(buf) do { const v4i oa_ = *(const LAS v4i*)(lds + OFF_ONES), ob_ = *(const LAS v4i*)(lds + OFF_ONES + 16); buf = (v8i){oa_[0], oa_[1], oa_[2], oa_[3], ob_[0], ob_[1], ob_[2], ob_[3]}; } while (0)
  const int swv = (r32 >> 2) & 3;
  A3_WAITBAR();
  if (NT2 > 2) A3_DMAK(2);
  A3_DMAV(1);
  f32x16 C0 = negm, C1 = negm, C2 = negm, C3 = negm; v8i pf0 = {}, pf1 = {};
#define A3_BAR_ODD() do { asm volatile("s_waitcnt lgkmcnt(0)" ::: "memory"); __builtin_amdgcn_s_barrier(); asm volatile("" ::: "memory"); } while (0)
#define A3_BAR_EVEN(m) do { if ((m) + 1 < NT2) asm volatile("s_waitcnt vmcnt(3) lgkmcnt(0)" ::: "memory"); else asm volatile("s_waitcnt vmcnt(0) lgkmcnt(0)" ::: "memory"); \
    __builtin_amdgcn_s_barrier(); asm volatile("" ::: "memory"); if ((m) + 2 < NT2) A3_DMAK((m) + 2); if ((m) + 1 < NT2) A3_DMAV((m) + 1); } while (0)
#define A3_LD(buf, p) buf = ld32((p), 2 * hi, swv)
#define A3_W(n) asm volatile("s_waitcnt lgkmcnt(" #n ")" ::: "memory"); SBAR()
#define A3_A_FIRST() do { const LAS unsigned char* Ks_ = lds + K_OFF + r32 * 64; v8i b0_, b1_, b2_; A3_LDQ(b2_); A3_LD(b0_, Ks_); A3_LD(b1_, Ks_ + 2048); \
    A3_W(0); qk1(C0, b0_, b2_, negm); qk1(C1, b1_, b2_, negm); SBAR(); A3_LD(b0_, Ks_ + 4096); A3_LD(b1_, Ks_ + 6144); A3_W(0); qk1(C2, b0_, b2_, negm); qk1(C3, b1_, b2_, negm); SBAR(); } while (0)
#define A3_A_MID(k) do { \
    const LAS unsigned char* Ks_ = lds + K_OFF + (((k) + 1) % 3) * KSL + r32 * 64; \
    const LAS unsigned char* vt_ = lds + V_OFF + ((k) % 3) * VSL + r32 * 64; \
    __builtin_amdgcn_s_setprio(1);                                   \
    v8i b0_, b1_, b2_, b3_; A3_LDQ(b3_); A3_LD(b0_, Ks_); A3_LD(b1_, Ks_ + 2048); A3_LD(b2_, Ks_ + 4096); \
    A3_W(4); qk1(C0, b0_, b3_, negm); SBAR(); A3_LD(b0_, Ks_ + 6144); \
    A3_W(4); qk1(C1, b1_, b3_, negm); SBAR(); A3_LD(b1_, vt_); \
    A3_W(4); qk1(C2, b2_, b3_, negm); SBAR(); A3_LD(b2_, vt_ + 2048); \
    A3_W(4); qk1(C3, b0_, b3_, negm); SBAR(); A3_LD1(b3_); A3_LD(b0_, vt_ + 4096); \
    A3_W(6); pv1(o[0], pf0, b1_); SBAR(); A3_LD(b1_, vt_ + 6144); \
    A3_W(6); pv1(o[1], pf0, b2_); SBAR(); A3_LD(b2_, vt_ + 8192); \
    A3_W(6); pv1(osum, pf0, b3_); SBAR(); A3_LD(b3_, vt_ + 8192 + 2048); \
    A3_W(6); pv1(o[2], pf0, b0_); SBAR(); A3_LD1(b0_); \
    A3_W(6); pv1(o[3], pf0, b1_); SBAR(); A3_LD(b1_, vt_ + 8192 + 4096); \
    A3_W(6); pv1(o[0], pf1, b2_); SBAR(); A3_LD(b2_, vt_ + 8192 + 6144); \
    A3_W(6); pv1(o[1], pf1, b3_); \
    A3_W(4); pv1(osum, pf1, b0_); \
    A3_W(2); pv1(o[2], pf1, b1_); \
    A3_W(0); pv1(o[3], pf1, b2_); \
    __builtin_amdgcn_s_setprio(0); \
    SBAR(); } while (0)
#define A3_A_LAST(k) do { \
    const LAS unsigned char* vt_ = lds + V_OFF + ((k) % 3) * VSL + r32 * 64; \
    v8i b0_, b1_, b2_; \
    _Pragma("unroll") for (int sb_ = 0; sb_ < 2; ++sb_) { const v8i& pfs_ = sb_ ? pf1 : pf0; \
      A3_LD(b0_, vt_ + sb_ * 8192); A3_LD(b1_, vt_ + sb_ * 8192 + 2048); A3_LD1(b2_); \
      asm volatile("s_waitcnt lgkmcnt(0)\n\ts_nop 1" ::: "memory"); SBAR(); \
      pv1(o[0], pfs_, b0_); pv1(o[1], pfs_, b1_); pv1(osum, pfs_, b2_); SBAR(); \
      A3_LD(b0_, vt_ + sb_ * 8192 + 4096); A3_LD(b1_, vt_ + sb_ * 8192 + 6144); \
      asm volatile("s_waitcnt lgkmcnt(0)\n\ts_nop 1" ::: "memory"); SBAR(); \
      pv1(o[2], pfs_, b0_); pv1(o[3], pfs_, b1_); SBAR(); } \
    } while (0)
#define A3_B(FIRST) do { \
    asm volatile("s_nop 7" : "+v"(C0), "+v"(C1), "+v"(C2), "+v"(C3));     \
    const float rm_ = rowmax4(C0, C1, C2, C3); \
    if (FIRST) {                                                    \
      _Pragma("unroll") for (int r = 0; r < 16; ++r) { C0[r] -= rm_; C1[r] -= rm_; C2[r] -= rm_; C3[r] -= rm_; negm[r] = -rm_; } } \
    else if (__builtin_expect(__any(rm_ > THRL), 0)) {              \
      const float dl_ = fmaxf(rm_, 0.f); const float nm_ = negm[0] - dl_; \
      _Pragma("unroll") for (int r = 0; r < 16; ++r) { C0[r] -= dl_; C1[r] -= dl_; C2[r] -= dl_; C3[r] -= dl_; negm[r] = nm_; } \
      int lr_; asm volatile("v_mbcnt_lo_u32_b32 %0, -1, 0\n\tv_mbcnt_hi_u32_b32 %0, -1, %0" : "=v"(lr_));     \
      const int r32r_ = lr_ & 31, hir_ = lr_ >> 5; \
      const float f_ = __builtin_amdgcn_exp2f(-dl_); if (hir_ == 0) ws[r32r_] = f_; \
      asm volatile("s_waitcnt lgkmcnt(0)" ::: "memory"); A3_MFMA_FENCE(); \
      _Pragma("unroll") for (int r = 0; r < 16; ++r) { const float fr_ = ws[crow(r, hir_)]; osum[r] *= fr_; _Pragma("unroll") for (int d_ = 0; d_ < 4; ++d_) o[d_][r] *= fr_; } } \
    _Pragma("unroll") for (int r = 0; r < 16; ++r) { C0[r] = __builtin_amdgcn_exp2f(C0[r]); C1[r] = __builtin_amdgcn_exp2f(C1[r]); } \
    pf0 = pack_p(C0, C1); \
    _Pragma("unroll") for (int r = 0; r < 16; ++r) { C2[r] = __builtin_amdgcn_exp2f(C2[r]); C3[r] = __builtin_amdgcn_exp2f(C3[r]); } \
    pf1 = pack_p(C2, C3); \
    asm volatile("" : "+v"(pf0), "+v"(pf1)); SBAR(); } while (0)
  if (half == 0) {
    A3_A_FIRST();
    A3_BAR_ODD(); A3_B(true);
    int k = 0;
    for (; k + 1 < NT2; ++k) { A3_BAR_EVEN(k + 1); A3_A_MID(k); A3_BAR_ODD(); A3_B(false); }
    A3_BAR_EVEN(k + 1); A3_A_LAST(k);
    A3_BAR_ODD();
  } else {
    A3_BAR_ODD(); A3_A_FIRST();
    A3_BAR_EVEN(1); A3_B(true);
    int k = 0;
    for (; k + 1 < NT2; ++k) { A3_BAR_ODD(); A3_A_MID(k); A3_BAR_EVEN(k + 2); A3_B(false); }
    A3_BAR_ODD(); A3_A_LAST(k);
  }
  A3_MFMA_FENCE();
  A3_WAITBAR();
  if (mp == 0) {
    int lo_; asm volatile("v_mbcnt_lo_u32_b32 %0, -1, 0\n\tv_mbcnt_hi_u32_b32 %0, -1, %0" : "=v"(lo_));
    u32x4* o0s = o0g + wid * 512 + lo_;
#pragma unroll
    for (int d0 = 0; d0 < 4; ++d0) {
#pragma unroll
      for (int r = 0; r < 16; r += 8) { u32x4 w;
        w.x = cvt_pk_bf16(o[d0][r] * __builtin_amdgcn_rcpf(osum[r]), o[d0][r + 1] * __builtin_amdgcn_rcpf(osum[r + 1]));
        w.y = cvt_pk_bf16(o[d0][r + 2] * __builtin_amdgcn_rcpf(osum[r + 2]), o[d0][r + 3] * __builtin_amdgcn_rcpf(osum[r + 3]));
        w.z = cvt_pk_bf16(o[d0][r + 4] * __builtin_amdgcn_rcpf(osum[r + 4]), o[d0][r + 5] * __builtin_amdgcn_rcpf(osum[r + 5]));
        w.w = cvt_pk_bf16(o[d0][r + 6] * __builtin_amdgcn_rcpf(osum[r + 6]), o[d0][r + 7] * __builtin_amdgcn_rcpf(osum[r + 7]));
        o0s[(d0 * 2 + (r >> 3)) * 64] = w; } }
  }
  }
  { LAS bf16_t* stg = (LAS bf16_t*)lds + wid * 4096;
    u32x4 o0w[8];
    { int lo_; asm volatile("v_mbcnt_lo_u32_b32 %0, -1, 0\n\tv_mbcnt_hi_u32_b32 %0, -1, %0" : "=v"(lo_));
      const u32x4* o0s = o0g + wid * 512 + lo_;
#pragma unroll
      for (int j = 0; j < 8; ++j) o0w[j] = o0s[j * 64]; }
#pragma unroll
    for (int r = 0; r < 16; r += 2) { const float i0 = __builtin_amdgcn_rcpf(osum[r]), i1 = __builtin_amdgcn_rcpf(osum[r + 1]); const int or0 = crow(r, hi), or1 = crow(r + 1, hi);
#pragma unroll
      for (int d0 = 0; d0 < 4; ++d0) { const unsigned pk = o0w[d0 * 2 + (r >> 3)][(r >> 1) & 3];
        const float v0 = bf_lo(pk) - lam * (o[d0][r] * i0), v1 = bf_hi(pk) - lam * (o[d0][r + 1] * i1);
        stg[or0 * 128 + d0 * 32 + r32] = (bf16_t)(cvt_pk_bf16(v0, 0.f) & 0xffffu); stg[or1 * 128 + d0 * 32 + r32] = (bf16_t)(cvt_pk_bf16(v1, 0.f) & 0xffffu); } }
    asm volatile("s_waitcnt lgkmcnt(0)" ::: "memory");
    bf16_t* Ow = AOb + (long)(wid * QBLK) * ldo;
    int lane_e; asm volatile("v_mbcnt_lo_u32_b32 %0, -1, 0\n\tv_mbcnt_hi_u32_b32 %0, -1, %0" : "=v"(lane_e));
    const int ch = lane_e & 15; const f32x4 g0 = *(const f32x4*)(subln + ch * 8), g1 = *(const f32x4*)(subln + ch * 8 + 4);
#pragma unroll
    for (int i = 0; i < 8; ++i) { const int row = i * 4 + (lane_e >> 4); const u32x4 v = *(const LAS u32x4*)(stg + row * 128 + ch * 8);
      float e[8] = {bf_lo(v.x), bf_hi(v.x), bf_lo(v.y), bf_hi(v.y), bf_lo(v.z), bf_hi(v.z), bf_lo(v.w), bf_hi(v.w)};
      float ss = 0.f;
#pragma unroll
      for (int q = 0; q < 8; ++q) ss += e[q] * e[q];
      ss = row16_sum(ss);
      const float rn = osc / sqrtf(ss * (1.0f / 128.0f) + EPS);
      u32x4 w; w.x = cvt_pk_bf16(e[0] * rn * g0[0], e[1] * rn * g0[1]); w.y = cvt_pk_bf16(e[2] * rn * g0[2], e[3] * rn * g0[3]);
      w.z = cvt_pk_bf16(e[4] * rn * g1[0], e[5] * rn * g1[1]); w.w = cvt_pk_bf16(e[6] * rn * g1[2], e[7] * rn * g1[3]);
      *(u32x4*)(Ow + (long)row * ldo + ch * 8) = w; } }
  A3_WAITBAR();
#undef A3_WAITBAR
#undef A3_DMAK
#undef A3_DMAV
#undef A3_BAR_ODD
#undef A3_BAR_EVEN
#undef A3_A_FIRST
#undef A3_LD
#undef A3_LDQ
#undef A3_LD1
#undef A3_W
#undef A3_A_MID
#undef A3_A_LAST
#undef A3_B
#undef A3_MFMA_FENCE
}
#undef SBAR
}

constexpr int RING_BYTES = 131072, MISC_OFF = RING_BYTES + 320, INTAB_OFF = RING_BYTES + 1024, LDS_BYTES = 147456;
struct Args { const float* in[50]; float* out; unsigned char* ws; int ph_lo, ph_hi; };

struct Ctx {
    LAS unsigned char* lds;
    int tid, lane, wave, G, bid;
    unsigned char* ws; float* out;
    __device__ __forceinline__ const float* inp(int idx) const {
        const LAS unsigned* t = (const LAS unsigned*)(lds + INTAB_OFF) + 2 * idx;
        const unsigned lo_ = __builtin_amdgcn_readfirstlane(t[0]), hi_ = __builtin_amdgcn_readfirstlane(t[1]);
        typedef __attribute__((address_space(1))) const float* gp_t; return (const float*)(gp_t)(((uintptr_t)hi_ << 32) | (uintptr_t)lo_); }
};

template <class T> __device__ __forceinline__ T* launder_ptr(T* p) { unsigned lo = (unsigned)(uintptr_t)p, hi = (unsigned)((uintptr_t)p >> 32); lo = __builtin_amdgcn_readfirstlane(lo); hi = __builtin_amdgcn_readfirstlane(hi);
    asm volatile("" : "+s"(lo), "+s"(hi)); typedef __attribute__((address_space(1))) T* gp_t; return (T*)(gp_t)(((uintptr_t)hi << 32) | (uintptr_t)lo); }
__device__ __forceinline__ int launder_i(int v) { v = __builtin_amdgcn_readfirstlane(v); asm volatile("" : "+s"(v)); return v; }
__device__ __forceinline__ int map_col(int kind, int n) {
    if (kind == 1) { if (n < 1024) return n; const int w = n - 1024, T = w >> 8, r = w & 255; return 1024 + (r >> 7) * 1024 + T * 128 + (r & 127); }
    if (kind == 2) { const int T = n >> 8, r = n & 255; return (r >> 7) * DFF + T * 128 + (r & 127); }
    if (kind == 3) { const int T = n >> 8, r = n & 255; return (r >> 7) * 1024 + T * 128 + (r & 127); }
    if (kind == 4) { if (n >= 2048) return n; const int blk = n >> 6, w = n & 63, half = w >> 5, ww = w & 31; return blk * 64 + half * 32 + (ww & 1) * 16 + (ww >> 1); }
    return n;
}
__device__ __forceinline__ void stage_out(LAS unsigned char* stg, unsigned char* dst  , size_t pitch, int lane) {
    asm volatile("s_waitcnt lgkmcnt(0)" ::: "memory");
#pragma unroll
    for (int i = 0; i < 16; ++i) { const int row = 8 * i + (lane >> 3), c = lane & 7;
        const u32x4 v = *(const LAS u32x4*)(stg + row * 128 + ((c ^ ((row >> 1) & 7)) << 4));
        *(u32x4*)(dst + (size_t)row * pitch + c * 16) = v; }
    asm volatile("s_waitcnt lgkmcnt(0)" ::: "memory");
}
__device__ __forceinline__ void transpose_item8(const float* W, int K, int N, unsigned char* WT, int kind, int item, int lane, LAS unsigned char* stg) {
    const int nblk = N / 128, kb = item / nblk, nb = item % nblk, k0 = 128 * kb, n0 = 128 * nb;
    const int d0 = n0 + 2 * lane, s0 = map_col(kind, d0), s1 = map_col(kind, d0 + 1);
    const bool adj = (kind != 4) || (n0 >= 2048);
#pragma unroll
    for (int h = 0; h < 4; ++h) {
        float v0[32], v1[32];
        const float* wp = W + (size_t)(k0 + 32 * h) * N;
        if (adj) {
#pragma unroll
            for (int kk = 0; kk < 32; ++kk) { const f32x2 t = *(const f32x2*)(wp + (size_t)kk * N + s0); v0[kk] = t[0] * pg8::W8SCALE; v1[kk] = t[1] * pg8::W8SCALE; }
        } else {
#pragma unroll
            for (int kk = 0; kk < 32; ++kk) { v0[kk] = wp[(size_t)kk * N + s0] * pg8::W8SCALE; v1[kk] = wp[(size_t)kk * N + s1] * pg8::W8SCALE; }
        }
        LAS unsigned char* r0_ = stg + (2 * lane) * 128; LAS unsigned char* r1_ = r0_ + 128; const int sw_ = lane & 7;
#pragma unroll
        for (int j = 0; j < 2; ++j) {
            u32x4 a, b;
            a.x = cvt4_fp8(v0[16 * j + 0], v0[16 * j + 1], v0[16 * j + 2], v0[16 * j + 3]); a.y = cvt4_fp8(v0[16 * j + 4], v0[16 * j + 5], v0[16 * j + 6], v0[16 * j + 7]);
            a.z = cvt4_fp8(v0[16 * j + 8], v0[16 * j + 9], v0[16 * j + 10], v0[16 * j + 11]); a.w = cvt4_fp8(v0[16 * j + 12], v0[16 * j + 13], v0[16 * j + 14], v0[16 * j + 15]);
            b.x = cvt4_fp8(v1[16 * j + 0], v1[16 * j + 1], v1[16 * j + 2], v1[16 * j + 3]); b.y = cvt4_fp8(v1[16 * j + 4], v1[16 * j + 5], v1[16 * j + 6], v1[16 * j + 7]);
            b.z = cvt4_fp8(v1[16 * j + 8], v1[16 * j + 9], v1[16 * j + 10], v1[16 * j + 11]); b.w = cvt4_fp8(v1[16 * j + 12], v1[16 * j + 13], v1[16 * j + 14], v1[16 * j + 15]);
            *(LAS u32x4*)(r0_ + (((2 * h + j) ^ sw_) << 4)) = a; *(LAS u32x4*)(r1_ + (((2 * h + j) ^ sw_) << 4)) = b; }
    }
    stage_out(stg, WT + (size_t)n0 * K + k0, (size_t)K, lane);
}
__device__ __forceinline__ void transpose_item(const float* W, int K, int N, bf16_t* WT, int kind, int item, int lane, LAS unsigned char* stg) {
    const int nblk = N / 128, kb = item / nblk, nb = item % nblk, k0 = 64 * kb, n0 = 128 * nb;
    const int d0 = n0 + 2 * lane, s0 = map_col(kind, d0), s1 = map_col(kind, d0 + 1);
    const bool adj = (kind != 4) || (n0 >= 2048);
#pragma unroll
    for (int h = 0; h < 2; ++h) {
        float v0[32], v1[32];
        const float* wp = W + (size_t)(k0 + 32 * h) * N;
        if (adj) {
#pragma unroll
            for (int kk = 0; kk < 32; ++kk) { const f32x2 t = *(const f32x2*)(wp + (size_t)kk * N + s0); v0[kk] = t[0]; v1[kk] = t[1]; }
        } else {
#pragma unroll
            for (int kk = 0; kk < 32; ++kk) { v0[kk] = wp[(size_t)kk * N + s0]; v1[kk] = wp[(size_t)kk * N + s1]; }
        }
        LAS unsigned char* r0_ = stg + (2 * lane) * 128; LAS unsigned char* r1_ = r0_ + 128; const int sw_ = lane & 7;
#pragma unroll
        for (int j = 0; j < 4; ++j) {
            u32x4 a, b;
            a.x = cvt_pk_bf16(v0[8 * j + 0], v0[8 * j + 1]); a.y = cvt_pk_bf16(v0[8 * j + 2], v0[8 * j + 3]); a.z = cvt_pk_bf16(v0[8 * j + 4], v0[8 * j + 5]); a.w = cvt_pk_bf16(v0[8 * j + 6], v0[8 * j + 7]);
            b.x = cvt_pk_bf16(v1[8 * j + 0], v1[8 * j + 1]); b.y = cvt_pk_bf16(v1[8 * j + 2], v1[8 * j + 3]); b.z = cvt_pk_bf16(v1[8 * j + 4], v1[8 * j + 5]); b.w = cvt_pk_bf16(v1[8 * j + 6], v1[8 * j + 7]);
            *(LAS u32x4*)(r0_ + (((4 * h + j) ^ sw_) << 4)) = a; *(LAS u32x4*)(r1_ + (((4 * h + j) ^ sw_) << 4)) = b; }
    }
    stage_out(stg, (unsigned char*)(WT + (size_t)n0 * K + k0), (size_t)K * 2, lane);
}
struct WDesc { int in_idx, K, N, nb, kind, f8; unsigned long long off; };
__constant__ WDesc g_wd[15] = {
    {8, 1024, 3072, 1, 1, 0, WO_L0_CONVIN}, {10, 1024, 1024, 1, 0, 0, WO_L0_CONVOUT}, {11, 1024, 5632, 1, 2, (MK_FP8_FFN >> 0) & 1, WO_L0_GU}, {12, 2816, 1024, 1, 0, (MK_FP8_FFN >> 0) & 1, WO_L0_DOWN},
    {17, 1024, 3072, 1, 4, MK_FP8_QKV, WO_L1_QKV}, {20, 1024, 1024, 1, 0, 0, WO_L1_WO}, {22, 1024, 5632, 8, 2, 1, WO_L1_MGU}, {23, 2816, 1024, 8, 0, 1, WO_L1_MDOWN},
    {36, 1024, 2048, 1, 3, MK_FP8_GLU, WO_L2_GLU}, {37, 1024, 5632, 1, 2, (MK_FP8_FFN >> 2) & 1, WO_L2_GU}, {38, 2816, 1024, 1, 0, (MK_FP8_FFN >> 2) & 1, WO_L2_DOWN},
    {43, 1024, 3072, 1, 1, 0, WO_L3_CONVIN}, {45, 1024, 1024, 1, 0, 0, WO_L3_CONVOUT}, {47, 1024, 5632, 8, 2, 1, WO_L3_MGU}, {48, 2816, 1024, 8, 0, 1, WO_L3_MDOWN}};

__device__ __forceinline__ void p0_weights(Ctx& F) {
    unsigned* ctr = (unsigned*)(F.ws + WS_CTL) + 64;
    for (;;) {
        unsigned it = 0;
        if (F.lane == 0) it = __hip_atomic_fetch_add(ctr, 1u, __ATOMIC_RELAXED, __HIP_MEMORY_SCOPE_AGENT);
        it = (unsigned)__builtin_amdgcn_readfirstlane((int)it);
        int base = 0, d = 0; bool found = false;
        for (; d < 15; ++d) { const int tot = (g_wd[d].K / (g_wd[d].f8 ? 128 : 64)) * (g_wd[d].N / 128) * g_wd[d].nb; if ((int)it < base + tot) { found = true; break; } base += tot; }
        if (!found) break;
        const int K = g_wd[d].K, N = g_wd[d].N, kind = g_wd[d].kind; const int per = (K / (g_wd[d].f8 ? 128 : 64)) * (N / 128);
        const float* W = F.inp(g_wd[d].in_idx); bf16_t* WT = (bf16_t*)(F.ws + WS_W + g_wd[d].off);
        const int li = (int)it - base, e = li / per, r = li - e * per;
        if (g_wd[d].f8) transpose_item8(W + (size_t)e * K * N, K, N, (unsigned char*)WT + (size_t)e * K * N, kind, r, F.lane, F.lds + F.wave * 16384);
        else transpose_item(W + (size_t)e * K * N, K, N, WT + (size_t)e * K * N, kind, r, F.lane, F.lds + F.wave * 16384);
    }
}
__device__ __forceinline__ void p0_adaln(Ctx& F, const int item0) {
    LAS float* scond = (LAS float*)(F.lds);
    LAS float* red = (LAS float*)(F.lds + 20480);
    bool have = false;
    for (int item = item0; item < 96; item += 1 << 20) {
        if (!have) {
            for (int i = F.tid; i < 5 * 1024; i += NTHREADS) { const int cnd = i >> 10, k = i & 1023; const float v = cnd < 4 ? F.inp(IN_C)[cnd * 1024 + k] : F.inp(IN_CCTX)[k]; scond[i] = silu_f(v); }
            have = true; __syncthreads();
        }
        const int L = item / 24, cg = item % 24, col0 = cg * 256 + 4 * F.lane;
        const float* W = F.inp(lbase(L)) + col0; const float* bias = F.inp(lbase(L) + 1);
        f32x4 acc[5];
#pragma unroll
        for (int c = 0; c < 5; ++c) acc[c] = (f32x4){0.f, 0.f, 0.f, 0.f};
        const int kb = F.wave * 128;
#pragma unroll 8
        for (int k = 0; k < 128; ++k) { const f32x4 w = *(const f32x4*)(W + (size_t)(kb + k) * 6144);
#pragma unroll
            for (int c = 0; c < 5; ++c) acc[c] += scond[c * 1024 + kb + k] * w; }
#pragma unroll
        for (int c = 0; c < 5; ++c) *(f32x4*)(red + (F.wave * 5 + c) * 256 + 4 * F.lane) = acc[c];
        __syncthreads();
        float* MOD = (float*)(F.ws + WS_MOD) + (size_t)L * 5 * 6144;
        for (int i = F.tid; i < 5 * 256; i += NTHREADS) { const int c = i >> 8, j = i & 255; float s = bias[cg * 256 + j];
#pragma unroll
            for (int w = 0; w < 8; ++w) s += red[(w * 5 + c) * 256 + j];
            MOD[c * 6144 + cg * 256 + j] = s; }
        __syncthreads();
    }
}
__device__ __forceinline__ void p0_misc(Ctx& F) {
    { float* cosT = (float*)(F.ws + WS_ROPE); float* sinT = cosT + 128 * 16;
        for (int i = F.tid; i < 128 * 16; i += NTHREADS) { const int pos = i >> 4, f = i & 15; const float inv = powf(10000.0f, -(float)f / 16.0f); const float ang = (float)pos * inv; cosT[i] = cosf(ang); sinT[i] = sinf(ang); } }
}
__device__ __forceinline__ void p0_s5mats(Ctx& F, const int g0) {
    const int LB = lbase(2);
    const float* a_re = F.inp(LB + 4); const float* a_im = F.inp(LB + 5); const float* log_dt = F.inp(LB + 6); const float* b_re = F.inp(LB + 7); const float* b_im = F.inp(LB + 8);
    const float* c_re = F.inp(LB + 9); const float* c_im = F.inp(LB + 10); const float* dsk = F.inp(LB + 11);
    LAS float* AP = (LAS float*)F.lds;
    LAS float* BB = AP + 2 * 17 * 64 * 2;
    LAS float* CC = BB + 2 * 64 * 16 * 2;
    LAS float* KK = CC + 2 * 16 * 64 * 2;
    for (int g = g0; g < 64; g += 1 << 20) {
        __syncthreads();
        for (int i = F.tid; i < 2 * 17 * 64; i += NTHREADS) { const int d = i / (17 * 64), r = i % (17 * 64), j = r / 64, p = r % 64;
            const float dt = expf(log_dt[d * 64 + g]); const float ar = a_re[(d * 64 + g) * 64 + p], ai = a_im[(d * 64 + g) * 64 + p];
            const float mag = expf((float)j * dt * ar), ph = (float)j * dt * ai; AP[i * 2] = mag * cosf(ph); AP[i * 2 + 1] = mag * sinf(ph); }
        for (int i = F.tid; i < 2 * 64 * 16; i += NTHREADS) { const int d = i / 1024, r = i % 1024, p = r / 16, s = r % 16;
            const float dt = expf(log_dt[d * 64 + g]); const float ar = a_re[(d * 64 + g) * 64 + p], ai = a_im[(d * 64 + g) * 64 + p];
            const float mag = expf(dt * ar), abr = mag * cosf(dt * ai), abi = mag * sinf(dt * ai), den = ar * ar + ai * ai, nr = abr - 1.0f;
            const float cor = (nr * ar + abi * ai) / den, coi = (abi * ar - nr * ai) / den;
            const float br = b_re[((size_t)(d * 64 + g) * 64 + p) * 16 + s], bi = b_im[((size_t)(d * 64 + g) * 64 + p) * 16 + s];
            BB[i * 2] = cor * br - coi * bi; BB[i * 2 + 1] = cor * bi + coi * br;
            const int s2 = r / 64, p2 = r % 64;
            CC[i * 2] = c_re[((size_t)(d * 64 + g) * 16 + s2) * 64 + p2]; CC[i * 2 + 1] = c_im[((size_t)(d * 64 + g) * 16 + s2) * 64 + p2]; }
        __syncthreads();
        for (int i = F.tid; i < 2 * 16 * 256; i += NTHREADS) { const int d = i >> 12, j = (i >> 8) & 15, so = (i >> 4) & 15, si = i & 15; float s = 0.f;
            for (int p = 0; p < 64; ++p) { const float cr = CC[((d * 16 + so) * 64 + p) * 2], ci = CC[((d * 16 + so) * 64 + p) * 2 + 1];
                const float pr = AP[((d * 17 + j) * 64 + p) * 2], pi = AP[((d * 17 + j) * 64 + p) * 2 + 1];
                const float br = BB[((d * 64 + p) * 16 + si) * 2], bi = BB[((d * 64 + p) * 16 + si) * 2 + 1];
                const float wr_ = cr * pr - ci * pi, wi_ = cr * pi + ci * pr; s += wr_ * br - wi_ * bi; }
            KK[i] = s; }
        __syncthreads();
        bf16_t* M1 = (bf16_t*)(F.ws + WS_S5M1) + (size_t)g * 256 * 256; bf16_t* M3 = (bf16_t*)(F.ws + WS_S5M3) + (size_t)g * 256 * 512;
        for (int i = F.tid; i < 256 * 256; i += NTHREADS) { const int n = i >> 8, k = i & 255, d = n >> 7, p = (n & 127) >> 1, c = n & 1, tp = k >> 4, si = k & 15; const int e = d ? tp : 15 - tp;
            const float pr = AP[((d * 17 + e) * 64 + p) * 2], pi = AP[((d * 17 + e) * 64 + p) * 2 + 1], br = BB[((d * 64 + p) * 16 + si) * 2], bi = BB[((d * 64 + p) * 16 + si) * 2 + 1];
            const float v = c ? (pr * bi + pi * br) : (pr * br - pi * bi); M1[i] = (bf16_t)(cvt_pk_bf16(v, 0.f) & 0xffffu); }
        for (int i = F.tid; i < 256 * 512; i += NTHREADS) { const int n = i >> 9, k = i & 511, t = n >> 4, so = n & 15; float v;
            if (k < 256) { const int tp = k >> 4, si = k & 15;
                if (t > tp) v = KK[((0 * 16 + (t - tp)) * 16 + so) * 16 + si];
                else if (t < tp) v = KK[((1 * 16 + (tp - t)) * 16 + so) * 16 + si];
                else { v = KK[((0 * 16 + 0) * 16 + so) * 16 + si] + KK[((1 * 16 + 0) * 16 + so) * 16 + si]; if (si == so) v += dsk[g * 16 + si]; } }
            else { const int q = k - 256, d = q >> 7, p = (q & 127) >> 1, c = q & 1; const int e = d ? 16 - t : t + 1;
                const float cr = CC[((d * 16 + so) * 64 + p) * 2], ci = CC[((d * 16 + so) * 64 + p) * 2 + 1], pr = AP[((d * 17 + e) * 64 + p) * 2], pi = AP[((d * 17 + e) * 64 + p) * 2 + 1];
                v = c ? -(cr * pi + ci * pr) : (cr * pr - ci * pi); }
            M3[i] = (bf16_t)(cvt_pk_bf16(v, 0.f) & 0xffffu); }
    }
    __syncthreads();
}

__device__ __forceinline__ void p0_prologue(Ctx& F, volatile LAS unsigned* MISC) {
    unsigned* ctr = (unsigned*)(F.ws + WS_CTL) + 128;
    for (;;) {
        __syncthreads();
        if (F.tid == 0) MISC[16] = __hip_atomic_fetch_add(ctr, 1u, __ATOMIC_RELAXED, __HIP_MEMORY_SCOPE_AGENT);
        __syncthreads();
        const int item = (int)MISC[16];
        if (item >= 161) break;
        if (item < 96) p0_adaln(F, item); else if (item < 160) p0_s5mats(F, item - 96); else p0_misc(F);
    }
    __syncthreads();
    p0_weights(F);
}
template <int MODE, bool COMB, bool FROM_IN = false>
__device__ __forceinline__ void row_pass(Ctx& F, int L, bool latent_only, int jsh  , int Lprev, bool out8 = false) {
    xel_t* X = (xel_t*)(F.ws + WS_X); bf16_t* HL = (bf16_t*)(F.ws + WS_HL);
    const float* MOD = (const float*)(F.ws + WS_MOD) + (size_t)L * 5 * 6144; const float* MODP = (const float*)(F.ws + WS_MOD) + (size_t)Lprev * 5 * 6144;
    const float* gain = MODE == 2 ? F.inp(IN_FINAL) : F.inp(lbase(L) + (jsh ? 3 : 2));
    const int nrows = latent_only ? NB * SEQ : MALL;
    const int rpw = (nrows + F.G - 1) / F.G;
    const int r0 = F.bid * rpw, r1 = min(nrows, r0 + rpw);
    LAS float* wrl = (LAS float*)F.lds;
    LAS int* hist = (LAS int*)(F.lds + 32768);
    if (MODE == 1) { const float* wrt = F.inp(lbase(L) + (L == 1 ? 8 : 7));
        for (int i = F.tid; i < 8192; i += NTHREADS) { const int k = i >> 3, e = i & 7; wrl[((((k >> 8) * 4 + (k & 3)) * 2 + (e >> 2)) * 64 + ((k & 255) >> 2)) * 4 + (e & 3)] = wrt[i]; }
        if (F.tid < 8) hist[F.tid] = 0;
        __syncthreads(); }
    const bf16_t* OP = (const bf16_t*)(F.ws + WS_BIG + BIG_APERM);
    const int4* SEL = (const int4*)(F.ws + WS_SEL); const int2* SLOT = (const int2*)(F.ws + WS_SLOT);
    int cur_cond = -1; f32x4 ca[4], cb[4], gp[4];
    for (int lr = r0 + F.wave; lr < r1; lr += NWAVES) {
        const int row = latent_only ? (lr >> 13) * RPB + CTXL + (lr & 8191) : lr;
        const int cond = row_cond(row);
        if (cond != cur_cond) { cur_cond = cond;
#pragma unroll
            for (int q = 0; q < 4; ++q) { const int col = 4 * F.lane + 256 * q; const f32x4 g4 = *(const f32x4*)(gain + col);
                if (MODE == 2) { ca[q] = g4; cb[q] = (f32x4){0.f, 0.f, 0.f, 0.f}; }
                else { const f32x4 sh = *(const f32x4*)(MOD + cond * 6144 + jsh * 1024 + col), sc = *(const f32x4*)(MOD + cond * 6144 + (jsh + 1) * 1024 + col); ca[q] = g4 * (1.0f + sc); cb[q] = sh; }
                if (COMB) gp[q] = *(const f32x4*)(MODP + cond * 6144 + 5 * 1024 + col); } }
        xel_t* xr = X + (size_t)row * DM + 4 * F.lane;
        f32x4 v[4];
        if (FROM_IN) { const int b_ = row / RPB, j_ = row - b_ * RPB; const f32x4* xi = (const f32x4*)(j_ < CTXL ? F.inp(IN_CTX) + ((size_t)b_ * CTXL + j_) * DM : F.inp(IN_X) + ((size_t)b_ * SEQ + (j_ - CTXL)) * DM) + F.lane;
#pragma unroll
            for (int q = 0; q < 4; ++q) v[q] = xi[64 * q];
        } else {
#pragma unroll
            for (int q = 0; q < 4; ++q) v[q] = x_ld4(xr + 256 * q); }
        if (COMB && !((MK_DBG_NOMOE >> (Lprev == 1 ? 0 : 1)) & 1)) {
            const int4 sel = SEL[row]; const int2 sl = SLOT[row]; const float w0 = __int_as_float(sel.z), w1 = __int_as_float(sel.w);
            const u32x2* o0 = (const u32x2*)(OP + (size_t)sl.x * DM) + F.lane; const u32x2* o1 = (const u32x2*)(OP + (size_t)sl.y * DM) + F.lane;
#pragma unroll
            for (int q = 0; q < 4; ++q) { const u32x2 a = o0[64 * q], b = o1[64 * q];
                f32x4 m; m[0] = w0 * bf_lo(a.x) + w1 * bf_lo(b.x); m[1] = w0 * bf_hi(a.x) + w1 * bf_hi(b.x); m[2] = w0 * bf_lo(a.y) + w1 * bf_lo(b.y); m[3] = w0 * bf_hi(a.y) + w1 * bf_hi(b.y);
                v[q] = v[q] + gp[q] * m; if (MODE != 2) x_st4(xr + 256 * q, v[q]); }
        }
        float ss = 0.f;
#pragma unroll
        for (int q = 0; q < 4; ++q) ss += (v[q][0] * v[q][0] + v[q][1] * v[q][1]) + (v[q][2] * v[q][2] + v[q][3] * v[q][3]);
        const float rstd = 1.0f / sqrtf(wave_sum(ss) * (1.0f / DM) + EPS);
        f32x4 h[4];
#pragma unroll
        for (int q = 0; q < 4; ++q) h[q] = (v[q] * rstd) * ca[q] + cb[q];
        if (MODE == 2) { const int b = row / RPB, t = row - b * RPB - CTXL; f32x4* o4 = (f32x4*)(F.out + ((size_t)b * SEQ + t) * DM) + F.lane;
#pragma unroll
            for (int q = 0; q < 4; ++q) o4[64 * q] = h[q];
        } else {
            if (out8) { unsigned* o4 = (unsigned*)((unsigned char*)HL + (size_t)row * DM) + F.lane;
#pragma unroll
                for (int q = 0; q < 4; ++q) o4[64 * q] = cvt4_fp8(h[q][0], h[q][1], h[q][2], h[q][3]);
            } else {
            u32x2* o8 = (MODE == 0 && COMB) ? (u32x2*)HL + ((size_t)(F.lane >> 2) * MALL + row) * 4 + (F.lane & 3) : (u32x2*)(HL + (size_t)row * DM) + F.lane;
            const size_t qst = (MODE == 0 && COMB) ? (size_t)16 * MALL * 4 : 64;
#pragma unroll
            for (int q = 0; q < 4; ++q) { u32x2 w; w.x = cvt_pk_bf16(h[q][0], h[q][1]); w.y = cvt_pk_bf16(h[q][2], h[q][3]); o8[qst * q] = w; } }
        }
        if (MODE == 1) {
            float lg[8];
#pragma unroll
            for (int e = 0; e < 8; ++e) lg[e] = 0.f;
#pragma unroll
            for (int q = 0; q < 4; ++q)
#pragma unroll
                for (int i = 0; i < 4; ++i) { const LAS f32x4* wp_ = (const LAS f32x4*)wrl + ((q * 4 + i) * 2) * 64 + F.lane; const f32x4 wa = wp_[0], wb = wp_[64]; const float hv = h[q][i];
                    lg[0] += hv * wa[0]; lg[1] += hv * wa[1]; lg[2] += hv * wa[2]; lg[3] += hv * wa[3]; lg[4] += hv * wb[0]; lg[5] += hv * wb[1]; lg[6] += hv * wb[2]; lg[7] += hv * wb[3]; }
#pragma unroll
            for (int e = 0; e < 8; ++e) lg[e] = wave_sum(lg[e]);
            int e0 = 0; float v0 = lg[0];
#pragma unroll
            for (int e = 1; e < 8; ++e) if (lg[e] > v0) { v0 = lg[e]; e0 = e; }
            int e1 = -1; float v1 = -INFINITY;
#pragma unroll
            for (int e = 0; e < 8; ++e) if (e != e0 && lg[e] > v1) { v1 = lg[e]; e1 = e; }
            const float ex = __expf(v1 - v0), w0 = 1.0f / (1.0f + ex), w1 = ex * w0;
            if (F.lane == 0) { ((int4*)(F.ws + WS_SEL))[row] = make_int4(e0, e1, __float_as_int(w0), __float_as_int(w1)); atomicAdd((int*)(hist + e0), 1); atomicAdd((int*)(hist + e1), 1); }
        }
    }
    if (MODE == 1) { __syncthreads(); if (F.tid < 8) ((int*)(F.ws + WS_CNT))[F.bid * 8 + F.tid] = hist[F.tid]; __syncthreads(); }
}

__device__ __forceinline__ void conv_pass(Ctx& F, int L, bool latent_only) {
    const bf16_t* BZ = (const bf16_t*)(F.ws + WS_BIG + BIG_BZ); bf16_t* U = (bf16_t*)(F.ws + WS_BIG + BIG_U);
    const float* cw = F.inp(lbase(L) + 5);
    const int nrows = latent_only ? NB * SEQ : MALL;
    const long nitems = (long)nrows * 128;
    for (long it = (long)F.bid * NTHREADS + F.tid; it < nitems; it += (long)F.G * NTHREADS) {
        const int lr = (int)(it >> 7), cgp = (int)(it & 127), col = cgp * 8;
        const int row = latent_only ? (lr >> 13) * RPB + CTXL + (lr & 8191) : lr;
        const int j = row % RPB; const bool first = (j == 0) || (j == CTXL), lastr = (j == CTXL - 1) || (j == RPB - 1);
        const u32x4 bb = *(const u32x4*)(BZ + (size_t)row * 2048 + col);
        const u32x4 zc = *(const u32x4*)(BZ + (size_t)row * 2048 + 1024 + col);
        u32x4 zp = (u32x4){0u, 0u, 0u, 0u}, zn = (u32x4){0u, 0u, 0u, 0u};
        if (!first) zp = *(const u32x4*)(BZ + (size_t)(row - 1) * 2048 + 1024 + col);
        if (!lastr) zn = *(const u32x4*)(BZ + (size_t)(row + 1) * 2048 + 1024 + col);
        const f32x4 w0a = *(const f32x4*)(cw + col), w0b = *(const f32x4*)(cw + col + 4), w1a = *(const f32x4*)(cw + 1024 + col), w1b = *(const f32x4*)(cw + 1024 + col + 4), w2a = *(const f32x4*)(cw + 2048 + col), w2b = *(const f32x4*)(cw + 2048 + col + 4);
        float y[8];
#define CV(i, W0, W1, W2, ZP, ZC, ZN, LO) y[i] = (W0) * (LO ? bf_lo(ZP) : bf_hi(ZP)) + (W1) * (LO ? bf_lo(ZC) : bf_hi(ZC)) + (W2) * (LO ? bf_lo(ZN) : bf_hi(ZN))
        CV(0, w0a[0], w1a[0], w2a[0], zp.x, zc.x, zn.x, 1); CV(1, w0a[1], w1a[1], w2a[1], zp.x, zc.x, zn.x, 0);
        CV(2, w0a[2], w1a[2], w2a[2], zp.y, zc.y, zn.y, 1); CV(3, w0a[3], w1a[3], w2a[3], zp.y, zc.y, zn.y, 0);
        CV(4, w0b[0], w1b[0], w2b[0], zp.z, zc.z, zn.z, 1); CV(5, w0b[1], w1b[1], w2b[1], zp.z, zc.z, zn.z, 0);
        CV(6, w0b[2], w1b[2], w2b[2], zp.w, zc.w, zn.w, 1); CV(7, w0b[3], w1b[3], w2b[3], zp.w, zc.w, zn.w, 0);
#undef CV
        u32x4 o; o.x = cvt_pk_bf16(bf_lo(bb.x) * y[0], bf_hi(bb.x) * y[1]); o.y = cvt_pk_bf16(bf_lo(bb.y) * y[2], bf_hi(bb.y) * y[3]);
        o.z = cvt_pk_bf16(bf_lo(bb.z) * y[4], bf_hi(bb.z) * y[5]); o.w = cvt_pk_bf16(bf_lo(bb.w) * y[6], bf_hi(bb.w) * y[7]);
        *(u32x4*)(U + (size_t)row * DM + col) = o;
    }
}

__device__ __forceinline__ void attn_combine(Ctx& F, int L) {
    const float* lamv = F.inp(lbase(L) + 5); const float* subln = F.inp(lbase(L) + 6);
    const float lam_init = 0.8f - 0.6f * expf(-0.3f * (float)L);
    float s01 = 0.f, s23 = 0.f;
    for (int i = 0; i < 64; ++i) { s01 += lamv[i] * lamv[64 + i]; s23 += lamv[128 + i] * lamv[192 + i]; }
    const float lam = expf(s01) - expf(s23) + lam_init, osc = 1.0f - lam_init;
    bf16_t* O0 = (bf16_t*)(F.ws + WS_BIG + BIG_O0); const bf16_t* O1 = (const bf16_t*)(F.ws + WS_HL);
    const int sub = F.lane & 15;
    const f32x4 g0 = *(const f32x4*)(subln + sub * 8), g1 = *(const f32x4*)(subln + sub * 8 + 4);
    const long nit = (long)MALL * NHEAD;
    for (long it = ((long)F.bid * NTHREADS + F.tid) >> 4; it < nit; it += ((long)F.G * NTHREADS) >> 4) {
        const size_t off = (size_t)it * 128 + sub * 8;
        const u32x4 a = *(const u32x4*)(O0 + off), b = *(const u32x4*)(O1 + off);
        float o[8];
        o[0] = bf_lo(a.x) - lam * bf_lo(b.x); o[1] = bf_hi(a.x) - lam * bf_hi(b.x); o[2] = bf_lo(a.y) - lam * bf_lo(b.y); o[3] = bf_hi(a.y) - lam * bf_hi(b.y);
        o[4] = bf_lo(a.z) - lam * bf_lo(b.z); o[5] = bf_hi(a.z) - lam * bf_hi(b.z); o[6] = bf_lo(a.w) - lam * bf_lo(b.w); o[7] = bf_hi(a.w) - lam * bf_hi(b.w);
        float ss = 0.f;
#pragma unroll
        for (int i = 0; i < 8; ++i) ss += o[i] * o[i];
        ss = row16_sum(ss);
        const float r = osc / sqrtf(ss * (1.0f / 128.0f) + EPS);
        u32x4 w; w.x = cvt_pk_bf16(o[0] * r * g0[0], o[1] * r * g0[1]); w.y = cvt_pk_bf16(o[2] * r * g0[2], o[3] * r * g0[3]);
        w.z = cvt_pk_bf16(o[4] * r * g1[0], o[5] * r * g1[1]); w.w = cvt_pk_bf16(o[6] * r * g1[2], o[7] * r * g1[3]);
        *(u32x4*)(O0 + off) = w;
    }
}

__device__ __forceinline__ void attn_phase(Ctx& F) {
    const bf16_t* Q = (const bf16_t*)(F.ws + WS_BIG + BIG_QKV); const bf16_t* KH = (const bf16_t*)(F.ws + WS_BIG + BIG_KH); const bf16_t* VH = (const bf16_t*)(F.ws + WS_BIG + BIG_VH);
    bf16_t* O0 = (bf16_t*)(F.ws + WS_BIG + BIG_O0); bf16_t* O1 = (bf16_t*)(F.ws + WS_HL);
    const int vcu = (F.G % 8 == 0) ? (F.bid % 8) * (F.G / 8) + F.bid / 8 : F.bid;
    for (int u = vcu; u < 2048 + 64; u += F.G) {
        int bh, qb; bool isctx = u >= 2048;
        if (!isctx) { bh = u >> 5; qb = u & 31; } else { bh = u - 2048; qb = 0; }
        const int b = bh >> 4, vh = bh & 15, h = vh >> 1, m = vh & 1;
        const size_t rowb = (size_t)b * RPB;
        const size_t qrow = isctx ? rowb : rowb + CTXL + (size_t)qb * 256;
        const bf16_t* Qb = Q + qrow * DM + h * 128 + m * 64;
        const bf16_t* Kh = KH + (size_t)(b * 16 + vh) * RPB * 64;
        const bf16_t* Vh = VH + (size_t)(b * 8 + h) * RPB * 128;
        bf16_t* Ob = (m ? O1 : O0) + qrow * DM + h * 128;
        att2::attn_unit(Qb, Kh, Vh, Ob, DM, isctx ? CTXL : RPB, F.lds, F.tid);
    }
}

__device__ __forceinline__ void v_transpose(Ctx& F) {
    const unsigned char* V8 = F.ws + WS_BIG + BIG_V8; unsigned char* VT8 = F.ws + WS_BIG + BIG_VT8;
    LAS unsigned char* buf = F.lds + F.wave * 8192;
    const int gw = F.bid * NWAVES + F.wave, NGW = F.G * NWAVES;
    for (int it = gw; it < NB * NHEAD * (RPB / 64); it += NGW) {
        const size_t tb = (size_t)it * 8192;
#pragma unroll
        for (int t = 0; t < 8; ++t) *(LAS u32x4*)(buf + (F.lane + 64 * t) * 16) = *(const u32x4*)(V8 + tb + (size_t)(F.lane + 64 * t) * 16);
        LDS_WAIT();
#pragma unroll
        for (int u = 0; u < 2; ++u) { const int d = F.lane + 64 * u;
#pragma unroll
            for (int q = 0; q < 4; ++q) { u32x4 w;
#pragma unroll
                for (int e = 0; e < 4; ++e) { unsigned x = 0;
#pragma unroll
                    for (int b = 0; b < 4; ++b) x |= (unsigned)buf[att3::slot_key(q * 16 + e * 4 + b) * 128 + d] << (8 * b);
                    w[e] = x; }
                *(u32x4*)(VT8 + tb + (size_t)d * 64 + q * 16) = w; } }
        LDS_WAIT();
    }
}
__device__ __forceinline__ void attn_phase3(Ctx& F, int L) {
    const unsigned char* Q8 = F.ws + WS_BIG + BIG_Q8; const unsigned char* K8 = F.ws + WS_BIG + BIG_K8; const unsigned char* VT8 = F.ws + WS_BIG + BIG_VT8;
    bf16_t* AO = (bf16_t*)(F.ws + WS_BIG + BIG_O0);
    const float* lamv = F.inp(lbase(L) + 5); const float* subln = F.inp(lbase(L) + 6);
    const float lam_init = 0.8f - 0.6f * expf(-0.3f * (float)L);
    float s01 = 0.f, s23 = 0.f;
    for (int i = 0; i < 64; ++i) { s01 += lamv[i] * lamv[64 + i]; s23 += lamv[128 + i] * lamv[192 + i]; }
    const float lam = expf(s01) - expf(s23) + lam_init, osc = 1.0f - lam_init;
    const int vcu = (F.G % 8 == 0) ? (F.bid % 8) * (F.G / 8) + F.bid / 8 : F.bid;
    for (int u = vcu; u < 1024 + 32; u += F.G) {
        int bh, qb; const bool isctx = u >= 1024;
        if (!isctx) { bh = u >> 5; qb = u & 31; } else { bh = u - 1024; qb = 0; }
        const int b = bh >> 3, h = bh & 7;
        const size_t rowb = (size_t)b * RPB;
        const size_t qrow = isctx ? rowb : rowb + CTXL + (size_t)qb * 256;
        att3::attn_unit(Q8 + qrow * DM + h * 128, K8 + (size_t)(b * 16 + 2 * h) * RPB * 64, (size_t)RPB * 64, VT8 + (size_t)(b * 8 + h) * RPB * 128, AO + qrow * DM + h * 128, DM, isctx ? CTXL : RPB,
                        lam, osc, subln, (u32x4*)(F.ws + WS_BIG + ((size_t)270 << 20)) + (size_t)F.bid * 4096, F.lds, F.tid);
    }
}

__device__ __forceinline__ void moe_scatter(Ctx& F, bool latent_only) {
    const int nrows = latent_only ? NB * SEQ : MALL;
    const int rpw = (nrows + F.G - 1) / F.G, r0 = F.bid * rpw, r1 = min(nrows, r0 + rpw);
    LAS int* tot = (LAS int*)F.lds; LAS int* pre = tot + 8; LAS int* base = tot + 16; LAS int* offs = tot + 24;
    LAS int* selc = tot + 64;
    LAS int* slc = selc + 1024;
    const int* CNT = (const int*)(F.ws + WS_CNT); const int4* SEL = (const int4*)(F.ws + WS_SEL); int2* SLOT = (int2*)(F.ws + WS_SLOT); int* TEXP = (int*)(F.ws + WS_TEXP);
    if (F.tid < 8) { int t = 0, p = 0; for (int w = 0; w < F.G; ++w) { const int c = CNT[w * 8 + F.tid]; t += c; if (w < F.bid) p += c; } tot[F.tid] = t; pre[F.tid] = p; }
    for (int i = F.tid; i < r1 - r0; i += NTHREADS) { const int lr = r0 + i; const int row = latent_only ? (lr >> 13) * RPB + CTXL + (lr & 8191) : lr; const int4 s = SEL[row]; selc[i] = s.x | (s.y << 8); }
    __syncthreads();
    if (F.tid == 0) { int o = 0; for (int e = 0; e < 8; ++e) { offs[e] = o; base[e] = o + pre[e]; o += (tot[e] + 255) & ~255; } offs[8] = o;
        for (int i = 0; i < r1 - r0; ++i) { const int s = selc[i], e0 = s & 255, e1 = s >> 8; slc[2 * i] = base[e0]++; slc[2 * i + 1] = base[e1]++; } }
    __syncthreads();
    if (F.bid == 0) { const int nT = offs[8] >> 8; for (int t = F.tid; t < nT; t += NTHREADS) { int e = 0; while (e < 7 && t * 256 >= offs[e + 1]) ++e; TEXP[t] = e; } if (F.tid == 0) TEXP[500] = nT; }
    const bf16_t* HL = (const bf16_t*)(F.ws + WS_HL); unsigned char* AP8 = (unsigned char*)(F.ws + WS_BIG + BIG_APERM);
    for (int i = F.wave; i < r1 - r0; i += NWAVES) { const int lr = r0 + i; const int row = latent_only ? (lr >> 13) * RPB + CTXL + (lr & 8191) : lr;
        const int s0 = slc[2 * i], s1 = slc[2 * i + 1];
        if (F.lane == 0) SLOT[row] = make_int2(s0, s1);
        const u32x4* src = (const u32x4*)(HL + (size_t)row * DM) + F.lane; const u32x4 a = src[0], b = src[64];
        u32x2 qa, qb; qa.x = cvt4_fp8(bf_lo(a.x), bf_hi(a.x), bf_lo(a.y), bf_hi(a.y)); qa.y = cvt4_fp8(bf_lo(a.z), bf_hi(a.z), bf_lo(a.w), bf_hi(a.w));
        qb.x = cvt4_fp8(bf_lo(b.x), bf_hi(b.x), bf_lo(b.y), bf_hi(b.y)); qb.y = cvt4_fp8(bf_lo(b.z), bf_hi(b.z), bf_lo(b.w), bf_hi(b.w));
        u32x2* d0 = (u32x2*)(AP8 + (size_t)s0 * DM) + F.lane; u32x2* d1 = (u32x2*)(AP8 + (size_t)s1 * DM) + F.lane;
        d0[0] = qa; d0[64] = qb; d1[0] = qa; d1[64] = qb; }
    __syncthreads();
}

__device__ __forceinline__ void s5_scan(Ctx& F) {
    const int LB = lbase(2);
    const float* a_re = F.inp(LB + 4); const float* a_im = F.inp(LB + 5); const float* log_dt = F.inp(LB + 6);
    const float* H = (const float*)(F.ws + WS_BIG + BIG_H); bf16_t* SB = (bf16_t*)(F.ws + WS_BIG + BIG_SBUF);
    LAS float* ex = (LAS float*)F.lds;
    constexpr int QS = CPB / 4;
    for (int pair = F.bid; pair < 256; pair += F.G) {
        const int task = 2 * pair + (F.wave >> 2), seg = F.wave & 3;
        const int b = task >> 7, d = (task >> 6) & 1, g = task & 63, p = F.lane;
        const float dt = expf(log_dt[d * 64 + g]); const float ar = a_re[(d * 64 + g) * 64 + p], ai = a_im[(d * 64 + g) * 64 + p];
        const float mag = expf(16.0f * dt * ar), ph = 16.0f * dt * ai, Ar = mag * cosf(ph), Ai = mag * sinf(ph);
        const float magq = expf((16.0f * QS) * dt * ar), phq = (16.0f * QS) * dt * ai, Qr = magq * cosf(phq), Qi = magq * sinf(phq);
        const int v = d * 128 + 2 * p;
        const float* Hb = H + ((size_t)b * CPB * 64 + g) * 256 + v;
        bf16_t* Sb = SB + ((size_t)g * (MALL / 16) + (size_t)b * CPB) * 256 + v;
        float er = 0.f, ei = 0.f;
        for (int s0 = seg * QS; s0 < (seg + 1) * QS; s0 += 4) {
            f32x2 hv[4];
#pragma unroll
            for (int i = 0; i < 4; ++i) { const int st = s0 + i; const int c = d ? (st < 16 ? 15 - st : CPB - 1 - (st - 16)) : st; hv[i] = *(const f32x2*)(Hb + (size_t)c * 64 * 256); }
#pragma unroll
            for (int i = 0; i < 4; ++i) { const float nr = Ar * er - Ai * ei + hv[i][0], ni = Ar * ei + Ai * er + hv[i][1]; er = nr; ei = ni; }
        }
        __syncthreads();
        ex[(F.wave * 64 + p) * 2] = er; ex[(F.wave * 64 + p) * 2 + 1] = ei;
        __syncthreads();
        er = 0.f; ei = 0.f;
        for (int q = 0; q < seg; ++q) { const int w = (F.wave & 4) + q; const float xr_ = ex[(w * 64 + p) * 2], xi_ = ex[(w * 64 + p) * 2 + 1];
            const float nr = Qr * er - Qi * ei + xr_, ni = Qr * ei + Qi * er + xi_; er = nr; ei = ni; }
        for (int s0 = seg * QS; s0 < (seg + 1) * QS; s0 += 4) {
            f32x2 hv[4]; int cc[4];
#pragma unroll
            for (int i = 0; i < 4; ++i) { const int st = s0 + i; cc[i] = d ? (st < 16 ? 15 - st : CPB - 1 - (st - 16)) : st; hv[i] = *(const f32x2*)(Hb + (size_t)cc[i] * 64 * 256); }
#pragma unroll
            for (int i = 0; i < 4; ++i) { *(unsigned*)(Sb + (size_t)cc[i] * 256) = cvt_pk_bf16(er, ei);
                const float nr = Ar * er - Ai * ei + hv[i][0], ni = Ar * ei + Ai * er + hv[i][1]; er = nr; ei = ni; }
        }
    }
}

__global__ void __launch_bounds__(NTHREADS, 2) mk_fwd(Args args) {
    extern __shared__ __attribute__((aligned(16))) unsigned char lds[];
    Ctx F;
    F.lds = (LAS unsigned char*)lds;
    F.tid = threadIdx.x; F.lane = F.tid & 63; F.wave = __builtin_amdgcn_readfirstlane(F.tid >> 6);
    F.G = gridDim.x; F.bid = blockIdx.x; F.ws = args.ws; F.out = args.out;
    volatile LAS unsigned* MISC = (volatile LAS unsigned*)(F.lds + MISC_OFF);
    if (F.tid < 32) MISC[F.tid] = 0u;
    if (F.tid == 0) {
#pragma unroll
        for (int i = 0; i < 50; ++i) *(LAS unsigned long long*)(F.lds + INTAB_OFF + 8 * i) = (unsigned long long)(uintptr_t)args.in[i]; }
    __syncthreads();
    const int lo = args.ph_lo, hi = args.ph_hi;
    XcdBarrier bar; bar.bar = (unsigned*)(F.ws + WS_CTL) + 1024; bar.x = 0; bar.st = nullptr;
    if (hi - lo > 1) bar = xcd_barrier_post((unsigned*)(F.ws + WS_CTL) + 1024, MISC + 8);
    int ph = 0;
#define LAUNDER() do { F.ws = launder_ptr(F.ws); F.out = launder_ptr(F.out); F.wave = launder_i(F.wave); asm volatile("v_mbcnt_lo_u32_b32 %0, -1, 0\n\tv_mbcnt_hi_u32_b32 %0, -1, %0" : "=v"(F.lane));     F.tid = F.wave * 64 + F.lane; \
    F.G = launder_i(F.G); F.bid = launder_i(F.bid); } while (0)
#define PHASE(id, ...) do { if (lo <= ph && ph < hi) { LAUNDER(); if ((MK_SITEMASK >> (id)) & 1u) { __VA_ARGS__; } if ((id) == MK_REPEAT_SITE) { __syncthreads(); LAUNDER(); __VA_ARGS__; } if (ph + 1 < hi) xcd_barrier(bar); } ++ph; } while (0)

#define WSB (F.ws)
#define XPTR ((xel_t*)(F.ws + WS_X))
#define HLPTR ((bf16_t*)(F.ws + WS_HL))
#define VBID (F.bid)
#define MODPTR ((const float*)(F.ws + WS_MOD) + (size_t)L * 5 * 6144)

    PHASE(0, p0_prologue(F, MISC));
#if MK_EXTRA_BARS
    if (hi - lo > 1) for (int eb = 0; eb < MK_EXTRA_BARS; ++eb) xcd_barrier(bar);
#endif

    for (int L = 0; L < 4; ++L) {
        const int kind = L % 3; const bool moe = (L & 1) != 0;
        const bool lat = (L >= 2);
        if (L == 2) PHASE(1, (row_pass<0, true>(F, L, false, 0, L - 1)));
        else if (L == 0) PHASE(2, (row_pass<0, false, true>(F, L, false, 0, 0)));
        else PHASE(3, (row_pass<0, false>(F, L, lat, 0, 0, L == 1 && MK_FP8_QKV)));
        if (kind == 0) {
            const size_t wo_in = (L == 0) ? WO_L0_CONVIN : WO_L3_CONVIN, wo_out = (L == 0) ? WO_L0_CONVOUT : WO_L3_CONVOUT;
            PHASE(4, { pg8::ProbPlain P{(const char*)HLPTR, (const char*)(WSB + WS_W + wo_in), 2048, 2048, 16, lat ? NT_LAT : NT_ALL, 12, F.G, VBID, lat};
                    pg8::EpiGated<0> E{(bf16_t*)(WSB + WS_BIG + BIG_BZ), 2048, 4, 1024, 0};
                    pg8::gemm_phase<pg8::EpiGated<0>, pg8::ProbPlain, true>(F.lds, P, E, F.tid); });
            PHASE(5, conv_pass(F, L, lat));
            PHASE(6, { pg8::ProbPlain P{(const char*)(WSB + WS_BIG + BIG_U), (const char*)(WSB + WS_W + wo_out), 2048, 2048, 16, lat ? NT_LAT : NT_ALL, 4, F.G, VBID, lat};
                    pg8::EpiResid E{XPTR, MODPTR + 2 * 1024, L == 0 ? F.inp(IN_X) : nullptr, L == 0 ? F.inp(IN_CTX) : nullptr, 1.f};
                    pg8::gemm_phase<pg8::EpiResid, pg8::ProbPlain, true>(F.lds, P, E, F.tid); });
        } else if (kind == 1) {
            if (MK_FP8_QKV) {
            PHASE(25, { pg8::ProbPlain P{(const char*)HLPTR, (const char*)(WSB + WS_W + WO_L1_QKV), 1024, 1024, 8, NT_ALL, 12, F.G, VBID, false};
                    pg8::EpiQkv<MK_ATT3 != 0, true> E{WSB + WS_BIG, (const float*)(WSB + WS_ROPE)};
                    pg8::gemm_phase<pg8::EpiQkv<MK_ATT3 != 0, true>, pg8::ProbPlain, true, true>(F.lds, P, E, F.tid); });
            } else {
            PHASE(7, { pg8::ProbPlain P{(const char*)HLPTR, (const char*)(WSB + WS_W + WO_L1_QKV), 2048, 2048, 16, NT_ALL, 12, F.G, VBID, false};
                    pg8::EpiQkv<MK_ATT3 != 0, false> E{WSB + WS_BIG, (const float*)(WSB + WS_ROPE)};
                    pg8::gemm_phase<pg8::EpiQkv<MK_ATT3 != 0, false>, pg8::ProbPlain, true>(F.lds, P, E, F.tid); });
            }
            if (MK_ATT3) { PHASE(27, v_transpose(F)); PHASE(28, attn_phase3(F, L)); }
            else { PHASE(8, attn_phase(F)); PHASE(9, attn_combine(F, L)); }
            PHASE(10, { pg8::ProbPlain P{(const char*)(WSB + WS_BIG + BIG_O0), (const char*)(WSB + WS_W + WO_L1_WO), 2048, 2048, 16, NT_ALL, 4, F.G, VBID, false};
                    pg8::EpiResid E{XPTR, MODPTR + 2 * 1024, nullptr, nullptr, 1.f};
                    pg8::gemm_phase<pg8::EpiResid, pg8::ProbPlain, true>(F.lds, P, E, F.tid); });
        } else {
            PHASE(11, { pg8::ProbS5 P{(const char*)HLPTR, (const char*)HLPTR, (const char*)(WSB + WS_S5M1), 4, 4, 9, F.G, VBID, (size_t)256 * 256 * 2, false};
                    pg8::EpiS1 E{(float*)(WSB + WS_BIG + BIG_H)};
                    pg8::gemm_phase<pg8::EpiS1, pg8::ProbS5, true>(F.lds, P, E, F.tid); });
            PHASE(12, s5_scan(F));
            PHASE(13, { pg8::ProbS5 P{(const char*)HLPTR, (const char*)(WSB + WS_BIG + BIG_SBUF), (const char*)(WSB + WS_S5M3), 8, 4, 8, F.G, VBID, (size_t)256 * 512 * 2, true};
                    pg8::EpiS3 E{(bf16_t*)(WSB + WS_BIG + BIG_YG), MK_FP8_GLU != 0};
                    pg8::gemm_phase<pg8::EpiS3, pg8::ProbS5, true>(F.lds, P, E, F.tid); });
            if (MK_FP8_GLU) {
            PHASE(26, { pg8::ProbPlain P{(const char*)(WSB + WS_BIG + BIG_YG), (const char*)(WSB + WS_W + WO_L2_GLU), 1024, 1024, 8, NT_LAT, 8, F.G, VBID, true};
                    pg8::EpiGlu E{XPTR, MODPTR + 2 * 1024, pg8::W8INV};
                    pg8::gemm_phase<pg8::EpiGlu, pg8::ProbPlain, true, true>(F.lds, P, E, F.tid); });
            } else {
            PHASE(14, { pg8::ProbPlain P{(const char*)(WSB + WS_BIG + BIG_YG), (const char*)(WSB + WS_W + WO_L2_GLU), 2048, 2048, 16, NT_LAT, 8, F.G, VBID, true};
                    pg8::EpiGlu E{XPTR, MODPTR + 2 * 1024, 1.f};
                    pg8::gemm_phase<pg8::EpiGlu, pg8::ProbPlain, true>(F.lds, P, E, F.tid); });
            }
        }
        if (moe) PHASE(15, (row_pass<1, false>(F, L, lat, 3, 0)));
        else PHASE(16, (row_pass<0, false>(F, L, lat, 3, 0, ((MK_FP8_FFN >> L) & 1) != 0)));
        if (!moe) {
            const size_t wo_gu = (L == 0) ? WO_L0_GU : WO_L2_GU, wo_dn = (L == 0) ? WO_L0_DOWN : WO_L2_DOWN;
            if ((MK_FP8_FFN >> L) & 1) {
                PHASE(23, { pg8::ProbPlain P{(const char*)HLPTR, (const char*)(WSB + WS_W + wo_gu), 1024, 1024, 8, lat ? NT_LAT : NT_ALL, 22, F.G, VBID, lat};
                        pg8::EpiGated8 E{(unsigned char*)(WSB + WS_BIG + BIG_HID), DFF, pg8::W8INV};
                        pg8::gemm_phase<pg8::EpiGated8, pg8::ProbPlain, true, true>(F.lds, P, E, F.tid); });
                PHASE(24, { pg8::ProbPlain P{(const char*)(WSB + WS_BIG + BIG_HID), (const char*)(WSB + WS_W + wo_dn), DFF, DFF, 22, lat ? NT_LAT : NT_ALL, 4, F.G, VBID, lat};
                        pg8::EpiResid E{XPTR, MODPTR + 5 * 1024, nullptr, nullptr, pg8::W8INV};
                        pg8::gemm_phase<pg8::EpiResid, pg8::ProbPlain, true, true>(F.lds, P, E, F.tid); });
            } else {
            PHASE(17, { pg8::ProbPlain P{(const char*)HLPTR, (const char*)(WSB + WS_W + wo_gu), 2048, 2048, 16, lat ? NT_LAT : NT_ALL, 22, F.G, VBID, lat};
                    pg8::EpiGated<1> E{(bf16_t*)(WSB + WS_BIG + BIG_HID), DFF, 0, 0, 0};
                    pg8::gemm_phase<pg8::EpiGated<1>, pg8::ProbPlain, true>(F.lds, P, E, F.tid); });
            PHASE(18, { pg8::ProbPlain P{(const char*)(WSB + WS_BIG + BIG_HID), (const char*)(WSB + WS_W + wo_dn), DFF * 2, DFF * 2, 44, lat ? NT_LAT : NT_ALL, 4, F.G, VBID, lat};
                    pg8::EpiResid E{XPTR, MODPTR + 5 * 1024, nullptr, nullptr, 1.f};
                    pg8::gemm_phase<pg8::EpiResid, pg8::ProbPlain, true>(F.lds, P, E, F.tid); });
            }
        } else {
            const size_t wo_gu = (L == 1) ? WO_L1_MGU : WO_L3_MGU, wo_dn = (L == 1) ? WO_L1_MDOWN : WO_L3_MDOWN;
            PHASE(19, moe_scatter(F, lat));
#define TEXPP ((const int*)(F.ws + WS_TEXP))
            PHASE(20, { const int nT = __builtin_amdgcn_readfirstlane(TEXPP[500]);
                    pg8::ProbMoe P{(const char*)(WSB + WS_BIG + BIG_APERM), (const char*)(WSB + WS_W + wo_gu), 1024, 1024, 8, 22, F.G, VBID, WSZ_GU / 2, TEXPP, 0, nT, 0};
                    pg8::EpiGated8 E{(unsigned char*)(WSB + WS_BIG + BIG_MHID), DFF, pg8::W8INV};
                    pg8::gemm_phase<pg8::EpiGated8, pg8::ProbMoe, true, true>(F.lds, P, E, F.tid); });
            PHASE(21, { const int nT = __builtin_amdgcn_readfirstlane(TEXPP[500]);
                    pg8::ProbMoe P{(const char*)(WSB + WS_BIG + BIG_MHID), (const char*)(WSB + WS_W + wo_dn), DFF, DFF, 22, 4, F.G, VBID, WSZ_DOWN / 2, TEXPP, 0, nT, 0};
                    pg8::EpiBf16 E{(bf16_t*)(WSB + WS_BIG + BIG_APERM), DM, 0, pg8::W8INV};
                    pg8::gemm_phase<pg8::EpiBf16, pg8::ProbMoe, true, true>(F.lds, P, E, F.tid); });
        }
    }
    PHASE(22, (row_pass<2, true>(F, 3, true, 0, 3)));
#undef PHASE
#undef WSB
#undef XPTR
#undef HLPTR
#undef VBID
#undef MODPTR
#undef TEXPP
}
constexpr int N_PHASES = 1 + (1 + 3 + 1 + 2) + (1 + 4 + 1 + 1 + 2) + (1 + 4 + 1 + 2) + (1 + 3 + 1 + 1 + 2) + 1;

extern "C" void kernel_launch(void* const* d_in, const int* in_sizes, int n_in, void* d_out, int out_size, void* d_ws, size_t ws_size, hipStream_t stream) {
    static int grid = 0;
    if (grid == 0) {
        if (n_in != 50 || in_sizes[0] != NB * SEQ * DM || out_size != NB * SEQ * DM || ws_size < WS_END) {
            fprintf(stderr, "kernel_launch: unexpected shapes (n_in %d, in0 %d, out %d, ws %zu < %zu)\n", n_in, n_in > 0 ? in_sizes[0] : -1, out_size, ws_size, (size_t)WS_END); grid = -1; return; }
        int dev = 0, cus = 0, per_cu = 0;
        if (hipGetDevice(&dev) != hipSuccess || hipDeviceGetAttribute(&cus, hipDeviceAttributeMultiprocessorCount, dev) != hipSuccess) { grid = -1; return; }
        if (hipFuncSetAttribute((const void*)mk_fwd, hipFuncAttributeMaxDynamicSharedMemorySize, LDS_BYTES) != hipSuccess) { fprintf(stderr, "kernel_launch: hipFuncSetAttribute failed\n"); grid = -1; return; }
        if (hipOccupancyMaxActiveBlocksPerMultiprocessor(&per_cu, (const void*)mk_fwd, NTHREADS, LDS_BYTES) != hipSuccess || per_cu < 1) { fprintf(stderr, "kernel_launch: occupancy query says %d\n", per_cu); }
        (void)hipGetLastError();
        grid = cus;
    }
    if (grid < 0) return;
    (void)hipMemsetAsync((char*)d_ws + WS_CTL, 0, CTL_ZERO_BYTES, stream);
    Args a{};
    for (int i = 0; i < 50; ++i) a.in[i] = (const float*)d_in[i];
    a.out = (float*)d_out; a.ws = (unsigned char*)d_ws;
#if MK_ONE_LAUNCH
    a.ph_lo = 0; a.ph_hi = N_PHASES;
    hipLaunchKernelGGL(mk_fwd, dim3(grid), dim3(NTHREADS), LDS_BYTES, stream, a);
#else
    for (int p = 0; p < N_PHASES; ++p) { a.ph_lo = p; a.ph_hi = p + 1; hipLaunchKernelGGL(mk_fwd, dim3(grid), dim3(NTHREADS), LDS_BYTES, stream, a); }
#endif
    const hipError_t le = hipPeekAtLastError();
    if (le != hipSuccess) fprintf(stderr, "kernel_launch: launch failed: %s\n", hipGetErrorName(le));
}
```

```cpp
#include <hip/hip_runtime.h>
#include <hip/hip_bf16.h>
#include <cstdio>
#include <cstdint>
#include <cmath>

#ifndef MK_SITEMASK
#define MK_SITEMASK 0xffffffffu
#endif
#ifndef MK_REPEAT_SITE
#define MK_REPEAT_SITE -1
#endif
#ifndef MK_DBG_NOMOE
#define MK_DBG_NOMOE 0
#endif
#ifndef MK_EXTRA_BARS
#define MK_EXTRA_BARS 0
#endif
#ifndef MK_FP8_FFN
#define MK_FP8_FFN 0x4
#endif
#ifndef MK_FP8_QKV
#define MK_FP8_QKV 1
#endif
#ifndef MK_FP8_DOWN0
#define MK_FP8_DOWN0 1
#endif
#ifndef MK_FP8_GLU
#define MK_FP8_GLU 1
#endif
#ifndef MK_ATT_XMFMA
#define MK_ATT_XMFMA 0
#endif
#ifndef MK_ATT_XEXP
#define MK_ATT_XEXP 0
#endif
#ifndef MK_ATT3
#define MK_ATT3 1
#endif
#ifndef MK_XBF16
#define MK_XBF16 1
#endif
#ifndef MK_ATT2
#define MK_ATT2 1
#endif
#ifndef MK_ONE_LAUNCH
#define MK_ONE_LAUNCH 1
#endif

constexpr int DM = 1024, NB = 4, SEQ = 8192, CTXL = 256, RPB = CTXL + SEQ, MALL = NB * RPB;
constexpr int TPB = RPB / 256, NT_ALL = MALL / 256, NT_LAT = NB * SEQ / 256;
constexpr int DFF = 2816, NE = 8, NHEAD = 8;
constexpr float EPS = 1e-6f;
constexpr int NWAVES = 8, NTHREADS = 512;
constexpr int CPB = RPB / 16;
constexpr int MOE_MAXT = 272;

constexpr size_t MiB = 1u << 20;
constexpr size_t WS_CTL = 0, CTL_ZERO_BYTES = 64 * 1024;
constexpr size_t WS_MOD = 1 * MiB;
constexpr size_t WS_ROPE = WS_MOD + 512 * 1024;
constexpr size_t WS_SEL = 2 * MiB;
constexpr size_t WS_SLOT = WS_SEL + (size_t)MALL * 16;
constexpr size_t WS_CNT = WS_SLOT + (size_t)MALL * 8;
constexpr size_t WS_TEXP = WS_CNT + 1024 * 8 * 4;
constexpr size_t WS_S5M3 = 8 * MiB;
constexpr size_t WS_S5M1 = 24 * MiB;
constexpr size_t WS_W = 32 * MiB;
constexpr size_t WS_X = 357 * MiB;
constexpr size_t WS_HL = 489 * MiB;
constexpr size_t WS_BIG = 555 * MiB;
constexpr size_t WS_END = 879 * MiB;
static_assert(WS_TEXP + 4096 <= WS_S5M3, "ws map");
constexpr size_t BIG_BZ = 0, BIG_U = 132 * MiB;
constexpr size_t BIG_Q8 = 0, BIG_K8 = 33 * MiB, BIG_V8 = 66 * MiB, BIG_VT8 = 99 * MiB;
constexpr size_t BIG_QKV = 0, BIG_KH = 66 * MiB, BIG_VH = 132 * MiB, BIG_O0 = 198 * MiB;
constexpr size_t BIG_HID = 0;
constexpr size_t BIG_APERM = 0, BIG_MHID = 136 * MiB;
constexpr size_t BIG_H = 0, BIG_SBUF = 144 * MiB, BIG_YG = 210 * MiB;
static_assert(BIG_MHID + (size_t)MOE_MAXT * 256 * DFF <= WS_END - WS_BIG && BIG_YG + 66 * MiB <= WS_END - WS_BIG && BIG_O0 + 66 * MiB <= WS_END - WS_BIG, "big map");

constexpr size_t WSZ_CONVIN = (size_t)3072 * 1024 * 2, WSZ_SQ = (size_t)1024 * 1024 * 2, WSZ_GU = (size_t)5632 * 1024 * 2, WSZ_DOWN = (size_t)1024 * 2816 * 2, WSZ_GLU = (size_t)2048 * 1024 * 2;
constexpr size_t WO_L0_CONVIN = 0, WO_L0_CONVOUT = WO_L0_CONVIN + WSZ_CONVIN, WO_L0_GU = WO_L0_CONVOUT + WSZ_SQ, WO_L0_DOWN = WO_L0_GU + WSZ_GU;
constexpr size_t WO_L1_QKV = WO_L0_DOWN + WSZ_DOWN, WO_L1_WO = WO_L1_QKV + WSZ_CONVIN, WO_L1_MGU = WO_L1_WO + WSZ_SQ, WO_L1_MDOWN = WO_L1_MGU + 8 * WSZ_GU;
constexpr size_t WO_L2_GLU = WO_L1_MDOWN + 8 * WSZ_DOWN, WO_L2_GU = WO_L2_GLU + WSZ_GLU, WO_L2_DOWN = WO_L2_GU + WSZ_GU;
constexpr size_t WO_L3_CONVIN = WO_L2_DOWN + WSZ_DOWN, WO_L3_CONVOUT = WO_L3_CONVIN + WSZ_CONVIN, WO_L3_MGU = WO_L3_CONVOUT + WSZ_SQ, WO_L3_MDOWN = WO_L3_MGU + 8 * WSZ_GU;
constexpr size_t WO_END = WO_L3_MDOWN + 8 * WSZ_DOWN;
static_assert(WS_W + WO_END <= WS_X, "weights fit");

enum { IN_X = 0, IN_C = 1, IN_CTX = 2, IN_CCTX = 3, IN_FINAL = 49 };
__host__ __device__ constexpr int lbase(int L) { return L == 0 ? 4 : L == 1 ? 13 : L == 2 ? 24 : 39; }

#define LAS __attribute__((address_space(3)))
typedef unsigned short bf16_t;
typedef short bf16x8 __attribute__((ext_vector_type(8)));
typedef float f32x4 __attribute__((ext_vector_type(4)));
typedef float f32x2 __attribute__((ext_vector_type(2)));
typedef unsigned u32x4 __attribute__((ext_vector_type(4)));
typedef unsigned u32x2 __attribute__((ext_vector_type(2)));
#define LDS_WAIT() asm volatile("s_waitcnt lgkmcnt(0)" ::: "memory")
#define VM_WAIT() asm volatile("s_waitcnt vmcnt(0)" ::: "memory")
__device__ __forceinline__ unsigned cvt_pk_bf16(float lo, float hi) { unsigned r; asm volatile("v_cvt_pk_bf16_f32 %0, %1, %2" : "=v"(r) : "v"(lo), "v"(hi)); return r; }
__device__ __forceinline__ float clamp8(float v) { return __builtin_amdgcn_fmed3f(v, -448.f, 448.f); }
__device__ __forceinline__ unsigned cvt4_fp8(float a, float b, float c, float d) {
    unsigned w = 0; w = __builtin_amdgcn_cvt_pk_fp8_f32(clamp8(a), clamp8(b), w, false); w = __builtin_amdgcn_cvt_pk_fp8_f32(clamp8(c), clamp8(d), w, true); return w; }
__device__ __forceinline__ unsigned cvt4_fp8_nc(float a, float b, float c, float d) {
    unsigned w = 0; w = __builtin_amdgcn_cvt_pk_fp8_f32(a, b, w, false); w = __builtin_amdgcn_cvt_pk_fp8_f32(c, d, w, true); return w; }
__device__ __forceinline__ float bf_lo(unsigned w) { return __uint_as_float(w << 16); }
__device__ __forceinline__ float bf_hi(unsigned w) { return __uint_as_float(w & 0xffff0000u); }
#if MK_XBF16
typedef bf16_t xel_t;
__device__ __forceinline__ f32x4 x_ld4(const xel_t* p) { const u32x2 w = *(const u32x2*)p; return (f32x4){bf_lo(w.x), bf_hi(w.x), bf_lo(w.y), bf_hi(w.y)}; }
__device__ __forceinline__ void x_st4(xel_t* p, f32x4 v) { u32x2 w; w.x = cvt_pk_bf16(v[0], v[1]); w.y = cvt_pk_bf16(v[2], v[3]); *(u32x2*)p = w; }
#else
typedef float xel_t;
__device__ __forceinline__ f32x4 x_ld4(const xel_t* p) { return *(const f32x4*)p; }
__device__ __forceinline__ void x_st4(xel_t* p, f32x4 v) { *(f32x4*)p = v; }
#endif
__device__ __forceinline__ float row16_sum(float v) {
    v += __int_as_float(__builtin_amdgcn_mov_dpp(__float_as_int(v), 0xB1, 0xf, 0xf, true));
    v += __int_as_float(__builtin_amdgcn_mov_dpp(__float_as_int(v), 0x4E, 0xf, 0xf, true));
    v += __int_as_float(__builtin_amdgcn_mov_dpp(__float_as_int(v), 0x141, 0xf, 0xf, true));
    v += __int_as_float(__builtin_amdgcn_mov_dpp(__float_as_int(v), 0x140, 0xf, 0xf, true));
    return v;
}
__device__ __forceinline__ float wave_sum(float v) {
    v = row16_sum(v);
    const int vi = __float_as_int(v);
    const float a = __int_as_float(__builtin_amdgcn_readlane(vi, 0)), b = __int_as_float(__builtin_amdgcn_readlane(vi, 16)), c = __int_as_float(__builtin_amdgcn_readlane(vi, 32)), d = __int_as_float(__builtin_amdgcn_readlane(vi, 48));
    return (a + b) + (c + d);
}
__device__ __forceinline__ float fast_sigmoid(float x) { return __builtin_amdgcn_rcpf(1.0f + __builtin_amdgcn_exp2f(-1.4426950408889634f * x)); }
__device__ __forceinline__ float silu_f(float x) { return x * fast_sigmoid(x); }
__device__ __forceinline__ float gelu_tanh_f(float x) { const float u = 0.7978845608028654f * (x + 0.044715f * x * x * x); return x * fast_sigmoid(2.0f * u); }
__device__ __forceinline__ int row_cond(int row) { const int b = row / RPB; return (row - b * RPB) < CTXL ? 4 : b; }
__device__ __forceinline__ int tile_cond(int pm) { const int b = pm / TPB; return (pm - b * TPB) == 0 ? 4 : b; }

#define XB_TMO      128
#define XB_XCNT(j)  (256  + 64 * (j))
#define XB_XSUB(j)  (1280 + 64 * (j))
#define XB_XGEN(j)  (2304 + 64 * (j))
#define XB_TOP      3328
#define XB_TOPGEN   3392
#define XCD_BAR_WORDS 3456
#define XB_SPIN_CAP (1u << 18)
__device__ __forceinline__ unsigned xb_ld(unsigned* p)              { return __hip_atomic_load(p, __ATOMIC_RELAXED, __HIP_MEMORY_SCOPE_AGENT); }
__device__ __forceinline__ unsigned xb_add(unsigned* p, unsigned v) { return __hip_atomic_fetch_add(p, v, __ATOMIC_RELAXED, __HIP_MEMORY_SCOPE_AGENT); }
__device__ __forceinline__ unsigned xb_xcc_id() { return (unsigned)__builtin_amdgcn_s_getreg((3 << 11) | 20) & 0xFu; }
#define XB_SPIN(cond, bar) do { unsigned _sp = 0; while (cond) { __builtin_amdgcn_s_sleep(1); \
    if ((++_sp & 255u) == 0u) { if (xb_ld(&(bar)[XB_TMO])) break; if (_sp > XB_SPIN_CAP) { atomicAdd(&(bar)[XB_TMO], 1u); break; } } } } while (0)
struct XcdBarrier { unsigned* bar; unsigned x; volatile LAS unsigned* st; };
__device__ __forceinline__ XcdBarrier xcd_barrier_post(unsigned* bar, volatile LAS unsigned* st) {
    XcdBarrier b; b.bar = bar; b.x = xb_xcc_id(); b.st = st;
    if (threadIdx.x == 0) (void)xb_add(&bar[XB_XCNT(b.x)], 1u);
    return b;
}
__device__ __forceinline__ void xcd_barrier_complete(unsigned* bar, unsigned x, unsigned& nloc, unsigned& nx) {
    const unsigned G = gridDim.x * gridDim.y * gridDim.z;
    unsigned sum, cnt, mine, sp = 0u;
    for (;;) {
        sum = 0u; cnt = 0u; mine = 0u;
#pragma unroll
        for (unsigned j = 0; j < 16; ++j) { const unsigned c = xb_ld(&bar[XB_XCNT(j)]); sum += c; cnt += (c > 0u) ? 1u : 0u; mine = (j == x) ? c : mine; }
        if (sum == G) break;
        __builtin_amdgcn_s_sleep(1);
        if ((++sp & 255u) == 0u) { if (xb_ld(&bar[XB_TMO])) break; if (sp > XB_SPIN_CAP) { atomicAdd(&bar[XB_TMO], 1u); break; } }
    }
    nloc = mine > 0u ? mine : 1u; nx = cnt > 0u ? cnt : 1u;
}
__device__ __forceinline__ void xcd_barrier(const XcdBarrier& b) {
    asm volatile("s_waitcnt vmcnt(0)" ::: "memory");
    __syncthreads();
    if (threadIdx.x == 0) {
        unsigned* bar = b.bar;
        __builtin_amdgcn_s_waitcnt(0);
        unsigned nloc = b.st[0], nx = b.st[1];
        if (nloc == 0u) { xcd_barrier_complete(bar, b.x, nloc, nx); b.st[0] = nloc; b.st[1] = nx; }
        const unsigned old = xb_add(&bar[XB_XSUB(b.x)], 1u);
        const unsigned gen = old / nloc;
        if (old + 1u == (gen + 1u) * nloc) {
            __builtin_amdgcn_fence(__ATOMIC_RELEASE, "agent");
            asm volatile("s_waitcnt vmcnt(0)" ::: "memory");
            const unsigned og = xb_add(&bar[XB_TOP], 1u);
            const unsigned tg = og / nx;
            if (og + 1u == (tg + 1u) * nx) xb_add(&bar[XB_TOPGEN], 1u);
            else XB_SPIN(xb_ld(&bar[XB_TOPGEN]) == tg, bar);
            __builtin_amdgcn_fence(__ATOMIC_ACQUIRE, "agent");
            xb_add(&bar[XB_XGEN(b.x)], 1u);
            asm volatile("s_waitcnt vmcnt(0)" ::: "memory");
        } else {
            XB_SPIN(xb_ld(&bar[XB_XGEN(b.x)]) == gen, bar);
            __builtin_amdgcn_fence(__ATOMIC_ACQUIRE, "agent");
            asm volatile("s_waitcnt vmcnt(0)" ::: "memory");
        }
    }
    __syncthreads();
}

namespace pg8 {
constexpr int BM = 256, BK = 64, HALF = 128, HTB = HALF * BK * 2, STAGE_BYTES = 8 * HTB, NXCD = 8, WGM = 8;
__host__ __device__ __forceinline__ int lds_byte(int r, int c) { const int st = (r >> 4) * 2 + (c >> 5), rr = r & 15, cc = c & 31, ob = rr * 64 + cc * 2; return st * 1024 + (ob ^ (((ob >> 9) & 1) << 5)); }
__host__ __device__ __forceinline__ void stage_rc(int b, int& R, int& C) { const int st = b / 1024, sb = b % 1024, swz = sb ^ (((sb >> 9) & 1) << 5); R = (st >> 1) * 16 + swz / 64; C = (st & 1) * 32 + (swz % 64) / 2; }
__host__ __device__ __forceinline__ int perm32(int rho) { const int n = rho >> 4, i = rho & 15; return 8 * (i >> 2) + 4 * n + (i & 3); }
struct Unit { int pm, pn, aux; };
__device__ __forceinline__ void order_map(int L, int nM, int nN, int& tm, int& tn) {
    const int nwg = nM * nN; int wgid = L; { const int q = nwg / NXCD, r = nwg % NXCD, xcd = wgid % NXCD, off = wgid / NXCD; wgid = (xcd < r ? xcd * (q + 1) : r * (q + 1) + (xcd - r) * q) + off; }
    const int nig = WGM * nN, gid = wgid / nig, fm = gid * WGM, gsz = (nM - fm) < WGM ? (nM - fm) : WGM;
    tm = fm + ((wgid % nig) % gsz); tn = (wgid % nig) / gsz;
}

template <class Epi, class Prob, bool ALIGN_EPI, bool FP8 = false>
__device__ __forceinline__ void gemm_phase(LAS unsigned char* lds, const Prob& P, const Epi& E, const int tid) {
    const int wid = __builtin_amdgcn_readfirstlane(tid >> 6), lane = tid & 63, wr = wid >> 2, wc = wid & 3, fr = lane & 15, fq = lane >> 4;
    const int nt = P.nt;
    unsigned voffA[2], voffB[2];
#pragma unroll
    for (int i = 0; i < 2; ++i) { int R, C; stage_rc(tid * 16 + i * 8192, R, C); const int Rb = Epi::PERM ? ((R & ~31) + perm32(R & 31)) : R;
        voffA[i] = P.lane_off_a(R, C); voffB[i] = P.lane_off_b(Rb, C); }
    const size_t hsA = P.hstep_a(), hsB = P.hstep_b();
    const unsigned ldsw = (unsigned)wid * 1024u;
    const int aoff = lds_byte(wr * 64 + fr, fq * 8), boff = lds_byte(wc * 32 + fr, fq * 8);
#define PG8_SA(b, h) (((b) * 2 + (h)) * HTB)
#define PG8_SB(b, h) ((4 + (b) * 2 + (h)) * HTB)
#define PG8_STAGE(bufoff, gbase, voff) do { _Pragma("unroll") for (int _i = 0; _i < 2; ++_i) \
        __builtin_amdgcn_global_load_lds((const unsigned*)((const char*)(gbase) + (voff)[_i]), (LAS unsigned*)(lds + (bufoff) + ldsw + _i * 8192), 16, 0, 0); } while (0)
#define PG8_LDA(dst, b, h) do { _Pragma("unroll") for (int m = 0; m < 4; ++m) _Pragma("unroll") for (int k = 0; k < 2; ++k) dst[m][k] = *(const LAS bf16x8*)(lds + PG8_SA(b, h) + aoff + m * 2048 + k * 1024); } while (0)
#define PG8_LDB(dst, b, h) do { _Pragma("unroll") for (int n = 0; n < 2; ++n) _Pragma("unroll") for (int k = 0; k < 2; ++k) dst[n][k] = *(const LAS bf16x8*)(lds + PG8_SB(b, h) + boff + n * 2048 + k * 1024); } while (0)
#define PG8_MMA(ai, bj, At, Bt) do { __builtin_amdgcn_s_setprio(1); _Pragma("unroll") for (int m = 0; m < 4; ++m) _Pragma("unroll") for (int n = 0; n < 2; ++n) { \
        if constexpr (FP8) { typedef int v4i_ __attribute__((ext_vector_type(4))); typedef int v8i_ __attribute__((ext_vector_type(8))); \
            const v4i_ b0_ = __builtin_bit_cast(v4i_, Bt[n][0]), b1_ = __builtin_bit_cast(v4i_, Bt[n][1]), a0_ = __builtin_bit_cast(v4i_, At[m][0]), a1_ = __builtin_bit_cast(v4i_, At[m][1]); \
            const v8i_ bb_ = {b0_[0], b0_[1], b0_[2], b0_[3], b1_[0], b1_[1], b1_[2], b1_[3]}, aa_ = {a0_[0], a0_[1], a0_[2], a0_[3], a1_[0], a1_[1], a1_[2], a1_[3]}; \
              \
            asm volatile("v_mfma_scale_f32_16x16x128_f8f6f4 %0, %1, %2, %0, %3, %3 op_sel_hi:[0,0,0]" : "+v"(acc[ai][bj][m][n]) : "v"(bb_), "v"(aa_), "v"(0x7f7f7f7f)); } \
        else { _Pragma("unroll") for (int k = 0; k < 2; ++k) acc[ai][bj][m][n] = __builtin_amdgcn_mfma_f32_16x16x32_bf16(Bt[n][k], At[m][k], acc[ai][bj][m][n], 0, 0, 0); } } \
        __builtin_amdgcn_s_setprio(0); } while (0)
#define PG8_WAIT_V(n) asm volatile("s_waitcnt vmcnt(" #n ")" ::: "memory")
#define PG8_WAIT_L(n) asm volatile("s_waitcnt lgkmcnt(" #n ")" ::: "memory")
#define PG8_BAR __builtin_amdgcn_s_barrier()
#define PG8_SCHED __builtin_amdgcn_sched_barrier(0)
    Unit cur, nxt; int ui = 0;
    if (!P.next(0, cur)) return;
    f32x4 acc[2][2][4][2];
#pragma unroll
    for (int a = 0; a < 2; ++a)
#pragma unroll
        for (int b = 0; b < 2; ++b)
#pragma unroll
            for (int m = 0; m < 4; ++m)
#pragma unroll
                for (int n = 0; n < 2; ++n) acc[a][b][m][n] = (f32x4){0.f, 0.f, 0.f, 0.f};
    bf16x8 At[4][2], B0[2][2], B1[2][2];
    {
        const char* cA = P.a_ptr(cur, 0); const char* cB = P.b_ptr(cur, 0); const char* cA1 = P.a_ptr(cur, 1); const char* cB1 = P.b_ptr(cur, 1);
        PG8_STAGE(PG8_SB(0, 0), cB, voffB); PG8_STAGE(PG8_SB(0, 1), cB + hsB, voffB); PG8_STAGE(PG8_SA(0, 0), cA, voffA); PG8_STAGE(PG8_SA(0, 1), cA + hsA, voffA);
        if (wr == 1) PG8_BAR;
        PG8_WAIT_V(2); PG8_BAR;
        PG8_STAGE(PG8_SB(1, 0), cB1, voffB); PG8_STAGE(PG8_SA(1, 0), cA1, voffA); PG8_STAGE(PG8_SB(1, 1), cB1 + hsB, voffB);
        PG8_WAIT_V(6); PG8_BAR;
    }
    for (;;) {
        const bool has_next = P.next(ui + 1, nxt);
        const Unit nu = has_next ? nxt : cur;
        for (int t = 0; t < nt; t += 2) {
            const bool last = (t == nt - 2);
            const char* a1 = P.a_ptr(cur, t + 1);
            const char* a2 = last ? P.a_ptr(nu, 0) : P.a_ptr(cur, t + 2); const char* b2 = last ? P.b_ptr(nu, 0) : P.b_ptr(cur, t + 2);
            const char* a3 = last ? P.a_ptr(nu, 1) : P.a_ptr(cur, t + 3); const char* b3 = last ? P.b_ptr(nu, 1) : P.b_ptr(cur, t + 3);
            PG8_LDB(B0, 0, 0); PG8_LDB(B1, 0, 1); PG8_SCHED; PG8_LDA(At, 0, 0); PG8_STAGE(PG8_SA(1, 1), a1 + hsA, voffA);
            PG8_WAIT_V(8); PG8_WAIT_L(0); PG8_BAR; PG8_MMA(0, 0, At, B0); PG8_MMA(0, 1, At, B1); PG8_BAR; PG8_SCHED;
            PG8_LDA(At, 0, 1); PG8_STAGE(PG8_SB(0, 0), b2, voffB); PG8_STAGE(PG8_SB(0, 1), b2 + hsB, voffB); PG8_STAGE(PG8_SA(0, 0), a2, voffA);
            PG8_WAIT_V(8); PG8_WAIT_L(0); PG8_BAR; PG8_MMA(1, 0, At, B0); PG8_MMA(1, 1, At, B1); PG8_BAR; PG8_SCHED;
            PG8_LDB(B0, 1, 0); PG8_LDB(B1, 1, 1); PG8_SCHED; PG8_LDA(At, 1, 0); PG8_STAGE(PG8_SA(0, 1), a2 + hsA, voffA);
            PG8_WAIT_V(8); PG8_WAIT_L(0); PG8_BAR; PG8_MMA(0, 0, At, B0); PG8_MMA(0, 1, At, B1); PG8_BAR; PG8_SCHED;
            PG8_LDA(At, 1, 1); PG8_STAGE(PG8_SB(1, 0), b3, voffB); PG8_STAGE(PG8_SB(1, 1), b3 + hsB, voffB); PG8_STAGE(PG8_SA(1, 0), a3, voffA);
            PG8_WAIT_V(8); PG8_WAIT_L(0); PG8_BAR; PG8_MMA(1, 0, At, B0); PG8_MMA(1, 1, At, B1); PG8_BAR; PG8_SCHED;
        }
        if constexpr (ALIGN_EPI) { if (wr == 0) PG8_BAR; }
        if constexpr (FP8) { asm volatile("s_nop 15\n\ts_nop 15" ::: "memory");
#pragma unroll
            for (int a_ = 0; a_ < 2; ++a_)
#pragma unroll
                for (int b_ = 0; b_ < 2; ++b_)
#pragma unroll
                    for (int m_ = 0; m_ < 4; ++m_) asm volatile("" : "+v"(acc[a_][b_][m_][0]), "+v"(acc[a_][b_][m_][1])); }
        { int l_e; asm volatile("v_mbcnt_lo_u32_b32 %0, -1, 0\n\tv_mbcnt_hi_u32_b32 %0, -1, %0" : "=v"(l_e)); E(acc, cur, wr, wc, l_e & 15, l_e >> 4); }
        if (!has_next) break;
#pragma unroll
        for (int a = 0; a < 2; ++a)
#pragma unroll
            for (int b = 0; b < 2; ++b)
#pragma unroll
                for (int m = 0; m < 4; ++m)
#pragma unroll
                    for (int n = 0; n < 2; ++n) acc[a][b][m][n] = (f32x4){0.f, 0.f, 0.f, 0.f};
        cur = nxt; ++ui;
        if constexpr (ALIGN_EPI) { if (wr == 1) PG8_BAR; }
    }
    PG8_WAIT_V(0);
    if constexpr (!ALIGN_EPI) { if (wr == 0) PG8_BAR; }
    PG8_BAR;
#undef PG8_SA
#undef PG8_SB
#undef PG8_STAGE
#undef PG8_LDA
#undef PG8_LDB
#undef PG8_MMA
#undef PG8_WAIT_V
#undef PG8_WAIT_L
#undef PG8_BAR
#undef PG8_SCHED
}

struct ProbPlain {
    const char* A; const char* Bt; int lda_b, ldb_b, nt, nM, nN, G, c; bool latent;
    __device__ __forceinline__ bool next(int i, Unit& u) const {
        const long L = (long)i * G + c; if (L >= (long)nM * nN) return false;
        int tm, tn; order_map((int)L, nM, nN, tm, tn); u.pm = latent ? tm + (tm >> 5) + 1 : tm; u.pn = tn; u.aux = 0; return true; }
    __device__ __forceinline__ const char* a_ptr(const Unit& u, int kt) const { return A + (size_t)u.pm * 256 * lda_b + (size_t)kt * 128; }
    __device__ __forceinline__ const char* b_ptr(const Unit& u, int kt) const { return Bt + (size_t)u.pn * 256 * ldb_b + (size_t)kt * 128; }
    __device__ __forceinline__ size_t hstep_a() const { return (size_t)128 * lda_b; }
    __device__ __forceinline__ size_t hstep_b() const { return (size_t)128 * ldb_b; }
    __device__ __forceinline__ unsigned lane_off_a(int R, int C) const { return (unsigned)(R * lda_b + C * 2); }
    __device__ __forceinline__ unsigned lane_off_b(int R, int C) const { return (unsigned)(R * ldb_b + C * 2); }
};
struct ProbMoe {
    const char* A; const char* Bt; int lda_b, ldb_b, nt, nN, G, c; size_t bstride_e; const int* texp; int tile0, ntile, a_rel;
    __device__ __forceinline__ bool next(int i, Unit& u) const {
        const long L = (long)i * G + c; if (L >= (long)ntile * nN) return false;
        int tm, tn; order_map((int)L, ntile, nN, tm, tn); u.pm = tile0 + tm; u.pn = tn; u.aux = __builtin_amdgcn_readfirstlane(texp[u.pm]); return true; }
    __device__ __forceinline__ const char* a_ptr(const Unit& u, int kt) const { return A + (size_t)(u.pm - a_rel) * 256 * lda_b + (size_t)kt * 128; }
    __device__ __forceinline__ const char* b_ptr(const Unit& u, int kt) const { return Bt + (size_t)u.aux * bstride_e + (size_t)u.pn * 256 * ldb_b + (size_t)kt * 128; }
    __device__ __forceinline__ size_t hstep_a() const { return (size_t)128 * lda_b; }
    __device__ __forceinline__ size_t hstep_b() const { return (size_t)128 * ldb_b; }
    __device__ __forceinline__ unsigned lane_off_a(int R, int C) const { return (unsigned)(R * lda_b + C * 2); }
    __device__ __forceinline__ unsigned lane_off_b(int R, int C) const { return (unsigned)(R * ldb_b + C * 2); }
};
constexpr int S5_ROWS = 4 * 8448;
struct ProbS5 {
    const char* A0; const char* A1; const char* Bt; int nt, nt0, ntile, G, c; size_t bstride_g; bool s3;
    __device__ __forceinline__ bool next(int i, Unit& u) const {
        const int vcu = (G % 8 == 0) ? (c % 8) * (G / 8) + c / 8 : c;
        const long L = (long)i * G + vcu; if (L >= (long)ntile * 64) return false;
        u.pm = (int)(L >> 6); u.pn = (int)(L & 63); u.aux = 0; return true; }
    __device__ __forceinline__ size_t tokbase(int pm) const { return s3 ? (size_t)(pm >> 1) * RPB + CTXL + (size_t)(pm & 1) * 4096 : (size_t)pm * 4096; }
    __device__ __forceinline__ const char* a_ptr(const Unit& u, int kt) const { return kt < nt0 ? A0 + ((size_t)u.pn * S5_ROWS + tokbase(u.pm)) * 32 + (size_t)kt * 128 : A1 + ((size_t)u.pn * (S5_ROWS / 16) + tokbase(u.pm) / 16) * 512 + (size_t)(kt - nt0) * 128; }
    __device__ __forceinline__ const char* b_ptr(const Unit& u, int kt) const { return Bt + (size_t)u.pn * bstride_g + (size_t)kt * 128; }
    __device__ __forceinline__ size_t hstep_a() const { return (size_t)128 * 512; }
    __device__ __forceinline__ size_t hstep_b() const { return (size_t)128 * nt * 128; }
    __device__ __forceinline__ unsigned lane_off_a(int R, int C) const { return (unsigned)(R * 512 + C * 2); }
    __device__ __forceinline__ unsigned lane_off_b(int R, int C) const { return (unsigned)(R * nt * 128 + C * 2); }
};

typedef f32x4 Acc[2][2][4][2];
constexpr float W8SCALE = 64.f, W8INV = 1.f / 64.f;
constexpr float QSCALE = 0.125f * 1.4426950408889634f;
__device__ __forceinline__ u32x4 pack8(f32x4 v0, f32x4 v1) { u32x4 w; w.x = cvt_pk_bf16(v0[0], v0[1]); w.y = cvt_pk_bf16(v0[2], v0[3]); w.z = cvt_pk_bf16(v1[0], v1[1]); w.w = cvt_pk_bf16(v1[2], v1[3]); return w; }

struct EpiBf16 {
    static constexpr bool PERM = true;
    bf16_t* O; int ldc; int pm_sub; float s;
    __device__ __forceinline__ void operator()(const Acc& acc, const Unit& u, int wr, int wc, int fr, int fq) const {
        const int row0 = (u.pm - pm_sub) * BM + wr * 64 + fr, col0 = u.pn * BM + wc * 32 + 8 * fq;
#pragma unroll
        for (int ai = 0; ai < 2; ++ai)
#pragma unroll
            for (int m = 0; m < 4; ++m) { bf16_t* rowp = O + (size_t)(row0 + ai * HALF + m * 16) * ldc + col0;
#pragma unroll
                for (int bj = 0; bj < 2; ++bj) *(u32x4*)(rowp + bj * HALF) = pack8(acc[ai][bj][m][0] * s, acc[ai][bj][m][1] * s); }
    }
};
template <int ACT> struct EpiGated {
    static constexpr bool PERM = true;
    bf16_t* O; int ldc; int pn0; int col_base; int pm_sub;
    __device__ __forceinline__ void operator()(const Acc& acc, const Unit& u, int wr, int wc, int fr, int fq) const {
        const int row0 = (u.pm - pm_sub) * BM + wr * 64 + fr;
        if (u.pn < pn0) {
            const int col0 = u.pn * BM + wc * 32 + 8 * fq;
#pragma unroll
            for (int ai = 0; ai < 2; ++ai)
#pragma unroll
                for (int m = 0; m < 4; ++m) { bf16_t* rowp = O + (size_t)(row0 + ai * HALF + m * 16) * ldc + col0;
#pragma unroll
                    for (int bj = 0; bj < 2; ++bj) *(u32x4*)(rowp + bj * HALF) = pack8(acc[ai][bj][m][0], acc[ai][bj][m][1]); }
        } else {
            const int col0 = col_base + (u.pn - pn0) * HALF + wc * 32 + 8 * fq;
#pragma unroll
            for (int ai = 0; ai < 2; ++ai)
#pragma unroll
                for (int m = 0; m < 4; ++m) { bf16_t* rowp = O + (size_t)(row0 + ai * HALF + m * 16) * ldc + col0;
                    f32x4 a0 = acc[ai][0][m][0], a1 = acc[ai][0][m][1];
                    if (ACT == 1) {
#pragma unroll
                        for (int e = 0; e < 4; ++e) { a0[e] = silu_f(a0[e]); a1[e] = silu_f(a1[e]); } }
                    *(u32x4*)rowp = pack8(a0 * acc[ai][1][m][0], a1 * acc[ai][1][m][1]); }
        }
    }
};
struct EpiGated8 {
    static constexpr bool PERM = true;
    unsigned char* O; int ldc; float s;
    __device__ __forceinline__ void operator()(const Acc& acc, const Unit& u, int wr, int wc, int fr, int fq) const {
        const int row0 = u.pm * BM + wr * 64 + fr, col0 = u.pn * HALF + wc * 32 + 8 * fq;
#pragma unroll
        for (int ai = 0; ai < 2; ++ai)
#pragma unroll
            for (int m = 0; m < 4; ++m) { unsigned char* rowp = O + (size_t)(row0 + ai * HALF + m * 16) * ldc + col0;
                f32x4 a0 = acc[ai][0][m][0] * s, a1 = acc[ai][0][m][1] * s; const f32x4 b0 = acc[ai][1][m][0] * s, b1 = acc[ai][1][m][1] * s;
#pragma unroll
                for (int e = 0; e < 4; ++e) { a0[e] = silu_f(a0[e]) * b0[e]; a1[e] = silu_f(a1[e]) * b1[e]; }
                u32x2 w; w.x = cvt4_fp8(a0[0], a0[1], a0[2], a0[3]); w.y = cvt4_fp8(a1[0], a1[1], a1[2], a1[3]);
                *(u32x2*)rowp = w; }
    }
};
struct EpiResid {
    static constexpr bool PERM = false;
    xel_t* X; const float* gate;
    const float* xin; const float* cin;
    float s;
    __device__ __forceinline__ void operator()(const Acc& acc, const Unit& u, int wr, int wc, int fr, int fq) const {
        const int row0 = u.pm * BM + wr * 64 + fr, col0 = u.pn * BM + wc * 32 + 4 * fq;
        const float* gp = gate + tile_cond(u.pm) * 6144 + col0;
        const int bq = u.pm / TPB, tq = u.pm - bq * TPB;
        const float* srcin = xin ? (tq == 0 ? cin + (size_t)bq * CTXL * DM : xin + ((size_t)bq * SEQ + (size_t)(tq - 1) * 256) * DM) - (size_t)u.pm * BM * DM : nullptr;
        f32x4 gv[2][2];
#pragma unroll
        for (int bj = 0; bj < 2; ++bj)
#pragma unroll
            for (int n = 0; n < 2; ++n) gv[bj][n] = *(const f32x4*)(gp + bj * HALF + n * 16);
#pragma unroll
        for (int ai = 0; ai < 2; ++ai)
#pragma unroll
            for (int m = 0; m < 4; ++m) { const size_t off = (size_t)(row0 + ai * HALF + m * 16) * DM + col0;
#pragma unroll
                for (int bj = 0; bj < 2; ++bj)
#pragma unroll
                    for (int n = 0; n < 2; ++n) { const size_t o2 = off + bj * HALF + n * 16; const f32x4 xv = srcin ? *(const f32x4*)(srcin + o2) : x_ld4(X + o2); x_st4(X + o2, xv + gv[bj][n] * (acc[ai][bj][m][n] * s)); }
                if (m & 1) asm volatile("" ::: "memory"); }
    }
};
struct EpiGlu {
    static constexpr bool PERM = false;
    xel_t* X; const float* gate; float s;
    __device__ __forceinline__ void operator()(const Acc& acc, const Unit& u, int wr, int wc, int fr, int fq) const {
        const int row0 = u.pm * BM + wr * 64 + fr, col0 = u.pn * HALF + wc * 32 + 4 * fq;
        const float* gp = gate + tile_cond(u.pm) * 6144 + col0;
        f32x4 gv[2];
#pragma unroll
        for (int n = 0; n < 2; ++n) gv[n] = *(const f32x4*)(gp + n * 16);
#pragma unroll
        for (int ai = 0; ai < 2; ++ai)
#pragma unroll
            for (int m = 0; m < 4; ++m) { xel_t* rowp = X + (size_t)(row0 + ai * HALF + m * 16) * DM + col0;
#pragma unroll
                for (int n = 0; n < 2; ++n) { f32x4 sg = acc[ai][1][m][n] * s;
#pragma unroll
                    for (int e = 0; e < 4; ++e) sg[e] = fast_sigmoid(sg[e]);
                    xel_t* p = rowp + n * 16; x_st4(p, x_ld4(p) + gv[n] * ((acc[ai][0][m][n] * s) * sg)); }
                if (m & 1) asm volatile("" ::: "memory"); }
    }
};
template <bool OUT8, bool W8> struct EpiQkv {
    static constexpr bool PERM = true;
    unsigned char* big; const float* cosT;
    __device__ __forceinline__ void operator()(const Acc& acc, const Unit& u, int wr, int wc, int fr, int fq) const {
        const float s = W8 ? W8INV : 1.f; const float* sinT = cosT + 128 * 16;
        const int row0 = u.pm * BM + wr * 64 + fr;
        const int bq = u.pm / TPB, tq = u.pm - bq * TPB;
        const bool rope = (u.pn < 8) && (tq != 0);
        const int sect = u.pn >> 2;
        const int cs0 = (u.pn & 3) * BM + wc * 32 + 8 * fq;
#pragma unroll
        for (int ai = 0; ai < 2; ++ai)
#pragma unroll
            for (int m = 0; m < 4; ++m) { const int row = row0 + ai * HALF + m * 16; const int j = row - bq * RPB;
                f32x4 c4 = (f32x4){1.f, 1.f, 1.f, 1.f}, s4 = (f32x4){0.f, 0.f, 0.f, 0.f};
                if (rope) { const int t = j - CTXL; const int pos = (wc & 1) ? (t & 63) : (t >> 6);
                    c4 = *(const f32x4*)(cosT + pos * 16 + 4 * fq); s4 = *(const f32x4*)(sinT + pos * 16 + 4 * fq); }
#pragma unroll
                for (int bj = 0; bj < 2; ++bj) { const f32x4 v0 = acc[ai][bj][m][0] * s, v1 = acc[ai][bj][m][1] * s; f32x4 o0, o1;
                    o0[0] = v0[0] * c4[0] - v0[1] * s4[0]; o0[1] = v0[1] * c4[0] + v0[0] * s4[0];
                    o0[2] = v0[2] * c4[1] - v0[3] * s4[1]; o0[3] = v0[3] * c4[1] + v0[2] * s4[1];
                    o1[0] = v1[0] * c4[2] - v1[1] * s4[2]; o1[1] = v1[1] * c4[2] + v1[0] * s4[2];
                    o1[2] = v1[2] * c4[3] - v1[3] * s4[3]; o1[3] = v1[3] * c4[3] + v1[2] * s4[3];
                    const int cs = cs0 + bj * HALF;
                    if constexpr (OUT8) {
                        size_t off8; float sc8 = 1.f;
                        if (sect == 0) { sc8 = QSCALE * 16.f; off8 = BIG_Q8 + (size_t)row * DM + cs; }
                        else if (sect == 1) off8 = BIG_K8 + ((size_t)(bq * 16 + (cs >> 6)) * RPB + j) * 64 + (cs & 63);
                        else off8 = BIG_V8 + ((size_t)(bq * 8 + (cs >> 7)) * RPB + j) * 128 + (cs & 127);
                        u32x2 w8; w8.x = cvt4_fp8(o0[0] * sc8, o0[1] * sc8, o0[2] * sc8, o0[3] * sc8); w8.y = cvt4_fp8(o1[0] * sc8, o1[1] * sc8, o1[2] * sc8, o1[3] * sc8);
                        *(u32x2*)(big + off8) = w8;
                    } else { size_t offb;
                        if (sect == 0) { o0 = o0 * QSCALE; o1 = o1 * QSCALE; offb = BIG_QKV + ((size_t)row * DM + cs) * 2; }
                        else if (sect == 1) offb = BIG_KH + (((size_t)(bq * 16 + (cs >> 6)) * RPB + j) * 64 + (cs & 63)) * 2;
                        else offb = BIG_VH + (((size_t)(bq * 8 + (cs >> 7)) * RPB + j) * 128 + (cs & 127)) * 2;
                        *(u32x4*)(big + offb) = pack8(o0, o1); } } }
    }
};
struct EpiS1 {
    static constexpr bool PERM = false;
    float* H;
    __device__ __forceinline__ void operator()(const Acc& acc, const Unit& u, int wr, int wc, int fr, int fq) const {
        const int row0 = u.pm * BM + wr * 64 + fr, col0 = wc * 32 + 4 * fq;
#pragma unroll
        for (int ai = 0; ai < 2; ++ai)
#pragma unroll
            for (int m = 0; m < 4; ++m) { float* rowp = H + ((size_t)(row0 + ai * HALF + m * 16) * 64 + u.pn) * 256 + col0;
#pragma unroll
                for (int bj = 0; bj < 2; ++bj)
#pragma unroll
                    for (int n = 0; n < 2; ++n) *(f32x4*)(rowp + bj * HALF + n * 16) = acc[ai][bj][m][n]; }
    }
};
struct EpiS3 {
    static constexpr bool PERM = true;
    bf16_t* YG; bool out8;
    __device__ __forceinline__ void operator()(const Acc& acc, const Unit& u, int wr, int wc, int fr, int fq) const {
        const size_t tb = (size_t)(u.pm >> 1) * RPB + CTXL + (size_t)(u.pm & 1) * 4096;
        const int r0 = wr * 64 + fr;
#pragma unroll
        for (int ai = 0; ai < 2; ++ai)
#pragma unroll
            for (int m = 0; m < 4; ++m) { const int R = r0 + ai * HALF + m * 16;
#pragma unroll
                for (int bj = 0; bj < 2; ++bj) { const int t = 8 * bj + 2 * wc + (fq >> 1), s0 = 8 * (fq & 1);
                    f32x4 v0 = acc[ai][bj][m][0], v1 = acc[ai][bj][m][1];
#pragma unroll
                    for (int e = 0; e < 4; ++e) { v0[e] = gelu_tanh_f(v0[e]); v1[e] = gelu_tanh_f(v1[e]); }
                    const size_t eoff = (tb + (size_t)R * 16 + t) * DM + u.pn * 16 + s0;
                    if (out8) { u32x2 w; w.x = cvt4_fp8(v0[0], v0[1], v0[2], v0[3]); w.y = cvt4_fp8(v1[0], v1[1], v1[2], v1[3]); *(u32x2*)((unsigned char*)YG + eoff) = w; }
                    else *(u32x4*)(YG + eoff) = pack8(v0, v1); } }
    }
};
}

namespace att {
using bf16x8 = __attribute__((ext_vector_type(8))) short;
using s16x4  = __attribute__((ext_vector_type(4))) short;
using f32x16 = __attribute__((ext_vector_type(16))) float;
constexpr int NW = 8, QBLK = 32, KVBLK = 64;
constexpr float SCALE = 0.125f, THR = 8.f;
constexpr int KROW = 144;
constexpr int SHM_V = KVBLK * 128 * 2, SHM_K = KVBLK * KROW;
constexpr int OFF_V = 0, OFF_K = 2 * SHM_V, OFF_WS = OFF_K + 2 * SHM_K, OFF_OST = OFF_WS + NW * 64 * 4, ATT_LDS = OFF_OST + NW * 8192;
constexpr int LDQ = 3072;
#define SBAR() __builtin_amdgcn_sched_barrier(0)
__device__ __forceinline__ int crow(int r, int hi) { return (r & 3) + 8 * (r >> 2) + 4 * hi; }
__device__ __forceinline__ void partialSM(f32x16& p0, f32x16& p1, float& m_reg, float& mn, float& alpha) {
  constexpr float C = SCALE * 1.4426950408889634f;
  float pmax = p0[0];
#pragma unroll
  for (int r = 1; r < 16; ++r) pmax = fmaxf(pmax, p0[r]);
#pragma unroll
  for (int r = 0; r < 16; ++r) pmax = fmaxf(pmax, p1[r]);
  { auto rr = __builtin_amdgcn_permlane32_swap(__float_as_uint(pmax), __float_as_uint(pmax), false, false);
    pmax = fmaxf(__uint_as_float(rr[0]), __uint_as_float(rr[1])); }
  if (__builtin_expect(__all(pmax - m_reg <= THR / SCALE), 1)) { mn = m_reg; alpha = 1.f; }
  else { mn = fmaxf(m_reg, pmax); alpha = __builtin_amdgcn_exp2f((m_reg - mn) * C); m_reg = mn; }
  float mnC = -mn * C;
#pragma unroll
  for (int r = 0; r < 16; ++r) p0[r] = fmaf(p0[r], C, mnC);
#pragma unroll
  for (int r = 0; r < 16; ++r) p1[r] = fmaf(p1[r], C, mnC);
#pragma unroll
  for (int r = 0; r < 16; ++r) p0[r] = __builtin_amdgcn_exp2f(p0[r]);
}
__device__ __forceinline__ void finishSM(f32x16& p0, f32x16& p1, float alpha, float& l_reg, bf16x8& pa0, bf16x8& pa1, bf16x8& pa2, bf16x8& pa3) {
#pragma unroll
  for (int r = 0; r < 16; ++r) p1[r] = __builtin_amdgcn_exp2f(p1[r]);
  float ps = 0;
#pragma unroll
  for (int r = 0; r < 16; ++r) ps += p0[r];
#pragma unroll
  for (int r = 0; r < 16; ++r) ps += p1[r];
  { auto rr = __builtin_amdgcn_permlane32_swap(__float_as_uint(ps), __float_as_uint(ps), false, false);
    ps = __uint_as_float(rr[0]) + __uint_as_float(rr[1]); }
  l_reg = l_reg * alpha + ps;
#define PK4(P, BASE, OUT) do { u32x4 w = {cvt_pk_bf16(P[BASE + 0], P[BASE + 1]), cvt_pk_bf16(P[BASE + 2], P[BASE + 3]), cvt_pk_bf16(P[BASE + 4], P[BASE + 5]), cvt_pk_bf16(P[BASE + 6], P[BASE + 7])}; \
    OUT = *reinterpret_cast<bf16x8*>(&w); } while (0)
  PK4(p0, 0, pa0); PK4(p0, 8, pa1); PK4(p1, 0, pa2); PK4(p1, 8, pa3);
#undef PK4
}
__device__ __forceinline__ void qkt(f32x16& p0, f32x16& p1, const char* Ks, const bf16x8* qr, int r32, int hi) {
  p0 = f32x16{}; p1 = f32x16{};
#pragma unroll
  for (int d0 = 0; d0 < 4; ++d0) { const int cb = (d0 * 16 + hi * 8) * 2;
    bf16x8 b0 = *reinterpret_cast<const bf16x8*>(Ks + r32 * KROW + cb);
    bf16x8 b1 = *reinterpret_cast<const bf16x8*>(Ks + (32 + r32) * KROW + cb);
    p0 = __builtin_amdgcn_mfma_f32_32x32x16_bf16(b0, qr[d0], p0, 0, 0, 0);
    p1 = __builtin_amdgcn_mfma_f32_32x32x16_bf16(b1, qr[d0], p1, 0, 0, 0); }
}
__device__ __forceinline__ int v_st(int k, int c) { const int kk = k; return ((kk >> 3) * 4 + (c >> 5)) * 512 + ((kk & 7) * 32 + (c & 31)) * 2; }
__device__ __forceinline__ int v_rd_base(int lane) { return ((lane & 3) << 3) | (((lane >> 2) & 3) << 6) | (((lane >> 4) & 1) << 5) | (((lane >> 5) & 1) << 8); }
constexpr int v_rd_off(int d0, int ks, int half) { return d0 * 512 + ks * 4096 + half * 2048; }
template <int OFF> __device__ __forceinline__ s16x4 tr_read(int vb) {
  s16x4 r; asm volatile("ds_read_b64_tr_b16 %0, %1 offset:%2" : "=&v"(r) : "v"(vb), "i"(OFF) : "memory"); return r;
}
template <int D0> __device__ __forceinline__ void pv_one(f32x16& od, int vb, bf16x8 pa0, bf16x8 pa1, bf16x8 pa2, bf16x8 pa3) {
  const s16x4 l0 = tr_read<v_rd_off(D0, 0, 0)>(vb), h0 = tr_read<v_rd_off(D0, 0, 1)>(vb), l1 = tr_read<v_rd_off(D0, 1, 0)>(vb), h1 = tr_read<v_rd_off(D0, 1, 1)>(vb);
  const s16x4 l2 = tr_read<v_rd_off(D0, 2, 0)>(vb), h2 = tr_read<v_rd_off(D0, 2, 1)>(vb), l3 = tr_read<v_rd_off(D0, 3, 0)>(vb), h3 = tr_read<v_rd_off(D0, 3, 1)>(vb);
  asm volatile("s_waitcnt lgkmcnt(0)" ::: "memory"); SBAR();
#define PK(L, H) (bf16x8){L[0], L[1], L[2], L[3], H[0], H[1], H[2], H[3]}
  od = __builtin_amdgcn_mfma_f32_32x32x16_bf16(pa0, PK(l0, h0), od, 0, 0, 0);
  od = __builtin_amdgcn_mfma_f32_32x32x16_bf16(pa1, PK(l1, h1), od, 0, 0, 0);
  od = __builtin_amdgcn_mfma_f32_32x32x16_bf16(pa2, PK(l2, h2), od, 0, 0, 0);
  od = __builtin_amdgcn_mfma_f32_32x32x16_bf16(pa3, PK(l3, h3), od, 0, 0, 0);
#undef PK
}
__device__ __forceinline__ void pv_d0(f32x16* o, int vb, bf16x8 pa0, bf16x8 pa1, bf16x8 pa2, bf16x8 pa3) {
  pv_one<0>(o[0], vb, pa0, pa1, pa2, pa3); pv_one<1>(o[1], vb, pa0, pa1, pa2, pa3); pv_one<2>(o[2], vb, pa0, pa1, pa2, pa3); pv_one<3>(o[3], vb, pa0, pa1, pa2, pa3);
}
__device__ __forceinline__ void attn_unit(const bf16_t* __restrict__ Qb, const bf16_t* __restrict__ Kh, const bf16_t* __restrict__ Vh, bf16_t* __restrict__ Ob, int ldo, int seq, char* lds, const int tid) {
  const int wid = tid >> 6, lane = tid & 63, r32 = lane & 31, hi = lane >> 5;
  char* V_lds = lds + OFF_V; char* K_lds = lds + OFF_K;
  float* ws = (float*)(lds + OFF_WS) + wid * 64; float* li_l = ws; float* al_l = ws + 32;
  float m_reg = -1e30f, l_reg = 0; f32x16 o[4] = {}; bf16x8 qr[4];
  const bf16_t* Qw = Qb + (long)(wid * QBLK + r32) * LDQ + hi * 8;
#pragma unroll
  for (int d0 = 0; d0 < 4; ++d0) qr[d0] = *reinterpret_cast<const bf16x8*>(Qw + d0 * 16);
  const int sr = tid >> 4, sc = (tid & 15) * 8, vst0 = v_st(sr, sc), vst1 = v_st(32 + sr, sc);
  const int kr = tid >> 3, kc = (tid & 7) * 8, kst = kr * KROW + kc * 2;
  const int vb0 = (int)(uintptr_t)V_lds + v_rd_base(lane);
  struct { bf16x8 vs0, vs1, ks0; } sr_[2];
#define SLOAD(i, k0) do { sr_[i].vs0 = *reinterpret_cast<const bf16x8*>(&Vh[(long)((k0) + sr) * LDQ + sc]); sr_[i].vs1 = *reinterpret_cast<const bf16x8*>(&Vh[(long)((k0) + 32 + sr) * LDQ + sc]); \
    sr_[i].ks0 = *reinterpret_cast<const bf16x8*>(&Kh[(long)((k0) + kr) * LDQ + kc]); } while (0)
#define SWRITE(b, i) do { *(bf16x8*)(V_lds + (b) * SHM_V + vst0) = sr_[i].vs0; *(bf16x8*)(V_lds + (b) * SHM_V + vst1) = sr_[i].vs1; \
    *(bf16x8*)(K_lds + (b) * SHM_K + kst) = sr_[i].ks0; } while (0)
#define SWAIT() asm volatile("s_waitcnt vmcnt(3)" ::: "memory")
#define RESC(a) do { if (__any((a) < 1.f)) { if (hi == 0) al_l[r32] = (a); asm volatile("s_waitcnt lgkmcnt(0)" ::: "memory"); \
    _Pragma("unroll") for (int d = 0; d < 4; ++d) _Pragma("unroll") for (int r = 0; r < 16; ++r) o[d][r] *= al_l[crow(r, hi)]; } } while (0)
  f32x16 pA0, pA1, pB0, pB1; float mnA, mnB, alA, alB; bf16x8 pa0, pa1, pa2, pa3; const int NT = seq / KVBLK;
  constexpr int SE = 0, SO = 1;
  SLOAD(SE, 0); asm volatile("s_waitcnt vmcnt(0)" ::: "memory"); SWRITE(0, SE); __syncthreads();
  qkt(pA0, pA1, K_lds, qr, r32, hi); partialSM(pA0, pA1, m_reg, mnA, alA);
  SLOAD(SO, KVBLK); if (2 < NT) SLOAD(SE, 2 * KVBLK);
  SWAIT(); SWRITE(1, SO); __syncthreads();
  for (int j = 1; j + 1 < NT; j += 2) {
    SBAR(); qkt(pB0, pB1, K_lds + SHM_K, qr, r32, hi);
    finishSM(pA0, pA1, alA, l_reg, pa0, pa1, pa2, pa3); SBAR();
    SLOAD(SO, (j + 2) * KVBLK); SBAR();
    pv_d0(o, vb0, pa0, pa1, pa2, pa3); partialSM(pB0, pB1, m_reg, mnB, alB);
    __syncthreads(); SWAIT(); SWRITE(0, SE);
    RESC(alB); __syncthreads();
    SBAR(); qkt(pA0, pA1, K_lds, qr, r32, hi);
    finishSM(pB0, pB1, alB, l_reg, pa0, pa1, pa2, pa3); SBAR();
    if (j + 3 < NT) SLOAD(SE, (j + 3) * KVBLK); SBAR();
    pv_d0(o, vb0 + SHM_V, pa0, pa1, pa2, pa3); partialSM(pA0, pA1, m_reg, mnA, alA);
    __syncthreads(); SWAIT(); SWRITE(1, SO);
    RESC(alA); __syncthreads();
  }
  SBAR(); qkt(pB0, pB1, K_lds + SHM_K, qr, r32, hi);
  finishSM(pA0, pA1, alA, l_reg, pa0, pa1, pa2, pa3); SBAR();
  pv_d0(o, vb0, pa0, pa1, pa2, pa3); partialSM(pB0, pB1, m_reg, mnB, alB);
  __syncthreads(); RESC(alB);
  finishSM(pB0, pB1, alB, l_reg, pa0, pa1, pa2, pa3); SBAR();
  pv_d0(o, vb0 + SHM_V, pa0, pa1, pa2, pa3);
  if (hi == 0) li_l[r32] = l_reg; asm volatile("s_waitcnt lgkmcnt(0)" ::: "memory");
  float rli[16];
#pragma unroll
  for (int r = 0; r < 16; ++r) rli[r] = __builtin_amdgcn_rcpf(li_l[crow(r, hi)]);
  { bf16_t* stg = (bf16_t*)(lds + OFF_OST) + wid * 4096;
#pragma unroll
    for (int r = 0; r < 16; ++r) { const int orow = crow(r, hi);
#pragma unroll
      for (int d0 = 0; d0 < 4; ++d0) stg[orow * 128 + d0 * 32 + r32] = (bf16_t)(cvt_pk_bf16(o[d0][r] * rli[r], 0.f) & 0xffffu); }
    asm volatile("s_waitcnt lgkmcnt(0)" ::: "memory");
    bf16_t* Ow = Ob + (long)(wid * QBLK) * ldo;
#pragma unroll
    for (int i = 0; i < 8; ++i) { const int row = i * 4 + (lane >> 4), ch = lane & 15; const u32x4 v = *(const u32x4*)(stg + row * 128 + ch * 8); *(u32x4*)(Ow + (long)row * ldo + ch * 8) = v; } }
  __syncthreads();
#undef SLOAD
#undef SWRITE
#undef SWAIT
#undef RESC
}
#undef SBAR
}


namespace att2 {
using bf16x8 = __attribute__((ext_vector_type(8))) short;
using s16x4  = __attribute__((ext_vector_type(4))) short;
using f32x16 = __attribute__((ext_vector_type(16))) float;
constexpr int NW = 8, QBLK = 32, KVBLK = 64, LDQ = 1024, LDK = 64, LDV = 128;
constexpr int KSL = 8192, VSL = 16384, K_OFF = 0, V_OFF = 3 * KSL, OFF_WS = V_OFF + 4 * VSL, ATT_LDS = OFF_WS + NW * 64 * 4;
constexpr float THRL = 8.f;
#define SBAR() __builtin_amdgcn_sched_barrier(0)
__device__ __forceinline__ int crow(int r, int hi) { return (r & 3) + 8 * (r >> 2) + 4 * hi; }
__device__ __forceinline__ int v_rd_base(int lane) { return ((lane & 3) << 3) | (((lane >> 2) & 3) << 6) | (((lane >> 4) & 1) << 5) | (((lane >> 5) & 1) << 8); }
constexpr int v_rd_off(int d0, int ks, int half) { return d0 * 512 + ks * 4096 + half * 2048; }
template <int OFF> __device__ __forceinline__ s16x4 tr_read(int vb) {
  s16x4 r; asm volatile("ds_read_b64_tr_b16 %0, %1 offset:%2" : "=&v"(r) : "v"(vb), "i"(OFF) : "memory"); return r;
}
template <int D0> __device__ __forceinline__ void pv_one(f32x16& od, int vb, bf16x8 pa0, bf16x8 pa1, bf16x8 pa2, bf16x8 pa3) {
  const s16x4 l0 = tr_read<v_rd_off(D0, 0, 0)>(vb), h0 = tr_read<v_rd_off(D0, 0, 1)>(vb), l1 = tr_read<v_rd_off(D0, 1, 0)>(vb), h1 = tr_read<v_rd_off(D0, 1, 1)>(vb);
  const s16x4 l2 = tr_read<v_rd_off(D0, 2, 0)>(vb), h2 = tr_read<v_rd_off(D0, 2, 1)>(vb), l3 = tr_read<v_rd_off(D0, 3, 0)>(vb), h3 = tr_read<v_rd_off(D0, 3, 1)>(vb);
  asm volatile("s_waitcnt lgkmcnt(0)" ::: "memory"); SBAR();
#define PK(L, H) (bf16x8){L[0], L[1], L[2], L[3], H[0], H[1], H[2], H[3]}
  od = __builtin_amdgcn_mfma_f32_32x32x16_bf16(pa0, PK(l0, h0), od, 0, 0, 0);
  od = __builtin_amdgcn_mfma_f32_32x32x16_bf16(pa1, PK(l1, h1), od, 0, 0, 0);
  od = __builtin_amdgcn_mfma_f32_32x32x16_bf16(pa2, PK(l2, h2), od, 0, 0, 0);
  od = __builtin_amdgcn_mfma_f32_32x32x16_bf16(pa3, PK(l3, h3), od, 0, 0, 0);
#undef PK
}
struct VFrag { s16x4 l0, h0, l1, h1, l2, h2, l3, h3; };
template <int D0> __device__ __forceinline__ void v_issue(VFrag& f, int vb) {
  f.l0 = tr_read<v_rd_off(D0, 0, 0)>(vb); f.h0 = tr_read<v_rd_off(D0, 0, 1)>(vb); f.l1 = tr_read<v_rd_off(D0, 1, 0)>(vb); f.h1 = tr_read<v_rd_off(D0, 1, 1)>(vb);
  f.l2 = tr_read<v_rd_off(D0, 2, 0)>(vb); f.h2 = tr_read<v_rd_off(D0, 2, 1)>(vb); f.l3 = tr_read<v_rd_off(D0, 3, 0)>(vb); f.h3 = tr_read<v_rd_off(D0, 3, 1)>(vb);
}
template <int WAITN> __device__ __forceinline__ void pv_mma(f32x16& od, const VFrag& f, bf16x8 pa0, bf16x8 pa1, bf16x8 pa2, bf16x8 pa3) {
  if (WAITN == 8) asm volatile("s_waitcnt lgkmcnt(8)" ::: "memory"); else asm volatile("s_waitcnt lgkmcnt(0)" ::: "memory");
  SBAR();
#define PK(L, H) (bf16x8){L[0], L[1], L[2], L[3], H[0], H[1], H[2], H[3]}
  od = __builtin_amdgcn_mfma_f32_32x32x16_bf16(pa0, PK(f.l0, f.h0), od, 0, 0, 0);
  od = __builtin_amdgcn_mfma_f32_32x32x16_bf16(pa1, PK(f.l1, f.h1), od, 0, 0, 0);
  od = __builtin_amdgcn_mfma_f32_32x32x16_bf16(pa2, PK(f.l2, f.h2), od, 0, 0, 0);
  od = __builtin_amdgcn_mfma_f32_32x32x16_bf16(pa3, PK(f.l3, f.h3), od, 0, 0, 0);
#undef PK
}
__device__ __forceinline__ void pv_pipe(f32x16* o, int vb, bf16x8 pa0, bf16x8 pa1, bf16x8 pa2, bf16x8 pa3) {
  VFrag f0, f1;
  v_issue<0>(f0, vb); SBAR();
  v_issue<1>(f1, vb); SBAR(); pv_mma<8>(o[0], f0, pa0, pa1, pa2, pa3); SBAR();
  v_issue<2>(f0, vb); SBAR(); pv_mma<8>(o[1], f1, pa0, pa1, pa2, pa3); SBAR();
  v_issue<3>(f1, vb); SBAR(); pv_mma<8>(o[2], f0, pa0, pa1, pa2, pa3); SBAR();
  pv_mma<0>(o[3], f1, pa0, pa1, pa2, pa3);
}
__device__ __forceinline__ void qkt(f32x16& p0, f32x16& p1, const LAS unsigned char* Ks, const bf16x8* qr, const f32x16& cinit, int r32, int hi) {
  const LAS unsigned char* kb0 = Ks + r32 * 128; const int sw = r32 & 7;
#pragma unroll
  for (int d0 = 0; d0 < 4; ++d0) { const int ch = ((2 * d0 + hi) ^ sw) << 4;
    const bf16x8 b0 = *(const LAS bf16x8*)(kb0 + ch), b1 = *(const LAS bf16x8*)(kb0 + 4096 + ch);
    if (d0 == 0) { p0 = __builtin_amdgcn_mfma_f32_32x32x16_bf16(b0, qr[0], cinit, 0, 0, 0); p1 = __builtin_amdgcn_mfma_f32_32x32x16_bf16(b1, qr[0], cinit, 0, 0, 0); }
    else { p0 = __builtin_amdgcn_mfma_f32_32x32x16_bf16(b0, qr[d0], p0, 0, 0, 0); p1 = __builtin_amdgcn_mfma_f32_32x32x16_bf16(b1, qr[d0], p1, 0, 0, 0); } }
}
__device__ __forceinline__ float rowmax(const f32x16& p0, const f32x16& p1) {
  float a = fmaxf(fmaxf(p0[0], p0[1]), p1[0]), b = fmaxf(fmaxf(p0[2], p0[3]), p1[1]); a = fmaxf(fmaxf(a, p1[2]), p1[3]);
#pragma unroll
  for (int r = 4; r < 16; r += 4) { a = fmaxf(fmaxf(a, p0[r]), p0[r + 1]); b = fmaxf(fmaxf(b, p0[r + 2]), p0[r + 3]); a = fmaxf(fmaxf(a, p1[r]), p1[r + 1]); b = fmaxf(fmaxf(b, p1[r + 2]), p1[r + 3]); }
  const float m = fmaxf(a, b);
  auto rr = __builtin_amdgcn_permlane32_swap(__float_as_uint(m), __float_as_uint(m), false, false);
  return fmaxf(__uint_as_float(rr[0]), __uint_as_float(rr[1]));
}
#define A2_PK4(P, BASE, OUT) do { u32x4 w_ = {cvt_pk_bf16(P[BASE + 0], P[BASE + 1]), cvt_pk_bf16(P[BASE + 2], P[BASE + 3]), cvt_pk_bf16(P[BASE + 4], P[BASE + 5]), cvt_pk_bf16(P[BASE + 6], P[BASE + 7])}; \
    OUT = *reinterpret_cast<bf16x8*>(&w_); } while (0)

__device__ __forceinline__ void attn_unit(const bf16_t* __restrict__ Qb, const bf16_t* __restrict__ Kh, const bf16_t* __restrict__ Vh, bf16_t* __restrict__ Ob, int ldo, int seq, LAS unsigned char* lds, const int tid) {
  const int wid = __builtin_amdgcn_readfirstlane(tid >> 6), lane = tid & 63, r32 = lane & 31, hi = lane >> 5;
  LAS float* ws = (LAS float*)(lds + OFF_WS) + wid * 64;
  const unsigned koff = (unsigned)(((8 * wid + (lane >> 3)) * LDK + (((lane & 7) ^ (lane >> 3)) * 8)) * 2);
  const unsigned voff = (unsigned)(((8 * wid + ((lane & 31) >> 2)) * LDV + 32 * (lane >> 5) + 8 * (lane & 3)) * 2);
#define A2_DMA(t, ks, vs) do { const char* kb_ = (const char*)Kh + (size_t)(t) * (KVBLK * LDK * 2); const char* vb_ = (const char*)Vh + (size_t)(t) * (KVBLK * LDV * 2); \
    __builtin_amdgcn_global_load_lds((const unsigned*)(kb_ + koff), (LAS unsigned*)(lds + K_OFF + (ks) + wid * 1024), 16, 0, 0); \
    __builtin_amdgcn_global_load_lds((const unsigned*)(vb_ + voff), (LAS unsigned*)(lds + V_OFF + (vs) + wid * 2048), 16, 0, 0); \
    __builtin_amdgcn_global_load_lds((const unsigned*)(vb_ + voff + 128), (LAS unsigned*)(lds + V_OFF + (vs) + wid * 2048 + 1024), 16, 0, 0); } while (0)
#define A2_WAITBAR() do { asm volatile("s_waitcnt vmcnt(0) lgkmcnt(0)" ::: "memory"); __builtin_amdgcn_s_barrier(); asm volatile("" ::: "memory"); } while (0)
  const int NT = seq / KVBLK;
  const bool trail = wid >= 4;
  A2_DMA(0, 0, 0); A2_DMA(1, KSL, VSL);
  bf16x8 qr[4];
  { const bf16_t* Qw = Qb + (long)(wid * QBLK + r32) * LDQ + hi * 8;
#pragma unroll
    for (int d0 = 0; d0 < 4; ++d0) qr[d0] = *reinterpret_cast<const bf16x8*>(Qw + d0 * 16); }
  float mhat = 0.f, l_reg = 0.f; f32x16 o[4] = {}; f32x16 negm = {};
  const int vbase = (int)(uintptr_t)(lds + V_OFF) + v_rd_base(lane);
  A2_WAITBAR();
  if (NT > 2) A2_DMA(2, 2 * KSL, 2 * VSL);
  f32x16 pA0, pA1, pB0, pB1; bf16x8 pa0, pa1, pa2, pa3;
  qkt(pA0, pA1, lds + K_OFF, qr, negm, r32, hi);
  { const float rm = rowmax(pA0, pA1); mhat = rm;
#pragma unroll
    for (int r = 0; r < 16; ++r) { pA0[r] -= rm; pA1[r] -= rm; negm[r] = -rm; }
#pragma unroll
    for (int r = 0; r < 16; ++r) { pA0[r] = __builtin_amdgcn_exp2f(pA0[r]); pA1[r] = __builtin_amdgcn_exp2f(pA1[r]); } }
  int k_cur = KSL, k_dma = 0;
  int v_prev = 0, v_dma = 3 * VSL;
#define A2_ROT() do { k_cur = (k_cur == 2 * KSL) ? 0 : k_cur + KSL; k_dma = (k_dma == 2 * KSL) ? 0 : k_dma + KSL; v_prev = (v_prev == 3 * VSL) ? 0 : v_prev + VSL; v_dma = (v_dma == 3 * VSL) ? 0 : v_dma + VSL; } while (0)
#define A2_SEAM(t) do { A2_WAITBAR(); if ((t) + 2 < NT) A2_DMA((t) + 2, k_dma, v_dma); } while (0)
#define A2_EXP(X, i) X[i] = __builtin_amdgcn_exp2f(X[i])
#define A2_SG(mask, n) __builtin_amdgcn_sched_group_barrier(mask, n, 0)
#define A2_STEP(C0, C1, P0, P1, t) do { bool resc_ = false; \
    SBAR(); \
      \
    qkt(C0, C1, lds + K_OFF + k_cur, qr, negm, r32, hi); \
    { float sa_ = 0.f, sb_ = 0.f; _Pragma("unroll") for (int r = 0; r < 16; ++r) { sa_ += P0[r]; sb_ += P1[r]; } l_reg += sa_ + sb_; } \
    A2_PK4(P0, 0, pa0); A2_PK4(P0, 8, pa1); A2_PK4(P1, 0, pa2); A2_PK4(P1, 8, pa3); \
    A2_SG(0x100, 2); A2_SG(0x100, 2); A2_SG(0x8, 1); A2_SG(0x402, 6); A2_SG(0x8, 1); A2_SG(0x402, 6); A2_SG(0x100, 2); A2_SG(0x8, 1); A2_SG(0x402, 6); A2_SG(0x8, 1); A2_SG(0x402, 6); \
    A2_SG(0x100, 2); A2_SG(0x8, 1); A2_SG(0x402, 6); A2_SG(0x8, 1); A2_SG(0x402, 6); A2_SG(0x8, 1); A2_SG(0x402, 6); A2_SG(0x8, 1); A2_SG(0x402, 6); \
    if (MK_ATT_XMFMA) { f32x16 dz_ = negm; _Pragma("unroll") for (int x_ = 0; x_ < 8; ++x_) asm volatile("v_mfma_f32_32x32x16_bf16 %0, %1, %2, %0" : "+v"(dz_) : "v"(qr[x_ & 3]), "v"(qr[(x_ + 1) & 3])); asm volatile("" :: "v"(dz_)); } \
    if (MK_ATT_XEXP) { float dx_ = mhat; _Pragma("unroll") for (int x_ = 0; x_ < 32; ++x_) asm volatile("v_exp_f32 %0, %0" : "+v"(dx_)); asm volatile("" :: "v"(dx_)); } \
    asm volatile("" : "+v"(l_reg), "+v"(pa0), "+v"(pa1), "+v"(pa2), "+v"(pa3)); SBAR(); \
    if (trail) A2_SEAM(t); \
    { const int vb_ = vbase + v_prev; VFrag f0_, f1_; \
        \
      v_issue<0>(f0_, vb_); v_issue<1>(f1_, vb_); SBAR(); \
      pv_mma<8>(o[0], f0_, pa0, pa1, pa2, pa3); \
      { const float rm_ = rowmax(C0, C1); \
        if (__builtin_expect(__any(rm_ > THRL), 0)) { const float dl_ = fmaxf(rm_, 0.f); mhat += dl_; \
          _Pragma("unroll") for (int r = 0; r < 16; ++r) { C0[r] -= dl_; C1[r] -= dl_; negm[r] = -mhat; } \
          const float f_ = __builtin_amdgcn_exp2f(-dl_); l_reg *= f_; if (hi == 0) ws[r32] = f_; resc_ = true; } } \
      SBAR(); \
        \
      v_issue<2>(f0_, vb_); SBAR(); pv_mma<8>(o[1], f1_, pa0, pa1, pa2, pa3); \
      A2_EXP(C0, 0); A2_EXP(C0, 1); A2_EXP(C0, 2); A2_EXP(C0, 3); A2_EXP(C0, 4); A2_EXP(C0, 5); A2_EXP(C0, 6); A2_EXP(C0, 7); A2_EXP(C0, 8); A2_EXP(C0, 9); A2_EXP(C0, 10); \
      A2_SG(0x8, 1); A2_SG(0x402, 3); A2_SG(0x8, 1); A2_SG(0x402, 3); A2_SG(0x8, 1); A2_SG(0x402, 3); A2_SG(0x8, 1); A2_SG(0x402, 3); \
      asm volatile("" : "+v"(C0)); SBAR(); \
      v_issue<3>(f1_, vb_); SBAR(); pv_mma<8>(o[2], f0_, pa0, pa1, pa2, pa3); \
      A2_EXP(C0, 11); A2_EXP(C0, 12); A2_EXP(C0, 13); A2_EXP(C0, 14); A2_EXP(C0, 15); A2_EXP(C1, 0); A2_EXP(C1, 1); A2_EXP(C1, 2); A2_EXP(C1, 3); A2_EXP(C1, 4); A2_EXP(C1, 5); \
      A2_SG(0x8, 1); A2_SG(0x402, 3); A2_SG(0x8, 1); A2_SG(0x402, 3); A2_SG(0x8, 1); A2_SG(0x402, 3); A2_SG(0x8, 1); A2_SG(0x402, 3); \
      asm volatile("" : "+v"(C0), "+v"(C1)); SBAR(); \
      pv_mma<0>(o[3], f1_, pa0, pa1, pa2, pa3); \
      A2_EXP(C1, 6); A2_EXP(C1, 7); A2_EXP(C1, 8); A2_EXP(C1, 9); A2_EXP(C1, 10); A2_EXP(C1, 11); A2_EXP(C1, 12); A2_EXP(C1, 13); A2_EXP(C1, 14); A2_EXP(C1, 15); \
      A2_SG(0x8, 1); A2_SG(0x402, 3); A2_SG(0x8, 1); A2_SG(0x402, 3); A2_SG(0x8, 1); A2_SG(0x402, 3); A2_SG(0x8, 1); A2_SG(0x402, 3); \
      asm volatile("" : "+v"(C1)); SBAR(); } \
    if (resc_) { asm volatile("s_waitcnt lgkmcnt(0)" ::: "memory"); \
      _Pragma("unroll") for (int d_ = 0; d_ < 4; ++d_) _Pragma("unroll") for (int r = 0; r < 16; ++r) o[d_][r] *= ws[crow(r, hi)]; } \
    if (!trail) A2_SEAM(t); \
    A2_ROT(); } while (0)
  int t = 1;
  for (; t + 1 < NT; t += 2) { A2_STEP(pB0, pB1, pA0, pA1, t); A2_STEP(pA0, pA1, pB0, pB1, t + 1); }
  A2_STEP(pB0, pB1, pA0, pA1, t);
  { float sa_ = 0.f, sb_ = 0.f;
#pragma unroll
    for (int r = 0; r < 16; ++r) { sa_ += pB0[r]; sb_ += pB1[r]; }
    l_reg += sa_ + sb_;
    A2_PK4(pB0, 0, pa0); A2_PK4(pB0, 8, pa1); A2_PK4(pB1, 0, pa2); A2_PK4(pB1, 8, pa3);
    SBAR(); const int vb_ = vbase + v_prev;
    pv_pipe(o, vb_, pa0, pa1, pa2, pa3); }
  { auto rr = __builtin_amdgcn_permlane32_swap(__float_as_uint(l_reg), __float_as_uint(l_reg), false, false); l_reg = __uint_as_float(rr[0]) + __uint_as_float(rr[1]); }
  if (hi == 0) ws[32 + r32] = l_reg;
  A2_WAITBAR();
  float rli[16];
#pragma unroll
  for (int r = 0; r < 16; ++r) rli[r] = __builtin_amdgcn_rcpf(ws[32 + crow(r, hi)]);
  { LAS bf16_t* stg = (LAS bf16_t*)lds + wid * 4096;
#pragma unroll
    for (int r = 0; r < 16; ++r) { const int orow = crow(r, hi);
#pragma unroll
      for (int d0 = 0; d0 < 4; ++d0) stg[orow * 128 + d0 * 32 + r32] = (bf16_t)(cvt_pk_bf16(o[d0][r] * rli[r], 0.f) & 0xffffu); }
    asm volatile("s_waitcnt lgkmcnt(0)" ::: "memory");
    bf16_t* Ow = Ob + (long)(wid * QBLK) * ldo;
#pragma unroll
    for (int i = 0; i < 8; ++i) { const int row = i * 4 + (lane >> 4), ch = lane & 15; const u32x4 v = *(const LAS u32x4*)(stg + row * 128 + ch * 8); *(u32x4*)(Ow + (long)row * ldo + ch * 8) = v; } }
  A2_WAITBAR();
#undef A2_DMA
#undef A2_WAITBAR
#undef A2_ROT
#undef A2_SEAM
#undef A2_STEP
#undef A2_EXP
#undef A2_SG
}
#undef A2_PK4
#undef SBAR
}


namespace att3 {
using f32x16 = __attribute__((ext_vector_type(16))) float;
typedef int v8i __attribute__((ext_vector_type(8)));
typedef int v4i __attribute__((ext_vector_type(4)));
constexpr int NW = 8, QBLK = 32, KVBLK = 64;
constexpr int KSL = 8192, VSL = 16384, K_OFF = 0, V_OFF = 3 * KSL, OFF_WS = V_OFF + 3 * VSL, OFF_Q = OFF_WS + NW * 64 * 4, OFF_ONES = OFF_Q + NW * 2048, ATT_LDS = OFF_ONES + 64;
constexpr float THRL = 8.f;
constexpr int SC_ONE = 0x7f7f7f7f, SC_Q = 0x7b7b7b7b;
#define SBAR() __builtin_amdgcn_sched_barrier(0)
__device__ __forceinline__ int crow(int r, int hi) { return (r & 3) + 8 * (r >> 2) + 4 * hi; }
__host__ __device__ __forceinline__ int slot_key(int s) { const int hi = s >> 5, j = s & 31, jj = j & 15; return (j >> 4) * 32 + (jj & 3) + 8 * (jj >> 2) + 4 * hi; }
__device__ __forceinline__ v8i ld32(const LAS unsigned char* rowp, int c0, int sw) {
    const v4i a = *(const LAS v4i*)(rowp + ((c0 ^ sw) << 4)), b = *(const LAS v4i*)(rowp + (((c0 + 1) ^ sw) << 4));
    return (v8i){a[0], a[1], a[2], a[3], b[0], b[1], b[2], b[3]};
}
__device__ __forceinline__ void qkt(f32x16& p0, f32x16& p1, const LAS unsigned char* Ks, const v8i& qf, const f32x16& cinit, int r32, int hi) {
    const int sw = (r32 >> 2) & 3;
    const v8i k0 = ld32(Ks + r32 * 64, 2 * hi, sw), k1 = ld32(Ks + (32 + r32) * 64, 2 * hi, sw);
    p0 = __builtin_amdgcn_mfma_scale_f32_32x32x64_f8f6f4(k0, qf, cinit, 0, 0, 0, SC_ONE, 0, SC_Q);
    p1 = __builtin_amdgcn_mfma_scale_f32_32x32x64_f8f6f4(k1, qf, cinit, 0, 0, 0, SC_ONE, 0, SC_Q);
}
__device__ __forceinline__ float lanemax(const f32x16& p0, const f32x16& p1) {
  float a = fmaxf(fmaxf(p0[0], p0[1]), p1[0]), b = fmaxf(fmaxf(p0[2], p0[3]), p1[1]); a = fmaxf(fmaxf(a, p1[2]), p1[3]);
#pragma unroll
  for (int r = 4; r < 16; r += 4) { a = fmaxf(fmaxf(a, p0[r]), p0[r + 1]); b = fmaxf(fmaxf(b, p0[r + 2]), p0[r + 3]); a = fmaxf(fmaxf(a, p1[r]), p1[r + 1]); b = fmaxf(fmaxf(b, p1[r + 2]), p1[r + 3]); }
  return fmaxf(a, b);
}
__device__ __forceinline__ float rowmax4(const f32x16& p0, const f32x16& p1, const f32x16& p2, const f32x16& p3) {
  const float m = fmaxf(lanemax(p0, p1), lanemax(p2, p3));
  auto rr = __builtin_amdgcn_permlane32_swap(__float_as_uint(m), __float_as_uint(m), false, false);
  return fmaxf(__uint_as_float(rr[0]), __uint_as_float(rr[1]));
}
__device__ __forceinline__ v8i pack_p(const f32x16& p0, const f32x16& p1) {
    v8i w;
    w[0] = (int)cvt4_fp8_nc(p0[0], p0[1], p0[2], p0[3]); w[1] = (int)cvt4_fp8_nc(p0[4], p0[5], p0[6], p0[7]); w[2] = (int)cvt4_fp8_nc(p0[8], p0[9], p0[10], p0[11]); w[3] = (int)cvt4_fp8_nc(p0[12], p0[13], p0[14], p0[15]);
    w[4] = (int)cvt4_fp8_nc(p1[0], p1[1], p1[2], p1[3]); w[5] = (int)cvt4_fp8_nc(p1[4], p1[5], p1[6], p1[7]); w[6] = (int)cvt4_fp8_nc(p1[8], p1[9], p1[10], p1[11]); w[7] = (int)cvt4_fp8_nc(p1[12], p1[13], p1[14], p1[15]);
    return w;
}
__device__ __forceinline__ void qk1(f32x16& d, const v8i& kop, const v8i& qf, const f32x16& c) {
    asm volatile("s_nop 1\n\tv_mfma_scale_f32_32x32x64_f8f6f4 %0, %1, %2, %3, %4, %5 op_sel_hi:[0,0,0]" : "=&v"(d) : "v"(kop), "v"(qf), "v"(c), "v"(SC_ONE), "v"(SC_Q));
}
__device__ __forceinline__ void pv1(f32x16& od, const v8i& pf, const v8i& vf) {
    asm volatile("s_nop 1\n\tv_mfma_scale_f32_32x32x64_f8f6f4 %0, %1, %2, %0, %3, %3 op_sel_hi:[0,0,0]" : "+v"(od) : "v"(pf), "v"(vf), "v"(SC_ONE));
}

__device__ __forceinline__ void attn_unit(const unsigned char* __restrict__ Q8b, const unsigned char* __restrict__ K8h0, size_t kmap_stride, const unsigned char* __restrict__ VT8h, bf16_t* __restrict__ AOb, int ldo, int seq,
                                          float lam, float osc, const float* __restrict__ subln, u32x4* __restrict__ o0g, LAS unsigned char* lds, const int tid) {
  const int wid = __builtin_amdgcn_readfirstlane(tid >> 6), lane = tid & 63, r32 = lane & 31, hi = lane >> 5;
  LAS float* ws = (LAS float*)(lds + OFF_WS) + wid * 64;
  const int prow = 16 * wid + (lane >> 2); const unsigned poff = (unsigned)(prow * 64 + (((lane & 3) ^ ((prow >> 2) & 3)) << 4));
#define A3_MFMA_FENCE() asm volatile("s_nop 15\n\ts_nop 15" : "+v"(o[0]), "+v"(o[1]), "+v"(o[2]), "+v"(o[3]), "+v"(osum))
#define A3_WAITBAR() do { asm volatile("s_waitcnt vmcnt(0) lgkmcnt(0)" ::: "memory"); __builtin_amdgcn_s_barrier(); asm volatile("" ::: "memory"); } while (0)
  const int NT2 = seq / 128;
  const int half = wid >> 2;
#define A3_DMAK(t) __builtin_amdgcn_global_load_lds((const unsigned*)(K8h + (size_t)(t) * 8192 + poff), (LAS unsigned*)(lds + K_OFF + ((t) % 3) * KSL + wid * 1024), 16, 0, 0)
#define A3_DMAV(t) do { __builtin_amdgcn_global_load_lds((const unsigned*)(VT8h + (size_t)(t) * 16384 + poff), (LAS unsigned*)(lds + V_OFF + ((t) % 3) * VSL + wid * 1024), 16, 0, 0); \
    __builtin_amdgcn_global_load_lds((const unsigned*)(VT8h + (size_t)(t) * 16384 + 8192 + poff), (LAS unsigned*)(lds + V_OFF + ((t) % 3) * VSL + 8192 + wid * 1024), 16, 0, 0); } while (0)
  f32x16 o[4]; f32x16 osum;
  for (int mp = 0; mp < 2; ++mp) {
  const unsigned char* K8h = K8h0 + (size_t)mp * kmap_stride;
  A3_DMAK(0); A3_DMAK(1); A3_DMAV(0);
  LAS v4i* qs = (LAS v4i*)(lds + OFF_Q + wid * 2048) + lane;
  { int lq_; asm volatile("v_mbcnt_lo_u32_b32 %0, -1, 0\n\tv_mbcnt_hi_u32_b32 %0, -1, %0" : "=v"(lq_));
    const unsigned char* Qw = Q8b + mp * 64 + (size_t)(wid * QBLK + (lq_ & 31)) * 1024 + (lq_ >> 5) * 32; const v4i a = *(const v4i*)Qw, b = *(const v4i*)(Qw + 16); qs[0] = a; qs[64] = b; }
#define A3_LDQ(buf) do { const v4i qa_ = qs[0], qb_ = qs[64]; buf = (v8i){qa_[0], qa_[1], qa_[2], qa_[3], qb_[0], qb_[1], qb_[2], qb_[3]}; } while (0)
  f32x16 negm = {};
#pragma unroll
  for (int r = 0; r < 16; ++r) { o[0][r] = 0.f; o[1][r] = 0.f; o[2][r] = 0.f; o[3][r] = 0.f; osum[r] = 0.f; }
  if (wid == 0 && lane < 8) *(LAS unsigned*)(lds + OFF_ONES + 4 * lane) = 0x38383838u;
#define A3_LD1(buf) do { const v4i oa_ = *(const LAS v4i*)(lds + OFF_ONES), ob_ = *(const LAS v4i*)(lds + OFF_ONES + 16); buf = (v8i){oa_[0], oa_[1], oa_[2], oa_[3], ob_[0], ob_[1], ob_[2], ob_[3]}; } while (0)
  const int swv = (r32 >> 2) & 3;
  A3_WAITBAR();
  if (NT2 > 2) A3_DMAK(2);
  A3_DMAV(1);
  f32x16 C0 = negm, C1 = negm, C2 = negm, C3 = negm; v8i pf0 = {}, pf1 = {};
#define A3_BAR_ODD() do { asm volatile("s_waitcnt lgkmcnt(0)" ::: "memory"); __builtin_amdgcn_s_barrier(); asm volatile("" ::: "memory"); } while (0)
#define A3_BAR_EVEN(m) do { if ((m) + 1 < NT2) asm volatile("s_waitcnt vmcnt(3) lgkmcnt(0)" ::: "memory"); else asm volatile("s_waitcnt vmcnt(0) lgkmcnt(0)" ::: "memory"); \
    __builtin_amdgcn_s_barrier(); asm volatile("" ::: "memory"); if ((m) + 2 < NT2) A3_DMAK((m) + 2); if ((m) + 1 < NT2) A3_DMAV((m) + 1); } while (0)
#define A3_LD(buf, p) buf = ld32((p), 2 * hi, swv)
#define A3_W(n) asm volatile("s_waitcnt lgkmcnt(" #n ")" ::: "memory"); SBAR()
#define A3_A_FIRST() do { const LAS unsigned char* Ks_ = lds + K_OFF + r32 * 64; v8i b0_, b1_, b2_; A3_LDQ(b2_); A3_LD(b0_, Ks_); A3_LD(b1_, Ks_ + 2048); \
    A3_W(0); qk1(C0, b0_, b2_, negm); qk1(C1, b1_, b2_, negm); SBAR(); A3_LD(b0_, Ks_ + 4096); A3_LD(b1_, Ks_ + 6144); A3_W(0); qk1(C2, b0_, b2_, negm); qk1(C3, b1_, b2_, negm); SBAR(); } while (0)
#define A3_A_MID(k) do { \
    const LAS unsigned char* Ks_ = lds + K_OFF + (((k) + 1) % 3) * KSL + r32 * 64; \
    const LAS unsigned char* vt_ = lds + V_OFF + ((k) % 3) * VSL + r32 * 64; \
    __builtin_amdgcn_s_setprio(1);                                   \
    v8i b0_, b1_, b2_, b3_; A3_LDQ(b3_); A3_LD(b0_, Ks_); A3_LD(b1_, Ks_ + 2048); A3_LD(b2_, Ks_ + 4096); \
    A3_W(4); qk1(C0, b0_, b3_, negm); SBAR(); A3_LD(b0_, Ks_ + 6144); \
    A3_W(4); qk1(C1, b1_, b3_, negm); SBAR(); A3_LD(b1_, vt_); \
    A3_W(4); qk1(C2, b2_, b3_, negm); SBAR(); A3_LD(b2_, vt_ + 2048); \
    A3_W(4); qk1(C3, b0_, b3_, negm); SBAR(); A3_LD1(b3_); A3_LD(b0_, vt_ + 4096); \
    A3_W(6); pv1(o[0], pf0, b1_); SBAR(); A3_LD(b1_, vt_ + 6144); \
    A3_W(6); pv1(o[1], pf0, b2_); SBAR(); A3_LD(b2_, vt_ + 8192); \
    A3_W(6); pv1(osum, pf0, b3_); SBAR(); A3_LD(b3_, vt_ + 8192 + 2048); \
    A3_W(6); pv1(o[2], pf0, b0_); SBAR(); A3_LD1(b0_); \
    A3_W(6); pv1(o[3], pf0, b1_); SBAR(); A3_LD(b1_, vt_ + 8192 + 4096); \
    A3_W(6); pv1(o[0], pf1, b2_); SBAR(); A3_LD(b2_, vt_ + 8192 + 6144); \
    A3_W(6); pv1(o[1], pf1, b3_); \
    A3_W(4); pv1(osum, pf1, b0_); \
    A3_W(2); pv1(o[2], pf1, b1_); \
    A3_W(0); pv1(o[3], pf1, b2_); \
    __builtin_amdgcn_s_setprio(0); \
    SBAR(); } while (0)
#define A3_A_LAST(k) do { \
    const LAS unsigned char* vt_ = lds + V_OFF + ((k) % 3) * VSL + r32 * 64; \
    v8i b0_, b1_, b2_; \
    _Pragma("unroll") for (int sb_ = 0; sb_ < 2; ++sb_) { const v8i& pfs_ = sb_ ? pf1 : pf0; \
      A3_LD(b0_, vt_ + sb_ * 8192); A3_LD(b1_, vt_ + sb_ * 8192 + 2048); A3_LD1(b2_); \
      asm volatile("s_waitcnt lgkmcnt(0)\n\ts_nop 1" ::: "memory"); SBAR(); \
      pv1(o[0], pfs_, b0_); pv1(o[1], pfs_, b1_); pv1(osum, pfs_, b2_); SBAR(); \
      A3_LD(b0_, vt_ + sb_ * 8192 + 4096); A3_LD(b1_, vt_ + sb_ * 8192 + 6144); \
      asm volatile("s_waitcnt lgkmcnt(0)\n\ts_nop 1" ::: "memory"); SBAR(); \
      pv1(o[2], pfs_, b0_); pv1(o[3], pfs_, b1_); SBAR(); } \
    } while (0)
#define A3_B(FIRST) do { \
    asm volatile("s_nop 7" : "+v"(C0), "+v"(C1), "+v"(C2), "+v"(C3));     \
    const float rm_ = rowmax4(C0, C1, C2, C3); \
    if (FIRST) {                                                    \
      _Pragma("unroll") for (int r = 0; r < 16; ++r) { C0[r] -= rm_; C1[r] -= rm_; C2[r] -= rm_; C3[r] -= rm_; negm[r] = -rm_; } } \
    else if (__builtin_expect(__any(rm_ > THRL), 0)) {              \
      const float dl_ = fmaxf(rm_, 0.f); const float nm_ = negm[0] - dl_; \
      _Pragma("unroll") for (int r = 0; r < 16; ++r) { C0[r] -= dl_; C1[r] -= dl_; C2[r] -= dl_; C3[r] -= dl_; negm[r] = nm_; } \
      int lr_; asm volatile("v_mbcnt_lo_u32_b32 %0, -1, 0\n\tv_mbcnt_hi_u32_b32 %0, -1, %0" : "=v"(lr_));     \
      const int r32r_ = lr_ & 31, hir_ = lr_ >> 5; \
      const float f_ = __builtin_amdgcn_exp2f(-dl_); if (hir_ == 0) ws[r32r_] = f_; \
      asm volatile("s_waitcnt lgkmcnt(0)" ::: "memory"); A3_MFMA_FENCE(); \
      _Pragma("unroll") for (int r = 0; r < 16; ++r) { const float fr_ = ws[crow(r, hir_)]; osum[r] *= fr_; _Pragma("unroll") for (int d_ = 0; d_ < 4; ++d_) o[d_][r] *= fr_; } } \
    _Pragma("unroll") for (int r = 0; r < 16; ++r) { C0[r] = __builtin_amdgcn_exp2f(C0[r]); C1[r] = __builtin_amdgcn_exp2f(C1[r]); } \
    pf0 = pack_p(C0, C1); \
    _Pragma("unroll") for (int r = 0; r < 16; ++r) { C2[r] = __builtin_amdgcn_exp2f(C2[r]); C3[r] = __builtin_amdgcn_exp2f(C3[r]); } \
    pf1 = pack_p(C2, C3); \
    asm volatile("" : "+v"(pf0), "+v"(pf1)); SBAR(); } while (0)
  if (half == 0) {
    A3_A_FIRST();
    A3_BAR_ODD(); A3_B(true);
    int k = 0;
    for (; k + 1 < NT2; ++k) { A3_BAR_EVEN(k + 1); A3_A_MID(k); A3_BAR_ODD(); A3_B(false); }
    A3_BAR_EVEN(k + 1); A3_A_LAST(k);
    A3_BAR_ODD();
  } else {
    A3_BAR_ODD(); A3_A_FIRST();
    A3_BAR_EVEN(1); A3_B(true);
    int k = 0;
    for (; k + 1 < NT2; ++k) { A3_BAR_ODD(); A3_A_MID(k); A3_BAR_EVEN(k + 2); A3_B(false); }
    A3_BAR_ODD(); A3_A_LAST(k);
  }
  A3_MFMA_FENCE();
  A3_WAITBAR();
  if (mp == 0) {
    int lo_; asm volatile("v_mbcnt_lo_u32_b32 %0, -1, 0\n\tv_mbcnt_hi_u32_b32 %0, -1, %0" : "=v"(lo_));
    u32x4* o0s = o0g + wid * 512 + lo_;
#pragma unroll
    for (int d0 = 0; d0 < 4; ++d0) {
#pragma unroll
      for (int r = 0; r < 16; r += 8) { u32x4 w;
        w.x = cvt_pk_bf16(o[d0][r] * __builtin_amdgcn_rcpf(osum[r]), o[d0][r + 1] * __builtin_amdgcn_rcpf(osum[r + 1]));
        w.y = cvt_pk_bf16(o[d0][r + 2] * __builtin_amdgcn_rcpf(osum[r + 2]), o[d0][r + 3] * __builtin_amdgcn_rcpf(osum[r + 3]));
        w.z = cvt_pk_bf16(o[d0][r + 4] * __builtin_amdgcn_rcpf(osum[r + 4]), o[d0][r + 5] * __builtin_amdgcn_rcpf(osum[r + 5]));
        w.w = cvt_pk_bf16(o[d0][r + 6] * __builtin_amdgcn_rcpf(osum[r + 6]), o[d0][r + 7] * __builtin_amdgcn_rcpf(osum[r + 7]));
        o0s[(d0 * 2 + (r >> 3)) * 64] = w; } }
  }
  }
  { LAS bf16_t* stg = (LAS bf16_t*)lds + wid * 4096;
    u32x4 o0w[8];
    { int lo_; asm volatile("v_mbcnt_lo_u32_b32 %0, -1, 0\n\tv_mbcnt_hi_u32_b32 %0, -1, %0" : "=v"(lo_));
      const u32x4* o0s = o0g + wid * 512 + lo_;
#pragma unroll
      for (int j = 0; j < 8; ++j) o0w[j] = o0s[j * 64]; }
#pragma unroll
    for (int r = 0; r < 16; r += 2) { const float i0 = __builtin_amdgcn_rcpf(osum[r]), i1 = __builtin_amdgcn_rcpf(osum[r + 1]); const int or0 = crow(r, hi), or1 = crow(r + 1, hi);
#pragma unroll
      for (int d0 = 0; d0 < 4; ++d0) { const unsigned pk = o0w[d0 * 2 + (r >> 3)][(r >> 1) & 3];
        const float v0 = bf_lo(pk) - lam * (o[d0][r] * i0), v1 = bf_hi(pk) - lam * (o[d0][r + 1] * i1);
        stg[or0 * 128 + d0 * 32 + r32] = (bf16_t)(cvt_pk_bf16(v0, 0.f) & 0xffffu); stg[or1 * 128 + d0 * 32 + r32] = (bf16_t)(cvt_pk_bf16(v1, 0.f) & 0xffffu); } }
    asm volatile("s_waitcnt lgkmcnt(0)" ::: "memory");
    bf16_t* Ow = AOb + (long)(wid * QBLK) * ldo;
    int lane_e; asm volatile("v_mbcnt_lo_u32_b32 %0, -1, 0\n\tv_mbcnt_hi_u32_b32 %0, -1, %0" : "=v"(lane_e));
    const int ch = lane_e & 15; const f32x4 g0 = *(const f32x4*)(subln + ch * 8), g1 = *(const f32x4*)(subln + ch * 8 + 4);
#pragma unroll
    for (int i = 0; i < 8; ++i) { const int row = i * 4 + (lane_e >> 4); const u32x4 v = *(const LAS u32x4*)(stg + row * 128 + ch * 8);
      float e[8] = {bf_lo(v.x), bf_hi(v.x), bf_lo(v.y), bf_hi(v.y), bf_lo(v.z), bf_hi(v.z), bf_lo(v.w), bf_hi(v.w)};
      float ss = 0.f;
#pragma unroll
      for (int q = 0; q < 8; ++q) ss += e[q] * e[q];
      ss = row16_sum(ss);
      const float rn = osc / sqrtf(ss * (1.0f / 128.0f) + EPS);
      u32x4 w; w.x = cvt_pk_bf16(e[0] * rn * g0[0], e[1] * rn * g0[1]); w.y = cvt_pk_bf16(e[2] * rn * g0[2], e[3] * rn * g0[3]);
      w.z = cvt_pk_bf16(e[4] * rn * g1[0], e[5] * rn * g1[1]); w.w = cvt_pk_bf16(e[6] * rn * g1[2], e[7] * rn * g1[3]);
      *(u32x4*)(Ow + (long)row * ldo + ch * 8) = w; } }
  A3_WAITBAR();
#undef A3_WAITBAR
#undef A3_DMAK
#undef A3_DMAV
#undef A3_BAR_ODD
#undef A3_BAR_EVEN
#undef A3_A_FIRST
#undef A3_LD
#undef A3_LDQ
#undef A3_LD1
#undef A3_W
#undef A3_A_MID
#undef A3_A_LAST
#undef A3_B
#undef A3_MFMA_FENCE
}
#undef SBAR
}

constexpr int RING_BYTES = 131072, MISC_OFF = RING_BYTES + 320, INTAB_OFF = RING_BYTES + 1024, LDS_BYTES = 147456;
struct Args { const float* in[50]; float* out; unsigned char* ws; int ph_lo, ph_hi; };

struct Ctx {
    LAS unsigned char* lds;
    int tid, lane, wave, G, bid;
    unsigned char* ws; float* out;
    __device__ __forceinline__ const float* inp(int idx) const {
        const LAS unsigned* t = (const LAS unsigned*)(lds + INTAB_OFF) + 2 * idx;
        const unsigned lo_ = __builtin_amdgcn_readfirstlane(t[0]), hi_ = __builtin_amdgcn_readfirstlane(t[1]);
        typedef __attribute__((address_space(1))) const float* gp_t; return (const float*)(gp_t)(((uintptr_t)hi_ << 32) | (uintptr_t)lo_); }
};

template <class T> __device__ __forceinline__ T* launder_ptr(T* p) { unsigned lo = (unsigned)(uintptr_t)p, hi = (unsigned)((uintptr_t)p >> 32); lo = __builtin_amdgcn_readfirstlane(lo); hi = __builtin_amdgcn_readfirstlane(hi);
    asm volatile("" : "+s"(lo), "+s"(hi)); typedef __attribute__((address_space(1))) T* gp_t; return (T*)(gp_t)(((uintptr_t)hi << 32) | (uintptr_t)lo); }
__device__ __forceinline__ int launder_i(int v) { v = __builtin_amdgcn_readfirstlane(v); asm volatile("" : "+s"(v)); return v; }
__device__ __forceinline__ int map_col(int kind, int n) {
    if (kind == 1) { if (n < 1024) return n; const int w = n - 1024, T = w >> 8, r = w & 255; return 1024 + (r >> 7) * 1024 + T * 128 + (r & 127); }
    if (kind == 2) { const int T = n >> 8, r = n & 255; return (r >> 7) * DFF + T * 128 + (r & 127); }
    if (kind == 3) { const int T = n >> 8, r = n & 255; return (r >> 7) * 1024 + T * 128 + (r & 127); }
    if (kind == 4) { if (n >= 2048) return n; const int blk = n >> 6, w = n & 63, half = w >> 5, ww = w & 31; return blk * 64 + half * 32 + (ww & 1) * 16 + (ww >> 1); }
    return n;
}
__device__ __forceinline__ void stage_out(LAS unsigned char* stg, unsigned char* dst  , size_t pitch, int lane) {
    asm volatile("s_waitcnt lgkmcnt(0)" ::: "memory");
#pragma unroll
    for (int i = 0; i < 16; ++i) { const int row = 8 * i + (lane >> 3), c = lane & 7;
        const u32x4 v = *(const LAS u32x4*)(stg + row * 128 + ((c ^ ((row >> 1) & 7)) << 4));
        *(u32x4*)(dst + (size_t)row * pitch + c * 16) = v; }
    asm volatile("s_waitcnt lgkmcnt(0)" ::: "memory");
}
__device__ __forceinline__ void transpose_item8(const float* W, int K, int N, unsigned char* WT, int kind, int item, int lane, LAS unsigned char* stg) {
    const int nblk = N / 128, kb = item / nblk, nb = item % nblk, k0 = 128 * kb, n0 = 128 * nb;
    const int d0 = n0 + 2 * lane, s0 = map_col(kind, d0), s1 = map_col(kind, d0 + 1);
    const bool adj = (kind != 4) || (n0 >= 2048);
#pragma unroll
    for (int h = 0; h < 4; ++h) {
        float v0[32], v1[32];
        const float* wp = W + (size_t)(k0 + 32 * h) * N;
        if (adj) {
#pragma unroll
            for (int kk = 0; kk < 32; ++kk) { const f32x2 t = *(const f32x2*)(wp + (size_t)kk * N + s0); v0[kk] = t[0] * pg8::W8SCALE; v1[kk] = t[1] * pg8::W8SCALE; }
        } else {
#pragma unroll
            for (int kk = 0; kk < 32; ++kk) { v0[kk] = wp[(size_t)kk * N + s0] * pg8::W8SCALE; v1[kk] = wp[(size_t)kk * N + s1] * pg8::W8SCALE; }
        }
        LAS unsigned char* r0_ = stg + (2 * lane) * 128; LAS unsigned char* r1_ = r0_ + 128; const int sw_ = lane & 7;
#pragma unroll
        for (int j = 0; j < 2; ++j) {
            u32x4 a, b;
            a.x = cvt4_fp8(v0[16 * j + 0], v0[16 * j + 1], v0[16 * j + 2], v0[16 * j + 3]); a.y = cvt4_fp8(v0[16 * j + 4], v0[16 * j + 5], v0[16 * j + 6], v0[16 * j + 7]);
            a.z = cvt4_fp8(v0[16 * j + 8], v0[16 * j + 9], v0[16 * j + 10], v0[16 * j + 11]); a.w = cvt4_fp8(v0[16 * j + 12], v0[16 * j + 13], v0[16 * j + 14], v0[16 * j + 15]);
            b.x = cvt4_fp8(v1[16 * j + 0], v1[16 * j + 1], v1[16 * j + 2], v1[16 * j + 3]); b.y = cvt4_fp8(v1[16 * j + 4], v1[16 * j + 5], v1[16 * j + 6], v1[16 * j + 7]);
            b.z = cvt4_fp8(v1[16 * j + 8], v1[16 * j + 9], v1[16 * j + 10], v1[16 * j + 11]); b.w = cvt4_fp8(v1[16 * j + 12], v1[16 * j + 13], v1[16 * j + 14], v1[16 * j + 15]);
            *(LAS u32x4*)(r0_ + (((2 * h + j) ^ sw_) << 4)) = a; *(LAS u32x4*)(r1_ + (((2 * h + j) ^ sw_) << 4)) = b; }
    }
    stage_out(stg, WT + (size_t)n0 * K + k0, (size_t)K, lane);
}
__device__ __forceinline__ void transpose_item(const float* W, int K, int N, bf16_t* WT, int kind, int item, int lane, LAS unsigned char* stg) {
    const int nblk = N / 128, kb = item / nblk, nb = item % nblk, k0 = 64 * kb, n0 = 128 * nb;
    const int d0 = n0 + 2 * lane, s0 = map_col(kind, d0), s1 = map_col(kind, d0 + 1);
    const bool adj = (kind != 4) || (n0 >= 2048);
#pragma unroll
    for (int h = 0; h < 2; ++h) {
        float v0[32], v1[32];
        const float* wp = W + (size_t)(k0 + 32 * h) * N;
        if (adj) {
#pragma unroll
            for (int kk = 0; kk < 32; ++kk) { const f32x2 t = *(const f32x2*)(wp + (size_t)kk * N + s0); v0[kk] = t[0]; v1[kk] = t[1]; }
        } else {
#pragma unroll
            for (int kk = 0; kk < 32; ++kk) { v0[kk] = wp[(size_t)kk * N + s0]; v1[kk] = wp[(size_t)kk * N + s1]; }
        }
        LAS unsigned char* r0_ = stg + (2 * lane) * 128; LAS unsigned char* r1_ = r0_ + 128; const int sw_ = lane & 7;
#pragma unroll
        for (int j = 0; j < 4; ++j) {
            u32x4 a, b;
            a.x = cvt_pk_bf16(v0[8 * j + 0], v0[8 * j + 1]); a.y = cvt_pk_bf16(v0[8 * j + 2], v0[8 * j + 3]); a.z = cvt_pk_bf16(v0[8 * j + 4], v0[8 * j + 5]); a.w = cvt_pk_bf16(v0[8 * j + 6], v0[8 * j + 7]);
            b.x = cvt_pk_bf16(v1[8 * j + 0], v1[8 * j + 1]); b.y = cvt_pk_bf16(v1[8 * j + 2], v1[8 * j + 3]); b.z = cvt_pk_bf16(v1[8 * j + 4], v1[8 * j + 5]); b.w = cvt_pk_bf16(v1[8 * j + 6], v1[8 * j + 7]);
            *(LAS u32x4*)(r0_ + (((4 * h + j) ^ sw_) << 4)) = a; *(LAS u32x4*)(r1_ + (((4 * h + j) ^ sw_) << 4)) = b; }
    }
    stage_out(stg, (unsigned char*)(WT + (size_t)n0 * K + k0), (size_t)K * 2, lane);
}
struct WDesc { int in_idx, K, N, nb, kind, f8; unsigned long long off; };
__constant__ WDesc g_wd[15] = {
    {8, 1024, 3072, 1, 1, 0, WO_L0_CONVIN}, {10, 1024, 1024, 1, 0, 0, WO_L0_CONVOUT}, {11, 1024, 5632, 1, 2, (MK_FP8_FFN >> 0) & 1, WO_L0_GU}, {12, 2816, 1024, 1, 0, ((MK_FP8_FFN >> 0) & 1) | MK_FP8_DOWN0, WO_L0_DOWN},
    {17, 1024, 3072, 1, 4, MK_FP8_QKV, WO_L1_QKV}, {20, 1024, 1024, 1, 0, 0, WO_L1_WO}, {22, 1024, 5632, 8, 2, 1, WO_L1_MGU}, {23, 2816, 1024, 8, 0, 1, WO_L1_MDOWN},
    {36, 1024, 2048, 1, 3, MK_FP8_GLU, WO_L2_GLU}, {37, 1024, 5632, 1, 2, (MK_FP8_FFN >> 2) & 1, WO_L2_GU}, {38, 2816, 1024, 1, 0, (MK_FP8_FFN >> 2) & 1, WO_L2_DOWN},
    {43, 1024, 3072, 1, 1, 0, WO_L3_CONVIN}, {45, 1024, 1024, 1, 0, 0, WO_L3_CONVOUT}, {47, 1024, 5632, 8, 2, 1, WO_L3_MGU}, {48, 2816, 1024, 8, 0, 1, WO_L3_MDOWN}};

__device__ __forceinline__ void p0_weights(Ctx& F) {
    unsigned* ctr = (unsigned*)(F.ws + WS_CTL) + 64;
    for (;;) {
        unsigned it = 0;
        if (F.lane == 0) it = __hip_atomic_fetch_add(ctr, 1u, __ATOMIC_RELAXED, __HIP_MEMORY_SCOPE_AGENT);
        it = (unsigned)__builtin_amdgcn_readfirstlane((int)it);
        int base = 0, d = 0; bool found = false;
        for (; d < 15; ++d) { const int tot = (g_wd[d].K / (g_wd[d].f8 ? 128 : 64)) * (g_wd[d].N / 128) * g_wd[d].nb; if ((int)it < base + tot) { found = true; break; } base += tot; }
        if (!found) break;
        const int K = g_wd[d].K, N = g_wd[d].N, kind = g_wd[d].kind; const int per = (K / (g_wd[d].f8 ? 128 : 64)) * (N / 128);
        const float* W = F.inp(g_wd[d].in_idx); bf16_t* WT = (bf16_t*)(F.ws + WS_W + g_wd[d].off);
        const int li = (int)it - base, e = li / per, r = li - e * per;
        if (g_wd[d].f8) transpose_item8(W + (size_t)e * K * N, K, N, (unsigned char*)WT + (size_t)e * K * N, kind, r, F.lane, F.lds + F.wave * 16384);
        else transpose_item(W + (size_t)e * K * N, K, N, WT + (size_t)e * K * N, kind, r, F.lane, F.lds + F.wave * 16384);
    }
}
__device__ __forceinline__ void p0_adaln(Ctx& F, const int item0) {
    LAS float* scond = (LAS float*)(F.lds);
    LAS float* red = (LAS float*)(F.lds + 20480);
    bool have = false;
    for (int item = item0; item < 96; item += 1 << 20) {
        if (!have) {
            for (int i = F.tid; i < 5 * 1024; i += NTHREADS) { const int cnd = i >> 10, k = i & 1023; const float v = cnd < 4 ? F.inp(IN_C)[cnd * 1024 + k] : F.inp(IN_CCTX)[k]; scond[i] = silu_f(v); }
            have = true; __syncthreads();
        }
        const int L = item / 24, cg = item % 24, col0 = cg * 256 + 4 * F.lane;
        const float* W = F.inp(lbase(L)) + col0; const float* bias = F.inp(lbase(L) + 1);
        f32x4 acc[5];
#pragma unroll
        for (int c = 0; c < 5; ++c) acc[c] = (f32x4){0.f, 0.f, 0.f, 0.f};
        const int kb = F.wave * 128;
#pragma unroll 8
        for (int k = 0; k < 128; ++k) { const f32x4 w = *(const f32x4*)(W + (size_t)(kb + k) * 6144);
#pragma unroll
            for (int c = 0; c < 5; ++c) acc[c] += scond[c * 1024 + kb + k] * w; }
#pragma unroll
        for (int c = 0; c < 5; ++c) *(f32x4*)(red + (F.wave * 5 + c) * 256 + 4 * F.lane) = acc[c];
        __syncthreads();
        float* MOD = (float*)(F.ws + WS_MOD) + (size_t)L * 5 * 6144;
        for (int i = F.tid; i < 5 * 256; i += NTHREADS) { const int c = i >> 8, j = i & 255; float s = bias[cg * 256 + j];
#pragma unroll
            for (int w = 0; w < 8; ++w) s += red[(w * 5 + c) * 256 + j];
            MOD[c * 6144 + cg * 256 + j] = s; }
        __syncthreads();
    }
}
__device__ __forceinline__ void p0_misc(Ctx& F) {
    { float* cosT = (float*)(F.ws + WS_ROPE); float* sinT = cosT + 128 * 16;
        for (int i = F.tid; i < 128 * 16; i += NTHREADS) { const int pos = i >> 4, f = i & 15; const float inv = powf(10000.0f, -(float)f / 16.0f); const float ang = (float)pos * inv; cosT[i] = cosf(ang); sinT[i] = sinf(ang); } }
}
__device__ __forceinline__ void p0_s5mats(Ctx& F, const int g0) {
    const int LB = lbase(2);
    const float* a_re = F.inp(LB + 4); const float* a_im = F.inp(LB + 5); const float* log_dt = F.inp(LB + 6); const float* b_re = F.inp(LB + 7); const float* b_im = F.inp(LB + 8);
    const float* c_re = F.inp(LB + 9); const float* c_im = F.inp(LB + 10); const float* dsk = F.inp(LB + 11);
    LAS float* AP = (LAS float*)F.lds;
    LAS float* BB = AP + 2 * 17 * 64 * 2;
    LAS float* CC = BB + 2 * 64 * 16 * 2;
    LAS float* KK = CC + 2 * 16 * 64 * 2;
    for (int g = g0; g < 64; g += 1 << 20) {
        __syncthreads();
        for (int i = F.tid; i < 2 * 17 * 64; i += NTHREADS) { const int d = i / (17 * 64), r = i % (17 * 64), j = r / 64, p = r % 64;
            const float dt = expf(log_dt[d * 64 + g]); const float ar = a_re[(d * 64 + g) * 64 + p], ai = a_im[(d * 64 + g) * 64 + p];
            const float mag = expf((float)j * dt * ar), ph = (float)j * dt * ai; AP[i * 2] = mag * cosf(ph); AP[i * 2 + 1] = mag * sinf(ph); }
        for (int i = F.tid; i < 2 * 64 * 16; i += NTHREADS) { const int d = i / 1024, r = i % 1024, p = r / 16, s = r % 16;
            const float dt = expf(log_dt[d * 64 + g]); const float ar = a_re[(d * 64 + g) * 64 + p], ai = a_im[(d * 64 + g) * 64 + p];
            const float mag = expf(dt * ar), abr = mag * cosf(dt * ai), abi = mag * sinf(dt * ai), den = ar * ar + ai * ai, nr = abr - 1.0f;
            const float cor = (nr * ar + abi * ai) / den, coi = (abi * ar - nr * ai) / den;
            const float br = b_re[((size_t)(d * 64 + g) * 64 + p) * 16 + s], bi = b_im[((size_t)(d * 64 + g) * 64 + p) * 16 + s];
            BB[i * 2] = cor * br - coi * bi; BB[i * 2 + 1] = cor * bi + coi * br;
            const int s2 = r / 64, p2 = r % 64;
            CC[i * 2] = c_re[((size_t)(d * 64 + g) * 16 + s2) * 64 + p2]; CC[i * 2 + 1] = c_im[((size_t)(d * 64 + g) * 16 + s2) * 64 + p2]; }
        __syncthreads();
        for (int i = F.tid; i < 2 * 16 * 256; i += NTHREADS) { const int d = i >> 12, j = (i >> 8) & 15, so = (i >> 4) & 15, si = i & 15; float s = 0.f;
            for (int p = 0; p < 64; ++p) { const float cr = CC[((d * 16 + so) * 64 + p) * 2], ci = CC[((d * 16 + so) * 64 + p) * 2 + 1];
                const float pr = AP[((d * 17 + j) * 64 + p) * 2], pi = AP[((d * 17 + j) * 64 + p) * 2 + 1];
                const float br = BB[((d * 64 + p) * 16 + si) * 2], bi = BB[((d * 64 + p) * 16 + si) * 2 + 1];
                const float wr_ = cr * pr - ci * pi, wi_ = cr * pi + ci * pr; s += wr_ * br - wi_ * bi; }
            KK[i] = s; }
        __syncthreads();
        bf16_t* M1 = (bf16_t*)(F.ws + WS_S5M1) + (size_t)g * 256 * 256; bf16_t* M3 = (bf16_t*)(F.ws + WS_S5M3) + (size_t)g * 256 * 512;
        for (int i = F.tid; i < 256 * 256; i += NTHREADS) { const int n = i >> 8, k = i & 255, d = n >> 7, p = (n & 127) >> 1, c = n & 1, tp = k >> 4, si = k & 15; const int e = d ? tp : 15 - tp;
            const float pr = AP[((d * 17 + e) * 64 + p) * 2], pi = AP[((d * 17 + e) * 64 + p) * 2 + 1], br = BB[((d * 64 + p) * 16 + si) * 2], bi = BB[((d * 64 + p) * 16 + si) * 2 + 1];
            const float v = c ? (pr * bi + pi * br) : (pr * br - pi * bi); M1[i] = (bf16_t)(cvt_pk_bf16(v, 0.f) & 0xffffu); }
        for (int i = F.tid; i < 256 * 512; i += NTHREADS) { const int n = i >> 9, k = i & 511, t = n >> 4, so = n & 15; float v;
            if (k < 256) { const int tp = k >> 4, si = k & 15;
                if (t > tp) v = KK[((0 * 16 + (t - tp)) * 16 + so) * 16 + si];
                else if (t < tp) v = KK[((1 * 16 + (tp - t)) * 16 + so) * 16 + si];
                else { v = KK[((0 * 16 + 0) * 16 + so) * 16 + si] + KK[((1 * 16 + 0) * 16 + so) * 16 + si]; if (si == so) v += dsk[g * 16 + si]; } }
            else { const int q = k - 256, d = q >> 7, p = (q & 127) >> 1, c = q & 1; const int e = d ? 16 - t : t + 1;
                const float cr = CC[((d * 16 + so) * 64 + p) * 2], ci = CC[((d * 16 + so) * 64 + p) * 2 + 1], pr = AP[((d * 17 + e) * 64 + p) * 2], pi = AP[((d * 17 + e) * 64 + p) * 2 + 1];
                v = c ? -(cr * pi + ci * pr) : (cr * pr - ci * pi); }
            M3[i] = (bf16_t)(cvt_pk_bf16(v, 0.f) & 0xffffu); }
    }
    __syncthreads();
}

__device__ __forceinline__ void p0_prologue(Ctx& F, volatile LAS unsigned* MISC) {
    unsigned* ctr = (unsigned*)(F.ws + WS_CTL) + 128;
    for (;;) {
        __syncthreads();
        if (F.tid == 0) MISC[16] = __hip_atomic_fetch_add(ctr, 1u, __ATOMIC_RELAXED, __HIP_MEMORY_SCOPE_AGENT);
        __syncthreads();
        const int item = (int)MISC[16];
        if (item >= 161) break;
        if (item < 96) p0_adaln(F, item); else if (item < 160) p0_s5mats(F, item - 96); else p0_misc(F);
    }
    __syncthreads();
    p0_weights(F);
}
template <int MODE, bool COMB, bool FROM_IN = false>
__device__ __forceinline__ void row_pass(Ctx& F, int L, bool latent_only, int jsh  , int Lprev, bool out8 = false) {
    xel_t* X = (xel_t*)(F.ws + WS_X); bf16_t* HL = (bf16_t*)(F.ws + WS_HL);
    const float* MOD = (const float*)(F.ws + WS_MOD) + (size_t)L * 5 * 6144; const float* MODP = (const float*)(F.ws + WS_MOD) + (size_t)Lprev * 5 * 6144;
    const float* gain = MODE == 2 ? F.inp(IN_FINAL) : F.inp(lbase(L) + (jsh ? 3 : 2));
    const int nrows = latent_only ? NB * SEQ : MALL;
    const int rpw = (nrows + F.G - 1) / F.G;
    const int r0 = F.bid * rpw, r1 = min(nrows, r0 + rpw);
    LAS float* wrl = (LAS float*)F.lds;
    LAS int* hist = (LAS int*)(F.lds + 32768);
    if (MODE == 1) { const float* wrt = F.inp(lbase(L) + (L == 1 ? 8 : 7));
        for (int i = F.tid; i < 8192; i += NTHREADS) { const int k = i >> 3, e = i & 7; wrl[((((k >> 8) * 4 + (k & 3)) * 2 + (e >> 2)) * 64 + ((k & 255) >> 2)) * 4 + (e & 3)] = wrt[i]; }
        if (F.tid < 8) hist[F.tid] = 0;
        __syncthreads(); }
    const bf16_t* OP = (const bf16_t*)(F.ws + WS_BIG + BIG_APERM);
    const int4* SEL = (const int4*)(F.ws + WS_SEL); const int2* SLOT = (const int2*)(F.ws + WS_SLOT);
    int cur_cond = -1; f32x4 ca[4], cb[4], gp[4];
    for (int lr = r0 + F.wave; lr < r1; lr += NWAVES) {
        const int row = latent_only ? (lr >> 13) * RPB + CTXL + (lr & 8191) : lr;
        const int cond = row_cond(row);
        if (cond != cur_cond) { cur_cond = cond;
#pragma unroll
            for (int q = 0; q < 4; ++q) { const int col = 4 * F.lane + 256 * q; const f32x4 g4 = *(const f32x4*)(gain + col);
                if (MODE == 2) { ca[q] = g4; cb[q] = (f32x4){0.f, 0.f, 0.f, 0.f}; }
                else { const f32x4 sh = *(const f32x4*)(MOD + cond * 6144 + jsh * 1024 + col), sc = *(const f32x4*)(MOD + cond * 6144 + (jsh + 1) * 1024 + col); ca[q] = g4 * (1.0f + sc); cb[q] = sh; }
                if (COMB) gp[q] = *(const f32x4*)(MODP + cond * 6144 + 5 * 1024 + col); } }
        xel_t* xr = X + (size_t)row * DM + 4 * F.lane;
        f32x4 v[4];
        if (FROM_IN) { const int b_ = row / RPB, j_ = row - b_ * RPB; const f32x4* xi = (const f32x4*)(j_ < CTXL ? F.inp(IN_CTX) + ((size_t)b_ * CTXL + j_) * DM : F.inp(IN_X) + ((size_t)b_ * SEQ + (j_ - CTXL)) * DM) + F.lane;
#pragma unroll
            for (int q = 0; q < 4; ++q) v[q] = xi[64 * q];
        } else {
#pragma unroll
            for (int q = 0; q < 4; ++q) v[q] = x_ld4(xr + 256 * q); }
        if (COMB && !((MK_DBG_NOMOE >> (Lprev == 1 ? 0 : 1)) & 1)) {
            const int4 sel = SEL[row]; const int2 sl = SLOT[row]; const float w0 = __int_as_float(sel.z), w1 = __int_as_float(sel.w);
            const u32x2* o0 = (const u32x2*)(OP + (size_t)sl.x * DM) + F.lane; const u32x2* o1 = (const u32x2*)(OP + (size_t)sl.y * DM) + F.lane;
#pragma unroll
            for (int q = 0; q < 4; ++q) { const u32x2 a = o0[64 * q], b = o1[64 * q];
                f32x4 m; m[0] = w0 * bf_lo(a.x) + w1 * bf_lo(b.x); m[1] = w0 * bf_hi(a.x) + w1 * bf_hi(b.x); m[2] = w0 * bf_lo(a.y) + w1 * bf_lo(b.y); m[3] = w0 * bf_hi(a.y) + w1 * bf_hi(b.y);
                v[q] = v[q] + gp[q] * m; if (MODE != 2) x_st4(xr + 256 * q, v[q]); }
        }
        float ss = 0.f;
#pragma unroll
        for (int q = 0; q < 4; ++q) ss += (v[q][0] * v[q][0] + v[q][1] * v[q][1]) + (v[q][2] * v[q][2] + v[q][3] * v[q][3]);
        const float rstd = 1.0f / sqrtf(wave_sum(ss) * (1.0f / DM) + EPS);
        f32x4 h[4];
#pragma unroll
        for (int q = 0; q < 4; ++q) h[q] = (v[q] * rstd) * ca[q] + cb[q];
        if (MODE == 2) { const int b = row / RPB, t = row - b * RPB - CTXL; f32x4* o4 = (f32x4*)(F.out + ((size_t)b * SEQ + t) * DM) + F.lane;
#pragma unroll
            for (int q = 0; q < 4; ++q) o4[64 * q] = h[q];
        } else {
            if (out8) { unsigned* o4 = (unsigned*)((unsigned char*)HL + (size_t)row * DM) + F.lane;
#pragma unroll
                for (int q = 0; q < 4; ++q) o4[64 * q] = cvt4_fp8(h[q][0], h[q][1], h[q][2], h[q][3]);
            } else {
            u32x2* o8 = (MODE == 0 && COMB) ? (u32x2*)HL + ((size_t)(F.lane >> 2) * MALL + row) * 4 + (F.lane & 3) : (u32x2*)(HL + (size_t)row * DM) + F.lane;
            const size_t qst = (MODE == 0 && COMB) ? (size_t)16 * MALL * 4 : 64;
#pragma unroll
            for (int q = 0; q < 4; ++q) { u32x2 w; w.x = cvt_pk_bf16(h[q][0], h[q][1]); w.y = cvt_pk_bf16(h[q][2], h[q][3]); o8[qst * q] = w; } }
        }
        if (MODE == 1) {
            float lg[8];
#pragma unroll
            for (int e = 0; e < 8; ++e) lg[e] = 0.f;
#pragma unroll
            for (int q = 0; q < 4; ++q)
#pragma unroll
                for (int i = 0; i < 4; ++i) { const LAS f32x4* wp_ = (const LAS f32x4*)wrl + ((q * 4 + i) * 2) * 64 + F.lane; const f32x4 wa = wp_[0], wb = wp_[64]; const float hv = h[q][i];
                    lg[0] += hv * wa[0]; lg[1] += hv * wa[1]; lg[2] += hv * wa[2]; lg[3] += hv * wa[3]; lg[4] += hv * wb[0]; lg[5] += hv * wb[1]; lg[6] += hv * wb[2]; lg[7] += hv * wb[3]; }
#pragma unroll
            for (int e = 0; e < 8; ++e) lg[e] = wave_sum(lg[e]);
            int e0 = 0; float v0 = lg[0];
#pragma unroll
            for (int e = 1; e < 8; ++e) if (lg[e] > v0) { v0 = lg[e]; e0 = e; }
            int e1 = -1; float v1 = -INFINITY;
#pragma unroll
            for (int e = 0; e < 8; ++e) if (e != e0 && lg[e] > v1) { v1 = lg[e]; e1 = e; }
            const float ex = __expf(v1 - v0), w0 = 1.0f / (1.0f + ex), w1 = ex * w0;
            if (F.lane == 0) { ((int4*)(F.ws + WS_SEL))[row] = make_int4(e0, e1, __float_as_int(w0), __float_as_int(w1)); atomicAdd((int*)(hist + e0), 1); atomicAdd((int*)(hist + e1), 1); }
        }
    }
    if (MODE == 1) { __syncthreads(); if (F.tid < 8) ((int*)(F.ws + WS_CNT))[F.bid * 8 + F.tid] = hist[F.tid]; __syncthreads(); }
}

__device__ __forceinline__ void conv_pass(Ctx& F, int L, bool latent_only) {
    const bf16_t* BZ = (const bf16_t*)(F.ws + WS_BIG + BIG_BZ); bf16_t* U = (bf16_t*)(F.ws + WS_BIG + BIG_U);
    const float* cw = F.inp(lbase(L) + 5);
    const int nrows = latent_only ? NB * SEQ : MALL;
    const long nitems = (long)nrows * 128;
    for (long it = (long)F.bid * NTHREADS + F.tid; it < nitems; it += (long)F.G * NTHREADS) {
        const int lr = (int)(it >> 7), cgp = (int)(it & 127), col = cgp * 8;
        const int row = latent_only ? (lr >> 13) * RPB + CTXL + (lr & 8191) : lr;
        const int j = row % RPB; const bool first = (j == 0) || (j == CTXL), lastr = (j == CTXL - 1) || (j == RPB - 1);
        const u32x4 bb = *(const u32x4*)(BZ + (size_t)row * 2048 + col);
        const u32x4 zc = *(const u32x4*)(BZ + (size_t)row * 2048 + 1024 + col);
        u32x4 zp = (u32x4){0u, 0u, 0u, 0u}, zn = (u32x4){0u, 0u, 0u, 0u};
        if (!first) zp = *(const u32x4*)(BZ + (size_t)(row - 1) * 2048 + 1024 + col);
        if (!lastr) zn = *(const u32x4*)(BZ + (size_t)(row + 1) * 2048 + 1024 + col);
        const f32x4 w0a = *(const f32x4*)(cw + col), w0b = *(const f32x4*)(cw + col + 4), w1a = *(const f32x4*)(cw + 1024 + col), w1b = *(const f32x4*)(cw + 1024 + col + 4), w2a = *(const f32x4*)(cw + 2048 + col), w2b = *(const f32x4*)(cw + 2048 + col + 4);
        float y[8];
#define CV(i, W0, W1, W2, ZP, ZC, ZN, LO) y[i] = (W0) * (LO ? bf_lo(ZP) : bf_hi(ZP)) + (W1) * (LO ? bf_lo(ZC) : bf_hi(ZC)) + (W2) * (LO ? bf_lo(ZN) : bf_hi(ZN))
        CV(0, w0a[0], w1a[0], w2a[0], zp.x, zc.x, zn.x, 1); CV(1, w0a[1], w1a[1], w2a[1], zp.x, zc.x, zn.x, 0);
        CV(2, w0a[2], w1a[2], w2a[2], zp.y, zc.y, zn.y, 1); CV(3, w0a[3], w1a[3], w2a[3], zp.y, zc.y, zn.y, 0);
        CV(4, w0b[0], w1b[0], w2b[0], zp.z, zc.z, zn.z, 1); CV(5, w0b[1], w1b[1], w2b[1], zp.z, zc.z, zn.z, 0);
        CV(6, w0b[2], w1b[2], w2b[2], zp.w, zc.w, zn.w, 1); CV(7, w0b[3], w1b[3], w2b[3], zp.w, zc.w, zn.w, 0);
#undef CV
        u32x4 o; o.x = cvt_pk_bf16(bf_lo(bb.x) * y[0], bf_hi(bb.x) * y[1]); o.y = cvt_pk_bf16(bf_lo(bb.y) * y[2], bf_hi(bb.y) * y[3]);
        o.z = cvt_pk_bf16(bf_lo(bb.z) * y[4], bf_hi(bb.z) * y[5]); o.w = cvt_pk_bf16(bf_lo(bb.w) * y[6], bf_hi(bb.w) * y[7]);
        *(u32x4*)(U + (size_t)row * DM + col) = o;
    }
}

__device__ __forceinline__ void attn_combine(Ctx& F, int L) {
    const float* lamv = F.inp(lbase(L) + 5); const float* subln = F.inp(lbase(L) + 6);
    const float lam_init = 0.8f - 0.6f * expf(-0.3f * (float)L);
    float s01 = 0.f, s23 = 0.f;
    for (int i = 0; i < 64; ++i) { s01 += lamv[i] * lamv[64 + i]; s23 += lamv[128 + i] * lamv[192 + i]; }
    const float lam = expf(s01) - expf(s23) + lam_init, osc = 1.0f - lam_init;
    bf16_t* O0 = (bf16_t*)(F.ws + WS_BIG + BIG_O0); const bf16_t* O1 = (const bf16_t*)(F.ws + WS_HL);
    const int sub = F.lane & 15;
    const f32x4 g0 = *(const f32x4*)(subln + sub * 8), g1 = *(const f32x4*)(subln + sub * 8 + 4);
    const long nit = (long)MALL * NHEAD;
    for (long it = ((long)F.bid * NTHREADS + F.tid) >> 4; it < nit; it += ((long)F.G * NTHREADS) >> 4) {
        const size_t off = (size_t)it * 128 + sub * 8;
        const u32x4 a = *(const u32x4*)(O0 + off), b = *(const u32x4*)(O1 + off);
        float o[8];
        o[0] = bf_lo(a.x) - lam * bf_lo(b.x); o[1] = bf_hi(a.x) - lam * bf_hi(b.x); o[2] = bf_lo(a.y) - lam * bf_lo(b.y); o[3] = bf_hi(a.y) - lam * bf_hi(b.y);
        o[4] = bf_lo(a.z) - lam * bf_lo(b.z); o[5] = bf_hi(a.z) - lam * bf_hi(b.z); o[6] = bf_lo(a.w) - lam * bf_lo(b.w); o[7] = bf_hi(a.w) - lam * bf_hi(b.w);
        float ss = 0.f;
#pragma unroll
        for (int i = 0; i < 8; ++i) ss += o[i] * o[i];
        ss = row16_sum(ss);
        const float r = osc / sqrtf(ss * (1.0f / 128.0f) + EPS);
        u32x4 w; w.x = cvt_pk_bf16(o[0] * r * g0[0], o[1] * r * g0[1]); w.y = cvt_pk_bf16(o[2] * r * g0[2], o[3] * r * g0[3]);
        w.z = cvt_pk_bf16(o[4] * r * g1[0], o[5] * r * g1[1]); w.w = cvt_pk_bf16(o[6] * r * g1[2], o[7] * r * g1[3]);
        *(u32x4*)(O0 + off) = w;
    }
}

__device__ __forceinline__ void attn_phase(Ctx& F) {
    const bf16_t* Q = (const bf16_t*)(F.ws + WS_BIG + BIG_QKV); const bf16_t* KH = (const bf16_t*)(F.ws + WS_BIG + BIG_KH); const bf16_t* VH = (const bf16_t*)(F.ws + WS_BIG + BIG_VH);
    bf16_t* O0 = (bf16_t*)(F.ws + WS_BIG + BIG_O0); bf16_t* O1 = (bf16_t*)(F.ws + WS_HL);
    const int vcu = (F.G % 8 == 0) ? (F.bid % 8) * (F.G / 8) + F.bid / 8 : F.bid;
    for (int u = vcu; u < 2048 + 64; u += F.G) {
        int bh, qb; bool isctx = u >= 2048;
        if (!isctx) { bh = u >> 5; qb = u & 31; } else { bh = u - 2048; qb = 0; }
        const int b = bh >> 4, vh = bh & 15, h = vh >> 1, m = vh & 1;
        const size_t rowb = (size_t)b * RPB;
        const size_t qrow = isctx ? rowb : rowb + CTXL + (size_t)qb * 256;
        const bf16_t* Qb = Q + qrow * DM + h * 128 + m * 64;
        const bf16_t* Kh = KH + (size_t)(b * 16 + vh) * RPB * 64;
        const bf16_t* Vh = VH + (size_t)(b * 8 + h) * RPB * 128;
        bf16_t* Ob = (m ? O1 : O0) + qrow * DM + h * 128;
        att2::attn_unit(Qb, Kh, Vh, Ob, DM, isctx ? CTXL : RPB, F.lds, F.tid);
    }
}

__device__ __forceinline__ void v_transpose(Ctx& F) {
    const unsigned char* V8 = F.ws + WS_BIG + BIG_V8; unsigned char* VT8 = F.ws + WS_BIG + BIG_VT8;
    LAS unsigned char* buf = F.lds + F.wave * 8192;
    const int gw = F.bid * NWAVES + F.wave, NGW = F.G * NWAVES;
    for (int it = gw; it < NB * NHEAD * (RPB / 64); it += NGW) {
        const size_t tb = (size_t)it * 8192;
#pragma unroll
        for (int t = 0; t < 8; ++t) *(LAS u32x4*)(buf + (F.lane + 64 * t) * 16) = *(const u32x4*)(V8 + tb + (size_t)(F.lane + 64 * t) * 16);
        LDS_WAIT();
#pragma unroll
        for (int u = 0; u < 2; ++u) { const int d = F.lane + 64 * u;
#pragma unroll
            for (int q = 0; q < 4; ++q) { u32x4 w;
#pragma unroll
                for (int e = 0; e < 4; ++e) { unsigned x = 0;
#pragma unroll
                    for (int b = 0; b < 4; ++b) x |= (unsigned)buf[att3::slot_key(q * 16 + e * 4 + b) * 128 + d] << (8 * b);
                    w[e] = x; }
                *(u32x4*)(VT8 + tb + (size_t)d * 64 + q * 16) = w; } }
        LDS_WAIT();
    }
}
__device__ __forceinline__ void attn_phase3(Ctx& F, int L) {
    const unsigned char* Q8 = F.ws + WS_BIG + BIG_Q8; const unsigned char* K8 = F.ws + WS_BIG + BIG_K8; const unsigned char* VT8 = F.ws + WS_BIG + BIG_VT8;
    bf16_t* AO = (bf16_t*)(F.ws + WS_BIG + BIG_O0);
    const float* lamv = F.inp(lbase(L) + 5); const float* subln = F.inp(lbase(L) + 6);
    const float lam_init = 0.8f - 0.6f * expf(-0.3f * (float)L);
    float s01 = 0.f, s23 = 0.f;
    for (int i = 0; i < 64; ++i) { s01 += lamv[i] * lamv[64 + i]; s23 += lamv[128 + i] * lamv[192 + i]; }
    const float lam = expf(s01) - expf(s23) + lam_init, osc = 1.0f - lam_init;
    const int vcu = (F.G % 8 == 0) ? (F.bid % 8) * (F.G / 8) + F.bid / 8 : F.bid;
    for (int u = vcu; u < 1024 + 32; u += F.G) {
        int bh, qb; const bool isctx = u >= 1024;
        if (!isctx) { bh = u >> 5; qb = u & 31; } else { bh = u - 1024; qb = 0; }
        const int b = bh >> 3, h = bh & 7;
        const size_t rowb = (size_t)b * RPB;
        const size_t qrow = isctx ? rowb : rowb + CTXL + (size_t)qb * 256;
        att3::attn_unit(Q8 + qrow * DM + h * 128, K8 + (size_t)(b * 16 + 2 * h) * RPB * 64, (size_t)RPB * 64, VT8 + (size_t)(b * 8 + h) * RPB * 128, AO + qrow * DM + h * 128, DM, isctx ? CTXL : RPB,
                        lam, osc, subln, (u32x4*)(F.ws + WS_BIG + ((size_t)270 << 20)) + (size_t)F.bid * 4096, F.lds, F.tid);
    }
}

__device__ __forceinline__ void moe_scatter(Ctx& F, bool latent_only) {
    const int nrows = latent_only ? NB * SEQ : MALL;
    const int rpw = (nrows + F.G - 1) / F.G, r0 = F.bid * rpw, r1 = min(nrows, r0 + rpw);
    LAS int* tot = (LAS int*)F.lds; LAS int* pre = tot + 8; LAS int* base = tot + 16; LAS int* offs = tot + 24;
    LAS int* selc = tot + 64;
    LAS int* slc = selc + 1024;
    const int* CNT = (const int*)(F.ws + WS_CNT); const int4* SEL = (const int4*)(F.ws + WS_SEL); int2* SLOT = (int2*)(F.ws + WS_SLOT); int* TEXP = (int*)(F.ws + WS_TEXP);
    if (F.tid < 16) tot[F.tid] = 0;
    __syncthreads();
    for (int q = F.tid; q < 2 * F.G; q += NTHREADS) { const int w = q >> 1, e4 = (q & 1) * 4; const int4 c = *(const int4*)(CNT + w * 8 + e4);
        atomicAdd((int*)(tot + e4 + 0), c.x); atomicAdd((int*)(tot + e4 + 1), c.y); atomicAdd((int*)(tot + e4 + 2), c.z); atomicAdd((int*)(tot + e4 + 3), c.w);
        if (w < F.bid) { atomicAdd((int*)(pre + e4 + 0), c.x); atomicAdd((int*)(pre + e4 + 1), c.y); atomicAdd((int*)(pre + e4 + 2), c.z); atomicAdd((int*)(pre + e4 + 3), c.w); } }
    for (int i = F.tid; i < r1 - r0; i += NTHREADS) { const int lr = r0 + i; const int row = latent_only ? (lr >> 13) * RPB + CTXL + (lr & 8191) : lr; const int4 s = SEL[row]; selc[i] = s.x | (s.y << 8); }
    __syncthreads();
    if (F.tid == 0) { int o = 0; for (int e = 0; e < 8; ++e) { offs[e] = o; base[e] = o + pre[e]; o += (tot[e] + 255) & ~255; } offs[8] = o;
        for (int i = 0; i < r1 - r0; ++i) { const int s = selc[i], e0 = s & 255, e1 = s >> 8; slc[2 * i] = base[e0]++; slc[2 * i + 1] = base[e1]++; } }
    __syncthreads();
    if (F.bid == 0) { const int nT = offs[8] >> 8; for (int t = F.tid; t < nT; t += NTHREADS) { int e = 0; while (e < 7 && t * 256 >= offs[e + 1]) ++e; TEXP[t] = e; } if (F.tid == 0) TEXP[500] = nT; }
    const bf16_t* HL = (const bf16_t*)(F.ws + WS_HL); unsigned char* AP8 = (unsigned char*)(F.ws + WS_BIG + BIG_APERM);
    for (int i = F.wave; i < r1 - r0; i += NWAVES) { const int lr = r0 + i; const int row = latent_only ? (lr >> 13) * RPB + CTXL + (lr & 8191) : lr;
        const int s0 = slc[2 * i], s1 = slc[2 * i + 1];
        if (F.lane == 0) SLOT[row] = make_int2(s0, s1);
        const u32x4* src = (const u32x4*)(HL + (size_t)row * DM) + F.lane; const u32x4 a = src[0], b = src[64];
        u32x2 qa, qb; qa.x = cvt4_fp8(bf_lo(a.x), bf_hi(a.x), bf_lo(a.y), bf_hi(a.y)); qa.y = cvt4_fp8(bf_lo(a.z), bf_hi(a.z), bf_lo(a.w), bf_hi(a.w));
        qb.x = cvt4_fp8(bf_lo(b.x), bf_hi(b.x), bf_lo(b.y), bf_hi(b.y)); qb.y = cvt4_fp8(bf_lo(b.z), bf_hi(b.z), bf_lo(b.w), bf_hi(b.w));
        u32x2* d0 = (u32x2*)(AP8 + (size_t)s0 * DM) + F.lane; u32x2* d1 = (u32x2*)(AP8 + (size_t)s1 * DM) + F.lane;
        d0[0] = qa; d0[64] = qb; d1[0] = qa; d1[64] = qb; }
    __syncthreads();
}

__device__ __forceinline__ void s5_scan(Ctx& F) {
    const int LB = lbase(2);
    const float* a_re = F.inp(LB + 4); const float* a_im = F.inp(LB + 5); const float* log_dt = F.inp(LB + 6);
    const float* H = (const float*)(F.ws + WS_BIG + BIG_H); bf16_t* SB = (bf16_t*)(F.ws + WS_BIG + BIG_SBUF);
    LAS float* ex = (LAS float*)F.lds;
    constexpr int QS = CPB / 4;
    for (int pair = F.bid; pair < 256; pair += F.G) {
        const int task = 2 * pair + (F.wave >> 2), seg = F.wave & 3;
        const int b = task >> 7, d = (task >> 6) & 1, g = task & 63, p = F.lane;
        const float dt = expf(log_dt[d * 64 + g]); const float ar = a_re[(d * 64 + g) * 64 + p], ai = a_im[(d * 64 + g) * 64 + p];
        const float mag = expf(16.0f * dt * ar), ph = 16.0f * dt * ai, Ar = mag * cosf(ph), Ai = mag * sinf(ph);
        const float magq = expf((16.0f * QS) * dt * ar), phq = (16.0f * QS) * dt * ai, Qr = magq * cosf(phq), Qi = magq * sinf(phq);
        const int v = d * 128 + 2 * p;
        const float* Hb = H + ((size_t)b * CPB * 64 + g) * 256 + v;
        bf16_t* Sb = SB + ((size_t)g * (MALL / 16) + (size_t)b * CPB) * 256 + v;
        float er = 0.f, ei = 0.f;
        for (int s0 = seg * QS; s0 < (seg + 1) * QS; s0 += 4) {
            f32x2 hv[4];
#pragma unroll
            for (int i = 0; i < 4; ++i) { const int st = s0 + i; const int c = d ? (st < 16 ? 15 - st : CPB - 1 - (st - 16)) : st; hv[i] = *(const f32x2*)(Hb + (size_t)c * 64 * 256); }
#pragma unroll
            for (int i = 0; i < 4; ++i) { const float nr = Ar * er - Ai * ei + hv[i][0], ni = Ar * ei + Ai * er + hv[i][1]; er = nr; ei = ni; }
        }
        __syncthreads();
        ex[(F.wave * 64 + p) * 2] = er; ex[(F.wave * 64 + p) * 2 + 1] = ei;
        __syncthreads();
        er = 0.f; ei = 0.f;
        for (int q = 0; q < seg; ++q) { const int w = (F.wave & 4) + q; const float xr_ = ex[(w * 64 + p) * 2], xi_ = ex[(w * 64 + p) * 2 + 1];
            const float nr = Qr * er - Qi * ei + xr_, ni = Qr * ei + Qi * er + xi_; er = nr; ei = ni; }
        for (int s0 = seg * QS; s0 < (seg + 1) * QS; s0 += 4) {
            f32x2 hv[4]; int cc[4];
#pragma unroll
            for (int i = 0; i < 4; ++i) { const int st = s0 + i; cc[i] = d ? (st < 16 ? 15 - st : CPB - 1 - (st - 16)) : st; hv[i] = *(const f32x2*)(Hb + (size_t)cc[i] * 64 * 256); }
#pragma unroll
            for (int i = 0; i < 4; ++i) { *(unsigned*)(Sb + (size_t)cc[i] * 256) = cvt_pk_bf16(er, ei);
                const float nr = Ar * er - Ai * ei + hv[i][0], ni = Ar * ei + Ai * er + hv[i][1]; er = nr; ei = ni; }
        }
    }
}

__global__ void __launch_bounds__(NTHREADS, 2) mk_fwd(Args args) {
    extern __shared__ __attribute__((aligned(16))) unsigned char lds[];
    Ctx F;
    F.lds = (LAS unsigned char*)lds;
    F.tid = threadIdx.x; F.lane = F.tid & 63; F.wave = __builtin_amdgcn_readfirstlane(F.tid >> 6);
    F.G = gridDim.x; F.bid = blockIdx.x; F.ws = args.ws; F.out = args.out;
    volatile LAS unsigned* MISC = (volatile LAS unsigned*)(F.lds + MISC_OFF);
    if (F.tid < 32) MISC[F.tid] = 0u;
    if (F.tid == 0) {
#pragma unroll
        for (int i = 0; i < 50; ++i) *(LAS unsigned long long*)(F.lds + INTAB_OFF + 8 * i) = (unsigned long long)(uintptr_t)args.in[i]; }
    __syncthreads();
    const int lo = args.ph_lo, hi = args.ph_hi;
    XcdBarrier bar; bar.bar = (unsigned*)(F.ws + WS_CTL) + 1024; bar.x = 0; bar.st = nullptr;
    if (hi - lo > 1) bar = xcd_barrier_post((unsigned*)(F.ws + WS_CTL) + 1024, MISC + 8);
    int ph = 0;
#define LAUNDER() do { F.ws = launder_ptr(F.ws); F.out = launder_ptr(F.out); F.wave = launder_i(F.wave); asm volatile("v_mbcnt_lo_u32_b32 %0, -1, 0\n\tv_mbcnt_hi_u32_b32 %0, -1, %0" : "=v"(F.lane));     F.tid = F.wave * 64 + F.lane; \
    F.G = launder_i(F.G); F.bid = launder_i(F.bid); } while (0)
#define PHASE(id, ...) do { if (lo <= ph && ph < hi) { LAUNDER(); if ((MK_SITEMASK >> (id)) & 1u) { __VA_ARGS__; } if ((id) == MK_REPEAT_SITE) { __syncthreads(); LAUNDER(); __VA_ARGS__; } if (ph + 1 < hi) xcd_barrier(bar); } ++ph; } while (0)

#define WSB (F.ws)
#define XPTR ((xel_t*)(F.ws + WS_X))
#define HLPTR ((bf16_t*)(F.ws + WS_HL))
#define VBID (F.bid)
#define MODPTR ((const float*)(F.ws + WS_MOD) + (size_t)L * 5 * 6144)

    PHASE(0, p0_prologue(F, MISC));
#if MK_EXTRA_BARS
    if (hi - lo > 1) for (int eb = 0; eb < MK_EXTRA_BARS; ++eb) xcd_barrier(bar);
#endif

    for (int L = 0; L < 4; ++L) {
        const int kind = L % 3; const bool moe = (L & 1) != 0;
        const bool lat = (L >= 2);
        if (L == 2) PHASE(1, (row_pass<0, true>(F, L, false, 0, L - 1)));
        else if (L == 0) PHASE(2, (row_pass<0, false, true>(F, L, false, 0, 0)));
        else PHASE(3, (row_pass<0, false>(F, L, lat, 0, 0, L == 1 && MK_FP8_QKV)));
        if (kind == 0) {
            const size_t wo_in = (L == 0) ? WO_L0_CONVIN : WO_L3_CONVIN, wo_out = (L == 0) ? WO_L0_CONVOUT : WO_L3_CONVOUT;
            PHASE(4, { pg8::ProbPlain P{(const char*)HLPTR, (const char*)(WSB + WS_W + wo_in), 2048, 2048, 16, lat ? NT_LAT : NT_ALL, 12, F.G, VBID, lat};
                    pg8::EpiGated<0> E{(bf16_t*)(WSB + WS_BIG + BIG_BZ), 2048, 4, 1024, 0};
                    pg8::gemm_phase<pg8::EpiGated<0>, pg8::ProbPlain, true>(F.lds, P, E, F.tid); });
            PHASE(5, conv_pass(F, L, lat));
            PHASE(6, { pg8::ProbPlain P{(const char*)(WSB + WS_BIG + BIG_U), (const char*)(WSB + WS_W + wo_out), 2048, 2048, 16, lat ? NT_LAT : NT_ALL, 4, F.G, VBID, lat};
                    pg8::EpiResid E{XPTR, MODPTR + 2 * 1024, L == 0 ? F.inp(IN_X) : nullptr, L == 0 ? F.inp(IN_CTX) : nullptr, 1.f};
                    pg8::gemm_phase<pg8::EpiResid, pg8::ProbPlain, true>(F.lds, P, E, F.tid); });
        } else if (kind == 1) {
            if (MK_FP8_QKV) {
            PHASE(25, { pg8::ProbPlain P{(const char*)HLPTR, (const char*)(WSB + WS_W + WO_L1_QKV), 1024, 1024, 8, NT_ALL, 12, F.G, VBID, false};
                    pg8::EpiQkv<MK_ATT3 != 0, true> E{WSB + WS_BIG, (const float*)(WSB + WS_ROPE)};
                    pg8::gemm_phase<pg8::EpiQkv<MK_ATT3 != 0, true>, pg8::ProbPlain, true, true>(F.lds, P, E, F.tid); });
            } else {
            PHASE(7, { pg8::ProbPlain P{(const char*)HLPTR, (const char*)(WSB + WS_W + WO_L1_QKV), 2048, 2048, 16, NT_ALL, 12, F.G, VBID, false};
                    pg8::EpiQkv<MK_ATT3 != 0, false> E{WSB + WS_BIG, (const float*)(WSB + WS_ROPE)};
                    pg8::gemm_phase<pg8::EpiQkv<MK_ATT3 != 0, false>, pg8::ProbPlain, true>(F.lds, P, E, F.tid); });
            }
            if (MK_ATT3) { PHASE(27, v_transpose(F)); PHASE(28, attn_phase3(F, L)); }
            else { PHASE(8, attn_phase(F)); PHASE(9, attn_combine(F, L)); }
            PHASE(10, { pg8::ProbPlain P{(const char*)(WSB + WS_BIG + BIG_O0), (const char*)(WSB + WS_W + WO_L1_WO), 2048, 2048, 16, NT_ALL, 4, F.G, VBID, false};
                    pg8::EpiResid E{XPTR, MODPTR + 2 * 1024, nullptr, nullptr, 1.f};
                    pg8::gemm_phase<pg8::EpiResid, pg8::ProbPlain, true>(F.lds, P, E, F.tid); });
        } else {
            PHASE(11, { pg8::ProbS5 P{(const char*)HLPTR, (const char*)HLPTR, (const char*)(WSB + WS_S5M1), 4, 4, 9, F.G, VBID, (size_t)256 * 256 * 2, false};
                    pg8::EpiS1 E{(float*)(WSB + WS_BIG + BIG_H)};
                    pg8::gemm_phase<pg8::EpiS1, pg8::ProbS5, true>(F.lds, P, E, F.tid); });
            PHASE(12, s5_scan(F));
            PHASE(13, { pg8::ProbS5 P{(const char*)HLPTR, (const char*)(WSB + WS_BIG + BIG_SBUF), (const char*)(WSB + WS_S5M3), 8, 4, 8, F.G, VBID, (size_t)256 * 512 * 2, true};
                    pg8::EpiS3 E{(bf16_t*)(WSB + WS_BIG + BIG_YG), MK_FP8_GLU != 0};
                    pg8::gemm_phase<pg8::EpiS3, pg8::ProbS5, true>(F.lds, P, E, F.tid); });
            if (MK_FP8_GLU) {
            PHASE(26, { pg8::ProbPlain P{(const char*)(WSB + WS_BIG + BIG_YG), (const char*)(WSB + WS_W + WO_L2_GLU), 1024, 1024, 8, NT_LAT, 8, F.G, VBID, true};
                    pg8::EpiGlu E{XPTR, MODPTR + 2 * 1024, pg8::W8INV};
                    pg8::gemm_phase<pg8::EpiGlu, pg8::ProbPlain, true, true>(F.lds, P, E, F.tid); });
            } else {
            PHASE(14, { pg8::ProbPlain P{(const char*)(WSB + WS_BIG + BIG_YG), (const char*)(WSB + WS_W + WO_L2_GLU), 2048, 2048, 16, NT_LAT, 8, F.G, VBID, true};
                    pg8::EpiGlu E{XPTR, MODPTR + 2 * 1024, 1.f};
                    pg8::gemm_phase<pg8::EpiGlu, pg8::ProbPlain, true>(F.lds, P, E, F.tid); });
            }
        }
        if (moe) PHASE(15, (row_pass<1, false>(F, L, lat, 3, 0)));
        else PHASE(16, (row_pass<0, false>(F, L, lat, 3, 0, ((MK_FP8_FFN >> L) & 1) != 0)));
        if (!moe) {
            const size_t wo_gu = (L == 0) ? WO_L0_GU : WO_L2_GU, wo_dn = (L == 0) ? WO_L0_DOWN : WO_L2_DOWN;
            if ((MK_FP8_FFN >> L) & 1) {
                PHASE(23, { pg8::ProbPlain P{(const char*)HLPTR, (const char*)(WSB + WS_W + wo_gu), 1024, 1024, 8, lat ? NT_LAT : NT_ALL, 22, F.G, VBID, lat};
                        pg8::EpiGated8 E{(unsigned char*)(WSB + WS_BIG + BIG_HID), DFF, pg8::W8INV};
                        pg8::gemm_phase<pg8::EpiGated8, pg8::ProbPlain, true, true>(F.lds, P, E, F.tid); });
                PHASE(24, { pg8::ProbPlain P{(const char*)(WSB + WS_BIG + BIG_HID), (const char*)(WSB + WS_W + wo_dn), DFF, DFF, 22, lat ? NT_LAT : NT_ALL, 4, F.G, VBID, lat};
                        pg8::EpiResid E{XPTR, MODPTR + 5 * 1024, nullptr, nullptr, pg8::W8INV};
                        pg8::gemm_phase<pg8::EpiResid, pg8::ProbPlain, true, true>(F.lds, P, E, F.tid); });
            } else if (MK_FP8_DOWN0 && L == 0) {
                PHASE(17, { pg8::ProbPlain P{(const char*)HLPTR, (const char*)(WSB + WS_W + wo_gu), 2048, 2048, 16, NT_ALL, 22, F.G, VBID, false};
                        pg8::EpiGated8 E{(unsigned char*)(WSB + WS_BIG + BIG_HID), DFF, 1.f};
                        pg8::gemm_phase<pg8::EpiGated8, pg8::ProbPlain, true>(F.lds, P, E, F.tid); });
                PHASE(24, { pg8::ProbPlain P{(const char*)(WSB + WS_BIG + BIG_HID), (const char*)(WSB + WS_W + wo_dn), DFF, DFF, 22, NT_ALL, 4, F.G, VBID, false};
                        pg8::EpiResid E{XPTR, MODPTR + 5 * 1024, nullptr, nullptr, pg8::W8INV};
                        pg8::gemm_phase<pg8::EpiResid, pg8::ProbPlain, true, true>(F.lds, P, E, F.tid); });
            } else {
            PHASE(17, { pg8::ProbPlain P{(const char*)HLPTR, (const char*)(WSB + WS_W + wo_gu), 2048, 2048, 16, lat ? NT_LAT : NT_ALL, 22, F.G, VBID, lat};
                    pg8::EpiGated<1> E{(bf16_t*)(WSB + WS_BIG + BIG_HID), DFF, 0, 0, 0};
                    pg8::gemm_phase<pg8::EpiGated<1>, pg8::ProbPlain, true>(F.lds, P, E, F.tid); });
            PHASE(18, { pg8::ProbPlain P{(const char*)(WSB + WS_BIG + BIG_HID), (const char*)(WSB + WS_W + wo_dn), DFF * 2, DFF * 2, 44, lat ? NT_LAT : NT_ALL, 4, F.G, VBID, lat};
                    pg8::EpiResid E{XPTR, MODPTR + 5 * 1024, nullptr, nullptr, 1.f};
                    pg8::gemm_phase<pg8::EpiResid, pg8::ProbPlain, true>(F.lds, P, E, F.tid); });
            }
        } else {
            const size_t wo_gu = (L == 1) ? WO_L1_MGU : WO_L3_MGU, wo_dn = (L == 1) ? WO_L1_MDOWN : WO_L3_MDOWN;
            PHASE(19, moe_scatter(F, lat));
#define TEXPP ((const int*)(F.ws + WS_TEXP))
            PHASE(20, { const int nT = __builtin_amdgcn_readfirstlane(TEXPP[500]);
                    pg8::ProbMoe P{(const char*)(WSB + WS_BIG + BIG_APERM), (const char*)(WSB + WS_W + wo_gu), 1024, 1024, 8, 22, F.G, VBID, WSZ_GU / 2, TEXPP, 0, nT, 0};
                    pg8::EpiGated8 E{(unsigned char*)(WSB + WS_BIG + BIG_MHID), DFF, pg8::W8INV};
                    pg8::gemm_phase<pg8::EpiGated8, pg8::ProbMoe, true, true>(F.lds, P, E, F.tid); });
            PHASE(21, { const int nT = __builtin_amdgcn_readfirstlane(TEXPP[500]);
                    pg8::ProbMoe P{(const char*)(WSB + WS_BIG + BIG_MHID), (const char*)(WSB + WS_W + wo_dn), DFF, DFF, 22, 4, F.G, VBID, WSZ_DOWN / 2, TEXPP, 0, nT, 0};
                    pg8::EpiBf16 E{(bf16_t*)(WSB + WS_BIG + BIG_APERM), DM, 0, pg8::W8INV};
                    pg8::gemm_phase<pg8::EpiBf16, pg8::ProbMoe, true, true>(F.lds, P, E, F.tid); });
        }
    }
    PHASE(22, (row_pass<2, true>(F, 3, true, 0, 3)));
#undef PHASE
#undef WSB
#undef XPTR
#undef HLPTR
#undef VBID
#undef MODPTR
#undef TEXPP
}
constexpr int N_PHASES = 1 + (1 + 3 + 1 + 2) + (1 + 4 + 1 + 1 + 2) + (1 + 4 + 1 + 2) + (1 + 3 + 1 + 1 + 2) + 1;

extern "C" void kernel_launch(void* const* d_in, const int* in_sizes, int n_in, void* d_out, int out_size, void* d_ws, size_t ws_size, hipStream_t stream) {
    static int grid = 0;
    if (grid == 0) {
        if (n_in != 50 || in_sizes[0] != NB * SEQ * DM || out_size != NB * SEQ * DM || ws_size < WS_END) {
            fprintf(stderr, "kernel_launch: unexpected shapes (n_in %d, in0 %d, out %d, ws %zu < %zu)\n", n_in, n_in > 0 ? in_sizes[0] : -1, out_size, ws_size, (size_t)WS_END); grid = -1; return; }
        int dev = 0, cus = 0, per_cu = 0;
        if (hipGetDevice(&dev) != hipSuccess || hipDeviceGetAttribute(&cus, hipDeviceAttributeMultiprocessorCount, dev) != hipSuccess) { grid = -1; return; }
        if (hipFuncSetAttribute((const void*)mk_fwd, hipFuncAttributeMaxDynamicSharedMemorySize, LDS_BYTES) != hipSuccess) { fprintf(stderr, "kernel_launch: hipFuncSetAttribute failed\n"); grid = -1; return; }
        if (hipOccupancyMaxActiveBlocksPerMultiprocessor(&per_cu, (const void*)mk_fwd, NTHREADS, LDS_BYTES) != hipSuccess || per_cu < 1) { fprintf(stderr, "kernel_launch: occupancy query says %d\n", per_cu); }
        (void)hipGetLastError();
        grid = cus;
    }
    if (grid < 0) return;
    (void)hipMemsetAsync((char*)d_ws + WS_CTL, 0, CTL_ZERO_BYTES, stream);
    Args a{};
    for (int i = 0; i < 50; ++i) a.in[i] = (const float*)d_in[i];
    a.out = (float*)d_out; a.ws = (unsigned char*)d_ws;
#if MK_ONE_LAUNCH
    a.ph_lo = 0; a.ph_hi = N_PHASES;
    hipLaunchKernelGGL(mk_fwd, dim3(grid), dim3(NTHREADS), LDS_BYTES, stream, a);
#else
    for (int p = 0; p < N_PHASES; ++p) { a.ph_lo = p; a.ph_hi = p + 1; hipLaunchKernelGGL(mk_fwd, dim3(grid), dim3(NTHREADS), LDS_BYTES, stream, a); }
#endif
    const hipError_t le = hipPeekAtLastError();
    if (le != hipSuccess) fprintf(stderr, "kernel_launch: launch failed: %s\n", hipGetErrorName(le));
}
```

```cpp
#include <hip/hip_runtime.h>
#include <hip/hip_bf16.h>
#include <cstdio>
#include <cstdint>
#include <cmath>

#ifndef MK_SITEMASK
#define MK_SITEMASK 0xffffffffu
#endif
#ifndef MK_REPEAT_SITE
#define MK_REPEAT_SITE -1
#endif
#ifndef MK_DBG_NOMOE
#define MK_DBG_NOMOE 0
#endif
#ifndef MK_EXTRA_BARS
#define MK_EXTRA_BARS 0
#endif
#ifndef MK_FP8_FFN
#define MK_FP8_FFN 0x4
#endif
#ifndef MK_FP8_QKV
#define MK_FP8_QKV 1
#endif
#ifndef MK_FP8_DOWN0
#define MK_FP8_DOWN0 1
#endif
#ifndef MK_FP8_GLU
#define MK_FP8_GLU 1
#endif
#ifndef MK_ATT_XMFMA
#define MK_ATT_XMFMA 0
#endif
#ifndef MK_ATT_XEXP
#define MK_ATT_XEXP 0
#endif
#ifndef MK_ATT3
#define MK_ATT3 1
#endif
#ifndef MK_XBF16
#define MK_XBF16 1
#endif
#ifndef MK_ATT2
#define MK_ATT2 1
#endif
#ifndef MK_ONE_LAUNCH
#define MK_ONE_LAUNCH 1
#endif

constexpr int DM = 1024, NB = 4, SEQ = 8192, CTXL = 256, RPB = CTXL + SEQ, MALL = NB * RPB;
constexpr int TPB = RPB / 256, NT_ALL = MALL / 256, NT_LAT = NB * SEQ / 256;
constexpr int DFF = 2816, NE = 8, NHEAD = 8;
constexpr float EPS = 1e-6f;
constexpr int NWAVES = 8, NTHREADS = 512;
constexpr int CPB = RPB / 16;
constexpr int MOE_MAXT = 272;

constexpr size_t MiB = 1u << 20;
constexpr size_t WS_CTL = 0, CTL_ZERO_BYTES = 64 * 1024;
constexpr size_t WS_MOD = 1 * MiB;
constexpr size_t WS_ROPE = WS_MOD + 512 * 1024;
constexpr size_t WS_SEL = 2 * MiB;
constexpr size_t WS_SLOT = WS_SEL + (size_t)MALL * 16;
constexpr size_t WS_CNT = WS_SLOT + (size_t)MALL * 8;
constexpr size_t WS_TEXP = WS_CNT + 1024 * 8 * 4;
constexpr size_t WS_S5M3 = 8 * MiB;
constexpr size_t WS_S5M1 = 24 * MiB;
constexpr size_t WS_W = 32 * MiB;
constexpr size_t WS_X = 357 * MiB;
constexpr size_t WS_HL = 489 * MiB;
constexpr size_t WS_BIG = 555 * MiB;
constexpr size_t WS_END = 879 * MiB;
static_assert(WS_TEXP + 4096 <= WS_S5M3, "ws map");
constexpr size_t BIG_BZ = 0, BIG_U = 132 * MiB;
constexpr size_t BIG_Q8 = 0, BIG_K8 = 33 * MiB, BIG_V8 = 66 * MiB, BIG_VT8 = 99 * MiB;
constexpr size_t BIG_QKV = 0, BIG_KH = 66 * MiB, BIG_VH = 132 * MiB, BIG_O0 = 198 * MiB;
constexpr size_t BIG_HID = 0;
constexpr size_t BIG_APERM = 0, BIG_MHID = 136 * MiB;
constexpr size_t BIG_H = 0, BIG_SBUF = 144 * MiB, BIG_YG = 210 * MiB;
static_assert(BIG_MHID + (size_t)MOE_MAXT * 256 * DFF <= WS_END - WS_BIG && BIG_YG + 66 * MiB <= WS_END - WS_BIG && BIG_O0 + 66 * MiB <= WS_END - WS_BIG, "big map");

constexpr size_t WSZ_CONVIN = (size_t)3072 * 1024 * 2, WSZ_SQ = (size_t)1024 * 1024 * 2, WSZ_GU = (size_t)5632 * 1024 * 2, WSZ_DOWN = (size_t)1024 * 2816 * 2, WSZ_GLU = (size_t)2048 * 1024 * 2;
constexpr size_t WO_L0_CONVIN = 0, WO_L0_CONVOUT = WO_L0_CONVIN + WSZ_CONVIN, WO_L0_GU = WO_L0_CONVOUT + WSZ_SQ, WO_L0_DOWN = WO_L0_GU + WSZ_GU;
constexpr size_t WO_L1_QKV = WO_L0_DOWN + WSZ_DOWN, WO_L1_WO = WO_L1_QKV + WSZ_CONVIN, WO_L1_MGU = WO_L1_WO + WSZ_SQ, WO_L1_MDOWN = WO_L1_MGU + 8 * WSZ_GU;
constexpr size_t WO_L2_GLU = WO_L1_MDOWN + 8 * WSZ_DOWN, WO_L2_GU = WO_L2_GLU + WSZ_GLU, WO_L2_DOWN = WO_L2_GU + WSZ_GU;
constexpr size_t WO_L3_CONVIN = WO_L2_DOWN + WSZ_DOWN, WO_L3_CONVOUT = WO_L3_CONVIN + WSZ_CONVIN, WO_L3_MGU = WO_L3_CONVOUT + WSZ_SQ, WO_L3_MDOWN = WO_L3_MGU + 8 * WSZ_GU;
constexpr size_t WO_END = WO_L3_MDOWN + 8 * WSZ_DOWN;
static_assert(WS_W + WO_END <= WS_X, "weights fit");

enum { IN_X = 0, IN_C = 1, IN_CTX = 2, IN_CCTX = 3, IN_FINAL = 49 };
__host__ __device__ constexpr int lbase(int L) { return L == 0 ? 4 : L == 1 ? 13 : L == 2 ? 24 : 39; }

#define LAS __attribute__((address_space(3)))
typedef unsigned short bf16_t;
typedef short bf16x8 __attribute__((ext_vector_type(8)));
typedef float f32x4 __attribute__((ext_vector_type(4)));
typedef float f32x2 __attribute__((ext_vector_type(2)));
typedef unsigned u32x4 __attribute__((ext_vector_type(4)));
typedef unsigned u32x2 __attribute__((ext_vector_type(2)));
#define LDS_WAIT() asm volatile("s_waitcnt lgkmcnt(0)" ::: "memory")
#define VM_WAIT() asm volatile("s_waitcnt vmcnt(0)" ::: "memory")
__device__ __forceinline__ unsigned cvt_pk_bf16(float lo, float hi) { unsigned r; asm volatile("v_cvt_pk_bf16_f32 %0, %1, %2" : "=v"(r) : "v"(lo), "v"(hi)); return r; }
__device__ __forceinline__ float clamp8(float v) { return __builtin_amdgcn_fmed3f(v, -448.f, 448.f); }
__device__ __forceinline__ unsigned cvt4_fp8(float a, float b, float c, float d) {
    unsigned w = 0; w = __builtin_amdgcn_cvt_pk_fp8_f32(clamp8(a), clamp8(b), w, false); w = __builtin_amdgcn_cvt_pk_fp8_f32(clamp8(c), clamp8(d), w, true); return w; }
__device__ __forceinline__ unsigned cvt4_fp8_nc(float a, float b, float c, float d) {
    unsigned w = 0; w = __builtin_amdgcn_cvt_pk_fp8_f32(a, b, w, false); w = __builtin_amdgcn_cvt_pk_fp8_f32(c, d, w, true); return w; }
__device__ __forceinline__ float bf_lo(unsigned w) { return __uint_as_float(w << 16); }
__device__ __forceinline__ float bf_hi(unsigned w) { return __uint_as_float(w & 0xffff0000u); }
#if MK_XBF16
typedef bf16_t xel_t;
__device__ __forceinline__ f32x4 x_ld4(const xel_t* p) { const u32x2 w = *(const u32x2*)p; return (f32x4){bf_lo(w.x), bf_hi(w.x), bf_lo(w.y), bf_hi(w.y)}; }
__device__ __forceinline__ void x_st4(xel_t* p, f32x4 v) { u32x2 w; w.x = cvt_pk_bf16(v[0], v[1]); w.y = cvt_pk_bf16(v[2], v[3]); *(u32x2*)p = w; }
#else
typedef float xel_t;
__device__ __forceinline__ f32x4 x_ld4(const xel_t* p) { return *(const f32x4*)p; }
__device__ __forceinline__ void x_st4(xel_t* p, f32x4 v) { *(f32x4*)p = v; }
#endif
__device__ __forceinline__ float row16_sum(float v) {
    v += __int_as_float(__builtin_amdgcn_mov_dpp(__float_as_int(v), 0xB1, 0xf, 0xf, true));
    v += __int_as_float(__builtin_amdgcn_mov_dpp(__float_as_int(v), 0x4E, 0xf, 0xf, true));
    v += __int_as_float(__builtin_amdgcn_mov_dpp(__float_as_int(v), 0x141, 0xf, 0xf, true));
    v += __int_as_float(__builtin_amdgcn_mov_dpp(__float_as_int(v), 0x140, 0xf, 0xf, true));
    return v;
}
__device__ __forceinline__ float wave_sum(float v) {
    v = row16_sum(v);
    const int vi = __float_as_int(v);
    const float a = __int_as_float(__builtin_amdgcn_readlane(vi, 0)), b = __int_as_float(__builtin_amdgcn_readlane(vi, 16)), c = __int_as_float(__builtin_amdgcn_readlane(vi, 32)), d = __int_as_float(__builtin_amdgcn_readlane(vi, 48));
    return (a + b) + (c + d);
}
__device__ __forceinline__ float fast_sigmoid(float x) { return __builtin_amdgcn_rcpf(1.0f + __builtin_amdgcn_exp2f(-1.4426950408889634f * x)); }
__device__ __forceinline__ float silu_f(float x) { return x * fast_sigmoid(x); }
__device__ __forceinline__ float gelu_tanh_f(float x) { const float u = 0.7978845608028654f * (x + 0.044715f * x * x * x); return x * fast_sigmoid(2.0f * u); }
__device__ __forceinline__ int row_cond(int row) { const int b = row / RPB; return (row - b * RPB) < CTXL ? 4 : b; }
__device__ __forceinline__ int tile_cond(int pm) { const int b = pm / TPB; return (pm - b * TPB) == 0 ? 4 : b; }

#define XB_TMO      128
#define XB_XCNT(j)  (256  + 64 * (j))
#define XB_XSUB(j)  (1280 + 64 * (j))
#define XB_XGEN(j)  (2304 + 64 * (j))
#define XB_TOP      3328
#define XB_TOPGEN   3392
#define XCD_BAR_WORDS 3456
#define XB_SPIN_CAP (1u << 18)
__device__ __forceinline__ unsigned xb_ld(unsigned* p)              { return __hip_atomic_load(p, __ATOMIC_RELAXED, __HIP_MEMORY_SCOPE_AGENT); }
__device__ __forceinline__ unsigned xb_add(unsigned* p, unsigned v) { return __hip_atomic_fetch_add(p, v, __ATOMIC_RELAXED, __HIP_MEMORY_SCOPE_AGENT); }
__device__ __forceinline__ unsigned xb_xcc_id() { return (unsigned)__builtin_amdgcn_s_getreg((3 << 11) | 20) & 0xFu; }
#define XB_SPIN(cond, bar) do { unsigned _sp = 0; while (cond) { __builtin_amdgcn_s_sleep(1); \
    if ((++_sp & 255u) == 0u) { if (xb_ld(&(bar)[XB_TMO])) break; if (_sp > XB_SPIN_CAP) { atomicAdd(&(bar)[XB_TMO], 1u); break; } } } } while (0)
struct XcdBarrier { unsigned* bar; unsigned x; volatile LAS unsigned* st; };
__device__ __forceinline__ XcdBarrier xcd_barrier_post(unsigned* bar, volatile LAS unsigned* st) {
    XcdBarrier b; b.bar = bar; b.x = xb_xcc_id(); b.st = st;
    if (threadIdx.x == 0) (void)xb_add(&bar[XB_XCNT(b.x)], 1u);
    return b;
}
__device__ __forceinline__ void xcd_barrier_complete(unsigned* bar, unsigned x, unsigned& nloc, unsigned& nx) {
    const unsigned G = gridDim.x * gridDim.y * gridDim.z;
    unsigned sum, cnt, mine, sp = 0u;
    for (;;) {
        sum = 0u; cnt = 0u; mine = 0u;
#pragma unroll
        for (unsigned j = 0; j < 16; ++j) { const unsigned c = xb_ld(&bar[XB_XCNT(j)]); sum += c; cnt += (c > 0u) ? 1u : 0u; mine = (j == x) ? c : mine; }
        if (sum == G) break;
        __builtin_amdgcn_s_sleep(1);
        if ((++sp & 255u) == 0u) { if (xb_ld(&bar[XB_TMO])) break; if (sp > XB_SPIN_CAP) { atomicAdd(&bar[XB_TMO], 1u); break; } }
    }
    nloc = mine > 0u ? mine : 1u; nx = cnt > 0u ? cnt : 1u;
}
__device__ __forceinline__ void xcd_barrier(const XcdBarrier& b) {
    asm volatile("s_waitcnt vmcnt(0)" ::: "memory");
    __syncthreads();
    if (threadIdx.x == 0) {
        unsigned* bar = b.bar;
        __builtin_amdgcn_s_waitcnt(0);
        unsigned nloc = b.st[0], nx = b.st[1];
        if (nloc == 0u) { xcd_barrier_complete(bar, b.x, nloc, nx); b.st[0] = nloc; b.st[1] = nx; }
        const unsigned old = xb_add(&bar[XB_XSUB(b.x)], 1u);
        const unsigned gen = old / nloc;
        if (old + 1u == (gen + 1u) * nloc) {
            __builtin_amdgcn_fence(__ATOMIC_RELEASE, "agent");
            asm volatile("s_waitcnt vmcnt(0)" ::: "memory");
            const unsigned og = xb_add(&bar[XB_TOP], 1u);
            const unsigned tg = og / nx;
            if (og + 1u == (tg + 1u) * nx) xb_add(&bar[XB_TOPGEN], 1u);
            else XB_SPIN(xb_ld(&bar[XB_TOPGEN]) == tg, bar);
            __builtin_amdgcn_fence(__ATOMIC_ACQUIRE, "agent");
            xb_add(&bar[XB_XGEN(b.x)], 1u);
            asm volatile("s_waitcnt vmcnt(0)" ::: "memory");
        } else {
            XB_SPIN(xb_ld(&bar[XB_XGEN(b.x)]) == gen, bar);
            __builtin_amdgcn_fence(__ATOMIC_ACQUIRE, "agent");
            asm volatile("s_waitcnt vmcnt(0)" ::: "memory");
        }
    }
    __syncthreads();
}

namespace pg8 {
constexpr int BM = 256, BK = 64, HALF = 128, HTB = HALF * BK * 2, STAGE_BYTES = 8 * HTB, NXCD = 8, WGM = 8;
__host__ __device__ __forceinline__ int lds_byte(int r, int c) { const int st = (r >> 4) * 2 + (c >> 5), rr = r & 15, cc = c & 31, ob = rr * 64 + cc * 2; return st * 1024 + (ob ^ (((ob >> 9) & 1) << 5)); }
__host__ __device__ __forceinline__ void stage_rc(int b, int& R, int& C) { const int st = b / 1024, sb = b % 1024, swz = sb ^ (((sb >> 9) & 1) << 5); R = (st >> 1) * 16 + swz / 64; C = (st & 1) * 32 + (swz % 64) / 2; }
__host__ __device__ __forceinline__ int perm32(int rho) { const int n = rho >> 4, i = rho & 15; return 8 * (i >> 2) + 4 * n + (i & 3); }
struct Unit { int pm, pn, aux; };
__device__ __forceinline__ void order_map(int L, int nM, int nN, int& tm, int& tn) {
    const int nwg = nM * nN; int wgid = L; { const int q = nwg / NXCD, r = nwg % NXCD, xcd = wgid % NXCD, off = wgid / NXCD; wgid = (xcd < r ? xcd * (q + 1) : r * (q + 1) + (xcd - r) * q) + off; }
    const int nig = WGM * nN, gid = wgid / nig, fm = gid * WGM, gsz = (nM - fm) < WGM ? (nM - fm) : WGM;
    tm = fm + ((wgid % nig) % gsz); tn = (wgid % nig) / gsz;
}

template <class Epi, class Prob, bool ALIGN_EPI, bool FP8 = false>
__device__ __forceinline__ void gemm_phase(LAS unsigned char* lds, const Prob& P, const Epi& E, const int tid) {
    const int wid = __builtin_amdgcn_readfirstlane(tid >> 6), lane = tid & 63, wr = wid >> 2, wc = wid & 3, fr = lane & 15, fq = lane >> 4;
    const int nt = P.nt;
    unsigned voffA[2], voffB[2];
#pragma unroll
    for (int i = 0; i < 2; ++i) { int R, C; stage_rc(tid * 16 + i * 8192, R, C); const int Rb = Epi::PERM ? ((R & ~31) + perm32(R & 31)) : R;
        voffA[i] = P.lane_off_a(R, C); voffB[i] = P.lane_off_b(Rb, C); }
    const size_t hsA = P.hstep_a(), hsB = P.hstep_b();
    const unsigned ldsw = (unsigned)wid * 1024u;
    const int aoff = lds_byte(wr * 64 + fr, fq * 8), boff = lds_byte(wc * 32 + fr, fq * 8);
#define PG8_SA(b, h) (((b) * 2 + (h)) * HTB)
#define PG8_SB(b, h) ((4 + (b) * 2 + (h)) * HTB)
#define PG8_STAGE(bufoff, gbase, voff) do { _Pragma("unroll") for (int _i = 0; _i < 2; ++_i) \
        __builtin_amdgcn_global_load_lds((const unsigned*)((const char*)(gbase) + (voff)[_i]), (LAS unsigned*)(lds + (bufoff) + ldsw + _i * 8192), 16, 0, 0); } while (0)
#define PG8_LDA(dst, b, h) do { _Pragma("unroll") for (int m = 0; m < 4; ++m) _Pragma("unroll") for (int k = 0; k < 2; ++k) dst[m][k] = *(const LAS bf16x8*)(lds + PG8_SA(b, h) + aoff + m * 2048 + k * 1024); } while (0)
#define PG8_LDB(dst, b, h) do { _Pragma("unroll") for (int n = 0; n < 2; ++n) _Pragma("unroll") for (int k = 0; k < 2; ++k) dst[n][k] = *(const LAS bf16x8*)(lds + PG8_SB(b, h) + boff + n * 2048 + k * 1024); } while (0)
#define PG8_MMA(ai, bj, At, Bt) do { __builtin_amdgcn_s_setprio(1); _Pragma("unroll") for (int m = 0; m < 4; ++m) _Pragma("unroll") for (int n = 0; n < 2; ++n) { \
        if constexpr (FP8) { typedef int v4i_ __attribute__((ext_vector_type(4))); typedef int v8i_ __attribute__((ext_vector_type(8))); \
            const v4i_ b0_ = __builtin_bit_cast(v4i_, Bt[n][0]), b1_ = __builtin_bit_cast(v4i_, Bt[n][1]), a0_ = __builtin_bit_cast(v4i_, At[m][0]), a1_ = __builtin_bit_cast(v4i_, At[m][1]); \
            const v8i_ bb_ = {b0_[0], b0_[1], b0_[2], b0_[3], b1_[0], b1_[1], b1_[2], b1_[3]}, aa_ = {a0_[0], a0_[1], a0_[2], a0_[3], a1_[0], a1_[1], a1_[2], a1_[3]}; \
              \
            asm volatile("v_mfma_scale_f32_16x16x128_f8f6f4 %0, %1, %2, %0, %3, %3 op_sel_hi:[0,0,0]" : "+v"(acc[ai][bj][m][n]) : "v"(bb_), "v"(aa_), "v"(0x7f7f7f7f)); } \
        else { _Pragma("unroll") for (int k = 0; k < 2; ++k) acc[ai][bj][m][n] = __builtin_amdgcn_mfma_f32_16x16x32_bf16(Bt[n][k], At[m][k], acc[ai][bj][m][n], 0, 0, 0); } } \
        __builtin_amdgcn_s_setprio(0); } while (0)
#define PG8_WAIT_V(n) asm volatile("s_waitcnt vmcnt(" #n ")" ::: "memory")
#define PG8_WAIT_L(n) asm volatile("s_waitcnt lgkmcnt(" #n ")" ::: "memory")
#define PG8_BAR __builtin_amdgcn_s_barrier()
#define PG8_SCHED __builtin_amdgcn_sched_barrier(0)
    Unit cur, nxt; int ui = 0;
    if (!P.next(0, cur)) return;
    f32x4 acc[2][2][4][2];
#pragma unroll
    for (int a = 0; a < 2; ++a)
#pragma unroll
        for (int b = 0; b < 2; ++b)
#pragma unroll
            for (int m = 0; m < 4; ++m)
#pragma unroll
                for (int n = 0; n < 2; ++n) acc[a][b][m][n] = (f32x4){0.f, 0.f, 0.f, 0.f};
    bf16x8 At[4][2], B0[2][2], B1[2][2];
    {
        const char* cA = P.a_ptr(cur, 0); const char* cB = P.b_ptr(cur, 0); const char* cA1 = P.a_ptr(cur, 1); const char* cB1 = P.b_ptr(cur, 1);
        PG8_STAGE(PG8_SB(0, 0), cB, voffB); PG8_STAGE(PG8_SB(0, 1), cB + hsB, voffB); PG8_STAGE(PG8_SA(0, 0), cA, voffA); PG8_STAGE(PG8_SA(0, 1), cA + hsA, voffA);
        if (wr == 1) PG8_BAR;
        PG8_WAIT_V(2); PG8_BAR;
        PG8_STAGE(PG8_SB(1, 0), cB1, voffB); PG8_STAGE(PG8_SA(1, 0), cA1, voffA); PG8_STAGE(PG8_SB(1, 1), cB1 + hsB, voffB);
        PG8_WAIT_V(6); PG8_BAR;
    }
    for (;;) {
        const bool has_next = P.next(ui + 1, nxt);
        const Unit nu = has_next ? nxt : cur;
        for (int t = 0; t < nt; t += 2) {
            const bool last = (t == nt - 2);
            const char* a1 = P.a_ptr(cur, t + 1);
            const char* a2 = last ? P.a_ptr(nu, 0) : P.a_ptr(cur, t + 2); const char* b2 = last ? P.b_ptr(nu, 0) : P.b_ptr(cur, t + 2);
            const char* a3 = last ? P.a_ptr(nu, 1) : P.a_ptr(cur, t + 3); const char* b3 = last ? P.b_ptr(nu, 1) : P.b_ptr(cur, t + 3);
            PG8_LDB(B0, 0, 0); PG8_LDB(B1, 0, 1); PG8_SCHED; PG8_LDA(At, 0, 0); PG8_STAGE(PG8_SA(1, 1), a1 + hsA, voffA);
            PG8_WAIT_V(8); PG8_WAIT_L(0); PG8_BAR; PG8_MMA(0, 0, At, B0); PG8_MMA(0, 1, At, B1); PG8_BAR; PG8_SCHED;
            PG8_LDA(At, 0, 1); PG8_STAGE(PG8_SB(0, 0), b2, voffB); PG8_STAGE(PG8_SB(0, 1), b2 + hsB, voffB); PG8_STAGE(PG8_SA(0, 0), a2, voffA);
            PG8_WAIT_V(8); PG8_WAIT_L(0); PG8_BAR; PG8_MMA(1, 0, At, B0); PG8_MMA(1, 1, At, B1); PG8_BAR; PG8_SCHED;
            PG8_LDB(B0, 1, 0); PG8_LDB(B1, 1, 1); PG8_SCHED; PG8_LDA(At, 1, 0); PG8_STAGE(PG8_SA(0, 1), a2 + hsA, voffA);
            PG8_WAIT_V(8); PG8_WAIT_L(0); PG8_BAR; PG8_MMA(0, 0, At, B0); PG8_MMA(0, 1, At, B1); PG8_BAR; PG8_SCHED;
            PG8_LDA(At, 1, 1); PG8_STAGE(PG8_SB(1, 0), b3, voffB); PG8_STAGE(PG8_SB(1, 1), b3 + hsB, voffB); PG8_STAGE(PG8_SA(1, 0), a3, voffA);
            PG8_WAIT_V(8); PG8_WAIT_L(0); PG8_BAR; PG8_MMA(1, 0, At, B0); PG8_MMA(1, 1, At, B1); PG8_BAR; PG8_SCHED;
        }
        if constexpr (ALIGN_EPI) { if (wr == 0) PG8_BAR; }
        if constexpr (FP8) { asm volatile("s_nop 15\n\ts_nop 15" ::: "memory");
#pragma unroll
            for (int a_ = 0; a_ < 2; ++a_)
#pragma unroll
                for (int b_ = 0; b_ < 2; ++b_)
#pragma unroll
                    for (int m_ = 0; m_ < 4; ++m_) asm volatile("" : "+v"(acc[a_][b_][m_][0]), "+v"(acc[a_][b_][m_][1])); }
        { int l_e; asm volatile("v_mbcnt_lo_u32_b32 %0, -1, 0\n\tv_mbcnt_hi_u32_b32 %0, -1, %0" : "=v"(l_e)); E(acc, cur, wr, wc, l_e & 15, l_e >> 4); }
        if (!has_next) break;
#pragma unroll
        for (int a = 0; a < 2; ++a)
#pragma unroll
            for (int b = 0; b < 2; ++b)
#pragma unroll
                for (int m = 0; m < 4; ++m)
#pragma unroll
                    for (int n = 0; n < 2; ++n) acc[a][b][m][n] = (f32x4){0.f, 0.f, 0.f, 0.f};
        cur = nxt; ++ui;
        if constexpr (ALIGN_EPI) { if (wr == 1) PG8_BAR; }
    }
    PG8_WAIT_V(0);
    if constexpr (!ALIGN_EPI) { if (wr == 0) PG8_BAR; }
    PG8_BAR;
#undef PG8_SA
#undef PG8_SB
#undef PG8_STAGE
#undef PG8_LDA
#undef PG8_LDB
#undef PG8_MMA
#undef PG8_WAIT_V
#undef PG8_WAIT_L
#undef PG8_BAR
#undef PG8_SCHED
}

struct ProbPlain {
    const char* A; const char* Bt; int lda_b, ldb_b, nt, nM, nN, G, c; bool latent;
    __device__ __forceinline__ bool next(int i, Unit& u) const {
        const long L = (long)i * G + c; if (L >= (long)nM * nN) return false;
        int tm, tn; order_map((int)L, nM, nN, tm, tn); u.pm = latent ? tm + (tm >> 5) + 1 : tm; u.pn = tn; u.aux = 0; return true; }
    __device__ __forceinline__ const char* a_ptr(const Unit& u, int kt) const { return A + (size_t)u.pm * 256 * lda_b + (size_t)kt * 128; }
    __device__ __forceinline__ const char* b_ptr(const Unit& u, int kt) const { return Bt + (size_t)u.pn * 256 * ldb_b + (size_t)kt * 128; }
    __device__ __forceinline__ size_t hstep_a() const { return (size_t)128 * lda_b; }
    __device__ __forceinline__ size_t hstep_b() const { return (size_t)128 * ldb_b; }
    __device__ __forceinline__ unsigned lane_off_a(int R, int C) const { return (unsigned)(R * lda_b + C * 2); }
    __device__ __forceinline__ unsigned lane_off_b(int R, int C) const { return (unsigned)(R * ldb_b + C * 2); }
};
struct ProbMoe {
    const char* A; const char* Bt; int lda_b, ldb_b, nt, nN, G, c; size_t bstride_e; const int* texp; int tile0, ntile, a_rel;
    __device__ __forceinline__ bool next(int i, Unit& u) const {
        const long L = (long)i * G + c; if (L >= (long)ntile * nN) return false;
        int tm, tn; order_map((int)L, ntile, nN, tm, tn); u.pm = tile0 + tm; u.pn = tn; u.aux = __builtin_amdgcn_readfirstlane(texp[u.pm]); return true; }
    __device__ __forceinline__ const char* a_ptr(const Unit& u, int kt) const { return A + (size_t)(u.pm - a_rel) * 256 * lda_b + (size_t)kt * 128; }
    __device__ __forceinline__ const char* b_ptr(const Unit& u, int kt) const { return Bt + (size_t)u.aux * bstride_e + (size_t)u.pn * 256 * ldb_b + (size_t)kt * 128; }
    __device__ __forceinline__ size_t hstep_a() const { return (size_t)128 * lda_b; }
    __device__ __forceinline__ size_t hstep_b() const { return (size_t)128 * ldb_b; }
    __device__ __forceinline__ unsigned lane_off_a(int R, int C) const { return (unsigned)(R * lda_b + C * 2); }
    __device__ __forceinline__ unsigned lane_off_b(int R, int C) const { return (unsigned)(R * ldb_b + C * 2); }
};
constexpr int S5_ROWS = 4 * 8448;
struct ProbS5 {
    const char* A0; const char* A1; const char* Bt; int nt, nt0, ntile, G, c; size_t bstride_g; bool s3;
    __device__ __forceinline__ bool next(int i, Unit& u) const {
        const int vcu = (G % 8 == 0) ? (c % 8) * (G / 8) + c / 8 : c;
        const long L = (long)i * G + vcu; if (L >= (long)ntile * 64) return false;
        u.pm = (int)(L >> 6); u.pn = (int)(L & 63); u.aux = 0; return true; }
    __device__ __forceinline__ size_t tokbase(int pm) const { return s3 ? (size_t)(pm >> 1) * RPB + CTXL + (size_t)(pm & 1) * 4096 : (size_t)pm * 4096; }
    __device__ __forceinline__ const char* a_ptr(const Unit& u, int kt) const { return kt < nt0 ? A0 + ((size_t)u.pn * S5_ROWS + tokbase(u.pm)) * 32 + (size_t)kt * 128 : A1 + ((size_t)u.pn * (S5_ROWS / 16) + tokbase(u.pm) / 16) * 512 + (size_t)(kt - nt0) * 128; }
    __device__ __forceinline__ const char* b_ptr(const Unit& u, int kt) const { return Bt + (size_t)u.pn * bstride_g + (size_t)kt * 128; }
    __device__ __forceinline__ size_t hstep_a() const { return (size_t)128 * 512; }
    __device__ __forceinline__ size_t hstep_b() const { return (size_t)128 * nt * 128; }
    __device__ __forceinline__ unsigned lane_off_a(int R, int C) const { return (unsigned)(R * 512 + C * 2); }
    __device__ __forceinline__ unsigned lane_off_b(int R, int C) const { return (unsigned)(R * nt * 128 + C * 2); }
};

typedef f32x4 Acc[2][2][4][2];
constexpr float W8SCALE = 64.f, W8INV = 1.f / 64.f;
constexpr float QSCALE = 0.125f * 1.4426950408889634f;
__device__ __forceinline__ u32x4 pack8(f32x4 v0, f32x4 v1) { u32x4 w; w.x = cvt_pk_bf16(v0[0], v0[1]); w.y = cvt_pk_bf16(v0[2], v0[3]); w.z = cvt_pk_bf16(v1[0], v1[1]); w.w = cvt_pk_bf16(v1[2], v1[3]); return w; }

struct EpiBf16 {
    static constexpr bool PERM = true;
    bf16_t* O; int ldc; int pm_sub; float s;
    __device__ __forceinline__ void operator()(const Acc& acc, const Unit& u, int wr, int wc, int fr, int fq) const {
        const int row0 = (u.pm - pm_sub) * BM + wr * 64 + fr, col0 = u.pn * BM + wc * 32 + 8 * fq;
#pragma unroll
        for (int ai = 0; ai < 2; ++ai)
#pragma unroll
            for (int m = 0; m < 4; ++m) { bf16_t* rowp = O + (size_t)(row0 + ai * HALF + m * 16) * ldc + col0;
#pragma unroll
                for (int bj = 0; bj < 2; ++bj) *(u32x4*)(rowp + bj * HALF) = pack8(acc[ai][bj][m][0] * s, acc[ai][bj][m][1] * s); }
    }
};
template <int ACT> struct EpiGated {
    static constexpr bool PERM = true;
    bf16_t* O; int ldc; int pn0; int col_base; int pm_sub;
    __device__ __forceinline__ void operator()(const Acc& acc, const Unit& u, int wr, int wc, int fr, int fq) const {
        const int row0 = (u.pm - pm_sub) * BM + wr * 64 + fr;
        if (u.pn < pn0) {
            const int col0 = u.pn * BM + wc * 32 + 8 * fq;
#pragma unroll
            for (int ai = 0; ai < 2; ++ai)
#pragma unroll
                for (int m = 0; m < 4; ++m) { bf16_t* rowp = O + (size_t)(row0 + ai * HALF + m * 16) * ldc + col0;
#pragma unroll
                    for (int bj = 0; bj < 2; ++bj) *(u32x4*)(rowp + bj * HALF) = pack8(acc[ai][bj][m][0], acc[ai][bj][m][1]); }
        } else {
            const int col0 = col_base + (u.pn - pn0) * HALF + wc * 32 + 8 * fq;
#pragma unroll
            for (int ai = 0; ai < 2; ++ai)
#pragma unroll
                for (int m = 0; m < 4; ++m) { bf16_t* rowp = O + (size_t)(row0 + ai * HALF + m * 16) * ldc + col0;
                    f32x4 a0 = acc[ai][0][m][0], a1 = acc[ai][0][m][1];
                    if (ACT == 1) {
#pragma unroll
                        for (int e = 0; e < 4; ++e) { a0[e] = silu_f(a0[e]); a1[e] = silu_f(a1[e]); } }
                    *(u32x4*)rowp = pack8(a0 * acc[ai][1][m][0], a1 * acc[ai][1][m][1]); }
        }
    }
};
struct EpiGated8 {
    static constexpr bool PERM = true;
    unsigned char* O; int ldc; float s;
    __device__ __forceinline__ void operator()(const Acc& acc, const Unit& u, int wr, int wc, int fr, int fq) const {
        const int row0 = u.pm * BM + wr * 64 + fr, col0 = u.pn * HALF + wc * 32 + 8 * fq;
#pragma unroll
        for (int ai = 0; ai < 2; ++ai)
#pragma unroll
            for (int m = 0; m < 4; ++m) { unsigned char* rowp = O + (size_t)(row0 + ai * HALF + m * 16) * ldc + col0;
                f32x4 a0 = acc[ai][0][m][0] * s, a1 = acc[ai][0][m][1] * s; const f32x4 b0 = acc[ai][1][m][0] * s, b1 = acc[ai][1][m][1] * s;
#pragma unroll
                for (int e = 0; e < 4; ++e) { a0[e] = silu_f(a0[e]) * b0[e]; a1[e] = silu_f(a1[e]) * b1[e]; }
                u32x2 w; w.x = cvt4_fp8(a0[0], a0[1], a0[2], a0[3]); w.y = cvt4_fp8(a1[0], a1[1], a1[2], a1[3]);
                *(u32x2*)rowp = w; }
    }
};
struct EpiResid {
    static constexpr bool PERM = false;
    xel_t* X; const float* gate;
    const float* xin; const float* cin;
    float s;
    __device__ __forceinline__ void operator()(const Acc& acc, const Unit& u, int wr, int wc, int fr, int fq) const {
        const int row0 = u.pm * BM + wr * 64 + fr, col0 = u.pn * BM + wc * 32 + 4 * fq;
        const float* gp = gate + tile_cond(u.pm) * 6144 + col0;
        const int bq = u.pm / TPB, tq = u.pm - bq * TPB;
        const float* srcin = xin ? (tq == 0 ? cin + (size_t)bq * CTXL * DM : xin + ((size_t)bq * SEQ + (size_t)(tq - 1) * 256) * DM) - (size_t)u.pm * BM * DM : nullptr;
        f32x4 gv[2][2];
#pragma unroll
        for (int bj = 0; bj < 2; ++bj)
#pragma unroll
            for (int n = 0; n < 2; ++n) gv[bj][n] = *(const f32x4*)(gp + bj * HALF + n * 16);
#pragma unroll
        for (int ai = 0; ai < 2; ++ai)
#pragma unroll
            for (int m = 0; m < 4; ++m) { const size_t off = (size_t)(row0 + ai * HALF + m * 16) * DM + col0;
#pragma unroll
                for (int bj = 0; bj < 2; ++bj)
#pragma unroll
                    for (int n = 0; n < 2; ++n) { const size_t o2 = off + bj * HALF + n * 16; const f32x4 xv = srcin ? *(const f32x4*)(srcin + o2) : x_ld4(X + o2); x_st4(X + o2, xv + gv[bj][n] * (acc[ai][bj][m][n] * s)); }
                if (m & 1) asm volatile("" ::: "memory"); }
    }
};
struct EpiGlu {
    static constexpr bool PERM = false;
    xel_t* X; const float* gate; float s;
    __device__ __forceinline__ void operator()(const Acc& acc, const Unit& u, int wr, int wc, int fr, int fq) const {
        const int row0 = u.pm * BM + wr * 64 + fr, col0 = u.pn * HALF + wc * 32 + 4 * fq;
        const float* gp = gate + tile_cond(u.pm) * 6144 + col0;
        f32x4 gv[2];
#pragma unroll
        for (int n = 0; n < 2; ++n) gv[n] = *(const f32x4*)(gp + n * 16);
#pragma unroll
        for (int ai = 0; ai < 2; ++ai)
#pragma unroll
            for (int m = 0; m < 4; ++m) { xel_t* rowp = X + (size_t)(row0 + ai * HALF + m * 16) * DM + col0;
#pragma unroll
                for (int n = 0; n < 2; ++n) { f32x4 sg = acc[ai][1][m][n] * s;
#pragma unroll
                    for (int e = 0; e < 4; ++e) sg[e] = fast_sigmoid(sg[e]);
                    xel_t* p = rowp + n * 16; x_st4(p, x_ld4(p) + gv[n] * ((acc[ai][0][m][n] * s) * sg)); }
                if (m & 1) asm volatile("" ::: "memory"); }
    }
};
template <bool OUT8, bool W8> struct EpiQkv {
    static constexpr bool PERM = true;
    unsigned char* big; const float* cosT;
    __device__ __forceinline__ void operator()(const Acc& acc, const Unit& u, int wr, int wc, int fr, int fq) const {
        const float s = W8 ? W8INV : 1.f; const float* sinT = cosT + 128 * 16;
        const int row0 = u.pm * BM + wr * 64 + fr;
        const int bq = u.pm / TPB, tq = u.pm - bq * TPB;
        const bool rope = (u.pn < 8) && (tq != 0);
        const int sect = u.pn >> 2;
        const int cs0 = (u.pn & 3) * BM + wc * 32 + 8 * fq;
#pragma unroll
        for (int ai = 0; ai < 2; ++ai)
#pragma unroll
            for (int m = 0; m < 4; ++m) { const int row = row0 + ai * HALF + m * 16; const int j = row - bq * RPB;
                f32x4 c4 = (f32x4){1.f, 1.f, 1.f, 1.f}, s4 = (f32x4){0.f, 0.f, 0.f, 0.f};
                if (rope) { const int t = j - CTXL; const int pos = (wc & 1) ? (t & 63) : (t >> 6);
                    c4 = *(const f32x4*)(cosT + pos * 16 + 4 * fq); s4 = *(const f32x4*)(sinT + pos * 16 + 4 * fq); }
#pragma unroll
                for (int bj = 0; bj < 2; ++bj) { const f32x4 v0 = acc[ai][bj][m][0] * s, v1 = acc[ai][bj][m][1] * s; f32x4 o0, o1;
                    o0[0] = v0[0] * c4[0] - v0[1] * s4[0]; o0[1] = v0[1] * c4[0] + v0[0] * s4[0];
                    o0[2] = v0[2] * c4[1] - v0[3] * s4[1]; o0[3] = v0[3] * c4[1] + v0[2] * s4[1];
                    o1[0] = v1[0] * c4[2] - v1[1] * s4[2]; o1[1] = v1[1] * c4[2] + v1[0] * s4[2];
                    o1[2] = v1[2] * c4[3] - v1[3] * s4[3]; o1[3] = v1[3] * c4[3] + v1[2] * s4[3];
                    const int cs = cs0 + bj * HALF;
                    if constexpr (OUT8) {
                        size_t off8; float sc8 = 1.f;
                        if (sect == 0) { sc8 = QSCALE * 16.f; off8 = BIG_Q8 + (size_t)row * DM + cs; }
                        else if (sect == 1) off8 = BIG_K8 + ((size_t)(bq * 16 + (cs >> 6)) * RPB + j) * 64 + (cs & 63);
                        else off8 = BIG_V8 + ((size_t)(bq * 8 + (cs >> 7)) * RPB + j) * 128 + (cs & 127);
                        u32x2 w8; w8.x = cvt4_fp8(o0[0] * sc8, o0[1] * sc8, o0[2] * sc8, o0[3] * sc8); w8.y = cvt4_fp8(o1[0] * sc8, o1[1] * sc8, o1[2] * sc8, o1[3] * sc8);
                        *(u32x2*)(big + off8) = w8;
                    } else { size_t offb;
                        if (sect == 0) { o0 = o0 * QSCALE; o1 = o1 * QSCALE; offb = BIG_QKV + ((size_t)row * DM + cs) * 2; }
                        else if (sect == 1) offb = BIG_KH + (((size_t)(bq * 16 + (cs >> 6)) * RPB + j) * 64 + (cs & 63)) * 2;
                        else offb = BIG_VH + (((size_t)(bq * 8 + (cs >> 7)) * RPB + j) * 128 + (cs & 127)) * 2;
                        *(u32x4*)(big + offb) = pack8(o0, o1); } } }
    }
};
struct EpiS1 {
    static constexpr bool PERM = false;
    float* H;
    __device__ __forceinline__ void operator()(const Acc& acc, const Unit& u, int wr, int wc, int fr, int fq) const {
        const int row0 = u.pm * BM + wr * 64 + fr, col0 = wc * 32 + 4 * fq;
#pragma unroll
        for (int ai = 0; ai < 2; ++ai)
#pragma unroll
            for (int m = 0; m < 4; ++m) { float* rowp = H + ((size_t)(row0 + ai * HALF + m * 16) * 64 + u.pn) * 256 + col0;
#pragma unroll
                for (int bj = 0; bj < 2; ++bj)
#pragma unroll
                    for (int n = 0; n < 2; ++n) *(f32x4*)(rowp + bj * HALF + n * 16) = acc[ai][bj][m][n]; }
    }
};
struct EpiS3 {
    static constexpr bool PERM = true;
    bf16_t* YG; bool out8;
    __device__ __forceinline__ void operator()(const Acc& acc, const Unit& u, int wr, int wc, int fr, int fq) const {
        const size_t tb = (size_t)(u.pm >> 1) * RPB + CTXL + (size_t)(u.pm & 1) * 4096;
        const int r0 = wr * 64 + fr;
#pragma unroll
        for (int ai = 0; ai < 2; ++ai)
#pragma unroll
            for (int m = 0; m < 4; ++m) { const int R = r0 + ai * HALF + m * 16;
#pragma unroll
                for (int bj = 0; bj < 2; ++bj) { const int t = 8 * bj + 2 * wc + (fq >> 1), s0 = 8 * (fq & 1);
                    f32x4 v0 = acc[ai][bj][m][0], v1 = acc[ai][bj][m][1];
#pragma unroll
                    for (int e = 0; e < 4; ++e) { v0[e] = gelu_tanh_f(v0[e]); v1[e] = gelu_tanh_f(v1[e]); }
                    const size_t eoff = (tb + (size_t)R * 16 + t) * DM + u.pn * 16 + s0;
                    if (out8) { u32x2 w; w.x = cvt4_fp8(v0[0], v0[1], v0[2], v0[3]); w.y = cvt4_fp8(v1[0], v1[1], v1[2], v1[3]); *(u32x2*)((unsigned char*)YG + eoff) = w; }
                    else *(u32x4*)(YG + eoff) = pack8(v0, v1); } }
    }
};
}

namespace att {
using bf16x8 = __attribute__((ext_vector_type(8))) short;
using s16x4  = __attribute__((ext_vector_type(4))) short;
using f32x16 = __attribute__((ext_vector_type(16))) float;
constexpr int NW = 8, QBLK = 32, KVBLK = 64;
constexpr float SCALE = 0.125f, THR = 8.f;
constexpr int KROW = 144;
constexpr int SHM_V = KVBLK * 128 * 2, SHM_K = KVBLK * KROW;
constexpr int OFF_V = 0, OFF_K = 2 * SHM_V, OFF_WS = OFF_K + 2 * SHM_K, OFF_OST = OFF_WS + NW * 64 * 4, ATT_LDS = OFF_OST + NW * 8192;
constexpr int LDQ = 3072;
#define SBAR() __builtin_amdgcn_sched_barrier(0)
__device__ __forceinline__ int crow(int r, int hi) { return (r & 3) + 8 * (r >> 2) + 4 * hi; }
__device__ __forceinline__ void partialSM(f32x16& p0, f32x16& p1, float& m_reg, float& mn, float& alpha) {
  constexpr float C = SCALE * 1.4426950408889634f;
  float pmax = p0[0];
#pragma unroll
  for (int r = 1; r < 16; ++r) pmax = fmaxf(pmax, p0[r]);
#pragma unroll
  for (int r = 0; r < 16; ++r) pmax = fmaxf(pmax, p1[r]);
  { auto rr = __builtin_amdgcn_permlane32_swap(__float_as_uint(pmax), __float_as_uint(pmax), false, false);
    pmax = fmaxf(__uint_as_float(rr[0]), __uint_as_float(rr[1])); }
  if (__builtin_expect(__all(pmax - m_reg <= THR / SCALE), 1)) { mn = m_reg; alpha = 1.f; }
  else { mn = fmaxf(m_reg, pmax); alpha = __builtin_amdgcn_exp2f((m_reg - mn) * C); m_reg = mn; }
  float mnC = -mn * C;
#pragma unroll
  for (int r = 0; r < 16; ++r) p0[r] = fmaf(p0[r], C, mnC);
#pragma unroll
  for (int r = 0; r < 16; ++r) p1[r] = fmaf(p1[r], C, mnC);
#pragma unroll
  for (int r = 0; r < 16; ++r) p0[r] = __builtin_amdgcn_exp2f(p0[r]);
}
__device__ __forceinline__ void finishSM(f32x16& p0, f32x16& p1, float alpha, float& l_reg, bf16x8& pa0, bf16x8& pa1, bf16x8& pa2, bf16x8& pa3) {
#pragma unroll
  for (int r = 0; r < 16; ++r) p1[r] = __builtin_amdgcn_exp2f(p1[r]);
  float ps = 0;
#pragma unroll
  for (int r = 0; r < 16; ++r) ps += p0[r];
#pragma unroll
  for (int r = 0; r < 16; ++r) ps += p1[r];
  { auto rr = __builtin_amdgcn_permlane32_swap(__float_as_uint(ps), __float_as_uint(ps), false, false);
    ps = __uint_as_float(rr[0]) + __uint_as_float(rr[1]); }
  l_reg = l_reg * alpha + ps;
#define PK4(P, BASE, OUT) do { u32x4 w = {cvt_pk_bf16(P[BASE + 0], P[BASE + 1]), cvt_pk_bf16(P[BASE + 2], P[BASE + 3]), cvt_pk_bf16(P[BASE + 4], P[BASE + 5]), cvt_pk_bf16(P[BASE + 6], P[BASE + 7])}; \
    OUT = *reinterpret_cast<bf16x8*>(&w); } while (0)
  PK4(p0, 0, pa0); PK4(p0, 8, pa1); PK4(p1, 0, pa2); PK4(p1, 8, pa3);
#undef PK4
}
__device__ __forceinline__ void qkt(f32x16& p0, f32x16& p1, const char* Ks, const bf16x8* qr, int r32, int hi) {
  p0 = f32x16{}; p1 = f32x16{};
#pragma unroll
  for (int d0 = 0; d0 < 4; ++d0) { const int cb = (d0 * 16 + hi * 8) * 2;
    bf16x8 b0 = *reinterpret_cast<const bf16x8*>(Ks + r32 * KROW + cb);
    bf16x8 b1 = *reinterpret_cast<const bf16x8*>(Ks + (32 + r32) * KROW + cb);
    p0 = __builtin_amdgcn_mfma_f32_32x32x16_bf16(b0, qr[d0], p0, 0, 0, 0);
    p1 = __builtin_amdgcn_mfma_f32_32x32x16_bf16(b1, qr[d0], p1, 0, 0, 0); }
}
__device__ __forceinline__ int v_st(int k, int c) { const int kk = k; return ((kk >> 3) * 4 + (c >> 5)) * 512 + ((kk & 7) * 32 + (c & 31)) * 2; }
__device__ __forceinline__ int v_rd_base(int lane) { return ((lane & 3) << 3) | (((lane >> 2) & 3) << 6) | (((lane >> 4) & 1) << 5) | (((lane >> 5) & 1) << 8); }
constexpr int v_rd_off(int d0, int ks, int half) { return d0 * 512 + ks * 4096 + half * 2048; }
template <int OFF> __device__ __forceinline__ s16x4 tr_read(int vb) {
  s16x4 r; asm volatile("ds_read_b64_tr_b16 %0, %1 offset:%2" : "=&v"(r) : "v"(vb), "i"(OFF) : "memory"); return r;
}
template <int D0> __device__ __forceinline__ void pv_one(f32x16& od, int vb, bf16x8 pa0, bf16x8 pa1, bf16x8 pa2, bf16x8 pa3) {
  const s16x4 l0 = tr_read<v_rd_off(D0, 0, 0)>(vb), h0 = tr_read<v_rd_off(D0, 0, 1)>(vb), l1 = tr_read<v_rd_off(D0, 1, 0)>(vb), h1 = tr_read<v_rd_off(D0, 1, 1)>(vb);
  const s16x4 l2 = tr_read<v_rd_off(D0, 2, 0)>(vb), h2 = tr_read<v_rd_off(D0, 2, 1)>(vb), l3 = tr_read<v_rd_off(D0, 3, 0)>(vb), h3 = tr_read<v_rd_off(D0, 3, 1)>(vb);
  asm volatile("s_waitcnt lgkmcnt(0)" ::: "memory"); SBAR();
#define PK(L, H) (bf16x8){L[0], L[1], L[2], L[3], H[0], H[1], H[2], H[3]}
  od = __builtin_amdgcn_mfma_f32_32x32x16_bf16(pa0, PK(l0, h0), od, 0, 0, 0);
  od = __builtin_amdgcn_mfma_f32_32x32x16_bf16(pa1, PK(l1, h1), od, 0, 0, 0);
  od = __builtin_amdgcn_mfma_f32_32x32x16_bf16(pa2, PK(l2, h2), od, 0, 0, 0);
  od = __builtin_amdgcn_mfma_f32_32x32x16_bf16(pa3, PK(l3, h3), od, 0, 0, 0);
#undef PK
}
__device__ __forceinline__ void pv_d0(f32x16* o, int vb, bf16x8 pa0, bf16x8 pa1, bf16x8 pa2, bf16x8 pa3) {
  pv_one<0>(o[0], vb, pa0, pa1, pa2, pa3); pv_one<1>(o[1], vb, pa0, pa1, pa2, pa3); pv_one<2>(o[2], vb, pa0, pa1, pa2, pa3); pv_one<3>(o[3], vb, pa0, pa1, pa2, pa3);
}
__device__ __forceinline__ void attn_unit(const bf16_t* __restrict__ Qb, const bf16_t* __restrict__ Kh, const bf16_t* __restrict__ Vh, bf16_t* __restrict__ Ob, int ldo, int seq, char* lds, const int tid) {
  const int wid = tid >> 6, lane = tid & 63, r32 = lane & 31, hi = lane >> 5;
  char* V_lds = lds + OFF_V; char* K_lds = lds + OFF_K;
  float* ws = (float*)(lds + OFF_WS) + wid * 64; float* li_l = ws; float* al_l = ws + 32;
  float m_reg = -1e30f, l_reg = 0; f32x16 o[4] = {}; bf16x8 qr[4];
  const bf16_t* Qw = Qb + (long)(wid * QBLK + r32) * LDQ + hi * 8;
#pragma unroll
  for (int d0 = 0; d0 < 4; ++d0) qr[d0] = *reinterpret_cast<const bf16x8*>(Qw + d0 * 16);
  const int sr = tid >> 4, sc = (tid & 15) * 8, vst0 = v_st(sr, sc), vst1 = v_st(32 + sr, sc);
  const int kr = tid >> 3, kc = (tid & 7) * 8, kst = kr * KROW + kc * 2;
  const int vb0 = (int)(uintptr_t)V_lds + v_rd_base(lane);
  struct { bf16x8 vs0, vs1, ks0; } sr_[2];
#define SLOAD(i, k0) do { sr_[i].vs0 = *reinterpret_cast<const bf16x8*>(&Vh[(long)((k0) + sr) * LDQ + sc]); sr_[i].vs1 = *reinterpret_cast<const bf16x8*>(&Vh[(long)((k0) + 32 + sr) * LDQ + sc]); \
    sr_[i].ks0 = *reinterpret_cast<const bf16x8*>(&Kh[(long)((k0) + kr) * LDQ + kc]); } while (0)
#define SWRITE(b, i) do { *(bf16x8*)(V_lds + (b) * SHM_V + vst0) = sr_[i].vs0; *(bf16x8*)(V_lds + (b) * SHM_V + vst1) = sr_[i].vs1; \
    *(bf16x8*)(K_lds + (b) * SHM_K + kst) = sr_[i].ks0; } while (0)
#define SWAIT() asm volatile("s_waitcnt vmcnt(3)" ::: "memory")
#define RESC(a) do { if (__any((a) < 1.f)) { if (hi == 0) al_l[r32] = (a); asm volatile("s_waitcnt lgkmcnt(0)" ::: "memory"); \
    _Pragma("unroll") for (int d = 0; d < 4; ++d) _Pragma("unroll") for (int r = 0; r < 16; ++r) o[d][r] *= al_l[crow(r, hi)]; } } while (0)
  f32x16 pA0, pA1, pB0, pB1; float mnA, mnB, alA, alB; bf16x8 pa0, pa1, pa2, pa3; const int NT = seq / KVBLK;
  constexpr int SE = 0, SO = 1;
  SLOAD(SE, 0); asm volatile("s_waitcnt vmcnt(0)" ::: "memory"); SWRITE(0, SE); __syncthreads();
  qkt(pA0, pA1, K_lds, qr, r32, hi); partialSM(pA0, pA1, m_reg, mnA, alA);
  SLOAD(SO, KVBLK); if (2 < NT) SLOAD(SE, 2 * KVBLK);
  SWAIT(); SWRITE(1, SO); __syncthreads();
  for (int j = 1; j + 1 < NT; j += 2) {
    SBAR(); qkt(pB0, pB1, K_lds + SHM_K, qr, r32, hi);
    finishSM(pA0, pA1, alA, l_reg, pa0, pa1, pa2, pa3); SBAR();
    SLOAD(SO, (j + 2) * KVBLK); SBAR();
    pv_d0(o, vb0, pa0, pa1, pa2, pa3); partialSM(pB0, pB1, m_reg, mnB, alB);
    __syncthreads(); SWAIT(); SWRITE(0, SE);
    RESC(alB); __syncthreads();
    SBAR(); qkt(pA0, pA1, K_lds, qr, r32, hi);
    finishSM(pB0, pB1, alB, l_reg, pa0, pa1, pa2, pa3); SBAR();
    if (j + 3 < NT) SLOAD(SE, (j + 3) * KVBLK); SBAR();
    pv_d0(o, vb0 + SHM_V, pa0, pa1, pa2, pa3); partialSM(pA0, pA1, m_reg, mnA, alA);
    __syncthreads(); SWAIT(); SWRITE(1, SO);
    RESC(alA); __syncthreads();
  }
  SBAR(); qkt(pB0, pB1, K_lds + SHM_K, qr, r32, hi);
  finishSM(pA0, pA1, alA, l_reg, pa0, pa1, pa2, pa3); SBAR();
  pv_d0(o, vb0, pa0, pa1, pa2, pa3); partialSM(pB0, pB1, m_reg, mnB, alB);
  __syncthreads(); RESC(alB);
  finishSM(pB0, pB1, alB, l_reg, pa0, pa1, pa2, pa3); SBAR();
  pv_d0(o, vb0 + SHM_V, pa0, pa1, pa2, pa3);
  if (hi == 0) li_l[r32] = l_reg; asm volatile("s_waitcnt lgkmcnt(0)" ::: "memory");
  float rli[16];
#pragma unroll
  for (int r = 0; r < 16; ++r) rli[r] = __builtin_amdgcn_rcpf(li_l[crow(r, hi)]);
  { bf16_t* stg = (bf16_t*)(lds + OFF_OST) + wid * 4096;
#pragma unroll
    for (int r = 0; r < 16; ++r) { const int orow = crow(r, hi);
#pragma unroll
      for (int d0 = 0; d0 < 4; ++d0) stg[orow * 128 + d0 * 32 + r32] = (bf16_t)(cvt_pk_bf16(o[d0][r] * rli[r], 0.f) & 0xffffu); }
    asm volatile("s_waitcnt lgkmcnt(0)" ::: "memory");
    bf16_t* Ow = Ob + (long)(wid * QBLK) * ldo;
#pragma unroll
    for (int i = 0; i < 8; ++i) { const int row = i * 4 + (lane >> 4), ch = lane & 15; const u32x4 v = *(const u32x4*)(stg + row * 128 + ch * 8); *(u32x4*)(Ow + (long)row * ldo + ch * 8) = v; } }
  __syncthreads();
#undef SLOAD
#undef SWRITE
#undef SWAIT
#undef RESC
}
#undef SBAR
}


namespace att2 {
using bf16x8 = __attribute__((ext_vector_type(8))) short;
using s16x4  = __attribute__((ext_vector_type(4))) short;
using f32x16 = __attribute__((ext_vector_type(16))) float;
constexpr int NW = 8, QBLK = 32, KVBLK = 64, LDQ = 1024, LDK = 64, LDV = 128;
constexpr int KSL = 8192, VSL = 16384, K_OFF = 0, V_OFF = 3 * KSL, OFF_WS = V_OFF + 4 * VSL, ATT_LDS = OFF_WS + NW * 64 * 4;
constexpr float THRL = 8.f;
#define SBAR() __builtin_amdgcn_sched_barrier(0)
__device__ __forceinline__ int crow(int r, int hi) { return (r & 3) + 8 * (r >> 2) + 4 * hi; }
__device__ __forceinline__ int v_rd_base(int lane) { return ((lane & 3) << 3) | (((lane >> 2) & 3) << 6) | (((lane >> 4) & 1) << 5) | (((lane >> 5) & 1) << 8); }
constexpr int v_rd_off(int d0, int ks, int half) { return d0 * 512 + ks * 4096 + half * 2048; }
template <int OFF> __device__ __forceinline__ s16x4 tr_read(int vb) {
  s16x4 r; asm volatile("ds_read_b64_tr_b16 %0, %1 offset:%2" : "=&v"(r) : "v"(vb), "i"(OFF) : "memory"); return r;
}
template <int D0> __device__ __forceinline__ void pv_one(f32x16& od, int vb, bf16x8 pa0, bf16x8 pa1, bf16x8 pa2, bf16x8 pa3) {
  const s16x4 l0 = tr_read<v_rd_off(D0, 0, 0)>(vb), h0 = tr_read<v_rd_off(D0, 0, 1)>(vb), l1 = tr_read<v_rd_off(D0, 1, 0)>(vb), h1 = tr_read<v_rd_off(D0, 1, 1)>(vb);
  const s16x4 l2 = tr_read<v_rd_off(D0, 2, 0)>(vb), h2 = tr_read<v_rd_off(D0, 2, 1)>(vb), l3 = tr_read<v_rd_off(D0, 3, 0)>(vb), h3 = tr_read<v_rd_off(D0, 3, 1)>(vb);
  asm volatile("s_waitcnt lgkmcnt(0)" ::: "memory"); SBAR();
#define PK(L, H) (bf16x8){L[0], L[1], L[2], L[3], H[0], H[1], H[2], H[3]}
  od = __builtin_amdgcn_mfma_f32_32x32x16_bf16(pa0, PK(l0, h0), od, 0, 0, 0);
  od = __builtin_amdgcn_mfma_f32_32x32x16_bf16(pa1, PK(l1, h1), od, 0, 0, 0);
  od = __builtin_amdgcn_mfma_f32_32x32x16_bf16(pa2, PK(l2, h2), od, 0, 0, 0);
  od = __builtin_amdgcn_mfma_f32_32x32x16_bf16(pa3, PK(l3, h3), od, 0, 0, 0);
#undef PK
}
struct VFrag { s16x4 l0, h0, l1, h1, l2, h2, l3, h3; };
template <int D0> __device__ __forceinline__ void v_issue(VFrag& f, int vb) {
  f.l0 = tr_read<v_rd_off(D0, 0, 0)>(vb); f.h0 = tr_read<v_rd_off(D0, 0, 1)>(vb); f.l1 = tr_read<v_rd_off(D0, 1, 0)>(vb); f.h1 = tr_read<v_rd_off(D0, 1, 1)>(vb);
  f.l2 = tr_read<v_rd_off(D0, 2, 0)>(vb); f.h2 = tr_read<v_rd_off(D0, 2, 1)>(vb); f.l3 = tr_read<v_rd_off(D0, 3, 0)>(vb); f.h3 = tr_read<v_rd_off(D0, 3, 1)>(vb);
}
template <int WAITN> __device__ __forceinline__ void pv_mma(f32x16& od, const VFrag& f, bf16x8 pa0, bf16x8 pa1, bf16x8 pa2, bf16x8 pa3) {
  if (WAITN == 8) asm volatile("s_waitcnt lgkmcnt(8)" ::: "memory"); else asm volatile("s_waitcnt lgkmcnt(0)" ::: "memory");
  SBAR();
#define PK(L, H) (bf16x8){L[0], L[1], L[2], L[3], H[0], H[1], H[2], H[3]}
  od = __builtin_amdgcn_mfma_f32_32x32x16_bf16(pa0, PK(f.l0, f.h0), od, 0, 0, 0);
  od = __builtin_amdgcn_mfma_f32_32x32x16_bf16(pa1, PK(f.l1, f.h1), od, 0, 0, 0);
  od = __builtin_amdgcn_mfma_f32_32x32x16_bf16(pa2, PK(f.l2, f.h2), od, 0, 0, 0);
  od = __builtin_amdgcn_mfma_f32_32x32x16_bf16(pa3, PK(f.l3, f.h3), od, 0, 0, 0);
#undef PK
}
__device__ __forceinline__ void pv_pipe(f32x16* o, int vb, bf16x8 pa0, bf16x8 pa1, bf16x8 pa2, bf16x8 pa3) {
  VFrag f0, f1;
  v_issue<0>(f0, vb); SBAR();
  v_issue<1>(f1, vb); SBAR(); pv_mma<8>(o[0], f0, pa0, pa1, pa2, pa3); SBAR();
  v_issue<2>(f0, vb); SBAR(); pv_mma<8>(o[1], f1, pa0, pa1, pa2, pa3); SBAR();
  v_issue<3>(f1, vb); SBAR(); pv_mma<8>(o[2], f0, pa0, pa1, pa2, pa3); SBAR();
  pv_mma<0>(o[3], f1, pa0, pa1, pa2, pa3);
}
__device__ __forceinline__ void qkt(f32x16& p0, f32x16& p1, const LAS unsigned char* Ks, const bf16x8* qr, const f32x16& cinit, int r32, int hi) {
  const LAS unsigned char* kb0 = Ks + r32 * 128; const int sw = r32 & 7;
#pragma unroll
  for (int d0 = 0; d0 < 4; ++d0) { const int ch = ((2 * d0 + hi) ^ sw) << 4;
    const bf16x8 b0 = *(const LAS bf16x8*)(kb0 + ch), b1 = *(const LAS bf16x8*)(kb0 + 4096 + ch);
    if (d0 == 0) { p0 = __builtin_amdgcn_mfma_f32_32x32x16_bf16(b0, qr[0], cinit, 0, 0, 0); p1 = __builtin_amdgcn_mfma_f32_32x32x16_bf16(b1, qr[0], cinit, 0, 0, 0); }
    else { p0 = __builtin_amdgcn_mfma_f32_32x32x16_bf16(b0, qr[d0], p0, 0, 0, 0); p1 = __builtin_amdgcn_mfma_f32_32x32x16_bf16(b1, qr[d0], p1, 0, 0, 0); } }
}
__device__ __forceinline__ float rowmax(const f32x16& p0, const f32x16& p1) {
  float a = fmaxf(fmaxf(p0[0], p0[1]), p1[0]), b = fmaxf(fmaxf(p0[2], p0[3]), p1[1]); a = fmaxf(fmaxf(a, p1[2]), p1[3]);
#pragma unroll
  for (int r = 4; r < 16; r += 4) { a = fmaxf(fmaxf(a, p0[r]), p0[r + 1]); b = fmaxf(fmaxf(b, p0[r + 2]), p0[r + 3]); a = fmaxf(fmaxf(a, p1[r]), p1[r + 1]); b = fmaxf(fmaxf(b, p1[r + 2]), p1[r + 3]); }
  const float m = fmaxf(a, b);
  auto rr = __builtin_amdgcn_permlane32_swap(__float_as_uint(m), __float_as_uint(m), false, false);
  return fmaxf(__uint_as_float(rr[0]), __uint_as_float(rr[1]));
}
#define A2_PK4(P, BASE, OUT) do { u32x4 w_ = {cvt_pk_bf16(P[BASE + 0], P[BASE + 1]), cvt_pk_bf16(P[BASE + 2], P[BASE + 3]), cvt_pk_bf16(P[BASE + 4], P[BASE + 5]), cvt_pk_bf16(P[BASE + 6], P[BASE + 7])}; \
    OUT = *reinterpret_cast<bf16x8*>(&w_); } while (0)

__device__ __forceinline__ void attn_unit(const bf16_t* __restrict__ Qb, const bf16_t* __restrict__ Kh, const bf16_t* __restrict__ Vh, bf16_t* __restrict__ Ob, int ldo, int seq, LAS unsigned char* lds, const int tid) {
  const int wid = __builtin_amdgcn_readfirstlane(tid >> 6), lane = tid & 63, r32 = lane & 31, hi = lane >> 5;
  LAS float* ws = (LAS float*)(lds + OFF_WS) + wid * 64;
  const unsigned koff = (unsigned)(((8 * wid + (lane >> 3)) * LDK + (((lane & 7) ^ (lane >> 3)) * 8)) * 2);
  const unsigned voff = (unsigned)(((8 * wid + ((lane & 31) >> 2)) * LDV + 32 * (lane >> 5) + 8 * (lane & 3)) * 2);
#define A2_DMA(t, ks, vs) do { const char* kb_ = (const char*)Kh + (size_t)(t) * (KVBLK * LDK * 2); const char* vb_ = (const char*)Vh + (size_t)(t) * (KVBLK * LDV * 2); \
    __builtin_amdgcn_global_load_lds((const unsigned*)(kb_ + koff), (LAS unsigned*)(lds + K_OFF + (ks) + wid * 1024), 16, 0, 0); \
    __builtin_amdgcn_global_load_lds((const unsigned*)(vb_ + voff), (LAS unsigned*)(lds + V_OFF + (vs) + wid * 2048), 16, 0, 0); \
    __builtin_amdgcn_global_load_lds((const unsigned*)(vb_ + voff + 128), (LAS unsigned*)(lds + V_OFF + (vs) + wid * 2048 + 1024), 16, 0, 0); } while (0)
#define A2_WAITBAR() do { asm volatile("s_waitcnt vmcnt(0) lgkmcnt(0)" ::: "memory"); __builtin_amdgcn_s_barrier(); asm volatile("" ::: "memory"); } while (0)
  const int NT = seq / KVBLK;
  const bool trail = wid >= 4;
  A2_DMA(0, 0, 0); A2_DMA(1, KSL, VSL);
  bf16x8 qr[4];
  { const bf16_t* Qw = Qb + (long)(wid * QBLK + r32) * LDQ + hi * 8;
#pragma unroll
    for (int d0 = 0; d0 < 4; ++d0) qr[d0] = *reinterpret_cast<const bf16x8*>(Qw + d0 * 16); }
  float mhat = 0.f, l_reg = 0.f; f32x16 o[4] = {}; f32x16 negm = {};
  const int vbase = (int)(uintptr_t)(lds + V_OFF) + v_rd_base(lane);
  A2_WAITBAR();
  if (NT > 2) A2_DMA(2, 2 * KSL, 2 * VSL);
  f32x16 pA0, pA1, pB0, pB1; bf16x8 pa0, pa1, pa2, pa3;
  qkt(pA0, pA1, lds + K_OFF, qr, negm, r32, hi);
  { const float rm = rowmax(pA0, pA1); mhat = rm;
#pragma unroll
    for (int r = 0; r < 16; ++r) { pA0[r] -= rm; pA1[r] -= rm; negm[r] = -rm; }
#pragma unroll
    for (int r = 0; r < 16; ++r) { pA0[r] = __builtin_amdgcn_exp2f(pA0[r]); pA1[r] = __builtin_amdgcn_exp2f(pA1[r]); } }
  int k_cur = KSL, k_dma = 0;
  int v_prev = 0, v_dma = 3 * VSL;
#define A2_ROT() do { k_cur = (k_cur == 2 * KSL) ? 0 : k_cur + KSL; k_dma = (k_dma == 2 * KSL) ? 0 : k_dma + KSL; v_prev = (v_prev == 3 * VSL) ? 0 : v_prev + VSL; v_dma = (v_dma == 3 * VSL) ? 0 : v_dma + VSL; } while (0)
#define A2_SEAM(t) do { A2_WAITBAR(); if ((t) + 2 < NT) A2_DMA((t) + 2, k_dma, v_dma); } while (0)
#define A2_EXP(X, i) X[i] = __builtin_amdgcn_exp2f(X[i])
#define A2_SG(mask, n) __builtin_amdgcn_sched_group_barrier(mask, n, 0)
#define A2_STEP(C0, C1, P0, P1, t) do { bool resc_ = false; \
    SBAR(); \
      \
    qkt(C0, C1, lds + K_OFF + k_cur, qr, negm, r32, hi); \
    { float sa_ = 0.f, sb_ = 0.f; _Pragma("unroll") for (int r = 0; r < 16; ++r) { sa_ += P0[r]; sb_ += P1[r]; } l_reg += sa_ + sb_; } \
    A2_PK4(P0, 0, pa0); A2_PK4(P0, 8, pa1); A2_PK4(P1, 0, pa2); A2_PK4(P1, 8, pa3); \
    A2_SG(0x100, 2); A2_SG(0x100, 2); A2_SG(0x8, 1); A2_SG(0x402, 6); A2_SG(0x8, 1); A2_SG(0x402, 6); A2_SG(0x100, 2); A2_SG(0x8, 1); A2_SG(0x402, 6); A2_SG(0x8, 1); A2_SG(0x402, 6); \
    A2_SG(0x100, 2); A2_SG(0x8, 1); A2_SG(0x402, 6); A2_SG(0x8, 1); A2_SG(0x402, 6); A2_SG(0x8, 1); A2_SG(0x402, 6); A2_SG(0x8, 1); A2_SG(0x402, 6); \
    if (MK_ATT_XMFMA) { f32x16 dz_ = negm; _Pragma("unroll") for (int x_ = 0; x_ < 8; ++x_) asm volatile("v_mfma_f32_32x32x16_bf16 %0, %1, %2, %0" : "+v"(dz_) : "v"(qr[x_ & 3]), "v"(qr[(x_ + 1) & 3])); asm volatile("" :: "v"(dz_)); } \
    if (MK_ATT_XEXP) { float dx_ = mhat; _Pragma("unroll") for (int x_ = 0; x_ < 32; ++x_) asm volatile("v_exp_f32 %0, %0" : "+v"(dx_)); asm volatile("" :: "v"(dx_)); } \
    asm volatile("" : "+v"(l_reg), "+v"(pa0), "+v"(pa1), "+v"(pa2), "+v"(pa3)); SBAR(); \
    if (trail) A2_SEAM(t); \
    { const int vb_ = vbase + v_prev; VFrag f0_, f1_; \
        \
      v_issue<0>(f0_, vb_); v_issue<1>(f1_, vb_); SBAR(); \
      pv_mma<8>(o[0], f0_, pa0, pa1, pa2, pa3); \
      { const float rm_ = rowmax(C0, C1); \
        if (__builtin_expect(__any(rm_ > THRL), 0)) { const float dl_ = fmaxf(rm_, 0.f); mhat += dl_; \
          _Pragma("unroll") for (int r = 0; r < 16; ++r) { C0[r] -= dl_; C1[r] -= dl_; negm[r] = -mhat; } \
          const float f_ = __builtin_amdgcn_exp2f(-dl_); l_reg *= f_; if (hi == 0) ws[r32] = f_; resc_ = true; } } \
      SBAR(); \
        \
      v_issue<2>(f0_, vb_); SBAR(); pv_mma<8>(o[1], f1_, pa0, pa1, pa2, pa3); \
      A2_EXP(C0, 0); A2_EXP(C0, 1); A2_EXP(C0, 2); A2_EXP(C0, 3); A2_EXP(C0, 4); A2_EXP(C0, 5); A2_EXP(C0, 6); A2_EXP(C0, 7); A2_EXP(C0, 8); A2_EXP(C0, 9); A2_EXP(C0, 10); \
      A2_SG(0x8, 1); A2_SG(0x402, 3); A2_SG(0x8, 1); A2_SG(0x402, 3); A2_SG(0x8, 1); A2_SG(0x402, 3); A2_SG(0x8, 1); A2_SG(0x402, 3); \
      asm volatile("" : "+v"(C0)); SBAR(); \
      v_issue<3>(f1_, vb_); SBAR(); pv_mma<8>(o[2], f0_, pa0, pa1, pa2, pa3); \
      A2_EXP(C0, 11); A2_EXP(C0, 12); A2_EXP(C0, 13); A2_EXP(C0, 14); A2_EXP(C0, 15); A2_EXP(C1, 0); A2_EXP(C1, 1); A2_EXP(C1, 2); A2_EXP(C1, 3); A2_EXP(C1, 4); A2_EXP(C1, 5); \
      A2_SG(0x8, 1); A2_SG(0x402, 3); A2_SG(0x8, 1); A2_SG(0x402, 3); A2_SG(0x8, 1); A2_SG(0x402, 3); A2_SG(0x8, 1); A2_SG(0x402, 3); \
      asm volatile("" : "+v"(C0), "+v"(C1)); SBAR(); \
      pv_mma<0>(o[3], f1_, pa0, pa1, pa2, pa3); \
      A2_EXP(C1, 6); A2_EXP(C1, 7); A2_EXP(C1, 8); A2_EXP(C1, 9); A2_EXP(C1, 10); A2_EXP(C1, 11); A2_EXP(C1, 12); A2_EXP(C1, 13); A2_EXP(C1, 14); A2_EXP(C1, 15); \
      A2_SG(0x8, 1); A2_SG(0x402, 3); A2_SG(0x8, 1); A2_SG(0x402, 3); A2_SG(0x8, 1); A2_SG(0x402, 3); A2_SG(0x8, 1); A2_SG(0x402, 3); \
      asm volatile("" : "+v"(C1)); SBAR(); } \
    if (resc_) { asm volatile("s_waitcnt lgkmcnt(0)" ::: "memory"); \
      _Pragma("unroll") for (int d_ = 0; d_ < 4; ++d_) _Pragma("unroll") for (int r = 0; r < 16; ++r) o[d_][r] *= ws[crow(r, hi)]; } \
    if (!trail) A2_SEAM(t); \
    A2_ROT(); } while (0)
  int t = 1;
  for (; t + 1 < NT; t += 2) { A2_STEP(pB0, pB1, pA0, pA1, t); A2_STEP(pA0, pA1, pB0, pB1, t + 1); }
  A2_STEP(pB0, pB1, pA0, pA1, t);
  { float sa_ = 0.f, sb_ = 0.f;
#pragma unroll
    for (int r = 0; r < 16; ++r) { sa_ += pB0[r]; sb_ += pB1[r]; }
    l_reg += sa_ + sb_;
    A2_PK4(pB0, 0, pa0); A2_PK4(pB0, 8, pa1); A2_PK4(pB1, 0, pa2); A2_PK4(pB1, 8, pa3);
    SBAR(); const int vb_ = vbase + v_prev;
    pv_pipe(o, vb_, pa0, pa1, pa2, pa3); }
  { auto rr = __builtin_amdgcn_permlane32_swap(__float_as_uint(l_reg), __float_as_uint(l_reg), false, false); l_reg = __uint_as_float(rr[0]) + __uint_as_float(rr[1]); }
  if (hi == 0) ws[32 + r32] = l_reg;
  A2_WAITBAR();
  float rli[16];
#pragma unroll
  for (int r = 0; r < 16; ++r) rli[r] = __builtin_amdgcn_rcpf(ws[32 + crow(r, hi)]);
  { LAS bf16_t* stg = (LAS bf16_t*)lds + wid * 4096;
#pragma unroll
    for (int r = 0; r < 16; ++r) { const int orow = crow(r, hi);
#pragma unroll
      for (int d0 = 0; d0 < 4; ++d0) stg[orow * 128 + d0 * 32 + r32] = (bf16_t)(cvt_pk_bf16(o[d0][r] * rli[r], 0.f) & 0xffffu); }
    asm volatile("s_waitcnt lgkmcnt(0)" ::: "memory");
    bf16_t* Ow = Ob + (long)(wid * QBLK) * ldo;
#pragma unroll
    for (int i = 0; i < 8; ++i) { const int row = i * 4 + (lane >> 4), ch = lane & 15; const u32x4 v = *(const LAS u32x4*)(stg + row * 128 + ch * 8); *(u32x4*)(Ow + (long)row * ldo + ch * 8) = v; } }
  A2_WAITBAR();
#undef A2_DMA
#undef A2_WAITBAR
#undef A2_ROT
#undef A2_SEAM
#undef A2_STEP
#undef A2_EXP
#undef A2_SG
}
#undef A2_PK4
#undef SBAR
}


namespace att3 {
using f32x16 = __attribute__((ext_vector_type(16))) float;
typedef int v8i __attribute__((ext_vector_type(8)));
typedef int v4i __attribute__((ext_vector_type(4)));
constexpr int NW = 8, QBLK = 32, KVBLK = 64;
constexpr int KSL = 8192, VSL = 16384, K_OFF = 0, V_OFF = 3 * KSL, OFF_WS = V_OFF + 3 * VSL, OFF_Q = OFF_WS + NW * 64 * 4, OFF_ONES = OFF_Q + NW * 2048, ATT_LDS = OFF_ONES + 64;
constexpr float THRL = 8.f;
constexpr int SC_ONE = 0x7f7f7f7f, SC_Q = 0x7b7b7b7b;
#define SBAR() __builtin_amdgcn_sched_barrier(0)
__device__ __forceinline__ int crow(int r, int hi) { return (r & 3) + 8 * (r >> 2) + 4 * hi; }
__host__ __device__ __forceinline__ int slot_key(int s) { const int hi = s >> 5, j = s & 31, jj = j & 15; return (j >> 4) * 32 + (jj & 3) + 8 * (jj >> 2) + 4 * hi; }
__device__ __forceinline__ v8i ld32(const LAS unsigned char* rowp, int c0, int sw) {
    const v4i a = *(const LAS v4i*)(rowp + ((c0 ^ sw) << 4)), b = *(const LAS v4i*)(rowp + (((c0 + 1) ^ sw) << 4));
    return (v8i){a[0], a[1], a[2], a[3], b[0], b[1], b[2], b[3]};
}
__device__ __forceinline__ void qkt(f32x16& p0, f32x16& p1, const LAS unsigned char* Ks, const v8i& qf, const f32x16& cinit, int r32, int hi) {
    const int sw = (r32 >> 2) & 3;
    const v8i k0 = ld32(Ks + r32 * 64, 2 * hi, sw), k1 = ld32(Ks + (32 + r32) * 64, 2 * hi, sw);
    p0 = __builtin_amdgcn_mfma_scale_f32_32x32x64_f8f6f4(k0, qf, cinit, 0, 0, 0, SC_ONE, 0, SC_Q);
    p1 = __builtin_amdgcn_mfma_scale_f32_32x32x64_f8f6f4(k1, qf, cinit, 0, 0, 0, SC_ONE, 0, SC_Q);
}
__device__ __forceinline__ float lanemax(const f32x16& p0, const f32x16& p1) {
  float a = fmaxf(fmaxf(p0[0], p0[1]), p1[0]), b = fmaxf(fmaxf(p0[2], p0[3]), p1[1]); a = fmaxf(fmaxf(a, p1[2]), p1[3]);
#pragma unroll
  for (int r = 4; r < 16; r += 4) { a = fmaxf(fmaxf(a, p0[r]), p0[r + 1]); b = fmaxf(fmaxf(b, p0[r + 2]), p0[r + 3]); a = fmaxf(fmaxf(a, p1[r]), p1[r + 1]); b = fmaxf(fmaxf(b, p1[r + 2]), p1[r + 3]); }
  return fmaxf(a, b);
}
__device__ __forceinline__ float rowmax4(const f32x16& p0, const f32x16& p1, const f32x16& p2, const f32x16& p3) {
  const float m = fmaxf(lanemax(p0, p1), lanemax(p2, p3));
  auto rr = __builtin_amdgcn_permlane32_swap(__float_as_uint(m), __float_as_uint(m), false, false);
  return fmaxf(__uint_as_float(rr[0]), __uint_as_float(rr[1]));
}
__device__ __forceinline__ v8i pack_p(const f32x16& p0, const f32x16& p1) {
    v8i w;
    w[0] = (int)cvt4_fp8_nc(p0[0], p0[1], p0[2], p0[3]); w[1] = (int)cvt4_fp8_nc(p0[4], p0[5], p0[6], p0[7]); w[2] = (int)cvt4_fp8_nc(p0[8], p0[9], p0[10], p0[11]); w[3] = (int)cvt4_fp8_nc(p0[12], p0[13], p0[14], p0[15]);
    w[4] = (int)cvt4_fp8_nc(p1[0], p1[1], p1[2], p1[3]); w[5] = (int)cvt4_fp8_nc(p1[4], p1[5], p1[6], p1[7]); w[6] = (int)cvt4_fp8_nc(p1[8], p1[9], p1[10], p1[11]); w[7] = (int)cvt4_fp8_nc(p1[12], p1[13], p1[14], p1[15]);
    return w;
}
__device__ __forceinline__ void qk1(f32x16& d, const v8i& kop, const v8i& qf, const f32x16& c) {
    asm volatile("s_nop 1\n\tv_mfma_scale_f32_32x32x64_f8f6f4 %0, %1, %2, %3, %4, %5 op_sel_hi:[0,0,0]" : "=&v"(d) : "v"(kop), "v"(qf), "v"(c), "v"(SC_ONE), "v"(SC_Q));
}
__device__ __forceinline__ void pv1(f32x16& od, const v8i& pf, const v8i& vf) {
    asm volatile("s_nop 1\n\tv_mfma_scale_f32_32x32x64_f8f6f4 %0, %1, %2, %0, %3, %3 op_sel_hi:[0,0,0]" : "+v"(od) : "v"(pf), "v"(vf), "v"(SC_ONE));
}

__device__ __forceinline__ void attn_unit(const unsigned char* __restrict__ Q8b, const unsigned char* __restrict__ K8h0, size_t kmap_stride, const unsigned char* __restrict__ VT8h, bf16_t* __restrict__ AOb, int ldo, int seq,
                                          float lam, float osc, const float* __restrict__ subln, u32x4* __restrict__ o0g, LAS unsigned char* lds, const int tid) {
  const int wid = __builtin_amdgcn_readfirstlane(tid >> 6), lane = tid & 63, r32 = lane & 31, hi = lane >> 5;
  LAS float* ws = (LAS float*)(lds + OFF_WS) + wid * 64;
  const int prow = 16 * wid + (lane >> 2); const unsigned poff = (unsigned)(prow * 64 + (((lane & 3) ^ ((prow >> 2) & 3)) << 4));
#define A3_MFMA_FENCE() asm volatile("s_nop 15\n\ts_nop 15" : "+v"(o[0]), "+v"(o[1]), "+v"(o[2]), "+v"(o[3]), "+v"(osum))
#define A3_WAITBAR() do { asm volatile("s_waitcnt vmcnt(0) lgkmcnt(0)" ::: "memory"); __builtin_amdgcn_s_barrier(); asm volatile("" ::: "memory"); } while (0)
  const int NT2 = seq / 128;
  const int half = wid >> 2;
#define A3_DMAK(t) __builtin_amdgcn_global_load_lds((const unsigned*)(K8h + (size_t)(t) * 8192 + poff), (LAS unsigned*)(lds + K_OFF + ((t) % 3) * KSL + wid * 1024), 16, 0, 0)
#define A3_DMAV(t) do { __builtin_amdgcn_global_load_lds((const unsigned*)(VT8h + (size_t)(t) * 16384 + poff), (LAS unsigned*)(lds + V_OFF + ((t) % 3) * VSL + wid * 1024), 16, 0, 0); \
    __builtin_amdgcn_global_load_lds((const unsigned*)(VT8h + (size_t)(t) * 16384 + 8192 + poff), (LAS unsigned*)(lds + V_OFF + ((t) % 3) * VSL + 8192 + wid * 1024), 16, 0, 0); } while (0)
  f32x16 o[4]; f32x16 osum;
  for (int mp = 0; mp < 2; ++mp) {
  const unsigned char* K8h = K8h0 + (size_t)mp * kmap_stride;
  A3_DMAK(0); A3_DMAK(1); A3_DMAV(0);
  LAS v4i* qs = (LAS v4i*)(lds + OFF_Q + wid * 2048) + lane;
  { int lq_; asm volatile("v_mbcnt_lo_u32_b32 %0, -1, 0\n\tv_mbcnt_hi_u32_b32 %0, -1, %0" : "=v"(lq_));
    const unsigned char* Qw = Q8b + mp * 64 + (size_t)(wid * QBLK + (lq_ & 31)) * 1024 + (lq_ >> 5) * 32; const v4i a = *(const v4i*)Qw, b = *(const v4i*)(Qw + 16); qs[0] = a; qs[64] = b; }
#define A3_LDQ(buf) do { const v4i qa_ = qs[0], qb_ = qs[64]; buf = (v8i){qa_[0], qa_[1], qa_[2], qa_[3], qb_[0], qb_[1], qb_[2], qb_[3]}; } while (0)
  f32x16 negm = {};
#pragma unroll
  for (int r = 0; r < 16; ++r) { o[0][r] = 0.f; o[1][r] = 0.f; o[2][r] = 0.f; o[3][r] = 0.f; osum[r] = 0.f; }
  if (wid == 0 && lane < 8) *(LAS unsigned*)(lds + OFF_ONES + 4 * lane) = 0x38383838u;
#define A3_LD1(buf) do { const v4i oa_ = *(const LAS v4i*)(lds + OFF_ONES), ob_ = *(const LAS v4i*)(lds + OFF_ONES + 16); buf = (v8i){oa_[0], oa_[1], oa_[2], oa_[3], ob_[0], ob_[1], ob_[2], ob_[3]}; } while (0)
  const int swv = (r32 >> 2) & 3;
  A3_WAITBAR();
  if (NT2 > 2) A3_DMAK(2);
  A3_DMAV(1);
  f32x16 C0 = negm, C1 = negm, C2 = negm, C3 = negm; v8i pf0 = {}, pf1 = {};
#define A3_BAR_ODD() do { asm volatile("s_waitcnt lgkmcnt(0)" ::: "memory"); __builtin_amdgcn_s_barrier(); asm volatile("" ::: "memory"); } while (0)
#define A3_BAR_EVEN(m) do { if ((m) + 1 < NT2) asm volatile("s_waitcnt vmcnt(3) lgkmcnt(0)" ::: "memory"); else asm volatile("s_waitcnt vmcnt(0) lgkmcnt(0)" ::: "memory"); \
    __builtin_amdgcn_s_barrier(); asm volatile("" ::: "memory"); if ((m) + 2 < NT2) A3_DMAK((m) + 2); if ((m) + 1 < NT2) A3_DMAV((m) + 1); } while (0)
#define A3_LD(buf, p) buf = ld32((p), 2 * hi, swv)
#define A3_W(n) asm volatile("s_waitcnt lgkmcnt(" #n ")" ::: "memory"); SBAR()
#define A3_A_FIRST() do { const LAS unsigned char* Ks_ = lds + K_OFF + r32 * 64; v8i b0_, b1_, b2_; A3_LDQ(b2_); A3_LD(b0_, Ks_); A3_LD(b1_, Ks_ + 2048); \
    A3_W(0); qk1(C0, b0_, b2_, negm); qk1(C1, b1_, b2_, negm); SBAR(); A3_LD(b0_, Ks_ + 4096); A3_LD(b1_, Ks_ + 6144); A3_W(0); qk1(C2, b0_, b2_, negm); qk1(C3, b1_, b2_, negm); SBAR(); } while (0)
#define A3_A_MID(k) do { \
    const LAS unsigned char* Ks_ = lds + K_OFF + (((k) + 1) % 3) * KSL + r32 * 64; \
    const LAS unsigned char* vt_ = lds + V_OFF + ((k) % 3) * VSL + r32 * 64; \
    __builtin_amdgcn_s_setprio(1);                                   \
    v8i b0_, b1_, b2_, b3_; A3_LDQ(b3_); A3_LD(b0_, Ks_); A3_LD(b1_, Ks_ + 2048); A3_LD(b2_, Ks_ + 4096); \
    A3_W(4); qk1(C0, b0_, b3_, negm); SBAR(); A3_LD(b0_, Ks_ + 6144); \
    A3_W(4); qk1(C1, b1_, b3_, negm); SBAR(); A3_LD(b1_, vt_); \
    A3_W(4); qk1(C2, b2_, b3_, negm); SBAR(); A3_LD(b2_, vt_ + 2048); \
    A3_W(4); qk1(C3, b0_, b3_, negm); SBAR(); A3_LD1(b3_); A3_LD(b0_, vt_ + 4096); \
    A3_W(6); pv1(o[0], pf0, b1_); SBAR(); A3_LD(b1_, vt_ + 6144); \
    A3_W(6); pv1(o[1], pf0, b2_); SBAR(); A3_LD(b2_, vt_ + 8192); \
    A3_W(6); pv1(osum, pf0, b3_); SBAR(); A3_LD(b3_, vt_ + 8192 + 2048); \
    A3_W(6); pv1(o[2], pf0, b0_); SBAR(); A3_LD1(b0_); \
    A3_W(6); pv1(o[3], pf0, b1_); SBAR(); A3_LD(b1_, vt_ + 8192 + 4096); \
    A3_W(6); pv1(o[0], pf1, b2_); SBAR(); A3_LD(b2_, vt_ + 8192 + 6144); \
    A3_W(6); pv1(o[1], pf1, b3_); \
    A3_W(4); pv1(osum, pf1, b0_); \
    A3_W(2); pv1(o[2], pf1, b1_); \
    A3_W(0); pv1(o[3], pf1, b2_); \
    __builtin_amdgcn_s_setprio(0); \
    SBAR(); } while (0)
#define A3_A_LAST(k) do { \
    const LAS unsigned char* vt_ = lds + V_OFF + ((k) % 3) * VSL + r32 * 64; \
    v8i b0_, b1_, b2_; \
    _Pragma("unroll") for (int sb_ = 0; sb_ < 2; ++sb_) { const v8i& pfs_ = sb_ ? pf1 : pf0; \
      A3_LD(b0_, vt_ + sb_ * 8192); A3_LD(b1_, vt_ + sb_ * 8192 + 2048); A3_LD1(b2_); \
      asm volatile("s_waitcnt lgkmcnt(0)\n\ts_nop 1" ::: "memory"); SBAR(); \
      pv1(o[0], pfs_, b0_); pv1(o[1], pfs_, b1_); pv1(osum, pfs_, b2_); SBAR(); \
      A3_LD(b0_, vt_ + sb_ * 8192 + 4096); A3_LD(b1_, vt_ + sb_ * 8192 + 6144); \
      asm volatile("s_waitcnt lgkmcnt(0)\n\ts_nop 1" ::: "memory"); SBAR(); \
      pv1(o[2], pfs_, b0_); pv1(o[3], pfs_, b1_); SBAR(); } \
    } while (0)
#define A3_B(FIRST) do { \
    asm volatile("s_nop 7" : "+v"(C0), "+v"(C1), "+v"(C2), "+v"(C3));     \
    const float rm_ = rowmax4(C0, C1, C2, C3); \
    if (FIRST) {                                                    \
      _Pragma("unroll") for (int r = 0; r < 16; ++r) { C0[r] -= rm_; C1[r] -= rm_; C2[r] -= rm_; C3[r] -= rm_; negm[r] = -rm_; } } \
    else if (__builtin_expect(__any(rm_ > THRL), 0)) {              \
      const float dl_ = fmaxf(rm_, 0.f); const float nm_ = negm[0] - dl_; \
      _Pragma("unroll") for (int r = 0; r < 16; ++r) { C0[r] -= dl_; C1[r] -= dl_; C2[r] -= dl_; C3[r] -= dl_; negm[r] = nm_; } \
      int lr_; asm volatile("v_mbcnt_lo_u32_b32 %0, -1, 0\n\tv_mbcnt_hi_u32_b32 %0, -1, %0" : "=v"(lr_));     \
      const int r32r_ = lr_ & 31, hir_ = lr_ >> 5; \
      const float f_ = __builtin_amdgcn_exp2f(-dl_); if (hir_ == 0) ws[r32r_] = f_; \
      asm volatile("s_waitcnt lgkmcnt(0)" ::: "memory"); A3_MFMA_FENCE(); \
      _Pragma("unroll") for (int r = 0; r < 16; ++r) { const float fr_ = ws[crow(r, hir_)]; osum[r] *= fr_; _Pragma("unroll") for (int d_ = 0; d_ < 4; ++d_) o[d_][r] *= fr_; } } \
    _Pragma("unroll") for (int r = 0; r < 16; ++r) { C0[r] = __builtin_amdgcn_exp2f(C0[r]); C1[r] = __builtin_amdgcn_exp2f(C1[r]); } \
    pf0 = pack_p(C0, C1); \
    _Pragma("unroll") for (int r = 0; r < 16; ++r) { C2[r] = __builtin_amdgcn_exp2f(C2[r]); C3[r] = __builtin_amdgcn_exp2f(C3[r]); } \
    pf1 = pack_p(C2, C3); \
    asm volatile("" : "+v"(pf0), "+v"(pf1)); SBAR(); } while (0)
  if (half == 0) {
    A3_A_FIRST();
    A3_BAR_ODD(); A3_B(true);
    int k = 0;
    for (; k + 1 < NT2; ++k) { A3_BAR_EVEN(k + 1); A3_A_MID(k); A3_BAR_ODD(); A3_B(false); }
    A3_BAR_EVEN(k + 1); A3_A_LAST(k);
    A3_BAR_ODD();
  } else {
    A3_BAR_ODD(); A3_A_FIRST();
    A3_BAR_EVEN(1); A3_B(true);
    int k = 0;
    for (; k + 1 < NT2; ++k) { A3_BAR_ODD(); A3_A_MID(k); A3_BAR_EVEN(k + 2); A3_B(false); }
    A3_BAR_ODD(); A3_A_LAST(k);
  }
  A3_MFMA_FENCE();
  A3_WAITBAR();
  if (mp == 0) {
    int lo_; asm volatile("v_mbcnt_lo_u32_b32 %0, -1, 0\n\tv_mbcnt_hi_u32_b32 %0, -1, %0" : "=v"(lo_));
    u32x4* o0s = o0g + wid * 512 + lo_;
#pragma unroll
    for (int d0 = 0; d0 < 4; ++d0) {
#pragma unroll
      for (int r = 0; r < 16; r += 8) { u32x4 w;
        w.x = cvt_pk_bf16(o[d0][r] * __builtin_amdgcn_rcpf(osum[r]), o[d0][r + 1] * __builtin_amdgcn_rcpf(osum[r + 1]));
        w.y = cvt_pk_bf16(o[d0][r + 2] * __builtin_amdgcn_rcpf(osum[r + 2]), o[d0][r + 3] * __builtin_amdgcn_rcpf(osum[r + 3]));
        w.z = cvt_pk_bf16(o[d0][r + 4] * __builtin_amdgcn_rcpf(osum[r + 4]), o[d0][r + 5] * __builtin_amdgcn_rcpf(osum[r + 5]));
        w.w = cvt_pk_bf16(o[d0][r + 6] * __builtin_amdgcn_rcpf(osum[r + 6]), o[d0][r + 7] * __builtin_amdgcn_rcpf(osum[r + 7]));
        o0s[(d0 * 2 + (r >> 3)) * 64] = w; } }
  }
  }
  { LAS bf16_t* stg = (LAS bf16_t*)lds + wid * 4096;
    u32x4 o0w[8];
    { int lo_; asm volatile("v_mbcnt_lo_u32_b32 %0, -1, 0\n\tv_mbcnt_hi_u32_b32 %0, -1, %0" : "=v"(lo_));
      const u32x4* o0s = o0g + wid * 512 + lo_;
#pragma unroll
      for (int j = 0; j < 8; ++j) o0w[j] = o0s[j * 64]; }
#pragma unroll
    for (int r = 0; r < 16; r += 2) { const float i0 = __builtin_amdgcn_rcpf(osum[r]), i1 = __builtin_amdgcn_rcpf(osum[r + 1]); const int or0 = crow(r, hi), or1 = crow(r + 1, hi);
#pragma unroll
      for (int d0 = 0; d0 < 4; ++d0) { const unsigned pk = o0w[d0 * 2 + (r >> 3)][(r >> 1) & 3];
        const float v0 = bf_lo(pk) - lam * (o[d0][r] * i0), v1 = bf_hi(pk) - lam * (o[d0][r + 1] * i1);
        stg[or0 * 128 + d0 * 32 + r32] = (bf16_t)(cvt_pk_bf16(v0, 0.f) & 0xffffu); stg[or1 * 128 + d0 * 32 + r32] = (bf16_t)(cvt_pk_bf16(v1, 0.f) & 0xffffu); } }
    asm volatile("s_waitcnt lgkmcnt(0)" ::: "memory");
    bf16_t* Ow = AOb + (long)(wid * QBLK) * ldo;
    int lane_e; asm volatile("v_mbcnt_lo_u32_b32 %0, -1, 0\n\tv_mbcnt_hi_u32_b32 %0, -1, %0" : "=v"(lane_e));
    const int ch = lane_e & 15; const f32x4 g0 = *(const f32x4*)(subln + ch * 8), g1 = *(const f32x4*)(subln + ch * 8 + 4);
#pragma unroll
    for (int i = 0; i < 8; ++i) { const int row = i * 4 + (lane_e >> 4); const u32x4 v = *(const LAS u32x4*)(stg + row * 128 + ch * 8);
      float e[8] = {bf_lo(v.x), bf_hi(v.x), bf_lo(v.y), bf_hi(v.y), bf_lo(v.z), bf_hi(v.z), bf_lo(v.w), bf_hi(v.w)};
      float ss = 0.f;
#pragma unroll
      for (int q = 0; q < 8; ++q) ss += e[q] * e[q];
      ss = row16_sum(ss);
      const float rn = osc / sqrtf(ss * (1.0f / 128.0f) + EPS);
      u32x4 w; w.x = cvt_pk_bf16(e[0] * rn * g0[0], e[1] * rn * g0[1]); w.y = cvt_pk_bf16(e[2] * rn * g0[2], e[3] * rn * g0[3]);
      w.z = cvt_pk_bf16(e[4] * rn * g1[0], e[5] * rn * g1[1]); w.w = cvt_pk_bf16(e[6] * rn * g1[2], e[7] * rn * g1[3]);
      *(u32x4*)(Ow + (long)row * ldo + ch * 8) = w; } }
  A3_WAITBAR();
#undef A3_WAITBAR
#undef A3_DMAK
#undef A3_DMAV
#undef A3_BAR_ODD
#undef A3_BAR_EVEN
#undef A3_A_FIRST
#undef A3_LD
#undef A3_LDQ
#undef A3_LD1
#undef A3_W
#undef A3_A_MID
#undef A3_A_LAST
#undef A3_B
#undef A3_MFMA_FENCE
}
#undef SBAR
}

constexpr int RING_BYTES = 131072, MISC_OFF = RING_BYTES + 320, INTAB_OFF = RING_BYTES + 1024, LDS_BYTES = 147456;
struct Args { const float* in[50]; float* out; unsigned char* ws; int ph_lo, ph_hi; };

struct Ctx {
    LAS unsigned char* lds;
    int tid, lane, wave, G, bid;
    unsigned char* ws; float* out;
    __device__ __forceinline__ const float* inp(int idx) const {
        const LAS unsigned* t = (const LAS unsigned*)(lds + INTAB_OFF) + 2 * idx;
        const unsigned lo_ = __builtin_amdgcn_readfirstlane(t[0]), hi_ = __builtin_amdgcn_readfirstlane(t[1]);
        typedef __attribute__((address_space(1))) const float* gp_t; return (const float*)(gp_t)(((uintptr_t)hi_ << 32) | (uintptr_t)lo_); }
};

template <class T> __device__ __forceinline__ T* launder_ptr(T* p) { unsigned lo = (unsigned)(uintptr_t)p, hi = (unsigned)((uintptr_t)p >> 32); lo = __builtin_amdgcn_readfirstlane(lo); hi = __builtin_amdgcn_readfirstlane(hi);
    asm volatile("" : "+s"(lo), "+s"(hi)); typedef __attribute__((address_space(1))) T* gp_t; return (T*)(gp_t)(((uintptr_t)hi << 32) | (uintptr_t)lo); }
__device__ __forceinline__ int launder_i(int v) { v = __builtin_amdgcn_readfirstlane(v); asm volatile("" : "+s"(v)); return v; }
__device__ __forceinline__ int map_col(int kind, int n) {
    if (kind == 1) { if (n < 1024) return n; const int w = n - 1024, T = w >> 8, r = w & 255; return 1024 + (r >> 7) * 1024 + T * 128 + (r & 127); }
    if (kind == 2) { const int T = n >> 8, r = n & 255; return (r >> 7) * DFF + T * 128 + (r & 127); }
    if (kind == 3) { const int T = n >> 8, r = n & 255; return (r >> 7) * 1024 + T * 128 + (r & 127); }
    if (kind == 4) { if (n >= 2048) return n; const int blk = n >> 6, w = n & 63, half = w >> 5, ww = w & 31; return blk * 64 + half * 32 + (ww & 1) * 16 + (ww >> 1); }
    return n;
}
__device__ __forceinline__ void stage_out(LAS unsigned char* stg, unsigned char* dst  , size_t pitch, int lane) {
    asm volatile("s_waitcnt lgkmcnt(0)" ::: "memory");
#pragma unroll
    for (int i = 0; i < 16; ++i) { const int row = 8 * i + (lane >> 3), c = lane & 7;
        const u32x4 v = *(const LAS u32x4*)(stg + row * 128 + ((c ^ ((row >> 1) & 7)) << 4));
        *(u32x4*)(dst + (size_t)row * pitch + c * 16) = v; }
    asm volatile("s_waitcnt lgkmcnt(0)" ::: "memory");
}
__device__ __forceinline__ void transpose_item8(const float* W, int K, int N, unsigned char* WT, int kind, int item, int lane, LAS unsigned char* stg) {
    const int nblk = N / 128, kb = item / nblk, nb = item % nblk, k0 = 128 * kb, n0 = 128 * nb;
    const int d0 = n0 + 2 * lane, s0 = map_col(kind, d0), s1 = map_col(kind, d0 + 1);
    const bool adj = (kind != 4) || (n0 >= 2048);
#pragma unroll
    for (int h = 0; h < 4; ++h) {
        float v0[32], v1[32];
        const float* wp = W + (size_t)(k0 + 32 * h) * N;
        if (adj) {
#pragma unroll
            for (int kk = 0; kk < 32; ++kk) { const f32x2 t = *(const f32x2*)(wp + (size_t)kk * N + s0); v0[kk] = t[0] * pg8::W8SCALE; v1[kk] = t[1] * pg8::W8SCALE; }
        } else {
#pragma unroll
            for (int kk = 0; kk < 32; ++kk) { v0[kk] = wp[(size_t)kk * N + s0] * pg8::W8SCALE; v1[kk] = wp[(size_t)kk * N + s1] * pg8::W8SCALE; }
        }
        LAS unsigned char* r0_ = stg + (2 * lane) * 128; LAS unsigned char* r1_ = r0_ + 128; const int sw_ = lane & 7;
#pragma unroll
        for (int j = 0; j < 2; ++j) {
            u32x4 a, b;
            a.x = cvt4_fp8(v0[16 * j + 0], v0[16 * j + 1], v0[16 * j + 2], v0[16 * j + 3]); a.y = cvt4_fp8(v0[16 * j + 4], v0[16 * j + 5], v0[16 * j + 6], v0[16 * j + 7]);
            a.z = cvt4_fp8(v0[16 * j + 8], v0[16 * j + 9], v0[16 * j + 10], v0[16 * j + 11]); a.w = cvt4_fp8(v0[16 * j + 12], v0[16 * j + 13], v0[16 * j + 14], v0[16 * j + 15]);
            b.x = cvt4_fp8(v1[16 * j + 0], v1[16 * j + 1], v1[16 * j + 2], v1[16 * j + 3]); b.y = cvt4_fp8(v1[16 * j + 4], v1[16 * j + 5], v1[16 * j + 6], v1[16 * j + 7]);
            b.z = cvt4_fp8(v1[16 * j + 8], v1[16 * j + 9], v1[16 * j + 10], v1[16 * j + 11]); b.w = cvt4_fp8(v1[16 * j + 12], v1[16 * j + 13], v1[16 * j + 14], v1[16 * j + 15]);
            *(LAS u32x4*)(r0_ + (((2 * h + j) ^ sw_) << 4)) = a; *(LAS u32x4*)(r1_ + (((2 * h + j) ^ sw_) << 4)) = b; }
    }
    stage_out(stg, WT + (size_t)n0 * K + k0, (size_t)K, lane);
}
__device__ __forceinline__ void transpose_item(const float* W, int K, int N, bf16_t* WT, int kind, int item, int lane, LAS unsigned char* stg) {
    const int nblk = N / 128, kb = item / nblk, nb = item % nblk, k0 = 64 * kb, n0 = 128 * nb;
    const int d0 = n0 + 2 * lane, s0 = map_col(kind, d0), s1 = map_col(kind, d0 + 1);
    const bool adj = (kind != 4) || (n0 >= 2048);
#pragma unroll
    for (int h = 0; h < 2; ++h) {
        float v0[32], v1[32];
        const float* wp = W + (size_t)(k0 + 32 * h) * N;
        if (adj) {
#pragma unroll
            for (int kk = 0; kk < 32; ++kk) { const f32x2 t = *(const f32x2*)(wp + (size_t)kk * N + s0); v0[kk] = t[0]; v1[kk] = t[1]; }
        } else {
#pragma unroll
            for (int kk = 0; kk < 32; ++kk) { v0[kk] = wp[(size_t)kk * N + s0]; v1[kk] = wp[(size_t)kk * N + s1]; }
        }
        LAS unsigned char* r0_ = stg + (2 * lane) * 128; LAS unsigned char* r1_ = r0_ + 128; const int sw_ = lane & 7;
#pragma unroll
        for (int j = 0; j < 4; ++j) {
            u32x4 a, b;
            a.x = cvt_pk_bf16(v0[8 * j + 0], v0[8 * j + 1]); a.y = cvt_pk_bf16(v0[8 * j + 2], v0[8 * j + 3]); a.z = cvt_pk_bf16(v0[8 * j + 4], v0[8 * j + 5]); a.w = cvt_pk_bf16(v0[8 * j + 6], v0[8 * j + 7]);
            b.x = cvt_pk_bf16(v1[8 * j + 0], v1[8 * j + 1]); b.y = cvt_pk_bf16(v1[8 * j + 2], v1[8 * j + 3]); b.z = cvt_pk_bf16(v1[8 * j + 4], v1[8 * j + 5]); b.w = cvt_pk_bf16(v1[8 * j + 6], v1[8 * j + 7]);
            *(LAS u32x4*)(r0_ + (((4 * h + j) ^ sw_) << 4)) = a; *(LAS u32x4*)(r1_ + (((4 * h + j) ^ sw_) << 4)) = b; }
    }
    stage_out(stg, (unsigned char*)(WT + (size_t)n0 * K + k0), (size_t)K * 2, lane);
}
struct WDesc { int in_idx, K, N, nb, kind, f8; unsigned long long off; };
__constant__ WDesc g_wd[15] = {
    {8, 1024, 3072, 1, 1, 0, WO_L0_CONVIN}, {10, 1024, 1024, 1, 0, 0, WO_L0_CONVOUT}, {11, 1024, 5632, 1, 2, (MK_FP8_FFN >> 0) & 1, WO_L0_GU}, {12, 2816, 1024, 1, 0, ((MK_FP8_FFN >> 0) & 1) | MK_FP8_DOWN0, WO_L0_DOWN},
    {17, 1024, 3072, 1, 4, MK_FP8_QKV, WO_L1_QKV}, {20, 1024, 1024, 1, 0, 0, WO_L1_WO}, {22, 1024, 5632, 8, 2, 1, WO_L1_MGU}, {23, 2816, 1024, 8, 0, 1, WO_L1_MDOWN},
    {36, 1024, 2048, 1, 3, MK_FP8_GLU, WO_L2_GLU}, {37, 1024, 5632, 1, 2, (MK_FP8_FFN >> 2) & 1, WO_L2_GU}, {38, 2816, 1024, 1, 0, (MK_FP8_FFN >> 2) & 1, WO_L2_DOWN},
    {43, 1024, 3072, 1, 1, 0, WO_L3_CONVIN}, {45, 1024, 1024, 1, 0, 0, WO_L3_CONVOUT}, {47, 1024, 5632, 8, 2, 1, WO_L3_MGU}, {48, 2816, 1024, 8, 0, 1, WO_L3_MDOWN}};

__device__ __forceinline__ void p0_weights(Ctx& F) {
    unsigned* ctr = (unsigned*)(F.ws + WS_CTL) + 64;
    for (;;) {
        unsigned it = 0;
        if (F.lane == 0) it = __hip_atomic_fetch_add(ctr, 1u, __ATOMIC_RELAXED, __HIP_MEMORY_SCOPE_AGENT);
        it = (unsigned)__builtin_amdgcn_readfirstlane((int)it);
        int base = 0, d = 0; bool found = false;
        for (; d < 15; ++d) { const int tot = (g_wd[d].K / (g_wd[d].f8 ? 128 : 64)) * (g_wd[d].N / 128) * g_wd[d].nb; if ((int)it < base + tot) { found = true; break; } base += tot; }
        if (!found) break;
        const int K = g_wd[d].K, N = g_wd[d].N, kind = g_wd[d].kind; const int per = (K / (g_wd[d].f8 ? 128 : 64)) * (N / 128);
        const float* W = F.inp(g_wd[d].in_idx); bf16_t* WT = (bf16_t*)(F.ws + WS_W + g_wd[d].off);
        const int li = (int)it - base, e = li / per, r = li - e * per;
        if (g_wd[d].f8) transpose_item8(W + (size_t)e * K * N, K, N, (unsigned char*)WT + (size_t)e * K * N, kind, r, F.lane, F.lds + F.wave * 16384);
        else transpose_item(W + (size_t)e * K * N, K, N, WT + (size_t)e * K * N, kind, r, F.lane, F.lds + F.wave * 16384);
    }
}
__device__ __forceinline__ void p0_adaln(Ctx& F, const int item0) {
    LAS float* scond = (LAS float*)(F.lds);
    LAS float* red = (LAS float*)(F.lds + 20480);
    bool have = false;
    for (int item = item0; item < 96; item += 1 << 20) {
        if (!have) {
            for (int i = F.tid; i < 5 * 1024; i += NTHREADS) { const int cnd = i >> 10, k = i & 1023; const float v = cnd < 4 ? F.inp(IN_C)[cnd * 1024 + k] : F.inp(IN_CCTX)[k]; scond[i] = silu_f(v); }
            have = true; __syncthreads();
        }
        const int L = item / 24, cg = item % 24, col0 = cg * 256 + 4 * F.lane;
        const float* W = F.inp(lbase(L)) + col0; const float* bias = F.inp(lbase(L) + 1);
        f32x4 acc[5];
#pragma unroll
        for (int c = 0; c < 5; ++c) acc[c] = (f32x4){0.f, 0.f, 0.f, 0.f};
        const int kb = F.wave * 128;
#pragma unroll 8
        for (int k = 0; k < 128; ++k) { const f32x4 w = *(const f32x4*)(W + (size_t)(kb + k) * 6144);
#pragma unroll
            for (int c = 0; c < 5; ++c) acc[c] += scond[c * 1024 + kb + k] * w; }
#pragma unroll
        for (int c = 0; c < 5; ++c) *(f32x4*)(red + (F.wave * 5 + c) * 256 + 4 * F.lane) = acc[c];
        __syncthreads();
        float* MOD = (float*)(F.ws + WS_MOD) + (size_t)L * 5 * 6144;
        for (int i = F.tid; i < 5 * 256; i += NTHREADS) { const int c = i >> 8, j = i & 255; float s = bias[cg * 256 + j];
#pragma unroll
            for (int w = 0; w < 8; ++w) s += red[(w * 5 + c) * 256 + j];
            MOD[c * 6144 + cg * 256 + j] = s; }
        __syncthreads();
    }
}
__device__ __forceinline__ void p0_misc(Ctx& F) {
    { float* cosT = (float*)(F.ws + WS_ROPE); float* sinT = cosT + 128 * 16;
        for (int i = F.tid; i < 128 * 16; i += NTHREADS) { const int pos = i >> 4, f = i & 15; const float inv = powf(10000.0f, -(float)f / 16.0f); const float ang = (float)pos * inv; cosT[i] = cosf(ang); sinT[i] = sinf(ang); } }
}
__device__ __forceinline__ void p0_s5mats(Ctx& F, const int g0) {
    const int LB = lbase(2);
    const float* a_re = F.inp(LB + 4); const float* a_im = F.inp(LB + 5); const float* log_dt = F.inp(LB + 6); const float* b_re = F.inp(LB + 7); const float* b_im = F.inp(LB + 8);
    const float* c_re = F.inp(LB + 9); const float* c_im = F.inp(LB + 10); const float* dsk = F.inp(LB + 11);
    LAS float* AP = (LAS float*)F.lds;
    LAS float* BB = AP + 2 * 17 * 64 * 2;
    LAS float* CC = BB + 2 * 64 * 16 * 2;
    LAS float* KK = CC + 2 * 16 * 64 * 2;
    for (int g = g0; g < 64; g += 1 << 20) {
        __syncthreads();
        for (int i = F.tid; i < 2 * 17 * 64; i += NTHREADS) { const int d = i / (17 * 64), r = i % (17 * 64), j = r / 64, p = r % 64;
            const float dt = expf(log_dt[d * 64 + g]); const float ar = a_re[(d * 64 + g) * 64 + p], ai = a_im[(d * 64 + g) * 64 + p];
            const float mag = expf((float)j * dt * ar), ph = (float)j * dt * ai; AP[i * 2] = mag * cosf(ph); AP[i * 2 + 1] = mag * sinf(ph); }
        for (int i = F.tid; i < 2 * 64 * 16; i += NTHREADS) { const int d = i / 1024, r = i % 1024, p = r / 16, s = r % 16;
            const float dt = expf(log_dt[d * 64 + g]); const float ar = a_re[(d * 64 + g) * 64 + p], ai = a_im[(d * 64 + g) * 64 + p];
            const float mag = expf(dt * ar), abr = mag * cosf(dt * ai), abi = mag * sinf(dt * ai), den = ar * ar + ai * ai, nr = abr - 1.0f;
            const float cor = (nr * ar + abi * ai) / den, coi = (abi * ar - nr * ai) / den;
            const float br = b_re[((size_t)(d * 64 + g) * 64 + p) * 16 + s], bi = b_im[((size_t)(d * 64 + g) * 64 + p) * 16 + s];
            BB[i * 2] = cor * br - coi * bi; BB[i * 2 + 1] = cor * bi + coi * br;
            const int s2 = r / 64, p2 = r % 64;
            CC[i * 2] = c_re[((size_t)(d * 64 + g) * 16 + s2) * 64 + p2]; CC[i * 2 + 1] = c_im[((size_t)(d * 64 + g) * 16 + s2) * 64 + p2]; }
        __syncthreads();
        for (int i = F.tid; i < 2 * 16 * 256; i += NTHREADS) { const int d = i >> 12, j = (i >> 8) & 15, so = (i >> 4) & 15, si = i & 15; float s = 0.f;
            for (int p = 0; p < 64; ++p) { const float cr = CC[((d * 16 + so) * 64 + p) * 2], ci = CC[((d * 16 + so) * 64 + p) * 2 + 1];
                const float pr = AP[((d * 17 + j) * 64 + p) * 2], pi = AP[((d * 17 + j) * 64 + p) * 2 + 1];
                const float br = BB[((d * 64 + p) * 16 + si) * 2], bi = BB[((d * 64 + p) * 16 + si) * 2 + 1];
                const float wr_ = cr * pr - ci * pi, wi_ = cr * pi + ci * pr; s += wr_ * br - wi_ * bi; }
            KK[i] = s; }
        __syncthreads();
        bf16_t* M1 = (bf16_t*)(F.ws + WS_S5M1) + (size_t)g * 256 * 256; bf16_t* M3 = (bf16_t*)(F.ws + WS_S5M3) + (size_t)g * 256 * 512;
        for (int i = F.tid; i < 256 * 256; i += NTHREADS) { const int n = i >> 8, k = i & 255, d = n >> 7, p = (n & 127) >> 1, c = n & 1, tp = k >> 4, si = k & 15; const int e = d ? tp : 15 - tp;
            const float pr = AP[((d * 17 + e) * 64 + p) * 2], pi = AP[((d * 17 + e) * 64 + p) * 2 + 1], br = BB[((d * 64 + p) * 16 + si) * 2], bi = BB[((d * 64 + p) * 16 + si) * 2 + 1];
            const float v = c ? (pr * bi + pi * br) : (pr * br - pi * bi); M1[i] = (bf16_t)(cvt_pk_bf16(v, 0.f) & 0xffffu); }
        for (int i = F.tid; i < 256 * 512; i += NTHREADS) { const int n = i >> 9, k = i & 511, t = n >> 4, so = n & 15; float v;
            if (k < 256) { const int tp = k >> 4, si = k & 15;
                if (t > tp) v = KK[((0 * 16 + (t - tp)) * 16 + so) * 16 + si];
                else if (t < tp) v = KK[((1 * 16 + (tp - t)) * 16 + so) * 16 + si];
                else { v = KK[((0 * 16 + 0) * 16 + so) * 16 + si] + KK[((1 * 16 + 0) * 16 + so) * 16 + si]; if (si == so) v += dsk[g * 16 + si]; } }
            else { const int q = k - 256, d = q >> 7, p = (q & 127) >> 1, c = q & 1; const int e = d ? 16 - t : t + 1;
                const float cr = CC[((d * 16 + so) * 64 + p) * 2], ci = CC[((d * 16 + so) * 64 + p) * 2 + 1], pr = AP[((d * 17 + e) * 64 + p) * 2], pi = AP[((d * 17 + e) * 64 + p) * 2 + 1];
                v = c ? -(cr * pi + ci * pr) : (cr * pr - ci * pi); }
            M3[i] = (bf16_t)(cvt_pk_bf16(v, 0.f) & 0xffffu); }
    }
    __syncthreads();
}

__device__ __forceinline__ void p0_prologue(Ctx& F, volatile LAS unsigned* MISC) {
    unsigned* ctr = (unsigned*)(F.ws + WS_CTL) + 128;
    for (;;) {
        __syncthreads();
        if (F.tid == 0) MISC[16] = __hip_atomic_fetch_add(ctr, 1u, __ATOMIC_RELAXED, __HIP_MEMORY_SCOPE_AGENT);
        __syncthreads();
        const int item = (int)MISC[16];
        if (item >= 161) break;
        if (item < 96) p0_adaln(F, item); else if (item < 160) p0_s5mats(F, item - 96); else p0_misc(F);
    }
    __syncthreads();
    p0_weights(F);
}
template <int MODE, bool COMB, bool FROM_IN = false>
__device__ __forceinline__ void row_pass(Ctx& F, int L, bool latent_only, int jsh  , int Lprev, bool out8 = false) {
    xel_t* X = (xel_t*)(F.ws + WS_X); bf16_t* HL = (bf16_t*)(F.ws + WS_HL);
    const float* MOD = (const float*)(F.ws + WS_MOD) + (size_t)L * 5 * 6144; const float* MODP = (const float*)(F.ws + WS_MOD) + (size_t)Lprev * 5 * 6144;
    const float* gain = MODE == 2 ? F.inp(IN_FINAL) : F.inp(lbase(L) + (jsh ? 3 : 2));
    const int nrows = latent_only ? NB * SEQ : MALL;
    const int rpw = (nrows + F.G - 1) / F.G;
    const int r0 = F.bid * rpw, r1 = min(nrows, r0 + rpw);
    LAS float* wrl = (LAS float*)F.lds;
    LAS int* hist = (LAS int*)(F.lds + 32768);
    if (MODE == 1) { const float* wrt = F.inp(lbase(L) + (L == 1 ? 8 : 7));
        for (int i = F.tid; i < 8192; i += NTHREADS) { const int k = i >> 3, e = i & 7; wrl[((((k >> 8) * 4 + (k & 3)) * 2 + (e >> 2)) * 64 + ((k & 255) >> 2)) * 4 + (e & 3)] = wrt[i]; }
        if (F.tid < 8) hist[F.tid] = 0;
        __syncthreads(); }
    const bf16_t* OP = (const bf16_t*)(F.ws + WS_BIG + BIG_APERM);
    const int4* SEL = (const int4*)(F.ws + WS_SEL); const int2* SLOT = (const int2*)(F.ws + WS_SLOT);
    int cur_cond = -1; f32x4 ca[4], cb[4], gp[4];
    for (int lr = r0 + F.wave; lr < r1; lr += NWAVES) {
        const int row = latent_only ? (lr >> 13) * RPB + CTXL + (lr & 8191) : lr;
        const int cond = row_cond(row);
        if (cond != cur_cond) { cur_cond = cond;
#pragma unroll
            for (int q = 0; q < 4; ++q) { const int col = 4 * F.lane + 256 * q; const f32x4 g4 = *(const f32x4*)(gain + col);
                if (MODE == 2) { ca[q] = g4; cb[q] = (f32x4){0.f, 0.f, 0.f, 0.f}; }
                else { const f32x4 sh = *(const f32x4*)(MOD + cond * 6144 + jsh * 1024 + col), sc = *(const f32x4*)(MOD + cond * 6144 + (jsh + 1) * 1024 + col); ca[q] = g4 * (1.0f + sc); cb[q] = sh; }
                if (COMB) gp[q] = *(const f32x4*)(MODP + cond * 6144 + 5 * 1024 + col); } }
        xel_t* xr = X + (size_t)row * DM + 4 * F.lane;
        f32x4 v[4];
        if (FROM_IN) { const int b_ = row / RPB, j_ = row - b_ * RPB; const f32x4* xi = (const f32x4*)(j_ < CTXL ? F.inp(IN_CTX) + ((size_t)b_ * CTXL + j_) * DM : F.inp(IN_X) + ((size_t)b_ * SEQ + (j_ - CTXL)) * DM) + F.lane;
#pragma unroll
            for (int q = 0; q < 4; ++q) v[q] = xi[64 * q];
        } else {
#pragma unroll
            for (int q = 0; q < 4; ++q) v[q] = x_ld4(xr + 256 * q); }
        if (COMB && !((MK_DBG_NOMOE >> (Lprev == 1 ? 0 : 1)) & 1)) {
            const int4 sel = SEL[row]; const int2 sl = SLOT[row]; const float w0 = __int_as_float(sel.z), w1 = __int_as_float(sel.w);
            const u32x2* o0 = (const u32x2*)(OP + (size_t)sl.x * DM) + F.lane; const u32x2* o1 = (const u32x2*)(OP + (size_t)sl.y * DM) + F.lane;
#pragma unroll
            for (int q = 0; q < 4; ++q) { const u32x2 a = o0[64 * q], b = o1[64 * q];
                f32x4 m; m[0] = w0 * bf_lo(a.x) + w1 * bf_lo(b.x); m[1] = w0 * bf_hi(a.x) + w1 * bf_hi(b.x); m[2] = w0 * bf_lo(a.y) + w1 * bf_lo(b.y); m[3] = w0 * bf_hi(a.y) + w1 * bf_hi(b.y);
                v[q] = v[q] + gp[q] * m; if (MODE != 2) x_st4(xr + 256 * q, v[q]); }
        }
        float ss = 0.f;
#pragma unroll
        for (int q = 0; q < 4; ++q) ss += (v[q][0] * v[q][0] + v[q][1] * v[q][1]) + (v[q][2] * v[q][2] + v[q][3] * v[q][3]);
        const float rstd = 1.0f / sqrtf(wave_sum(ss) * (1.0f / DM) + EPS);
        f32x4 h[4];
#pragma unroll
        for (int q = 0; q < 4; ++q) h[q] = (v[q] * rstd) * ca[q] + cb[q];
        if (MODE == 2) { const int b = row / RPB, t = row - b * RPB - CTXL; f32x4* o4 = (f32x4*)(F.out + ((size_t)b * SEQ + t) * DM) + F.lane;
#pragma unroll
            for (int q = 0; q < 4; ++q) o4[64 * q] = h[q];
        } else {
            if (out8) { unsigned* o4 = (unsigned*)((unsigned char*)HL + (size_t)row * DM) + F.lane;
#pragma unroll
                for (int q = 0; q < 4; ++q) o4[64 * q] = cvt4_fp8(h[q][0], h[q][1], h[q][2], h[q][3]);
            } else {
            u32x2* o8 = (MODE == 0 && COMB) ? (u32x2*)HL + ((size_t)(F.lane >> 2) * MALL + row) * 4 + (F.lane & 3) : (u32x2*)(HL + (size_t)row * DM) + F.lane;
            const size_t qst = (MODE == 0 && COMB) ? (size_t)16 * MALL * 4 : 64;
#pragma unroll
            for (int q = 0; q < 4; ++q) { u32x2 w; w.x = cvt_pk_bf16(h[q][0], h[q][1]); w.y = cvt_pk_bf16(h[q][2], h[q][3]); o8[qst * q] = w; } }
        }
        if (MODE == 1) {
            float lg[8];
#pragma unroll
            for (int e = 0; e < 8; ++e) lg[e] = 0.f;
#pragma unroll
            for (int q = 0; q < 4; ++q)
#pragma unroll
                for (int i = 0; i < 4; ++i) { const LAS f32x4* wp_ = (const LAS f32x4*)wrl + ((q * 4 + i) * 2) * 64 + F.lane; const f32x4 wa = wp_[0], wb = wp_[64]; const float hv = h[q][i];
                    lg[0] += hv * wa[0]; lg[1] += hv * wa[1]; lg[2] += hv * wa[2]; lg[3] += hv * wa[3]; lg[4] += hv * wb[0]; lg[5] += hv * wb[1]; lg[6] += hv * wb[2]; lg[7] += hv * wb[3]; }
#pragma unroll
            for (int e = 0; e < 8; ++e) lg[e] = wave_sum(lg[e]);
            int e0 = 0; float v0 = lg[0];
#pragma unroll
            for (int e = 1; e < 8; ++e) if (lg[e] > v0) { v0 = lg[e]; e0 = e; }
            int e1 = -1; float v1 = -INFINITY;
#pragma unroll
            for (int e = 0; e < 8; ++e) if (e != e0 && lg[e] > v1) { v1 = lg[e]; e1 = e; }
            const float ex = __expf(v1 - v0), w0 = 1.0f / (1.0f + ex), w1 = ex * w0;
            if (F.lane == 0) { ((int4*)(F.ws + WS_SEL))[row] = make_int4(e0, e1, __float_as_int(w0), __float_as_int(w1)); atomicAdd((int*)(hist + e0), 1); atomicAdd((int*)(hist + e1), 1); }
        }
    }
    if (MODE == 1) { __syncthreads(); if (F.tid < 8) ((int*)(F.ws + WS_CNT))[F.bid * 8 + F.tid] = hist[F.tid]; __syncthreads(); }
}

__device__ __forceinline__ void conv_pass(Ctx& F, int L, bool latent_only) {
    const bf16_t* BZ = (const bf16_t*)(F.ws + WS_BIG + BIG_BZ); bf16_t* U = (bf16_t*)(F.ws + WS_BIG + BIG_U);
    const float* cw = F.inp(lbase(L) + 5);
    const int nrows = latent_only ? NB * SEQ : MALL;
    const long nitems = (long)nrows * 128;
    for (long it = (long)F.bid * NTHREADS + F.tid; it < nitems; it += (long)F.G * NTHREADS) {
        const int lr = (int)(it >> 7), cgp = (int)(it & 127), col = cgp * 8;
        const int row = latent_only ? (lr >> 13) * RPB + CTXL + (lr & 8191) : lr;
        const int j = row % RPB; const bool first = (j == 0) || (j == CTXL), lastr = (j == CTXL - 1) || (j == RPB - 1);
        const u32x4 bb = *(const u32x4*)(BZ + (size_t)row * 2048 + col);
        const u32x4 zc = *(const u32x4*)(BZ + (size_t)row * 2048 + 1024 + col);
        u32x4 zp = (u32x4){0u, 0u, 0u, 0u}, zn = (u32x4){0u, 0u, 0u, 0u};
        if (!first) zp = *(const u32x4*)(BZ + (size_t)(row - 1) * 2048 + 1024 + col);
        if (!lastr) zn = *(const u32x4*)(BZ + (size_t)(row + 1) * 2048 + 1024 + col);
        const f32x4 w0a = *(const f32x4*)(cw + col), w0b = *(const f32x4*)(cw + col + 4), w1a = *(const f32x4*)(cw + 1024 + col), w1b = *(const f32x4*)(cw + 1024 + col + 4), w2a = *(const f32x4*)(cw + 2048 + col), w2b = *(const f32x4*)(cw + 2048 + col + 4);
        float y[8];
#define CV(i, W0, W1, W2, ZP, ZC, ZN, LO) y[i] = (W0) * (LO ? bf_lo(ZP) : bf_hi(ZP)) + (W1) * (LO ? bf_lo(ZC) : bf_hi(ZC)) + (W2) * (LO ? bf_lo(ZN) : bf_hi(ZN))
        CV(0, w0a[0], w1a[0], w2a[0], zp.x, zc.x, zn.x, 1); CV(1, w0a[1], w1a[1], w2a[1], zp.x, zc.x, zn.x, 0);
        CV(2, w0a[2], w1a[2], w2a[2], zp.y, zc.y, zn.y, 1); CV(3, w0a[3], w1a[3], w2a[3], zp.y, zc.y, zn.y, 0);
        CV(4, w0b[0], w1b[0], w2b[0], zp.z, zc.z, zn.z, 1); CV(5, w0b[1], w1b[1], w2b[1], zp.z, zc.z, zn.z, 0);
        CV(6, w0b[2], w1b[2], w2b[2], zp.w, zc.w, zn.w, 1); CV(7, w0b[3], w1b[3], w2b[3], zp.w, zc.w, zn.w, 0);
#undef CV
        u32x4 o; o.x = cvt_pk_bf16(bf_lo(bb.x) * y[0], bf_hi(bb.x) * y[1]); o.y = cvt_pk_bf16(bf_lo(bb.y) * y[2], bf_hi(bb.y) * y[3]);
        o.z = cvt_pk_bf16(bf_lo(bb.z) * y[4], bf_hi(bb.z) * y[5]); o.w = cvt_pk_bf16(bf_lo(bb.w) * y[6], bf_hi(bb.w) * y[7]);
        *(u32x4*)(U + (size_t)row * DM + col) = o;
    }
}

__device__ __forceinline__ void attn_combine(Ctx& F, int L) {
    const float* lamv = F.inp(lbase(L) + 5); const float* subln = F.inp(lbase(L) + 6);
    const float lam_init = 0.8f - 0.6f * expf(-0.3f * (float)L);
    float s01 = 0.f, s23 = 0.f;
    for (int i = 0; i < 64; ++i) { s01 += lamv[i] * lamv[64 + i]; s23 += lamv[128 + i] * lamv[192 + i]; }
    const float lam = expf(s01) - expf(s23) + lam_init, osc = 1.0f - lam_init;
    bf16_t* O0 = (bf16_t*)(F.ws + WS_BIG + BIG_O0); const bf16_t* O1 = (const bf16_t*)(F.ws + WS_HL);
    const int sub = F.lane & 15;
    const f32x4 g0 = *(const f32x4*)(subln + sub * 8), g1 = *(const f32x4*)(subln + sub * 8 + 4);
    const long nit = (long)MALL * NHEAD;
    for (long it = ((long)F.bid * NTHREADS + F.tid) >> 4; it < nit; it += ((long)F.G * NTHREADS) >> 4) {
        const size_t off = (size_t)it * 128 + sub * 8;
        const u32x4 a = *(const u32x4*)(O0 + off), b = *(const u32x4*)(O1 + off);
        float o[8];
        o[0] = bf_lo(a.x) - lam * bf_lo(b.x); o[1] = bf_hi(a.x) - lam * bf_hi(b.x); o[2] = bf_lo(a.y) - lam * bf_lo(b.y); o[3] = bf_hi(a.y) - lam * bf_hi(b.y);
        o[4] = bf_lo(a.z) - lam * bf_lo(b.z); o[5] = bf_hi(a.z) - lam * bf_hi(b.z); o[6] = bf_lo(a.w) - lam * bf_lo(b.w); o[7] = bf_hi(a.w) - lam * bf_hi(b.w);
        float ss = 0.f;
#pragma unroll
        for (int i = 0; i < 8; ++i) ss += o[i] * o[i];
        ss = row16_sum(ss);
        const float r = osc / sqrtf(ss * (1.0f / 128.0f) + EPS);
        u32x4 w; w.x = cvt_pk_bf16(o[0] * r * g0[0], o[1] * r * g0[1]); w.y = cvt_pk_bf16(o[2] * r * g0[2], o[3] * r * g0[3]);
        w.z = cvt_pk_bf16(o[4] * r * g1[0], o[5] * r * g1[1]); w.w = cvt_pk_bf16(o[6] * r * g1[2], o[7] * r * g1[3]);
        *(u32x4*)(O0 + off) = w;
    }
}

__device__ __forceinline__ void attn_phase(Ctx& F) {
    const bf16_t* Q = (const bf16_t*)(F.ws + WS_BIG + BIG_QKV); const bf16_t* KH = (const bf16_t*)(F.ws + WS_BIG + BIG_KH); const bf16_t* VH = (const bf16_t*)(F.ws + WS_BIG + BIG_VH);
    bf16_t* O0 = (bf16_t*)(F.ws + WS_BIG + BIG_O0); bf16_t* O1 = (bf16_t*)(F.ws + WS_HL);
    const int vcu = (F.G % 8 == 0) ? (F.bid % 8) * (F.G / 8) + F.bid / 8 : F.bid;
    for (int u = vcu; u < 2048 + 64; u += F.G) {
        int bh, qb; bool isctx = u >= 2048;
        if (!isctx) { bh = u >> 5; qb = u & 31; } else { bh = u - 2048; qb = 0; }
        const int b = bh >> 4, vh = bh & 15, h = vh >> 1, m = vh & 1;
        const size_t rowb = (size_t)b * RPB;
        const size_t qrow = isctx ? rowb : rowb + CTXL + (size_t)qb * 256;
        const bf16_t* Qb = Q + qrow * DM + h * 128 + m * 64;
        const bf16_t* Kh = KH + (size_t)(b * 16 + vh) * RPB * 64;
        const bf16_t* Vh = VH + (size_t)(b * 8 + h) * RPB * 128;
        bf16_t* Ob = (m ? O1 : O0) + qrow * DM + h * 128;
        att2::attn_unit(Qb, Kh, Vh, Ob, DM, isctx ? CTXL : RPB, F.lds, F.tid);
    }
}

__device__ __forceinline__ void v_transpose(Ctx& F) {
    const unsigned char* V8 = F.ws + WS_BIG + BIG_V8; unsigned char* VT8 = F.ws + WS_BIG + BIG_VT8;
    LAS unsigned char* buf = F.lds + F.wave * 8192;
    const int gw = F.bid * NWAVES + F.wave, NGW = F.G * NWAVES;
    for (int it = gw; it < NB * NHEAD * (RPB / 64); it += NGW) {
        const size_t tb = (size_t)it * 8192;
#pragma unroll
        for (int t = 0; t < 8; ++t) *(LAS u32x4*)(buf + (F.lane + 64 * t) * 16) = *(const u32x4*)(V8 + tb + (size_t)(F.lane + 64 * t) * 16);
        LDS_WAIT();
#pragma unroll
        for (int u = 0; u < 2; ++u) { const int d = F.lane + 64 * u;
#pragma unroll
            for (int q = 0; q < 4; ++q) { u32x4 w;
#pragma unroll
                for (int e = 0; e < 4; ++e) { unsigned x = 0;
#pragma unroll
                    for (int b = 0; b < 4; ++b) x |= (unsigned)buf[att3::slot_key(q * 16 + e * 4 + b) * 128 + d] << (8 * b);
                    w[e] = x; }
                *(u32x4*)(VT8 + tb + (size_t)d * 64 + q * 16) = w; } }
        LDS_WAIT();
    }
}
__device__ __forceinline__ void attn_phase3(Ctx& F, int L) {
    const unsigned char* Q8 = F.ws + WS_BIG + BIG_Q8; const unsigned char* K8 = F.ws + WS_BIG + BIG_K8; const unsigned char* VT8 = F.ws + WS_BIG + BIG_VT8;
    bf16_t* AO = (bf16_t*)(F.ws + WS_BIG + BIG_O0);
    const float* lamv = F.inp(lbase(L) + 5); const float* subln = F.inp(lbase(L) + 6);
    const float lam_init = 0.8f - 0.6f * expf(-0.3f * (float)L);
    float s01 = 0.f, s23 = 0.f;
    for (int i = 0; i < 64; ++i) { s01 += lamv[i] * lamv[64 + i]; s23 += lamv[128 + i] * lamv[192 + i]; }
    const float lam = expf(s01) - expf(s23) + lam_init, osc = 1.0f - lam_init;
    const int vcu = (F.G % 8 == 0) ? (F.bid % 8) * (F.G / 8) + F.bid / 8 : F.bid;
    for (int u = vcu; u < 1024 + 32; u += F.G) {
        int bh, qb; const bool isctx = u >= 1024;
        if (!isctx) { bh = u >> 5; qb = u & 31; } else { bh = u - 1024; qb = 0; }
        const int b = bh >> 3, h = bh & 7;
        const size_t rowb = (size_t)b * RPB;
        const size_t qrow = isctx ? rowb : rowb + CTXL + (size_t)qb * 256;
        att3::attn_unit(Q8 + qrow * DM + h * 128, K8 + (size_t)(b * 16 + 2 * h) * RPB * 64, (size_t)RPB * 64, VT8 + (size_t)(b * 8 + h) * RPB * 128, AO + qrow * DM + h * 128, DM, isctx ? CTXL : RPB,
                        lam, osc, subln, (u32x4*)(F.ws + WS_BIG + ((size_t)270 << 20)) + (size_t)F.bid * 4096, F.lds, F.tid);
    }
}

__device__ __forceinline__ void moe_scatter(Ctx& F, bool latent_only) {
    const int nrows = latent_only ? NB * SEQ : MALL;
    const int rpw = (nrows + F.G - 1) / F.G, r0 = F.bid * rpw, r1 = min(nrows, r0 + rpw);
    LAS int* tot = (LAS int*)F.lds; LAS int* pre = tot + 8; LAS int* base = tot + 16; LAS int* offs = tot + 24;
    LAS int* selc = tot + 64;
    LAS int* slc = selc + 1024;
    const int* CNT = (const int*)(F.ws + WS_CNT); const int4* SEL = (const int4*)(F.ws + WS_SEL); int2* SLOT = (int2*)(F.ws + WS_SLOT); int* TEXP = (int*)(F.ws + WS_TEXP);
    if (F.tid < 16) tot[F.tid] = 0;
    __syncthreads();
    for (int q = F.tid; q < 2 * F.G; q += NTHREADS) { const int w = q >> 1, e4 = (q & 1) * 4; const int4 c = *(const int4*)(CNT + w * 8 + e4);
        atomicAdd((int*)(tot + e4 + 0), c.x); atomicAdd((int*)(tot + e4 + 1), c.y); atomicAdd((int*)(tot + e4 + 2), c.z); atomicAdd((int*)(tot + e4 + 3), c.w);
        if (w < F.bid) { atomicAdd((int*)(pre + e4 + 0), c.x); atomicAdd((int*)(pre + e4 + 1), c.y); atomicAdd((int*)(pre + e4 + 2), c.z); atomicAdd((int*)(pre + e4 + 3), c.w); } }
    for (int i = F.tid; i < r1 - r0; i += NTHREADS) { const int lr = r0 + i; const int row = latent_only ? (lr >> 13) * RPB + CTXL + (lr & 8191) : lr; const int4 s = SEL[row]; selc[i] = s.x | (s.y << 8); }
    __syncthreads();
    if (F.tid == 0) { int o = 0; for (int e = 0; e < 8; ++e) { offs[e] = o; base[e] = o + pre[e]; o += (tot[e] + 255) & ~255; } offs[8] = o;
        for (int i = 0; i < r1 - r0; ++i) { const int s = selc[i], e0 = s & 255, e1 = s >> 8; slc[2 * i] = base[e0]++; slc[2 * i + 1] = base[e1]++; } }
    __syncthreads();
    if (F.bid == 0) { const int nT = offs[8] >> 8; for (int t = F.tid; t < nT; t += NTHREADS) { int e = 0; while (e < 7 && t * 256 >= offs[e + 1]) ++e; TEXP[t] = e; } if (F.tid == 0) TEXP[500] = nT; }
    const bf16_t* HL = (const bf16_t*)(F.ws + WS_HL); unsigned char* AP8 = (unsigned char*)(F.ws + WS_BIG + BIG_APERM);
    for (int i = F.wave; i < r1 - r0; i += NWAVES) { const int lr = r0 + i; const int row = latent_only ? (lr >> 13) * RPB + CTXL + (lr & 8191) : lr;
        const int s0 = slc[2 * i], s1 = slc[2 * i + 1];
        if (F.lane == 0) SLOT[row] = make_int2(s0, s1);
        const u32x4* src = (const u32x4*)(HL + (size_t)row * DM) + F.lane; const u32x4 a = src[0], b = src[64];
        u32x2 qa, qb; qa.x = cvt4_fp8(bf_lo(a.x), bf_hi(a.x), bf_lo(a.y), bf_hi(a.y)); qa.y = cvt4_fp8(bf_lo(a.z), bf_hi(a.z), bf_lo(a.w), bf_hi(a.w));
        qb.x = cvt4_fp8(bf_lo(b.x), bf_hi(b.x), bf_lo(b.y), bf_hi(b.y)); qb.y = cvt4_fp8(bf_lo(b.z), bf_hi(b.z), bf_lo(b.w), bf_hi(b.w));
        u32x2* d0 = (u32x2*)(AP8 + (size_t)s0 * DM) + F.lane; u32x2* d1 = (u32x2*)(AP8 + (size_t)s1 * DM) + F.lane;
        d0[0] = qa; d0[64] = qb; d1[0] = qa; d1[64] = qb; }
    __syncthreads();
}

__device__ __forceinline__ void s5_scan(Ctx& F) {
    const int LB = lbase(2);
    const float* a_re = F.inp(LB + 4); const float* a_im = F.inp(LB + 5); const float* log_dt = F.inp(LB + 6);
    const float* H = (const float*)(F.ws + WS_BIG + BIG_H); bf16_t* SB = (bf16_t*)(F.ws + WS_BIG + BIG_SBUF);
    LAS float* ex = (LAS float*)F.lds;
    constexpr int SU = 12;
    constexpr int QS = CPB / 4;
    for (int pair = F.bid; pair < 256; pair += F.G) {
        const int task = 2 * pair + (F.wave >> 2), seg = F.wave & 3;
        const int b = task >> 7, d = (task >> 6) & 1, g = task & 63, p = F.lane;
        const float dt = expf(log_dt[d * 64 + g]); const float ar = a_re[(d * 64 + g) * 64 + p], ai = a_im[(d * 64 + g) * 64 + p];
        const float mag = expf(16.0f * dt * ar), ph = 16.0f * dt * ai, Ar = mag * cosf(ph), Ai = mag * sinf(ph);
        const float magq = expf((16.0f * QS) * dt * ar), phq = (16.0f * QS) * dt * ai, Qr = magq * cosf(phq), Qi = magq * sinf(phq);
        const int v = d * 128 + 2 * p;
        const float* Hb = H + ((size_t)b * CPB * 64 + g) * 256 + v;
        bf16_t* Sb = SB + ((size_t)g * (MALL / 16) + (size_t)b * CPB) * 256 + v;
        float er = 0.f, ei = 0.f;
        for (int s0 = seg * QS; s0 < (seg + 1) * QS; s0 += SU) {
            f32x2 hv[SU];
#pragma unroll
            for (int i = 0; i < SU; ++i) { const int st = s0 + i; const int c = d ? (st < 16 ? 15 - st : CPB - 1 - (st - 16)) : st; hv[i] = *(const f32x2*)(Hb + (size_t)c * 64 * 256); }
#pragma unroll
            for (int i = 0; i < SU; ++i) { const float nr = Ar * er - Ai * ei + hv[i][0], ni = Ar * ei + Ai * er + hv[i][1]; er = nr; ei = ni; }
        }
        __syncthreads();
        ex[(F.wave * 64 + p) * 2] = er; ex[(F.wave * 64 + p) * 2 + 1] = ei;
        __syncthreads();
        er = 0.f; ei = 0.f;
        for (int q = 0; q < seg; ++q) { const int w = (F.wave & 4) + q; const float xr_ = ex[(w * 64 + p) * 2], xi_ = ex[(w * 64 + p) * 2 + 1];
            const float nr = Qr * er - Qi * ei + xr_, ni = Qr * ei + Qi * er + xi_; er = nr; ei = ni; }
        for (int s0 = seg * QS; s0 < (seg + 1) * QS; s0 += SU) {
            f32x2 hv[SU]; int cc[SU];
#pragma unroll
            for (int i = 0; i < SU; ++i) { const int st = s0 + i; cc[i] = d ? (st < 16 ? 15 - st : CPB - 1 - (st - 16)) : st; hv[i] = *(const f32x2*)(Hb + (size_t)cc[i] * 64 * 256); }
#pragma unroll
            for (int i = 0; i < SU; ++i) { *(unsigned*)(Sb + (size_t)cc[i] * 256) = cvt_pk_bf16(er, ei);
                const float nr = Ar * er - Ai * ei + hv[i][0], ni = Ar * ei + Ai * er + hv[i][1]; er = nr; ei = ni; }
        }
    }
}

__global__ void __launch_bounds__(NTHREADS, 2) mk_fwd(Args args) {
    extern __shared__ __attribute__((aligned(16))) unsigned char lds[];
    Ctx F;
    F.lds = (LAS unsigned char*)lds;
    F.tid = threadIdx.x; F.lane = F.tid & 63; F.wave = __builtin_amdgcn_readfirstlane(F.tid >> 6);
    F.G = gridDim.x; F.bid = blockIdx.x; F.ws = args.ws; F.out = args.out;
    volatile LAS unsigned* MISC = (volatile LAS unsigned*)(F.lds + MISC_OFF);
    if (F.tid < 32) MISC[F.tid] = 0u;
    if (F.tid == 0) {
#pragma unroll
        for (int i = 0; i < 50; ++i) *(LAS unsigned long long*)(F.lds + INTAB_OFF + 8 * i) = (unsigned long long)(uintptr_t)args.in[i]; }
    __syncthreads();
    const int lo = args.ph_lo, hi = args.ph_hi;
    XcdBarrier bar; bar.bar = (unsigned*)(F.ws + WS_CTL) + 1024; bar.x = 0; bar.st = nullptr;
    if (hi - lo > 1) bar = xcd_barrier_post((unsigned*)(F.ws + WS_CTL) + 1024, MISC + 8);
    int ph = 0;
#define LAUNDER() do { F.ws = launder_ptr(F.ws); F.out = launder_ptr(F.out); F.wave = launder_i(F.wave); asm volatile("v_mbcnt_lo_u32_b32 %0, -1, 0\n\tv_mbcnt_hi_u32_b32 %0, -1, %0" : "=v"(F.lane));     F.tid = F.wave * 64 + F.lane; \
    F.G = launder_i(F.G); F.bid = launder_i(F.bid); } while (0)
#define PHASE(id, ...) do { if (lo <= ph && ph < hi) { LAUNDER(); if ((MK_SITEMASK >> (id)) & 1u) { __VA_ARGS__; } if ((id) == MK_REPEAT_SITE) { __syncthreads(); LAUNDER(); __VA_ARGS__; } if (ph + 1 < hi) xcd_barrier(bar); } ++ph; } while (0)

#define WSB (F.ws)
#define XPTR ((xel_t*)(F.ws + WS_X))
#define HLPTR ((bf16_t*)(F.ws + WS_HL))
#define VBID (F.bid)
#define MODPTR ((const float*)(F.ws + WS_MOD) + (size_t)L * 5 * 6144)

    PHASE(0, p0_prologue(F, MISC));
#if MK_EXTRA_BARS
    if (hi - lo > 1) for (int eb = 0; eb < MK_EXTRA_BARS; ++eb) xcd_barrier(bar);
#endif

    for (int L = 0; L < 4; ++L) {
        const int kind = L % 3; const bool moe = (L & 1) != 0;
        const bool lat = (L >= 2);
        if (L == 2) PHASE(1, (row_pass<0, true>(F, L, false, 0, L - 1)));
        else if (L == 0) PHASE(2, (row_pass<0, false, true>(F, L, false, 0, 0)));
        else PHASE(3, (row_pass<0, false>(F, L, lat, 0, 0, L == 1 && MK_FP8_QKV)));
        if (kind == 0) {
            const size_t wo_in = (L == 0) ? WO_L0_CONVIN : WO_L3_CONVIN, wo_out = (L == 0) ? WO_L0_CONVOUT : WO_L3_CONVOUT;
            PHASE(4, { pg8::ProbPlain P{(const char*)HLPTR, (const char*)(WSB + WS_W + wo_in), 2048, 2048, 16, lat ? NT_LAT : NT_ALL, 12, F.G, VBID, lat};
                    pg8::EpiGated<0> E{(bf16_t*)(WSB + WS_BIG + BIG_BZ), 2048, 4, 1024, 0};
                    pg8::gemm_phase<pg8::EpiGated<0>, pg8::ProbPlain, true>(F.lds, P, E, F.tid); });
            PHASE(5, conv_pass(F, L, lat));
            PHASE(6, { pg8::ProbPlain P{(const char*)(WSB + WS_BIG + BIG_U), (const char*)(WSB + WS_W + wo_out), 2048, 2048, 16, lat ? NT_LAT : NT_ALL, 4, F.G, VBID, lat};
                    pg8::EpiResid E{XPTR, MODPTR + 2 * 1024, L == 0 ? F.inp(IN_X) : nullptr, L == 0 ? F.inp(IN_CTX) : nullptr, 1.f};
                    pg8::gemm_phase<pg8::EpiResid, pg8::ProbPlain, true>(F.lds, P, E, F.tid); });
        } else if (kind == 1) {
            if (MK_FP8_QKV) {
            PHASE(25, { pg8::ProbPlain P{(const char*)HLPTR, (const char*)(WSB + WS_W + WO_L1_QKV), 1024, 1024, 8, NT_ALL, 12, F.G, VBID, false};
                    pg8::EpiQkv<MK_ATT3 != 0, true> E{WSB + WS_BIG, (const float*)(WSB + WS_ROPE)};
                    pg8::gemm_phase<pg8::EpiQkv<MK_ATT3 != 0, true>, pg8::ProbPlain, true, true>(F.lds, P, E, F.tid); });
            } else {
            PHASE(7, { pg8::ProbPlain P{(const char*)HLPTR, (const char*)(WSB + WS_W + WO_L1_QKV), 2048, 2048, 16, NT_ALL, 12, F.G, VBID, false};
                    pg8::EpiQkv<MK_ATT3 != 0, false> E{WSB + WS_BIG, (const float*)(WSB + WS_ROPE)};
                    pg8::gemm_phase<pg8::EpiQkv<MK_ATT3 != 0, false>, pg8::ProbPlain, true>(F.lds, P, E, F.tid); });
            }
            if (MK_ATT3) { PHASE(27, v_transpose(F)); PHASE(28, attn_phase3(F, L)); }
            else { PHASE(8, attn_phase(F)); PHASE(9, attn_combine(F, L)); }
            PHASE(10, { pg8::ProbPlain P{(const char*)(WSB + WS_BIG + BIG_O0), (const char*)(WSB + WS_W + WO_L1_WO), 2048, 2048, 16, NT_ALL, 4, F.G, VBID, false};
                    pg8::EpiResid E{XPTR, MODPTR + 2 * 1024, nullptr, nullptr, 1.f};
                    pg8::gemm_phase<pg8::EpiResid, pg8::ProbPlain, true>(F.lds, P, E, F.tid); });
        } else {
            PHASE(11, { pg8::ProbS5 P{(const char*)HLPTR, (const char*)HLPTR, (const char*)(WSB + WS_S5M1), 4, 4, 9, F.G, VBID, (size_t)256 * 256 * 2, false};
                    pg8::EpiS1 E{(float*)(WSB + WS_BIG + BIG_H)};
                    pg8::gemm_phase<pg8::EpiS1, pg8::ProbS5, true>(F.lds, P, E, F.tid); });
            PHASE(12, s5_scan(F));
            PHASE(13, { pg8::ProbS5 P{(const char*)HLPTR, (const char*)(WSB + WS_BIG + BIG_SBUF), (const char*)(WSB + WS_S5M3), 8, 4, 8, F.G, VBID, (size_t)256 * 512 * 2, true};
                    pg8::EpiS3 E{(bf16_t*)(WSB + WS_BIG + BIG_YG), MK_FP8_GLU != 0};
                    pg8::gemm_phase<pg8::EpiS3, pg8::ProbS5, true>(F.lds, P, E, F.tid); });
            if (MK_FP8_GLU) {
            PHASE(26, { pg8::ProbPlain P{(const char*)(WSB + WS_BIG + BIG_YG), (const char*)(WSB + WS_W + WO_L2_GLU), 1024, 1024, 8, NT_LAT, 8, F.G, VBID, true};
                    pg8::EpiGlu E{XPTR, MODPTR + 2 * 1024, pg8::W8INV};
                    pg8::gemm_phase<pg8::EpiGlu, pg8::ProbPlain, true, true>(F.lds, P, E, F.tid); });
            } else {
            PHASE(14, { pg8::ProbPlain P{(const char*)(WSB + WS_BIG + BIG_YG), (const char*)(WSB + WS_W + WO_L2_GLU), 2048, 2048, 16, NT_LAT, 8, F.G, VBID, true};
                    pg8::EpiGlu E{XPTR, MODPTR + 2 * 1024, 1.f};
                    pg8::gemm_phase<pg8::EpiGlu, pg8::ProbPlain, true>(F.lds, P, E, F.tid); });
            }
        }
        if (moe) PHASE(15, (row_pass<1, false>(F, L, lat, 3, 0)));
        else PHASE(16, (row_pass<0, false>(F, L, lat, 3, 0, ((MK_FP8_FFN >> L) & 1) != 0)));
        if (!moe) {
            const size_t wo_gu = (L == 0) ? WO_L0_GU : WO_L2_GU, wo_dn = (L == 0) ? WO_L0_DOWN : WO_L2_DOWN;
            if ((MK_FP8_FFN >> L) & 1) {
                PHASE(23, { pg8::ProbPlain P{(const char*)HLPTR, (const char*)(WSB + WS_W + wo_gu), 1024, 1024, 8, lat ? NT_LAT : NT_ALL, 22, F.G, VBID, lat};
                        pg8::EpiGated8 E{(unsigned char*)(WSB + WS_BIG + BIG_HID), DFF, pg8::W8INV};
                        pg8::gemm_phase<pg8::EpiGated8, pg8::ProbPlain, true, true>(F.lds, P, E, F.tid); });
                PHASE(24, { pg8::ProbPlain P{(const char*)(WSB + WS_BIG + BIG_HID), (const char*)(WSB + WS_W + wo_dn), DFF, DFF, 22, lat ? NT_LAT : NT_ALL, 4, F.G, VBID, lat};
                        pg8::EpiResid E{XPTR, MODPTR + 5 * 1024, nullptr, nullptr, pg8::W8INV};
                        pg8::gemm_phase<pg8::EpiResid, pg8::ProbPlain, true, true>(F.lds, P, E, F.tid); });
            } else if (MK_FP8_DOWN0 && L == 0) {
                PHASE(17, { pg8::ProbPlain P{(const char*)HLPTR, (const char*)(WSB + WS_W + wo_gu), 2048, 2048, 16, NT_ALL, 22, F.G, VBID, false};
                        pg8::EpiGated8 E{(unsigned char*)(WSB + WS_BIG + BIG_HID), DFF, 1.f};
                        pg8::gemm_phase<pg8::EpiGated8, pg8::ProbPlain, true>(F.lds, P, E, F.tid); });
                PHASE(24, { pg8::ProbPlain P{(const char*)(WSB + WS_BIG + BIG_HID), (const char*)(WSB + WS_W + wo_dn), DFF, DFF, 22, NT_ALL, 4, F.G, VBID, false};
                        pg8::EpiResid E{XPTR, MODPTR + 5 * 1024, nullptr, nullptr, pg8::W8INV};
                        pg8::gemm_phase<pg8::EpiResid, pg8::ProbPlain, true, true>(F.lds, P, E, F.tid); });
            } else {
            PHASE(17, { pg8::ProbPlain P{(const char*)HLPTR, (const char*)(WSB + WS_W + wo_gu), 2048, 2048, 16, lat ? NT_LAT : NT_ALL, 22, F.G, VBID, lat};
                    pg8::EpiGated<1> E{(bf16_t*)(WSB + WS_BIG + BIG_HID), DFF, 0, 0, 0};
                    pg8::gemm_phase<pg8::EpiGated<1>, pg8::ProbPlain, true>(F.lds, P, E, F.tid); });
            PHASE(18, { pg8::ProbPlain P{(const char*)(WSB + WS_BIG + BIG_HID), (const char*)(WSB + WS_W + wo_dn), DFF * 2, DFF * 2, 44, lat ? NT_LAT : NT_ALL, 4, F.G, VBID, lat};
                    pg8::EpiResid E{XPTR, MODPTR + 5 * 1024, nullptr, nullptr, 1.f};
                    pg8::gemm_phase<pg8::EpiResid, pg8::ProbPlain, true>(F.lds, P, E, F.tid); });
            }
        } else {
            const size_t wo_gu = (L == 1) ? WO_L1_MGU : WO_L3_MGU, wo_dn = (L == 1) ? WO_L1_MDOWN : WO_L3_MDOWN;
            PHASE(19, moe_scatter(F, lat));
#define TEXPP ((const int*)(F.ws + WS_TEXP))
            PHASE(20, { const int nT = __builtin_amdgcn_readfirstlane(TEXPP[500]);
                    pg8::ProbMoe P{(const char*)(WSB + WS_BIG + BIG_APERM), (const char*)(WSB + WS_W + wo_gu), 1024, 1024, 8, 22, F.G, VBID, WSZ_GU / 2, TEXPP, 0, nT, 0};
                    pg8::EpiGated8 E{(unsigned char*)(WSB + WS_BIG + BIG_MHID), DFF, pg8::W8INV};
                    pg8::gemm_phase<pg8::EpiGated8, pg8::ProbMoe, true, true>(F.lds, P, E, F.tid); });
            PHASE(21, { const int nT = __builtin_amdgcn_readfirstlane(TEXPP[500]);
                    pg8::ProbMoe P{(const char*)(WSB + WS_BIG + BIG_MHID), (const char*)(WSB + WS_W + wo_dn), DFF, DFF, 22, 4, F.G, VBID, WSZ_DOWN / 2, TEXPP, 0, nT, 0};
                    pg8::EpiBf16 E{(bf16_t*)(WSB + WS_BIG + BIG_APERM), DM, 0, pg8::W8INV};
                    pg8::gemm_phase<pg8::EpiBf16, pg8::ProbMoe, true, true>(F.lds, P, E, F.tid); });
        }
    }
    PHASE(22, (row_pass<2, true>(F, 3, true, 0, 3)));
#undef PHASE
#undef WSB
#undef XPTR
#undef HLPTR
#undef VBID
#undef MODPTR
#undef TEXPP
}
constexpr int N_PHASES = 1 + (1 + 3 + 1 + 2) + (1 + 4 + 1 + 1 + 2) + (1 + 4 + 1 + 2) + (1 + 3 + 1 + 1 + 2) + 1;

extern "C" void kernel_launch(void* const* d_in, const int* in_sizes, int n_in, void* d_out, int out_size, void* d_ws, size_t ws_size, hipStream_t stream) {
    static int grid = 0;
    if (grid == 0) {
        if (n_in != 50 || in_sizes[0] != NB * SEQ * DM || out_size != NB * SEQ * DM || ws_size < WS_END) {
            fprintf(stderr, "kernel_launch: unexpected shapes (n_in %d, in0 %d, out %d, ws %zu < %zu)\n", n_in, n_in > 0 ? in_sizes[0] : -1, out_size, ws_size, (size_t)WS_END); grid = -1; return; }
        int dev = 0, cus = 0, per_cu = 0;
        if (hipGetDevice(&dev) != hipSuccess || hipDeviceGetAttribute(&cus, hipDeviceAttributeMultiprocessorCount, dev) != hipSuccess) { grid = -1; return; }
        if (hipFuncSetAttribute((const void*)mk_fwd, hipFuncAttributeMaxDynamicSharedMemorySize, LDS_BYTES) != hipSuccess) { fprintf(stderr, "kernel_launch: hipFuncSetAttribute failed\n"); grid = -1; return; }
        if (hipOccupancyMaxActiveBlocksPerMultiprocessor(&per_cu, (const void*)mk_fwd, NTHREADS, LDS_BYTES) != hipSuccess || per_cu < 1) { fprintf(stderr, "kernel_launch: occupancy query says %d\n", per_cu); }
        (void)hipGetLastError();
        grid = cus;
    }
    if (grid < 0) return;
    (void)hipMemsetAsync((char*)d_ws + WS_CTL, 0, CTL_ZERO_BYTES, stream);
    Args a{};
    for (int i = 0; i < 50; ++i) a.in[i] = (const float*)d_in[i];
    a.out = (float*)d_out; a.ws = (unsigned char*)d_ws;
#if MK_ONE_LAUNCH
    a.ph_lo = 0; a.ph_hi = N_PHASES;
    hipLaunchKernelGGL(mk_fwd, dim3(grid), dim3(NTHREADS), LDS_BYTES, stream, a);
#else
    for (int p = 0; p < N_PHASES; ++p) { a.ph_lo = p; a.ph_hi = p + 1; hipLaunchKernelGGL(mk_fwd, dim3(grid), dim3(NTHREADS), LDS_BYTES, stream, a); }
#endif
    const hipError_t le = hipPeekAtLastError();
    if (le != hipSuccess) fprintf(stderr, "kernel_launch: launch failed: %s\n", hipGetErrorName(le));
}
```
